# Optimizing an MI355X kernel written in HIP

```python
import jax
import jax.numpy as jnp
from jax import lax
import numpy as np

D_MODEL = 1024
BATCH = 8
SEQ = 4096
DEPTH = 4

N_MEM = 256
BLOCK = 128
ROPE_THETA = 10000.0
EPS = 1e-6
NEG = -1e30
MAX_POS_OFFSET = 1024

A_HEADS = 8
A_KV_HEADS = 2
A_GROUP = A_HEADS // A_KV_HEADS
A_HD = 64
A_WINDOW = 128
B_HEADS = 8
B_Q_LORA = 384
B_KV_LORA = 256
B_NOPE = 64
B_ROPE = 32
B_V = 64
C_PATTERNS = ((128, 1), (512, 4), (2048, 16))
N_C_GROUPS = len(C_PATTERNS)
C_HEADS = 8
C_HD = 64
M_HEADS = 4
M_HD = 128

N_BRANCH = 4
BRANCH_W = 512
D_FF = 4 * D_MODEL

IN_SIZES = ((A_HEADS * A_HD, A_KV_HEADS * A_HD, A_KV_HEADS * A_HD, B_Q_LORA, B_KV_LORA, B_ROPE)
            + (C_HEADS * C_HD,) * (3 * N_C_GROUPS)
            + (M_HEADS * M_HD, N_BRANCH * D_MODEL))
N_IN = sum(IN_SIZES)
IN_SPLITS = tuple(int(s) for s in np.cumsum(IN_SIZES)[:-1])

kernel_name = 'hybrid_gated_swa_mla_dilated_mem_block'


def rms_norm(x, g):
    xf = x.astype(jnp.float32)
    y = xf * lax.rsqrt(jnp.mean(xf * xf, axis=-1, keepdims=True) + EPS)
    return (y * g.astype(jnp.float32)).astype(x.dtype)


def rope_tables(positions, dim):
    inv = ROPE_THETA ** (-jnp.arange(0, dim, 2, dtype=jnp.float32) / dim)
    ang = positions.astype(jnp.float32)[..., None] * inv
    return jnp.cos(ang), jnp.sin(ang)


def apply_rope(x, cos, sin):
    xf = x.astype(jnp.float32)
    x1, x2 = jnp.split(xf, 2, axis=-1)
    c = cos[:, :, None, :]
    s = sin[:, :, None, :]
    return jnp.concatenate([x1 * c - x2 * s, x2 * c + x1 * s], axis=-1).astype(x.dtype)


def banded_attention(q, k, v, max_dist, sinks=None):
    n, length, hk, grp, hd = q.shape
    nb = -(-length // BLOCK)
    pad = nb * BLOCK - length
    if pad:
        q = jnp.pad(q, ((0, 0), (0, pad), (0, 0), (0, 0), (0, 0)))
        k = jnp.pad(k, ((0, 0), (0, pad), (0, 0), (0, 0)))
        v = jnp.pad(v, ((0, 0), (0, pad), (0, 0), (0, 0)))
    qb = q.reshape(n, nb, BLOCK, hk, grp, hd)

    def two_blocks(t):
        tb = t.reshape(n, nb, BLOCK, hk, t.shape[-1])
        prev = jnp.pad(tb, ((0, 0), (1, 0), (0, 0), (0, 0), (0, 0)))[:, :-1]
        return jnp.concatenate([prev, tb], axis=2)

    kk = two_blocks(k)
    vv = two_blocks(v)
    s = jnp.einsum('nbqhgd,nbkhd->nbhgqk', qb, kk).astype(jnp.float32) * (hd ** -0.5)
    qi = jnp.arange(BLOCK)[:, None]
    kj = jnp.arange(2 * BLOCK)[None, :]
    dist = qi - kj + BLOCK
    band = (dist >= 0) & (dist <= max_dist)
    valid_prev = (jnp.arange(nb)[:, None, None] > 0) | (kj >= BLOCK)[None]
    mask = band[None] & valid_prev
    s = jnp.where(mask[None, :, None, None], s, NEG)
    lse = jax.nn.logsumexp(s, axis=-1)
    if sinks is not None:
        lse = jnp.logaddexp(lse, sinks.astype(jnp.float32)[None, None, :, :, None])
    p = jnp.exp(s - lse[..., None]).astype(v.dtype)
    o = jnp.einsum('nbhgqk,nbkhd->nbqhgd', p, vv).reshape(n, nb * BLOCK, hk, grp, hd)[:, :length]
    lse = lse.transpose(0, 1, 4, 2, 3).reshape(n, nb * BLOCK, hk, grp)[:, :length]
    return o, lse


def dilated_group(q, k, v, window, dilation):
    b, s, h, hd = q.shape
    length = s // dilation

    def gather(t):
        return t.reshape(b, length, dilation, h, hd).transpose(0, 2, 1, 3, 4).reshape(b * dilation, length, h, hd)

    o, lse = banded_attention(gather(q)[:, :, :, None, :], gather(k), gather(v), window // dilation)
    o = o[:, :, :, 0].reshape(b, dilation, length, h, hd).transpose(0, 2, 1, 3, 4).reshape(b, s, h, hd)
    lse = lse[..., 0].reshape(b, dilation, length, h).transpose(0, 2, 1, 3).reshape(b, s, h)
    return o, lse


def mla_causal_attention(qn, qp, kn, kp, v):
    b, s, h, _ = qn.shape
    nb = s // BLOCK
    scale = (qn.shape[-1] + qp.shape[-1]) ** -0.5
    kpos = jnp.arange(s)

    def one_block(i):
        start = i * BLOCK
        qnb = lax.dynamic_slice_in_dim(qn, start, BLOCK, axis=1)
        qpb = lax.dynamic_slice_in_dim(qp, start, BLOCK, axis=1)
        sc = (jnp.einsum('bqhd,bkhd->bhqk', qnb, kn)
              + jnp.einsum('bqhr,bkr->bhqk', qpb, kp)).astype(jnp.float32) * scale
        qpos = start + jnp.arange(BLOCK)
        sc = jnp.where(kpos[None, :] <= qpos[:, None], sc, NEG)
        p = jax.nn.softmax(sc, axis=-1).astype(v.dtype)
        return jnp.einsum('bhqk,bkhd->bqhd', p, v)

    o = lax.map(one_block, jnp.arange(nb))
    return o.transpose(1, 0, 2, 3, 4).reshape(b, s, h, v.shape[-1])


def memory_attention(q, k, v):
    s = jnp.einsum('bshd,bmhd->bhsm', q, k).astype(jnp.float32) * (q.shape[-1] ** -0.5)
    p = jax.nn.softmax(s, axis=-1).astype(v.dtype)
    return jnp.einsum('bhsm,bmhd->bshd', p, v)


def setup_inputs(seed: int = 0) -> dict:
    key = jax.random.key(seed)
    ks = jax.random.split(key, 32)
    f32 = jnp.float32
    L = DEPTH
    D = D_MODEL

    def nrm(k, shape, scale):
        return jax.random.normal(k, shape, f32) * scale

    def gain(k, shape):
        return 1.0 + 0.1 * jax.random.normal(k, shape, f32)

    x = nrm(ks[0], (BATCH, SEQ, D), 1.0)
    mem = nrm(ks[1], (BATCH, N_MEM, D), 1.0)
    offsets = jax.random.randint(ks[2], (BATCH, 1), 0, MAX_POS_OFFSET, dtype=jnp.int32)
    positions = (offsets + jnp.arange(SEQ, dtype=jnp.int32)[None, :]).astype(jnp.int32)
    return {
        'x': x,
        'mem': mem,
        'positions': positions,
        'g_mix': gain(ks[3], (L, D)),
        'w_in': nrm(ks[4], (L, D, N_IN), D ** -0.5),
        'b_gate': nrm(ks[5], (L, N_BRANCH * D), 0.1),
        'a_qn': gain(ks[6], (L, A_HD)),
        'a_kn': gain(ks[7], (L, A_HD)),
        'a_sink': nrm(ks[8], (L, A_HEADS), 0.5),
        'b_qa_norm': gain(ks[9], (L, B_Q_LORA)),
        'b_kva_norm': gain(ks[10], (L, B_KV_LORA)),
        'b_w_uq': nrm(ks[11], (L, B_Q_LORA, B_HEADS * (B_NOPE + B_ROPE)), B_Q_LORA ** -0.5),
        'b_w_ukv': nrm(ks[12], (L, B_KV_LORA, B_HEADS * (B_NOPE + B_V)), B_KV_LORA ** -0.5),
        'b_qn': gain(ks[13], (L, B_NOPE + B_ROPE)),
        'b_kn': gain(ks[14], (L, B_NOPE + B_ROPE)),
        'c_qn': gain(ks[15], (L, N_C_GROUPS, C_HD)),
        'c_kn': gain(ks[16], (L, N_C_GROUPS, C_HD)),
        'm_g_mem': gain(ks[17], (L, D)),
        'm_w_kv': nrm(ks[18], (L, D, 2 * M_HEADS * M_HD), D ** -0.5),
        'm_qn': gain(ks[19], (L, M_HD)),
        'm_kn': gain(ks[20], (L, M_HD)),
        'w_branch': nrm(ks[21], (L, N_BRANCH, BRANCH_W, D), BRANCH_W ** -0.5),
        'w_out': nrm(ks[22], (L, D, D), D ** -0.5),
        'g_mlp': gain(ks[23], (L, D)),
        'w_up': nrm(ks[24], (L, D, D_FF), D ** -0.5),
        'w_down': nrm(ks[25], (L, D_FF, D), D_FF ** -0.5),
    }


def reference(x, mem, positions, g_mix, w_in, b_gate, a_qn, a_kn, a_sink, b_qa_norm, b_kva_norm,
              b_w_uq, b_w_ukv, b_qn, b_kn, c_qn, c_kn, m_g_mem, m_w_kv, m_qn, m_kn,
              w_branch, w_out, g_mlp, w_up, w_down):
    B, S, D = x.shape
    cos_h, sin_h = rope_tables(positions, A_HD)
    cos_r, sin_r = rope_tables(positions, B_ROPE)
    for l in range(DEPTH):
        h = rms_norm(x, g_mix[l])
        parts = jnp.split(h @ w_in[l], IN_SPLITS, axis=-1)
        a_q, a_k, a_v, b_cq, b_ckv, b_kr = parts[:6]
        c_parts = parts[6:6 + 3 * N_C_GROUPS]
        m_q, gate_pre = parts[6 + 3 * N_C_GROUPS:]

        qa = apply_rope(rms_norm(a_q.reshape(B, S, A_HEADS, A_HD), a_qn[l]), cos_h, sin_h)
        ka = apply_rope(rms_norm(a_k.reshape(B, S, A_KV_HEADS, A_HD), a_kn[l]), cos_h, sin_h)
        va = a_v.reshape(B, S, A_KV_HEADS, A_HD)
        o_a, _ = banded_attention(qa.reshape(B, S, A_KV_HEADS, A_GROUP, A_HD), ka, va,
                                  A_WINDOW - 1, a_sink[l].reshape(A_KV_HEADS, A_GROUP))
        o_a = o_a.reshape(B, S, BRANCH_W)

        q_up = (rms_norm(b_cq, b_qa_norm[l]) @ b_w_uq[l]).reshape(B, S, B_HEADS, B_NOPE + B_ROPE)
        kv_up = (rms_norm(b_ckv, b_kva_norm[l]) @ b_w_ukv[l]).reshape(B, S, B_HEADS, B_NOPE + B_V)
        qn = rms_norm(q_up[..., :B_NOPE], b_qn[l, :B_NOPE])
        qp = apply_rope(rms_norm(q_up[..., B_NOPE:], b_qn[l, B_NOPE:]), cos_r, sin_r)
        kn = rms_norm(kv_up[..., :B_NOPE], b_kn[l, :B_NOPE])
        vb = kv_up[..., B_NOPE:]
        kp = apply_rope(rms_norm(b_kr, b_kn[l, B_NOPE:])[:, :, None, :], cos_r, sin_r)[:, :, 0, :]
        o_b = mla_causal_attention(qn, qp, kn, kp, vb).reshape(B, S, BRANCH_W)

        outs = []
        lses = []
        for g, (win, dil) in enumerate(C_PATTERNS):
            cq, ck, cv = c_parts[3 * g:3 * g + 3]
            qc = apply_rope(rms_norm(cq.reshape(B, S, C_HEADS, C_HD), c_qn[l, g]), cos_h, sin_h)
            kc = apply_rope(rms_norm(ck.reshape(B, S, C_HEADS, C_HD), c_kn[l, g]), cos_h, sin_h)
            vc = cv.reshape(B, S, C_HEADS, C_HD)
            o_g, lse_g = dilated_group(qc, kc, vc, win, dil)
            outs.append(o_g)
            lses.append(lse_g)
        wts = jax.nn.softmax(jnp.stack(lses, axis=0), axis=0).astype(x.dtype)
        o_c = jnp.einsum('gbsh,gbshd->bshd', wts, jnp.stack(outs, axis=0)).reshape(B, S, BRANCH_W)

        mkv = rms_norm(mem, m_g_mem[l]) @ m_w_kv[l]
        mk = rms_norm(mkv[..., :M_HEADS * M_HD].reshape(B, N_MEM, M_HEADS, M_HD), m_kn[l])
        mv = mkv[..., M_HEADS * M_HD:].reshape(B, N_MEM, M_HEADS, M_HD)
        mq = rms_norm(m_q.reshape(B, S, M_HEADS, M_HD), m_qn[l])
        o_m = memory_attention(mq, mk, mv).reshape(B, S, BRANCH_W)

        o = jnp.stack([o_a, o_b, o_c, o_m], axis=2)
        y = jnp.einsum('bsnc,ncd->bsnd', o, w_branch[l])
        gates = jax.nn.sigmoid((gate_pre + b_gate[l]).astype(jnp.float32)).astype(x.dtype)
        gates = gates.reshape(B, S, N_BRANCH, D)
        x = x + jnp.einsum('bsnd,de->bse', gates * y, w_out[l])

        u = rms_norm(x, g_mlp[l]) @ w_up[l]
        x = x + jnp.square(jax.nn.relu(u)) @ w_down[l]
    return x
```

```cpp
#include <hip/hip_runtime.h>
#include <hip/hip_cooperative_groups.h>
#include <cstdio>
#include <cstdint>
#include <cmath>
namespace cg = cooperative_groups;

#define LAS __attribute__((address_space(3)))
#define DI __device__ __forceinline__
typedef unsigned short bf16_t;
typedef short bf16x8 __attribute__((ext_vector_type(8)));
typedef short s16x4 __attribute__((ext_vector_type(4)));
typedef float f32x4 __attribute__((ext_vector_type(4)));
typedef float f32x16 __attribute__((ext_vector_type(16)));
typedef unsigned u32x4 __attribute__((ext_vector_type(4)));
typedef unsigned u32x2 __attribute__((ext_vector_type(2)));
typedef float f32x2_t __attribute__((ext_vector_type(2)));
typedef __bf16 bf16x2_t __attribute__((ext_vector_type(2)));

constexpr int D = 1024, BATCH = 8, SEQ = 4096, DEPTH = 4, TT = BATCH * SEQ;
constexpr int NCHUNK = 2, BC = BATCH / NCHUNK, TC = BC * SEQ;
constexpr int N_IN = 10656, NT_IN = 10752;
constexpr int DFF = 4096, NMEM = 256;
constexpr float EPS = 1e-6f;
constexpr float LOG2E = 1.4426950408889634f;
constexpr float NEGBIG = -1e30f;
constexpr int NTHREADS = 512, NWAVES = 8;

constexpr size_t MiB = 1u << 20;
constexpr size_t WS_CTL = 0;
constexpr size_t WS_WIN = 1 * MiB, WS_WUQ = 22 * MiB, WS_WUKV = 23 * MiB, WS_WMKV = 24 * MiB, WS_WBR = 26 * MiB, WS_WOUT = 30 * MiB, WS_WUP = 32 * MiB, WS_WDN = 40 * MiB;
constexpr size_t WS_XB = 48 * MiB, WS_PX = 112 * MiB, WS_COSH = 114 * MiB, WS_SINH = 118 * MiB, WS_COSR = 122 * MiB, WS_SINR = 124 * MiB;
constexpr size_t WS_MEMN = 126 * MiB, WS_MK = 130 * MiB, WS_MV = 132 * MiB;
constexpr size_t WS_QA = 134 * MiB, WS_OB = 150 * MiB, WS_OC = 166 * MiB, WS_MQ = 182 * MiB;
constexpr size_t WS_KA = 198 * MiB, WS_VA = 202 * MiB, WS_CQ = 206 * MiB, WS_CKV = 218 * MiB, WS_KR = 226 * MiB, WS_PCQ = 227 * MiB, WS_PCKV = 227 * MiB + 512 * 1024;
constexpr size_t WS_CB = 228 * MiB;
constexpr size_t WS_GATES = 372 * MiB, WS_U = WS_GATES;
constexpr size_t WS_QB = 500 * MiB, WS_KN = 524 * MiB, WS_VB = 540 * MiB, WS_LSE = 556 * MiB, WS_GY = 558 * MiB;
constexpr size_t WS_END = 590 * MiB;

constexpr int LDS_BYTES = 155648;
constexpr int LDS_SCR = 149504;

struct Params {
    const float* in[26];
    float* out;
    unsigned char* ws;
    float inv_h[32];
    float inv_r[16];
    int pad[2];
};

DI unsigned cvtpk(float lo, float hi) { f32x2_t v = {lo, hi}; bf16x2_t b = __builtin_convertvector(v, bf16x2_t); return __builtin_bit_cast(unsigned, b); }
DI float bf_lo(unsigned w) { return __uint_as_float(w << 16); }
DI float bf_hi(unsigned w) { return __uint_as_float(w & 0xffff0000u); }
DI u32x4 pack8(const float* v) { u32x4 w; w.x = cvtpk(v[0], v[1]); w.y = cvtpk(v[2], v[3]); w.z = cvtpk(v[4], v[5]); w.w = cvtpk(v[6], v[7]); return w; }
DI void unpack8(u32x4 w, float* v) { v[0] = bf_lo(w.x); v[1] = bf_hi(w.x); v[2] = bf_lo(w.y); v[3] = bf_hi(w.y); v[4] = bf_lo(w.z); v[5] = bf_hi(w.z); v[6] = bf_lo(w.w); v[7] = bf_hi(w.w); }
DI float wave_sum(float v) {
#pragma unroll
    for (int o = 1; o < 64; o <<= 1) v += __shfl_xor(v, o);
    return v;
}
struct RopeTabs { const float* cosh; const float* sinh; const float* cosr; const float* sinr; };
typedef const struct Params __attribute__((address_space(4))) CParams;
DI CParams* fresh_params() { unsigned long long k = (unsigned long long)__builtin_amdgcn_kernarg_segment_ptr(); asm volatile("" : "+s"(k)); return (CParams*)k; }
#define PHASE_CTX \
    CParams* q = fresh_params(); unsigned char* ws = q->ws; (void)ws; \
    bf16_t* XB = (bf16_t*)(ws + WS_XB); float* PX = (float*)(ws + WS_PX); (void)XB; (void)PX; \
    const RopeTabs rt{(const float*)(ws + WS_COSH), (const float*)(ws + WS_SINH), (const float*)(ws + WS_COSR), (const float*)(ws + WS_SINR)}; (void)rt;
DI int opaque(int v) { asm volatile("" : "+v"(v)); return v; }
DI int lane_id() { int v; asm volatile("v_mbcnt_lo_u32_b32 %0, -1, 0\n\tv_mbcnt_hi_u32_b32 %0, -1, %0" : "=v"(v)); return v; }
#define LDS_WAIT() asm volatile("s_waitcnt lgkmcnt(0)" ::: "memory")

namespace pg8 {
constexpr int BM = 256, BK = 64, HALF = 128, HTB = HALF * BK * 2, STAGE_BYTES = 8 * HTB, NXCD = 8, WGM = 8;
DI int lds_byte(int r, int c) { const int st = (r >> 4) * 2 + (c >> 5), rr = r & 15, cc = c & 31, ob = rr * 64 + cc * 2; return st * 1024 + (ob ^ (((ob >> 9) & 1) << 5)); }
DI void stage_rc(int b, int& R, int& C) { const int st = b / 1024, sb = b % 1024, swz = sb ^ (((sb >> 9) & 1) << 5); R = (st >> 1) * 16 + swz / 64; C = (st & 1) * 32 + (swz % 64) / 2; }
DI int perm32(int rho) { const int n = rho >> 4, i = rho & 15; return 8 * (i >> 2) + 4 * n + (i & 3); }

struct Unit { int pm, pn, seg; const bf16_t* A; const bf16_t* Bt; };

struct TileOrder {
    int nM, nN, nwg, G, c, nseg;
    const bf16_t* A0; const bf16_t* B0; size_t segA, segB;
    DI void init(int M, int N, int G_, int c_, const bf16_t* A, const bf16_t* B) { nM = M / BM; nN = N / BM; nwg = nM * nN; G = G_; c = c_; nseg = 1; A0 = A; B0 = B; segA = 0; segB = 0; }
    DI bool next(int i, Unit& u) const {
        const int seg = i % nseg, ti = i / nseg;
        const long L = (long)ti * G + c; if (L >= nwg) return false;
        int wgid = (int)L; { const int q = nwg / NXCD, r = nwg % NXCD, xcd = wgid % NXCD, off = wgid / NXCD; wgid = (xcd < r ? xcd * (q + 1) : r * (q + 1) + (xcd - r) * q) + off; }
        const int nig = WGM * nN, gid = wgid / nig, fm = gid * WGM, gsz = (nM - fm) < WGM ? (nM - fm) : WGM;
        u.pm = fm + ((wgid % nig) % gsz); u.pn = (wgid % nig) / gsz; u.seg = seg;
        u.A = A0 + (size_t)seg * segA; u.Bt = B0 + (size_t)seg * segB;
        return true;
    }
};

template <class Epi, class Sched>
DI void gemm_phase(LAS unsigned char* lds, const int K, const int lda, const Sched& S, const Epi& E, const int wid) {
    const int lane = opaque(lane_id()), tid = wid * 64 + lane, wr = wid >> 2, wc = wid & 3, fr = lane & 15, fq = lane >> 4;
    const int nt = K / BK;
    unsigned voffA[2], voffB[2];
#pragma unroll
    for (int i = 0; i < 2; ++i) { int R, C; stage_rc(tid * 16 + i * 8192, R, C); const int Rb = (R & ~31) + perm32(R & 31);
        voffA[i] = (unsigned)(R * lda + C) * 2u; voffB[i] = (unsigned)(Rb * K + C) * 2u; }
    const size_t kstep = (size_t)(BK * 2);
    const size_t hstepA = (size_t)HALF * lda * 2, hstepB = (size_t)HALF * K * 2;
    const size_t tstepA = 2 * hstepA, tstepB = 2 * hstepB;
    const unsigned ldsw = (unsigned)wid * 1024u;
    const int aoff = lds_byte(wr * 64 + fr, fq * 8), boff = lds_byte(wc * 32 + fr, fq * 8);
#define PG8_SA(b, h) (((b) * 2 + (h)) * HTB)
#define PG8_SB(b, h) ((4 + (b) * 2 + (h)) * HTB)
#define PG8_STAGE(bufoff, gbase, voff) do { _Pragma("unroll") for (int _i = 0; _i < 2; ++_i) \
        __builtin_amdgcn_global_load_lds((const unsigned*)((const char*)(gbase) + (voff)[_i]), (LAS unsigned*)(lds + (bufoff) + ldsw + _i * 8192), 16, 0, 0); } while (0)
#define PG8_LDA(dst, b, h) do { _Pragma("unroll") for (int m = 0; m < 4; ++m) _Pragma("unroll") for (int k = 0; k < 2; ++k) dst[m][k] = *(const LAS bf16x8*)(lds + PG8_SA(b, h) + aoff + m * 2048 + k * 1024); } while (0)
#define PG8_LDB(dst, b, h) do { _Pragma("unroll") for (int n = 0; n < 2; ++n) _Pragma("unroll") for (int k = 0; k < 2; ++k) dst[n][k] = *(const LAS bf16x8*)(lds + PG8_SB(b, h) + boff + n * 2048 + k * 1024); } while (0)
#define PG8_MMA(ai, bj, At, Bt) do { __builtin_amdgcn_s_setprio(1); _Pragma("unroll") for (int m = 0; m < 4; ++m) _Pragma("unroll") for (int n = 0; n < 2; ++n) _Pragma("unroll") for (int k = 0; k < 2; ++k) \
        acc[ai][bj][m][n] = __builtin_amdgcn_mfma_f32_16x16x32_bf16(Bt[n][k], At[m][k], acc[ai][bj][m][n], 0, 0, 0); __builtin_amdgcn_s_setprio(0); } while (0)
#define PG8_WAIT_V(n) asm volatile("s_waitcnt vmcnt(" #n ")" ::: "memory")
#define PG8_WAIT_L(n) asm volatile("s_waitcnt lgkmcnt(" #n ")" ::: "memory")
#define PG8_BAR __builtin_amdgcn_s_barrier()
#define PG8_SCHED __builtin_amdgcn_sched_barrier(0)
    Unit cur, nxt; int ui = 0;
    if (!S.next(0, cur)) return;
    f32x4 acc[2][2][4][2];
#pragma unroll
    for (int a = 0; a < 2; ++a)
#pragma unroll
        for (int b = 0; b < 2; ++b)
#pragma unroll
            for (int m = 0; m < 4; ++m)
#pragma unroll
                for (int n = 0; n < 2; ++n) acc[a][b][m][n] = (f32x4){0.f, 0.f, 0.f, 0.f};
    bf16x8 At[4][2], B0[2][2], B1[2][2];
    const char* cA = (const char*)cur.A + (size_t)cur.pm * tstepA; const char* cB = (const char*)cur.Bt + (size_t)cur.pn * tstepB;
    PG8_STAGE(PG8_SB(0, 0), cB, voffB); PG8_STAGE(PG8_SB(0, 1), cB + hstepB, voffB); PG8_STAGE(PG8_SA(0, 0), cA, voffA); PG8_STAGE(PG8_SA(0, 1), cA + hstepA, voffA);
    if (wr == 1) PG8_BAR;
    PG8_WAIT_V(2); PG8_BAR;
    PG8_STAGE(PG8_SB(1, 0), cB + kstep, voffB); PG8_STAGE(PG8_SA(1, 0), cA + kstep, voffA); PG8_STAGE(PG8_SB(1, 1), cB + hstepB + kstep, voffB);
    PG8_WAIT_V(6); PG8_BAR;
    for (;;) {
        const bool has_next = S.next(ui + 1, nxt);
        const char* nA = has_next ? (const char*)nxt.A + (size_t)nxt.pm * tstepA : cA; const char* nB = has_next ? (const char*)nxt.Bt + (size_t)nxt.pn * tstepB : cB;
#pragma unroll 1
        for (int t = 0; t < nt; t += 2) {
            const bool last = (t == nt - 2);
            const char* a1 = cA + (size_t)(t + 1) * kstep;
            const char* a2 = last ? nA : cA + (size_t)(t + 2) * kstep; const char* b2 = last ? nB : cB + (size_t)(t + 2) * kstep;
            const char* a3 = a2 + kstep; const char* b3 = b2 + kstep;
            PG8_LDB(B0, 0, 0); PG8_LDB(B1, 0, 1); PG8_SCHED; PG8_LDA(At, 0, 0); PG8_STAGE(PG8_SA(1, 1), a1 + hstepA, voffA);
            PG8_WAIT_V(8); PG8_WAIT_L(0); PG8_BAR; PG8_MMA(0, 0, At, B0); PG8_MMA(0, 1, At, B1); PG8_BAR; PG8_SCHED;
            PG8_LDA(At, 0, 1); PG8_STAGE(PG8_SB(0, 0), b2, voffB); PG8_STAGE(PG8_SB(0, 1), b2 + hstepB, voffB); PG8_STAGE(PG8_SA(0, 0), a2, voffA);
            PG8_WAIT_V(8); PG8_WAIT_L(0); PG8_BAR; PG8_MMA(1, 0, At, B0); PG8_MMA(1, 1, At, B1); PG8_BAR; PG8_SCHED;
            PG8_LDB(B0, 1, 0); PG8_LDB(B1, 1, 1); PG8_SCHED; PG8_LDA(At, 1, 0); PG8_STAGE(PG8_SA(0, 1), a2 + hstepA, voffA);
            PG8_WAIT_V(8); PG8_WAIT_L(0); PG8_BAR; PG8_MMA(0, 0, At, B0); PG8_MMA(0, 1, At, B1); PG8_BAR; PG8_SCHED;
            PG8_LDA(At, 1, 1); PG8_STAGE(PG8_SB(1, 0), b3, voffB); PG8_STAGE(PG8_SB(1, 1), b3 + hstepB, voffB); PG8_STAGE(PG8_SA(1, 0), a3, voffA);
            PG8_WAIT_V(8); PG8_WAIT_L(0); PG8_BAR; PG8_MMA(1, 0, At, B0); PG8_MMA(1, 1, At, B1); PG8_BAR; PG8_SCHED;
        }
        if (wr == 0) PG8_BAR;
        E(acc, cur, wr, wc, fr, fq);
        if (!has_next) break;
#pragma unroll
        for (int a = 0; a < 2; ++a)
#pragma unroll
            for (int b = 0; b < 2; ++b)
#pragma unroll
                for (int m = 0; m < 4; ++m)
#pragma unroll
                    for (int n = 0; n < 2; ++n) acc[a][b][m][n] = (f32x4){0.f, 0.f, 0.f, 0.f};
        cur = nxt; cA = nA; cB = nB; ++ui;
        if (wr == 1) PG8_BAR;
    }
    PG8_WAIT_V(0);
    PG8_BAR;
#undef PG8_SA
#undef PG8_SB
#undef PG8_STAGE
#undef PG8_LDA
#undef PG8_LDB
#undef PG8_MMA
#undef PG8_WAIT_V
#undef PG8_WAIT_L
#undef PG8_BAR
#undef PG8_SCHED
}
}

struct RowScale {
    const float* part; int stride; int cnt; float inv_n;
    DI float get(int row) const {
        if (!part) return 1.f;
        float s = 0.f;
        const float* p = part + (size_t)row * stride;
        for (int i = 0; i < cnt; i += 4) { const f32x4 v = *(const f32x4*)(p + i); s += (v.x + v.y) + (v.z + v.w); }
        return __builtin_amdgcn_rsqf(s * inv_n + EPS);
    }
};

DI void rs_preload(const RowScale& rs, int rowbase, int fq, float (&out)[8]) {
    if (!rs.part) {
#pragma unroll
        for (int i = 0; i < 8; ++i) out[i] = 1.f;
        return;
    }
#pragma unroll
    for (int hb = 0; hb < 2; ++hb) {
        float s[4];
#pragma unroll
        for (int i = 0; i < 4; ++i) { s[i] = 0.f;
            if (4 * fq < rs.cnt) { const f32x4 v = *(const f32x4*)(rs.part + (size_t)(rowbase + hb * 128 + i * 16) * rs.stride + 4 * fq);
                s[i] = v.x + (4 * fq + 1 < rs.cnt ? v.y : 0.f) + (4 * fq + 2 < rs.cnt ? v.z : 0.f) + (4 * fq + 3 < rs.cnt ? v.w : 0.f); } }
#pragma unroll
        for (int i = 0; i < 4; ++i) { float t = s[i]; t += __shfl_xor(t, 16); t += __shfl_xor(t, 32); out[hb * 4 + i] = __builtin_amdgcn_rsqf(t * rs.inv_n + EPS); }
        asm volatile("" ::: "memory");
    }
}
enum { SK_SKIP = 0, SK_RAW = 1, SK_HEAD = 2, SK_ROPE32 = 3, SK_GATE = 4 };
struct SlotDesc { int kind; bf16_t* dst; int ld; int col; const float* gain; float scale; int rope; float* part; int pstride; int pidx; const float* bias; };


template <class Cfg>
struct EpiSlot {
    Cfg cfg; RowScale rs; int rs_off; RopeTabs rt; int tok_off;
    DI void operator()(const f32x4 (&acc)[2][2][4][2], const pg8::Unit& u, int wr, int wc, int fr, int fq) const {
        const SlotDesc d = cfg.get(u.pn * 4 + wc);
        if (d.kind == SK_SKIP) return;
        const int d0 = 8 * fq;
        float rsv[8]; rs_preload(rs, u.pm * 256 + wr * 64 + fr + rs_off, fq, rsv);
        float g0[8], g1[8];
        if (d.kind == SK_HEAD) {
#pragma unroll
            for (int i = 0; i < 8; ++i) { g0[i] = d.gain[d0 + i] * d.scale; g1[i] = d.gain[32 + d0 + i] * d.scale; }
        } else if (d.kind == SK_ROPE32) {
#pragma unroll
            for (int i = 0; i < 8; ++i) { g0[i] = fq < 2 ? d.gain[d0 + i] * d.scale : 0.f; g1[i] = fq < 2 ? d.gain[16 + d0 + i] * d.scale : 0.f; }
        } else if (d.kind == SK_GATE) {
#pragma unroll
            for (int i = 0; i < 8; ++i) { g0[i] = d.bias[d.col + d0 + i]; g1[i] = d.bias[d.col + 32 + d0 + i]; }
        } else {
#pragma unroll
            for (int i = 0; i < 8; ++i) { g0[i] = 0.f; g1[i] = 0.f; }
        }
#pragma unroll
        for (int ai = 0; ai < 2; ++ai)
#pragma unroll
            for (int m = 0; m < 4; ++m) {
                const int row = u.pm * 256 + ai * 128 + wr * 64 + m * 16 + fr;
                const float r = rsv[ai * 4 + m];
                float v0[8], v1[8];
#pragma unroll
                for (int n = 0; n < 2; ++n)
#pragma unroll
                    for (int j = 0; j < 4; ++j) { v0[4 * n + j] = acc[ai][0][m][n][j] * r; v1[4 * n + j] = acc[ai][1][m][n][j] * r; }
                bf16_t* dp = d.dst + (size_t)row * d.ld + d.col;
                if (d.kind == SK_RAW) {
                    if (d.part) {
                        float ss = 0.f;
#pragma unroll
                        for (int i = 0; i < 8; ++i) ss += v0[i] * v0[i] + v1[i] * v1[i];
                        ss += __shfl_xor(ss, 16); ss += __shfl_xor(ss, 32);
                        if (fq == 0) d.part[(size_t)row * d.pstride + d.pidx] = ss;
                    }
                    *(u32x4*)(dp + d0) = pack8(v0); *(u32x4*)(dp + 32 + d0) = pack8(v1);
                } else if (d.kind == SK_GATE) {
#pragma unroll
                    for (int i = 0; i < 8; ++i) { v0[i] = __builtin_amdgcn_rcpf(1.f + __builtin_amdgcn_exp2f(-(v0[i] + g0[i]) * LOG2E)); v1[i] = __builtin_amdgcn_rcpf(1.f + __builtin_amdgcn_exp2f(-(v1[i] + g1[i]) * LOG2E)); }
                    *(u32x4*)(dp + d0) = pack8(v0); *(u32x4*)(dp + 32 + d0) = pack8(v1);
                } else if (d.kind == SK_HEAD) {
                    float ss = 0.f;
#pragma unroll
                    for (int i = 0; i < 8; ++i) ss += v0[i] * v0[i] + v1[i] * v1[i];
                    ss += __shfl_xor(ss, 16); ss += __shfl_xor(ss, 32);
                    const float inv = __builtin_amdgcn_rsqf(ss * (1.f / 64.f) + EPS);
#pragma unroll
                    for (int i = 0; i < 8; ++i) { v0[i] *= inv * g0[i]; v1[i] *= inv * g1[i]; }
                    if (d.rope) {
                        const float* cp = rt.cosh + (size_t)(row + tok_off) * 32 + d0; const float* sp = rt.sinh + (size_t)(row + tok_off) * 32 + d0;
                        const f32x4 c0 = *(const f32x4*)cp, c1 = *(const f32x4*)(cp + 4), s0 = *(const f32x4*)sp, s1 = *(const f32x4*)(sp + 4);
#pragma unroll
                        for (int i = 0; i < 8; ++i) { const float c = i < 4 ? c0[i & 3] : c1[i & 3], s = i < 4 ? s0[i & 3] : s1[i & 3];
                            const float a = v0[i], b = v1[i]; v0[i] = a * c - b * s; v1[i] = b * c + a * s; }
                    }
                    *(u32x4*)(dp + d0) = pack8(v0); *(u32x4*)(dp + 32 + d0) = pack8(v1);
                } else {
                    float ss = 0.f;
#pragma unroll
                    for (int i = 0; i < 8; ++i) ss += v0[i] * v0[i] + v1[i] * v1[i];
                    ss += __shfl_xor(ss, 16); ss += __shfl_xor(ss, 32);
                    const float inv = __builtin_amdgcn_rsqf(ss * (1.f / 32.f) + EPS);
                    if (fq < 2) {
#pragma unroll
                        for (int i = 0; i < 8; ++i) { v0[i] *= inv * g0[i]; v1[i] *= inv * g1[i]; }
                        const float* cp = rt.cosr + (size_t)(row + tok_off) * 16 + d0; const float* sp = rt.sinr + (size_t)(row + tok_off) * 16 + d0;
                        const f32x4 c0 = *(const f32x4*)cp, c1 = *(const f32x4*)(cp + 4), s0 = *(const f32x4*)sp, s1 = *(const f32x4*)(sp + 4);
#pragma unroll
                        for (int i = 0; i < 8; ++i) { const float c = i < 4 ? c0[i & 3] : c1[i & 3], s = i < 4 ? s0[i & 3] : s1[i & 3];
                            const float a = v0[i], b = v1[i]; v0[i] = a * c - b * s; v1[i] = b * c + a * s; }
                        *(u32x4*)(dp + d0) = pack8(v0); *(u32x4*)(dp + 16 + d0) = pack8(v1);
                    }
                }
            }
    }
};

struct CfgIn {
    unsigned char* ws; const float* a_qn; const float* a_kn; const float* b_kn; const float* c_qn; const float* c_kn; const float* b_gate;
    DI SlotDesc get(int s) const {
        SlotDesc d; d.kind = SK_SKIP; d.dst = nullptr; d.ld = 0; d.col = 0; d.gain = nullptr; d.scale = 1.f; d.rope = 0; d.part = nullptr; d.pstride = 0; d.pidx = 0; d.bias = nullptr;
        if (s < 8) { d.kind = SK_HEAD; d.dst = (bf16_t*)(ws + WS_QA); d.ld = 512; d.col = 64 * s; d.gain = a_qn; d.scale = 0.125f * LOG2E; d.rope = 1; }
        else if (s < 10) { d.kind = SK_HEAD; d.dst = (bf16_t*)(ws + WS_KA); d.ld = 128; d.col = 64 * (s - 8); d.gain = a_kn; d.rope = 1; }
        else if (s < 12) { d.kind = SK_RAW; d.dst = (bf16_t*)(ws + WS_VA); d.ld = 128; d.col = 64 * (s - 10); }
        else if (s < 18) { d.kind = SK_RAW; d.dst = (bf16_t*)(ws + WS_CQ); d.ld = 384; d.col = 64 * (s - 12); d.part = (float*)(ws + WS_PCQ); d.pstride = 8; d.pidx = s - 12; }
        else if (s < 22) { d.kind = SK_RAW; d.dst = (bf16_t*)(ws + WS_CKV); d.ld = 256; d.col = 64 * (s - 18); d.part = (float*)(ws + WS_PCKV); d.pstride = 4; d.pidx = s - 18; }
        else if (s == 22) { d.kind = SK_ROPE32; d.dst = (bf16_t*)(ws + WS_KR); d.ld = 32; d.col = 0; d.gain = b_kn + 64; }
        else if (s < 95) { const int p = (s - 23) >> 3, h = (s - 23) & 7, g = p / 3, t = p % 3;
            d.dst = (bf16_t*)(ws + WS_CB + (size_t)p * 16 * MiB); d.ld = 512; d.col = 64 * h;
            if (t == 0) { d.kind = SK_HEAD; d.gain = c_qn + 64 * g; d.scale = 0.125f * LOG2E; d.rope = 1; }
            else if (t == 1) { d.kind = SK_HEAD; d.gain = c_kn + 64 * g; d.rope = 1; }
            else d.kind = SK_RAW; }
        else if (s < 103) { d.kind = SK_RAW; d.dst = (bf16_t*)(ws + WS_MQ); d.ld = 512; d.col = 64 * (s - 95); }
        else if (s < 167) { d.kind = SK_GATE; d.dst = (bf16_t*)(ws + WS_GATES); d.ld = 4096; d.col = 64 * (s - 103); d.bias = b_gate; }
        return d;
    }
};
DI void in_slot_src(int s, int& src, int& kind) {
    kind = 0;
    if (s < 22) src = 64 * s;
    else if (s == 22) { src = 1408; kind = 1; }
    else if (s < 167) src = 1440 + 64 * (s - 23);
    else { src = 0; kind = 2; }
}
struct CfgUq {
    unsigned char* ws; const float* b_qn;
    DI SlotDesc get(int s) const {
        SlotDesc d; d.dst = (bf16_t*)(ws + WS_QB); d.ld = 768; d.scale = 0.10206207261596575f * LOG2E; d.rope = 0; d.part = nullptr; d.pstride = 0; d.pidx = 0; d.bias = nullptr;
        if (s < 8) { d.kind = SK_HEAD; d.col = 96 * s; d.gain = b_qn; }
        else { d.kind = SK_ROPE32; d.col = 96 * (s - 8) + 64; d.gain = b_qn + 64; }
        return d;
    }
};
struct CfgUkv {
    unsigned char* ws; const float* b_kn;
    DI SlotDesc get(int s) const {
        SlotDesc d; d.ld = 512; d.scale = 1.f; d.rope = 0; d.part = nullptr; d.pstride = 0; d.pidx = 0; d.bias = nullptr; d.gain = b_kn;
        if (s < 8) { d.kind = SK_HEAD; d.dst = (bf16_t*)(ws + WS_KN); d.col = 64 * s; }
        else { d.kind = SK_RAW; d.dst = (bf16_t*)(ws + WS_VB); d.col = 64 * (s - 8); }
        return d;
    }
};
struct CfgMkv {
    unsigned char* ws;
    DI SlotDesc get(int s) const {
        SlotDesc d; d.kind = SK_RAW; d.ld = 512; d.scale = 1.f; d.rope = 0; d.part = nullptr; d.pstride = 0; d.pidx = 0; d.bias = nullptr; d.gain = nullptr;
        if (s < 8) { d.dst = (bf16_t*)(ws + WS_MK); d.col = 64 * s; } else { d.dst = (bf16_t*)(ws + WS_MV); d.col = 64 * (s - 8); }
        return d;
    }
};

struct EpiMerge {
    const bf16_t* gates; bf16_t* gy;
    DI void operator()(const f32x4 (&acc)[2][2][4][2], const pg8::Unit& u, int wr, int wc, int fr, int fq) const {
#pragma unroll
        for (int ai = 0; ai < 2; ++ai)
#pragma unroll
            for (int m = 0; m < 4; ++m) {
                const int row = u.pm * 256 + ai * 128 + wr * 64 + m * 16 + fr;
#pragma unroll
                for (int bj = 0; bj < 2; ++bj) {
                    const int col = u.pn * 256 + bj * 128 + wc * 32 + 8 * fq;
                    float g[8], o[8];
                    unpack8(*(const u32x4*)(gates + (size_t)row * 4096 + u.seg * 1024 + col), g);
                    bf16_t* gp = gy + (size_t)row * 1024 + col;
                    if (u.seg == 0) {
#pragma unroll
                        for (int i = 0; i < 8; ++i) o[i] = 0.f;
                    } else unpack8(*(const u32x4*)gp, o);
#pragma unroll
                    for (int n = 0; n < 2; ++n)
#pragma unroll
                        for (int j = 0; j < 4; ++j) o[4 * n + j] += g[4 * n + j] * acc[ai][bj][m][n][j];
                    *(u32x4*)gp = pack8(o);
                }
            }
    }
};
struct EpiRes {
    const float* xsrc; float* xdst; bf16_t* xb; float* px;
    DI void operator()(const f32x4 (&acc)[2][2][4][2], const pg8::Unit& u, int wr, int wc, int fr, int fq) const {
#pragma unroll
        for (int ai = 0; ai < 2; ++ai)
#pragma unroll
            for (int m = 0; m < 4; ++m) {
                const int row = u.pm * 256 + ai * 128 + wr * 64 + m * 16 + fr;
                float ss = 0.f;
#pragma unroll
                for (int bj = 0; bj < 2; ++bj) {
                    const size_t off = (size_t)row * 1024 + u.pn * 256 + bj * 128 + wc * 32 + 8 * fq;
                    float o[8];
#pragma unroll
                    for (int n = 0; n < 2; ++n) { const f32x4 xs = *(const f32x4*)(xsrc + off + 4 * n); const f32x4 xn = xs + acc[ai][bj][m][n]; *(f32x4*)(xdst + off + 4 * n) = xn;
#pragma unroll
                        for (int j = 0; j < 4; ++j) { o[4 * n + j] = xn[j]; ss += xn[j] * xn[j]; } }
                    *(u32x4*)(xb + off) = pack8(o);
                }
                ss += __shfl_xor(ss, 16); ss += __shfl_xor(ss, 32);
                if (fq == 0) px[(size_t)row * 16 + u.pn * 4 + wc] = ss;
            }
    }
};
struct EpiUp {
    bf16_t* U; RowScale rs; int rs_off;
    DI void operator()(const f32x4 (&acc)[2][2][4][2], const pg8::Unit& u, int wr, int wc, int fr, int fq) const {
        float rsv[8]; rs_preload(rs, u.pm * 256 + wr * 64 + fr + rs_off, fq, rsv);
#pragma unroll
        for (int ai = 0; ai < 2; ++ai)
#pragma unroll
            for (int m = 0; m < 4; ++m) {
                const int row = u.pm * 256 + ai * 128 + wr * 64 + m * 16 + fr;
                const float r = rsv[ai * 4 + m];
#pragma unroll
                for (int bj = 0; bj < 2; ++bj) {
                    float o[8];
#pragma unroll
                    for (int n = 0; n < 2; ++n)
#pragma unroll
                        for (int j = 0; j < 4; ++j) { const float v = fmaxf(acc[ai][bj][m][n][j] * r, 0.f); o[4 * n + j] = v * v; }
                    *(u32x4*)(U + (size_t)row * DFF + u.pn * 256 + bj * 128 + wc * 32 + 8 * fq) = pack8(o);
                }
            }
    }
};

DI void transpose_item(const float* W, int K, int N, const float* gk, bf16_t* WT, int rho0, int k0, int src0, int nvalid, LAS float* scr, int lane) {
#pragma unroll 8
    for (int i = 0; i < 32; ++i) { const int kk = 2 * i + (lane >> 5), c = lane & 31;
        float v = (c < nvalid) ? W[(size_t)(k0 + kk) * N + src0 + c] : 0.f;
        if (gk) v *= gk[k0 + kk];
        scr[kk * 33 + c] = v; }
    LDS_WAIT();
    const int c8 = lane & 7;
#pragma unroll
    for (int j = 0; j < 4; ++j) { const int n = (lane >> 3) + 8 * j; const LAS float* s = scr + (8 * c8) * 33 + n;
        u32x4 o; o.x = cvtpk(s[0 * 33], s[1 * 33]); o.y = cvtpk(s[2 * 33], s[3 * 33]); o.z = cvtpk(s[4 * 33], s[5 * 33]); o.w = cvtpk(s[6 * 33], s[7 * 33]);
        *(u32x4*)(WT + (size_t)(rho0 + n) * K + k0 + 8 * c8) = o; }
    LDS_WAIT();
}
DI void block_src(int mapk, int q  , int& src0, int& nvalid) {
    if (mapk == 0) { src0 = 32 * q; nvalid = 32; return; }
    const int pn = q >> 3, bj = (q >> 2) & 1, wc = q & 3, s = 4 * pn + wc;
    if (mapk == 1) { int src, kind; in_slot_src(s, src, kind);
        if (kind == 0) { src0 = src + 32 * bj; nvalid = 32; } else if (kind == 1) { src0 = src + 16 * bj; nvalid = 16; } else { src0 = 0; nvalid = 0; } }
    else if (mapk == 2) { if (s < 8) { src0 = 96 * s + 32 * bj; nvalid = 32; } else { src0 = 96 * (s - 8) + 64 + 16 * bj; nvalid = 16; } }
    else if (mapk == 3) { if (s < 8) { src0 = 128 * s + 32 * bj; nvalid = 32; } else { src0 = 128 * (s - 8) + 64 + 32 * bj; nvalid = 32; } }
    else { src0 = 64 * s + 32 * bj; nvalid = 32; }
}
DI void convert_matrix(const float* W, int K, int N, int Nt, const float* gk, bf16_t* WT, int mapk, LAS float* scr, int gw, int NGW, int lane) {
    const int nblk = Nt / 32, items = (K / 64) * nblk;
    for (int it = gw; it < items; it += NGW) {
        const int kb = it / nblk, q = it % nblk; int src0, nvalid; block_src(mapk, q, src0, nvalid);
        transpose_item(W, K, N, gk, WT, 32 * q, 64 * kb, src0, nvalid, scr, lane);
    }
}
DI void convert_layer(int l, LAS unsigned char* lds, int gw, int NGW, int wave) {
    const int lane = lane_id();
    CParams* q = fresh_params();
    LAS float* scr = (LAS float*)(lds + wave * 16384);
    unsigned char* ws = q->ws;
    convert_matrix(q->in[4] + (size_t)l * D * N_IN, D, N_IN, NT_IN, q->in[3] + l * D, (bf16_t*)(ws + WS_WIN), 1, scr, gw, NGW, lane);
    convert_matrix(q->in[11] + (size_t)l * 384 * 768, 384, 768, 1024, q->in[9] + l * 384, (bf16_t*)(ws + WS_WUQ), 2, scr, gw, NGW, lane);
    convert_matrix(q->in[12] + (size_t)l * 256 * 1024, 256, 1024, 1024, q->in[10] + l * 256, (bf16_t*)(ws + WS_WUKV), 3, scr, gw, NGW, lane);
    convert_matrix(q->in[18] + (size_t)l * D * 1024, D, 1024, 1024, q->in[17] + l * D, (bf16_t*)(ws + WS_WMKV), 4, scr, gw, NGW, lane);
    for (int n = 0; n < 4; ++n)
        convert_matrix(q->in[21] + ((size_t)l * 4 + n) * 512 * D, 512, D, D, nullptr, (bf16_t*)(ws + WS_WBR) + (size_t)n * D * 512, 0, scr, gw, NGW, lane);
    convert_matrix(q->in[22] + (size_t)l * D * D, D, D, D, nullptr, (bf16_t*)(ws + WS_WOUT), 0, scr, gw, NGW, lane);
    convert_matrix(q->in[24] + (size_t)l * D * DFF, D, DFF, DFF, q->in[23] + l * D, (bf16_t*)(ws + WS_WUP), 0, scr, gw, NGW, lane);
    convert_matrix(q->in[25] + (size_t)l * DFF * D, DFF, D, D, nullptr, (bf16_t*)(ws + WS_WDN), 0, scr, gw, NGW, lane);
}

DI int crow(int i, int h) { return (i & 3) + 8 * (i >> 2) + 4 * h; }
DI f32x16 mfma32(bf16x8 a, bf16x8 b, f32x16 c) { return __builtin_amdgcn_mfma_f32_32x32x16_bf16(a, b, c, 0, 0, 0); }
DI bf16x8 packp(const f32x16& x, int s) { u32x4 w; w.x = cvtpk(x[8 * s], x[8 * s + 1]); w.y = cvtpk(x[8 * s + 2], x[8 * s + 3]); w.z = cvtpk(x[8 * s + 4], x[8 * s + 5]); w.w = cvtpk(x[8 * s + 6], x[8 * s + 7]); return __builtin_bit_cast(bf16x8, w); }
DI s16x4 vtr(const LAS char* p) { return __builtin_bit_cast(s16x4, __builtin_amdgcn_ds_read_tr16_b64_v4i16((LAS s16x4*)p)); }

DI float xhalf_max(float v) { auto rr = __builtin_amdgcn_permlane32_swap(__float_as_uint(v), __float_as_uint(v), false, false); return fmaxf(__uint_as_float(rr[0]), __uint_as_float(rr[1])); }
DI float xhalf_sum(float v) { auto rr = __builtin_amdgcn_permlane32_swap(__float_as_uint(v), __float_as_uint(v), false, false); return __uint_as_float(rr[0]) + __uint_as_float(rr[1]); }
DI f32x16 splat16(float v) { f32x16 p;
#pragma unroll
    for (int i = 0; i < 16; ++i) p[i] = v;
    return p; }
template <int DQK, int NT, int TSTRIDE> DI void st_tiles(unsigned kaddr, const bf16x8* qf, const f32x16& init, f32x16* p) {
    bf16x8 a[NT][DQK / 16];
#pragma unroll
    for (int j = 0; j < NT; ++j)
#pragma unroll
        for (int ks = 0; ks < DQK / 16; ++ks) asm volatile("ds_read_b128 %0, %1 offset:%2" : "=v"(a[j][ks]) : "v"(kaddr), "i"(j * TSTRIDE + ks * 32));
    asm volatile("s_waitcnt lgkmcnt(0)" ::: "memory");
#pragma unroll
    for (int j = 0; j < NT; ++j)
#pragma unroll
        for (int ks = 0; ks < DQK / 16; ++ks) asm volatile("" : "+v"(a[j][ks]));
#pragma unroll
    for (int j = 0; j < NT; ++j) p[j] = init;
#pragma unroll
    for (int ks = 0; ks < DQK / 16; ++ks)
#pragma unroll
        for (int j = 0; j < NT; ++j) p[j] = mfma32(a[j][ks], qf[ks], p[j]);
}
template <int DV, int VP> DI void pv_tile(f32x16* o, const LAS char* vp, const f32x16& p, int h) {
#pragma unroll
    for (int s = 0; s < 2; ++s) {
        const bf16x8 pa = packp(p, s);
#pragma unroll
        for (int db = 0; db < DV / 32; ++db) {
            const s16x4 lo = vtr(vp + (16 * s + 4 * h) * VP + db * 64);
            const s16x4 hi = vtr(vp + (16 * s + 8 + 4 * h) * VP + db * 64);
            const bf16x8 vb = __builtin_shufflevector(lo, hi, 0, 1, 2, 3, 4, 5, 6, 7);
            o[db] = mfma32(pa, vb, o[db]);
        }
    }
}
template <int NDB> DI void scale_o(f32x16* o, float f, LAS float* sc, int r, int h) {
    if (h == 0) sc[r] = f;
    LDS_WAIT();
#pragma unroll
    for (int g = 0; g < 4; ++g) { const f32x4 f4 = *(const LAS f32x4*)(sc + 8 * g + 4 * h);
#pragma unroll
        for (int db = 0; db < NDB; ++db)
#pragma unroll
            for (int j = 0; j < 4; ++j) o[db][4 * g + j] *= f4[j]; }
    LDS_WAIT();
}
template <int NDB> DI void store_o(const f32x16* o, bf16_t* obase  , long rstride, int r, int h) {
#pragma unroll
    for (int i = 0; i < 16; ++i) { bf16_t* rp = obase + (long)crow(i, h) * rstride + r;
#pragma unroll
        for (int db = 0; db < NDB; ++db) rp[32 * db] = (bf16_t)(cvtpk(o[db][i], 0.f) & 0xffffu); }
}

constexpr int BKP = 144, BVP = 144;
constexpr int BSLOT = 256 * BKP + 256 * BVP;

DI void banded_load(LAS char* dst, int pitch, const bf16_t* src  , int ld, long row0  , int dil, int gi0, int tid) {
#pragma unroll
    for (int it = 0; it < 4; ++it) {
        const int c = tid + it * NTHREADS, key = c >> 3, cc = c & 7, gi = gi0 + key;
        u32x4 v = (u32x4){0u, 0u, 0u, 0u};
        if (gi >= 0) v = *(const u32x4*)(src + (row0 + (long)gi * dil) * ld + cc * 8);
        *(LAS u32x4*)(dst + key * pitch + cc * 16) = v;
    }
}
template <bool SINK, bool WANT_LSE>
DI void banded_task(const bf16_t* qrow  , bf16_t* obase, long rstride, const LAS char* Ks, const LAS char* Vs,
                    int wq, int jblk, int maxd, float sink2, float* lsep, LAS float* sc, int lane) {
    const int r = lane & 31, h = lane >> 5;
    bf16x8 qf[4];
#pragma unroll
    for (int ks = 0; ks < 4; ++ks) qf[ks] = *(const bf16x8*)(qrow + 16 * ks + 8 * h);
    f32x16 p[5];
    const f32x16 zero16 = splat16(0.f);
    { const unsigned ka = (unsigned)(uintptr_t)(Ks + (32 * wq + r) * BKP + 16 * h);
      st_tiles<64, 3, 32 * BKP>(ka, qf, zero16, p); st_tiles<64, 2, 32 * BKP>(ka + 96 * BKP, qf, zero16, p + 3); }
    const int tmin = (jblk == 0) ? 4 - wq : 0, lo = r + 128 - maxd;
#pragma unroll
    for (int t = 0; t < 5; ++t) {
        if (t < tmin) { p[t] = splat16(NEGBIG); }
        else if (t == 0) {
#pragma unroll
            for (int i = 0; i < 16; ++i) p[t][i] = (crow(i, h) >= lo) ? p[t][i] : NEGBIG;
        } else if (t == 4) {
#pragma unroll
            for (int i = 0; i < 16; ++i) p[t][i] = (crow(i, h) <= r) ? p[t][i] : NEGBIG;
        }
    }
    float mx = NEGBIG;
#pragma unroll
    for (int t = 0; t < 5; ++t)
#pragma unroll
        for (int i = 0; i < 16; ++i) mx = fmaxf(mx, p[t][i]);
    mx = xhalf_max(mx);
    if (SINK) mx = fmaxf(mx, sink2);
    float l = 0.f;
#pragma unroll
    for (int t = 0; t < 5; ++t)
#pragma unroll
        for (int i = 0; i < 16; ++i) { const float e = __builtin_amdgcn_exp2f(p[t][i] - mx); p[t][i] = e; l += e; }
    l = xhalf_sum(l);
    if (SINK) l += __builtin_amdgcn_exp2f(sink2 - mx);
    f32x16 o[2];
#pragma unroll
    for (int i = 0; i < 16; ++i) { o[0][i] = 0.f; o[1][i] = 0.f; }
    const LAS char* vl = Vs + ((lane & 15) >> 2) * BVP + ((lane >> 4) & 1) * 32 + (lane & 3) * 8;
#pragma unroll
    for (int t = 0; t < 5; ++t) pv_tile<64, BVP>(o, vl + 32 * (wq + t) * BVP, p[t], h);
    scale_o<2>(o, 1.f / l, sc, r, h);
    store_o<2>(o, obase, rstride, r, h);
    if (WANT_LSE) { if (h == 0) *lsep = mx + __builtin_amdgcn_logf(l); }
}

template <int DQK, int DV, bool CAUSAL, bool SPLITK, bool PF2>
DI void dense_unit(const bf16_t* Q, int ldq, const bf16_t* K1, int ldk1, const bf16_t* K2, int ldk2, const bf16_t* V, int ldv, bf16_t* O, int ldo,
                   int q0  , int ntiles, LAS char* lds, LAS float* sc, int tid) {
    constexpr int KP = DQK * 2 + 16, VP = DV * 2 + 16, KCH = DQK / 8, VCH = DV / 8, NK = 64 * KCH, NCH = NK + 64 * VCH, NIT = (NCH + NTHREADS - 1) / NTHREADS;
    constexpr int KBUF = 64 * KP, VBUF = 64 * VP;
    const int lane = tid & 63, w = __builtin_amdgcn_readfirstlane(tid >> 6), r = lane & 31, h = lane >> 5;
    LAS char* kb0 = lds; LAS char* vb0 = lds + 2 * KBUF;
    bf16x8 qf[DQK / 16];
    { const bf16_t* qr = Q + (long)(32 * w + r) * ldq;
#pragma unroll
      for (int ks = 0; ks < DQK / 16; ++ks) { qf[ks] = *(const bf16x8*)(qr + 16 * ks + 8 * h); asm volatile("" : "+v"(qf[ks])); } }
    u32x4 preA[NIT], preB[PF2 ? NIT : 1];
    auto gload = [&](int t, u32x4* pre) {
        const int tid2 = opaque(tid);
#pragma unroll
        for (int it = 0; it < NIT; ++it) { const int c = tid2 + it * NTHREADS;
            if (c < NK) { const int key = c / KCH, cc = c % KCH; const long kr = (long)(64 * t + key);
                pre[it] = (SPLITK && cc >= 8) ? *(const u32x4*)(K2 + kr * ldk2 + (cc - 8) * 8) : *(const u32x4*)(K1 + kr * ldk1 + cc * 8); }
            else if (c < NCH) { const int c2 = c - NK, key = c2 / VCH, cc = c2 % VCH; pre[it] = *(const u32x4*)(V + (long)(64 * t + key) * ldv + cc * 8); } }
    };
    auto lstore = [&](int b, const u32x4* pre) {
        const int tid2 = opaque(tid);
#pragma unroll
        for (int it = 0; it < NIT; ++it) { const int c = tid2 + it * NTHREADS;
            if (c < NK) { const int key = c / KCH, cc = c % KCH; *(LAS u32x4*)(kb0 + b * KBUF + key * KP + cc * 16) = pre[it]; }
            else if (c < NCH) { const int c2 = c - NK, key = c2 / VCH, cc = c2 % VCH; *(LAS u32x4*)(vb0 + b * VBUF + key * VP + cc * 16) = pre[it]; } }
    };
    gload(0, preA); lstore(0, preA);
    if (PF2 && ntiles > 1) gload(1, preA);
    __syncthreads();
    float m = 0.f, l = 0.f; bool first = true;
    f32x16 negm = splat16(0.f);
    f32x16 o[DV / 32];
#pragma unroll
    for (int db = 0; db < DV / 32; ++db)
#pragma unroll
        for (int i = 0; i < 16; ++i) o[db][i] = 0.f;
    const int qpos = q0 + 32 * w + r;
    auto compute = [&](int t, int b) {
        if (!CAUSAL || 64 * t <= q0 + 32 * w) {
            const LAS char* kp = kb0 + b * KBUF + r * KP + 16 * h;
            f32x16 pp[2]; st_tiles<DQK, 2, 32 * KP>((unsigned)(uintptr_t)kp, qf, negm, pp);
            f32x16& p0 = pp[0]; f32x16& p1 = pp[1];
            if (CAUSAL && 64 * t + 63 > q0 + 32 * w) {
#pragma unroll
                for (int i = 0; i < 16; ++i) { const int key = 64 * t + crow(i, h); if (key > qpos) p0[i] = NEGBIG; if (key + 32 > qpos) p1[i] = NEGBIG; }
            }
            float mx = NEGBIG;
#pragma unroll
            for (int i = 0; i < 16; ++i) mx = fmaxf(mx, fmaxf(p0[i], p1[i]));
            mx = xhalf_max(mx);
            if (first || __any(mx > 8.f)) {
                const float dl = first ? mx : (mx > 8.f ? mx : 0.f);
                m += dl;
                const float f = __builtin_amdgcn_exp2f(-dl);
                l *= f;
#pragma unroll
                for (int i = 0; i < 16; ++i) { p0[i] -= dl; p1[i] -= dl; }
                if (!first) scale_o<DV / 32>(o, f, sc, r, h);
                negm = splat16(-m);
                first = false;
            }
#pragma unroll
            for (int i = 0; i < 16; ++i) { p0[i] = __builtin_amdgcn_exp2f(p0[i]); p1[i] = __builtin_amdgcn_exp2f(p1[i]); l += p0[i] + p1[i]; }
            const LAS char* vl = vb0 + b * VBUF + ((lane & 15) >> 2) * VP + ((lane >> 4) & 1) * 32 + (lane & 3) * 8;
            pv_tile<DV, VP>(o, vl, p0, h);
            pv_tile<DV, VP>(o, vl + 32 * VP, p1, h);
        }
    };
    if (PF2) {
        for (int t = 0; t < ntiles; t += 2) {
            if (t + 2 < ntiles) gload(t + 2, preB);
            compute(t, 0);
            if (t + 1 < ntiles) lstore(1, preA);
            __syncthreads();
            if (t + 1 >= ntiles) break;
            if (t + 3 < ntiles) gload(t + 3, preA);
            compute(t + 1, 1);
            if (t + 2 < ntiles) lstore(0, preB);
            __syncthreads();
        }
    } else {
        for (int t = 0; t < ntiles; ++t) {
            const int b = t & 1;
            if (t + 1 < ntiles) gload(t + 1, preA);
            compute(t, b);
            if (t + 1 < ntiles) lstore(b ^ 1, preA);
            __syncthreads();
        }
    }
    l = xhalf_sum(l);
    scale_o<DV / 32>(o, 1.f / l, sc, r, h);
    store_o<DV / 32>(o, O + (long)(32 * w) * ldo, ldo, r, h);
}


#define XB_TMO      128
#define XB_XCNT(j)  (256  + 64 * (j))
#define XB_XSUB(j)  (1280 + 64 * (j))
#define XB_XGEN(j)  (2304 + 64 * (j))
#define XB_TOP      3328
#define XB_TOPGEN   3392
#define XCD_BAR_WORDS 3456
#define XB_SPIN_CAP (1u << 22)
DI unsigned xb_ld(unsigned* p)              { return __hip_atomic_load(p, __ATOMIC_RELAXED, __HIP_MEMORY_SCOPE_AGENT); }
DI unsigned xb_add(unsigned* p, unsigned v) { return __hip_atomic_fetch_add(p, v, __ATOMIC_RELAXED, __HIP_MEMORY_SCOPE_AGENT); }
DI unsigned xb_xcc_id() { return (unsigned)__builtin_amdgcn_s_getreg((3 << 11) | 20) & 0xFu; }
#define XB_SPIN(cond, bar) do { unsigned _sp = 0; while (cond) { __builtin_amdgcn_s_sleep(1); \
    if ((++_sp & 255u) == 0u) { if (xb_ld(&(bar)[XB_TMO])) break; if (_sp > XB_SPIN_CAP) { atomicAdd(&(bar)[XB_TMO], 1u); break; } } } } while (0)
struct XcdBarrier { unsigned* bar; unsigned x; volatile LAS unsigned* st; };
DI XcdBarrier xcd_barrier_post(unsigned* bar, volatile LAS unsigned* st) {
    XcdBarrier b; b.bar = bar; b.x = xb_xcc_id(); b.st = st;
    if (threadIdx.x == 0) (void)xb_add(&bar[XB_XCNT(b.x)], 1u);
    return b;
}
DI void xcd_barrier_complete(unsigned* bar, unsigned x, unsigned& nloc, unsigned& nx) {
    const unsigned G = gridDim.x * gridDim.y * gridDim.z;
    unsigned sum, cnt, mine, sp = 0u;
    for (;;) {
        sum = 0u; cnt = 0u; mine = 0u;
#pragma unroll
        for (unsigned j = 0; j < 16; ++j) { const unsigned c = xb_ld(&bar[XB_XCNT(j)]); sum += c; cnt += (c > 0u) ? 1u : 0u; mine = (j == x) ? c : mine; }
        if (sum == G) break;
        __builtin_amdgcn_s_sleep(1);
        if ((++sp & 255u) == 0u) { if (xb_ld(&bar[XB_TMO])) break; if (sp > XB_SPIN_CAP) { atomicAdd(&bar[XB_TMO], 1u); break; } }
    }
    nloc = mine > 0u ? mine : 1u; nx = cnt > 0u ? cnt : 1u;
}
DI void xcd_barrier(unsigned* bar, unsigned x, volatile LAS unsigned* st) {
    asm volatile("s_waitcnt vmcnt(0)" ::: "memory");
    __syncthreads();
    if (threadIdx.x == 0) {
        __builtin_amdgcn_s_waitcnt(0);
        unsigned nloc = st[0], nx = st[1];
        if (nloc == 0u) { xcd_barrier_complete(bar, x, nloc, nx); st[0] = nloc; st[1] = nx; }
        const unsigned old = xb_add(&bar[XB_XSUB(x)], 1u);
        const unsigned gen = old / nloc;
        if (old + 1u == (gen + 1u) * nloc) {
            __builtin_amdgcn_fence(__ATOMIC_RELEASE, "agent");
            asm volatile("s_waitcnt vmcnt(0)" ::: "memory");
            const unsigned og = xb_add(&bar[XB_TOP], 1u);
            const unsigned tg = og / nx;
            if (og + 1u == (tg + 1u) * nx) xb_add(&bar[XB_TOPGEN], 1u);
            else XB_SPIN(xb_ld(&bar[XB_TOPGEN]) == tg, bar);
            __builtin_amdgcn_fence(__ATOMIC_ACQUIRE, "agent");
            xb_add(&bar[XB_XGEN(x)], 1u);
            asm volatile("s_waitcnt vmcnt(0)" ::: "memory");
        } else {
            XB_SPIN(xb_ld(&bar[XB_XGEN(x)]) == gen, bar);
            __builtin_amdgcn_fence(__ATOMIC_ACQUIRE, "agent");
            asm volatile("s_waitcnt vmcnt(0)" ::: "memory");
        }
    }
    __syncthreads();
}

DI void sincos_acc(float ang, float& c, float& s) {
    const double x = (double)ang;
    const double n = __builtin_rint(x * 0.63661977236758134308);
    double rr = __builtin_fma(-n, 1.57079632679489655800e+00, x); rr = __builtin_fma(-n, 6.12323399573676603587e-17, rr);
    const double r2 = rr * rr;
    const double sn = rr * (1.0 + r2 * (-1.0 / 6 + r2 * (1.0 / 120 + r2 * (-1.0 / 5040 + r2 * (1.0 / 362880 + r2 * (-1.0 / 39916800 + r2 * (1.0 / 6227020800.0)))))));
    const double cs = 1.0 + r2 * (-0.5 + r2 * (1.0 / 24 + r2 * (-1.0 / 720 + r2 * (1.0 / 40320 + r2 * (-1.0 / 3628800 + r2 * (1.0 / 479001600.0))))));
    const int q = ((int)n) & 3;
    const double cc = (q == 0) ? cs : (q == 1) ? -sn : (q == 2) ? -cs : sn;
    const double ss = (q == 0) ? sn : (q == 1) ? cs : (q == 2) ? -sn : -cs;
    c = (float)cc; s = (float)ss;
}

#ifndef PH
#define PH 255
#endif
#ifndef REP_P1
#define REP_P1 1
#endif
#ifndef REP_B
#define REP_B 1
#endif
#ifndef REP_CONV
#define REP_CONV 1
#endif
#ifndef REP_P7
#define REP_P7 1
#endif
#define GRID_SYNC() do { CParams* qb_ = fresh_params(); xcd_barrier((unsigned*)(qb_->ws + WS_CTL), xcc, MISC); } while (0)

__global__ void __launch_bounds__(NTHREADS, 2) fwd_megakernel(Params p) {
    extern __shared__ __attribute__((aligned(16))) unsigned char lds_raw[];
    cg::grid_group grid = cg::this_grid();
    LAS unsigned char* lds = (LAS unsigned char*)lds_raw;
    const int wave = __builtin_amdgcn_readfirstlane((int)threadIdx.x >> 6);
    const int G = gridDim.x, bid = blockIdx.x;
    const int gw = bid * NWAVES + wave, NGW = G * NWAVES;
    LAS float* sc = (LAS float*)(lds + LDS_SCR) + wave * 64;
    volatile LAS unsigned* MISC = (volatile LAS unsigned*)(lds + LDS_SCR + 2048);
    if (threadIdx.x < 4) MISC[threadIdx.x] = 0u;
    __syncthreads();
    unsigned xcc;
    { CParams* q0 = fresh_params(); const XcdBarrier xb = xcd_barrier_post((unsigned*)(q0->ws + WS_CTL), MISC); xcc = xb.x; }

#ifndef NOPRO
    {
        PHASE_CTX
        float* COSH = (float*)(ws + WS_COSH); float* SINH = (float*)(ws + WS_SINH); float* COSR = (float*)(ws + WS_COSR); float* SINR = (float*)(ws + WS_SINR);
        const float* x = q->in[0]; const int* pos = (const int*)q->in[2];
        const int lane = lane_id(), tid = wave * 64 + lane;
        for (int i = bid * NTHREADS + tid; i < TT * 32; i += G * NTHREADS) { const int t = i >> 5, k = i & 31; float c, s; sincos_acc((float)pos[t] * q->inv_h[k], c, s); COSH[i] = c; SINH[i] = s; }
        for (int i = bid * NTHREADS + tid; i < TT * 16; i += G * NTHREADS) { const int t = i >> 4, k = i & 15; float c, s; sincos_acc((float)pos[t] * q->inv_r[k], c, s); COSR[i] = c; SINR[i] = s; }
        for (int row = gw; row < TT; row += NGW) {
            const f32x4* xr = (const f32x4*)(x + (size_t)row * D) + lane; float ss = 0.f;
            u32x2* o8 = (u32x2*)(XB + (size_t)row * D) + lane;
#pragma unroll
            for (int j = 0; j < 4; ++j) { const f32x4 v = xr[64 * j]; ss += (v.x * v.x + v.y * v.y) + (v.z * v.z + v.w * v.w); u32x2 w; w.x = cvtpk(v.x, v.y); w.y = cvtpk(v.z, v.w); o8[64 * j] = w; }
            ss = wave_sum(ss);
            if (lane < 16) PX[(size_t)row * 16 + lane] = lane == 0 ? ss : 0.f;
        }
        const float* mem = q->in[1]; bf16_t* MEMN = (bf16_t*)(ws + WS_MEMN);
        for (int row = gw; row < BATCH * NMEM; row += NGW) {
            const f32x4* xr = (const f32x4*)(mem + (size_t)row * D) + lane; f32x4 v[4]; float ss = 0.f;
#pragma unroll
            for (int j = 0; j < 4; ++j) { v[j] = xr[64 * j]; ss += (v[j].x * v[j].x + v[j].y * v[j].y) + (v[j].z * v[j].z + v[j].w * v[j].w); }
            const float rstd = __builtin_amdgcn_rsqf(wave_sum(ss) * (1.f / D) + EPS);
            u32x2* o8 = (u32x2*)(MEMN + (size_t)row * D) + lane;
#pragma unroll
            for (int j = 0; j < 4; ++j) { u32x2 w; w.x = cvtpk(v[j].x * rstd, v[j].y * rstd); w.y = cvtpk(v[j].z * rstd, v[j].w * rstd); o8[64 * j] = w; }
        }
    }

#endif
    for (int l = 0; l < DEPTH; ++l) {
#ifndef NOCONV
#pragma unroll 1
        for (int rep = 0; rep < REP_CONV; ++rep) convert_layer(l, lds, gw, NGW, wave);
#endif
        if (l == 0) grid.sync(); else GRID_SYNC();
        for (int ch = 0; ch < NCHUNK; ++ch) {
            const int tok0 = ch * TC;
#if PH & 1
            {
                PHASE_CTX
                pg8::TileOrder S; S.init(TC, NT_IN, G, bid, XB + (size_t)tok0 * D, (const bf16_t*)(ws + WS_WIN));
                EpiSlot<CfgIn> E{CfgIn{ws, q->in[6] + l * 64, q->in[7] + l * 64, q->in[14] + l * 96, q->in[15] + l * 192, q->in[16] + l * 192, q->in[5] + l * 4096},
                                 RowScale{PX, 16, 16, 1.f / D}, tok0, rt, tok0};
#pragma unroll 1
                for (int rep = 0; rep < REP_P1; ++rep) pg8::gemm_phase(lds, D, D, S, E, wave);
                if (ch == 0) {
                    pg8::TileOrder S2; S2.init(BATCH * NMEM, 1024, G, (bid + 128) % G, (const bf16_t*)(ws + WS_MEMN), (const bf16_t*)(ws + WS_WMKV));
                    EpiSlot<CfgMkv> E2{CfgMkv{ws}, RowScale{nullptr, 0, 0, 0.f}, 0, rt, 0};
                    pg8::gemm_phase(lds, D, D, S2, E2, wave);
                }
            }

#endif
            GRID_SYNC();
#if PH & 2
            {
                PHASE_CTX
                pg8::TileOrder S; S.init(TC, 1024, G, bid, (const bf16_t*)(ws + WS_CQ), (const bf16_t*)(ws + WS_WUQ));
                EpiSlot<CfgUq> E{CfgUq{ws, q->in[13] + l * 96}, RowScale{(const float*)(ws + WS_PCQ), 8, 6, 1.f / 384.f}, 0, rt, tok0};
                pg8::gemm_phase(lds, 384, 384, S, E, wave);
                pg8::TileOrder S2; S2.init(TC, 1024, G, bid, (const bf16_t*)(ws + WS_CKV), (const bf16_t*)(ws + WS_WUKV));
                EpiSlot<CfgUkv> E2{CfgUkv{ws, q->in[14] + l * 96}, RowScale{(const float*)(ws + WS_PCKV), 4, 4, 1.f / 256.f}, 0, rt, tok0};
                pg8::gemm_phase(lds, 256, 256, S2, E2, wave);
                const int lane = opaque(lane_id());
                const int nrows = TC + (ch == 0 ? BATCH * NMEM : 0);
                for (int rw = gw; rw < nrows; rw += NGW) {
                    const bool isq = rw < TC;
                    bf16_t* rp = isq ? (bf16_t*)(ws + WS_MQ) + (size_t)rw * 512 : (bf16_t*)(ws + WS_MK) + (size_t)(rw - TC) * 512;
                    const float* gn = (isq ? q->in[19] : q->in[20]) + l * 128 + (lane & 15) * 8;
                    const float scl = isq ? 0.08838834764831845f * LOG2E : 1.f;
                    float v[8]; unpack8(*(const u32x4*)(rp + lane * 8), v);
                    float ss = 0.f;
#pragma unroll
                    for (int i = 0; i < 8; ++i) ss += v[i] * v[i];
                    ss += __shfl_xor(ss, 1); ss += __shfl_xor(ss, 2); ss += __shfl_xor(ss, 4); ss += __shfl_xor(ss, 8);
                    const float inv = __builtin_amdgcn_rsqf(ss * (1.f / 128.f) + EPS) * scl;
#pragma unroll
                    for (int i = 0; i < 8; ++i) v[i] *= inv * gn[i];
                    *(u32x4*)(rp + lane * 8) = pack8(v);
                }
            }

#endif
            GRID_SYNC();
#if PH & 4
            {
                PHASE_CTX
                LAS char* al = (LAS char*)lds;
                const int lane = opaque(lane_id()), tid = wave * 64 + lane;
                const int vcu = (G % 8 == 0) ? (bid % 8) * (G / 8) + bid / 8 : bid;
#pragma unroll 1
                for (int rep = 0; rep < REP_B; ++rep)
                for (int idx = vcu; idx < BC * 8 * 16; idx += G) {
                    const int half = idx / (BC * 64), rem = idx % (BC * 64), bh = rem / 8, s = rem % 8;
                    const int qb = half == 0 ? s : 15 - s, b = bh / 8, hh = bh % 8;
                    const long r0 = (long)b * SEQ;
                    dense_unit<96, 64, true, true, true>((const bf16_t*)(ws + WS_QB) + (r0 + 256 * qb) * 768 + 96 * hh, 768,
                        (const bf16_t*)(ws + WS_KN) + r0 * 512 + 64 * hh, 512, (const bf16_t*)(ws + WS_KR) + r0 * 32, 32,
                        (const bf16_t*)(ws + WS_VB) + r0 * 512 + 64 * hh, 512, (bf16_t*)(ws + WS_OB) + (r0 + 256 * qb) * 512 + 64 * hh, 512,
                        256 * qb, 4 * (qb + 1), al, sc, tid);
                }
                for (int idx = vcu; idx < 3 * BC * 32 * 4; idx += G) {
                    const int g = idx / (BC * 128), rem = idx % (BC * 128), hp = rem / (BC * 32), sj = rem % (BC * 32);
                    const int dil = g == 0 ? 1 : g == 1 ? 4 : 16, nb = 32 / dil;
                    const int n = sj / nb, j = sj % nb, b = n / dil, res = n % dil;
                    const long row0 = (long)b * SEQ + res;
                    const bf16_t* Qg = (const bf16_t*)(ws + WS_CB + (size_t)(3 * g) * 16 * MiB); const bf16_t* Kg = (const bf16_t*)(ws + WS_CB + (size_t)(3 * g + 1) * 16 * MiB); const bf16_t* Vg = (const bf16_t*)(ws + WS_CB + (size_t)(3 * g + 2) * 16 * MiB);
#pragma unroll
                    for (int sl = 0; sl < 2; ++sl) {
                        banded_load(al + sl * BSLOT, BKP, Kg + 64 * (2 * hp + sl), 512, row0, dil, 128 * (j - 1), tid);
                        banded_load(al + sl * BSLOT + 256 * BKP, BVP, Vg + 64 * (2 * hp + sl), 512, row0, dil, 128 * (j - 1), tid);
                    }
                    __syncthreads();
                    { const int sl = wave >> 2, wq = wave & 3, hd = 2 * hp + sl, r = lane & 31;
                      const long qtok = row0 + (long)(128 * j + 32 * wq + r) * dil;
                      bf16_t* ob = (bf16_t*)Qg + (row0 + (long)(128 * j + 32 * wq) * dil) * 512 + 64 * hd;
                      banded_task<false, true>(Qg + qtok * 512 + 64 * hd, ob, (long)dil * 512, al + sl * BSLOT, al + sl * BSLOT + 256 * BKP, wq, j, 128, 0.f,
                                               (float*)(ws + WS_LSE) + (qtok * 8 + hd) * 4 + g, sc, lane); }
                    __syncthreads();
                }
                for (int idx = vcu; idx < BC * 32 * 2; idx += G) {
                    const int j = idx & 31, kvh = (idx >> 5) & 1, b = idx >> 6;
                    const long row0 = (long)b * SEQ;
                    banded_load(al, BKP, (const bf16_t*)(ws + WS_KA) + 64 * kvh, 128, row0, 1, 128 * (j - 1), tid);
                    banded_load(al + 256 * BKP, BVP, (const bf16_t*)(ws + WS_VA) + 64 * kvh, 128, row0, 1, 128 * (j - 1), tid);
                    __syncthreads();
#pragma unroll 1
                    for (int pass = 0; pass < 2; ++pass) {
                        const int hq = kvh * 4 + (wave >> 2) + 2 * pass, wq = wave & 3, r = lane & 31;
                        const long qtok = row0 + 128 * j + 32 * wq + r;
                        bf16_t* QA = (bf16_t*)(ws + WS_QA);
                        banded_task<true, false>(QA + qtok * 512 + 64 * hq, QA + (row0 + 128 * j + 32 * wq) * 512 + 64 * hq, 512, al, al + 256 * BKP, wq, j, 127,
                                                 (q->in[8] + l * 8)[hq] * LOG2E, nullptr, sc, lane);
                    }
                    __syncthreads();
                }
                for (int idx = vcu; idx < BC * 4 * 16; idx += G) {
                    const int qb = idx & 15, hh = (idx >> 4) & 3, b = idx >> 6;
                    const long r0 = (long)b * SEQ + 256 * qb; const long m0 = (long)(ch * BC + b) * NMEM;
                    bf16_t* MQ = (bf16_t*)(ws + WS_MQ);
                    dense_unit<128, 128, false, false, false>(MQ + r0 * 512 + 128 * hh, 512, (const bf16_t*)(ws + WS_MK) + m0 * 512 + 128 * hh, 512, nullptr, 0,
                        (const bf16_t*)(ws + WS_MV) + m0 * 512 + 128 * hh, 512, MQ + r0 * 512 + 128 * hh, 512, 0, 4, al, sc, tid);
                }
            }

#endif
            GRID_SYNC();
#if PH & 8
            {
                PHASE_CTX
                const float* LSE = (const float*)(ws + WS_LSE); bf16_t* OC = (bf16_t*)(ws + WS_OC);
                const int tid = wave * 64 + opaque(lane_id());
                for (int i = bid * NTHREADS + tid; i < TC * 64; i += G * NTHREADS) {
                    const int tok = i >> 6, c8 = i & 63, hd = c8 >> 3;
                    const f32x4 ls = *(const f32x4*)(LSE + ((size_t)tok * 8 + hd) * 4);
                    const float mx = fmaxf(ls.x, fmaxf(ls.y, ls.z));
                    float w0 = __builtin_amdgcn_exp2f(ls.x - mx), w1 = __builtin_amdgcn_exp2f(ls.y - mx), w2 = __builtin_amdgcn_exp2f(ls.z - mx);
                    const float inv = 1.f / (w0 + w1 + w2); w0 *= inv; w1 *= inv; w2 *= inv;
                    float a[8], b[8], c[8], o[8];
                    unpack8(*(const u32x4*)((const bf16_t*)(ws + WS_CB) + (size_t)tok * 512 + c8 * 8), a);
                    unpack8(*(const u32x4*)((const bf16_t*)(ws + WS_CB + 48 * MiB) + (size_t)tok * 512 + c8 * 8), b);
                    unpack8(*(const u32x4*)((const bf16_t*)(ws + WS_CB + 96 * MiB) + (size_t)tok * 512 + c8 * 8), c);
#pragma unroll
                    for (int k = 0; k < 8; ++k) o[k] = w0 * a[k] + w1 * b[k] + w2 * c[k];
                    *(u32x4*)(OC + (size_t)tok * 512 + c8 * 8) = pack8(o);
                }
            }

#endif
            GRID_SYNC();
#if PH & 16
            {
                PHASE_CTX
                pg8::TileOrder S; S.init(TC, D, G, bid, (const bf16_t*)(ws + WS_QA), (const bf16_t*)(ws + WS_WBR)); S.nseg = 4;
                S.segA = 8 * MiB; S.segB = (size_t)D * 512;
                EpiMerge E{(const bf16_t*)(ws + WS_GATES), (bf16_t*)(ws + WS_GY)};
                pg8::gemm_phase(lds, 512, 512, S, E, wave);
            }

#endif
            GRID_SYNC();
#if PH & 32
            {
                PHASE_CTX
                pg8::TileOrder S; S.init(TC, D, G, bid, (const bf16_t*)(ws + WS_GY), (const bf16_t*)(ws + WS_WOUT));
                EpiRes E{((l == 0) ? q->in[0] : q->out) + (size_t)tok0 * D, q->out + (size_t)tok0 * D, XB + (size_t)tok0 * D, PX + (size_t)tok0 * 16};
                pg8::gemm_phase(lds, D, D, S, E, wave);
            }

#endif
            GRID_SYNC();
#if PH & 64
            {
                PHASE_CTX
                pg8::TileOrder S; S.init(TC, DFF, G, bid, XB + (size_t)tok0 * D, (const bf16_t*)(ws + WS_WUP));
                EpiUp E{(bf16_t*)(ws + WS_U), RowScale{PX, 16, 16, 1.f / D}, tok0};
#pragma unroll 1
                for (int rep = 0; rep < REP_P7; ++rep) pg8::gemm_phase(lds, D, D, S, E, wave);
            }

#endif
            GRID_SYNC();
#if PH & 128
            {
                PHASE_CTX
                pg8::TileOrder S; S.init(TC, D, G, bid, (const bf16_t*)(ws + WS_U), (const bf16_t*)(ws + WS_WDN));
                EpiRes E{q->out + (size_t)tok0 * D, q->out + (size_t)tok0 * D, XB + (size_t)tok0 * D, PX + (size_t)tok0 * 16};
                pg8::gemm_phase(lds, DFF, DFF, S, E, wave);
            }

#endif
            GRID_SYNC();
        }
    }
}

extern "C" void kernel_launch(void* const* d_in, const int* in_sizes, int n_in, void* d_out, int out_size, void* d_ws, size_t ws_size, hipStream_t stream) {
    static int grid = 0;
    if (grid == 0) {
        if (n_in != 26 || out_size != TT * D || ws_size < WS_END) { fprintf(stderr, "kernel_launch: unexpected shapes (n_in %d out %d ws %zu)\n", n_in, out_size, ws_size); grid = -1; return; }
        int dev = 0, cus = 0, per_cu = 0;
        hipGetDevice(&dev); hipDeviceGetAttribute(&cus, hipDeviceAttributeMultiprocessorCount, dev);
        hipFuncSetAttribute((const void*)fwd_megakernel, hipFuncAttributeMaxDynamicSharedMemorySize, LDS_BYTES);
        hipOccupancyMaxActiveBlocksPerMultiprocessor(&per_cu, (const void*)fwd_megakernel, NTHREADS, LDS_BYTES);
        if (per_cu < 1) { fprintf(stderr, "kernel_launch: occupancy query says %d blocks per CU\n", per_cu); per_cu = 1; }
        (void)hipGetLastError();
        grid = cus;
    }
    if (grid < 0) return;
    if (hipMemsetAsync((char*)d_ws + WS_CTL, 0, XCD_BAR_WORDS * 4, stream) != hipSuccess) { fprintf(stderr, "kernel_launch: memset failed\n"); return; }
    Params p{};
    for (int i = 0; i < 26; ++i) p.in[i] = (const float*)d_in[i];
    p.out = (float*)d_out; p.ws = (unsigned char*)d_ws;
    for (int i = 0; i < 32; ++i) p.inv_h[i] = (float)std::pow(10000.0, -(double)(2 * i) / 64.0);
    for (int i = 0; i < 16; ++i) p.inv_r[i] = (float)std::pow(10000.0, -(double)(2 * i) / 32.0);
    void* args[] = {&p};
    hipError_t e = hipLaunchCooperativeKernel((const void*)fwd_megakernel, dim3(grid), dim3(NTHREADS), args, LDS_BYTES, stream);
    if (e != hipSuccess) fprintf(stderr, "cooperative launch failed: %s (grid %d)\n", hipGetErrorString(e), grid);
}
```

```cpp
#include <hip/hip_runtime.h>
#include <hip/hip_cooperative_groups.h>
#include <cstdio>
#include <cstdint>
#include <cmath>
namespace cg = cooperative_groups;

#define LAS __attribute__((address_space(3)))
#define DI __device__ __forceinline__
typedef unsigned short bf16_t;
typedef short bf16x8 __attribute__((ext_vector_type(8)));
typedef short s16x4 __attribute__((ext_vector_type(4)));
typedef float f32x4 __attribute__((ext_vector_type(4)));
typedef float f32x16 __attribute__((ext_vector_type(16)));
typedef unsigned u32x4 __attribute__((ext_vector_type(4)));
typedef unsigned u32x2 __attribute__((ext_vector_type(2)));
typedef float f32x2_t __attribute__((ext_vector_type(2)));
typedef __bf16 bf16x2_t __attribute__((ext_vector_type(2)));

constexpr int D = 1024, BATCH = 8, SEQ = 4096, DEPTH = 4, TT = BATCH * SEQ;
constexpr int NCHUNK = 2, BC = BATCH / NCHUNK, TC = BC * SEQ;
constexpr int N_IN = 10656, NT_IN = 10752;
constexpr int DFF = 4096, NMEM = 256;
constexpr float EPS = 1e-6f;
constexpr float LOG2E = 1.4426950408889634f;
constexpr float NEGBIG = -1e30f;
constexpr int NTHREADS = 512, NWAVES = 8;

constexpr size_t MiB = 1u << 20;
constexpr size_t WS_CTL = 0;
constexpr size_t WS_WIN = 1 * MiB, WS_WUQ = 22 * MiB, WS_WUKV = 23 * MiB, WS_WMKV = 24 * MiB, WS_WBR = 26 * MiB, WS_WOUT = 30 * MiB, WS_WUP = 32 * MiB, WS_WDN = 40 * MiB;
constexpr size_t WS_XB = 48 * MiB, WS_PX = 112 * MiB, WS_COSH = 114 * MiB, WS_SINH = 118 * MiB, WS_COSR = 122 * MiB, WS_SINR = 124 * MiB;
constexpr size_t WS_MEMN = 126 * MiB, WS_MK = 130 * MiB, WS_MV = 132 * MiB;
constexpr size_t WS_QA = 134 * MiB, WS_OB = 150 * MiB, WS_OC = 166 * MiB, WS_MQ = 182 * MiB;
constexpr size_t WS_KA = 198 * MiB, WS_VA = 202 * MiB, WS_CQ = 206 * MiB, WS_CKV = 218 * MiB, WS_KR = 226 * MiB, WS_PCQ = 227 * MiB, WS_PCKV = 227 * MiB + 512 * 1024;
constexpr size_t WS_CB = 228 * MiB;
constexpr size_t WS_GATES = 372 * MiB, WS_U = WS_CB;
constexpr size_t WS_QB = 500 * MiB, WS_KN = 524 * MiB, WS_VB = 540 * MiB, WS_LSE = 556 * MiB, WS_GY = 558 * MiB;
constexpr size_t WS_END = 622 * MiB;

constexpr int LDS_BYTES = 155648;
constexpr int LDS_SCR = 149504;

struct Params {
    const float* in[26];
    float* out;
    unsigned char* ws;
    float inv_h[32];
    float inv_r[16];
    int pad[2];
};

DI unsigned cvtpk(float lo, float hi) { f32x2_t v = {lo, hi}; bf16x2_t b = __builtin_convertvector(v, bf16x2_t); return __builtin_bit_cast(unsigned, b); }
DI float bf_lo(unsigned w) { return __uint_as_float(w << 16); }
DI float bf_hi(unsigned w) { return __uint_as_float(w & 0xffff0000u); }
DI u32x4 pack8(const float* v) { u32x4 w; w.x = cvtpk(v[0], v[1]); w.y = cvtpk(v[2], v[3]); w.z = cvtpk(v[4], v[5]); w.w = cvtpk(v[6], v[7]); return w; }
DI void unpack8(u32x4 w, float* v) { v[0] = bf_lo(w.x); v[1] = bf_hi(w.x); v[2] = bf_lo(w.y); v[3] = bf_hi(w.y); v[4] = bf_lo(w.z); v[5] = bf_hi(w.z); v[6] = bf_lo(w.w); v[7] = bf_hi(w.w); }
DI float wave_sum(float v) {
#pragma unroll
    for (int o = 1; o < 64; o <<= 1) v += __shfl_xor(v, o);
    return v;
}
struct RopeTabs { const float* cosh; const float* sinh; const float* cosr; const float* sinr; };
typedef const struct Params __attribute__((address_space(4))) CParams;
DI CParams* fresh_params() { unsigned long long k = (unsigned long long)__builtin_amdgcn_kernarg_segment_ptr(); asm volatile("" : "+s"(k)); return (CParams*)k; }
#define PHASE_CTX \
    CParams* q = fresh_params(); unsigned char* ws = q->ws; (void)ws; \
    bf16_t* XB = (bf16_t*)(ws + WS_XB); float* PX = (float*)(ws + WS_PX); (void)XB; (void)PX; \
    const RopeTabs rt{(const float*)(ws + WS_COSH), (const float*)(ws + WS_SINH), (const float*)(ws + WS_COSR), (const float*)(ws + WS_SINR)}; (void)rt;
DI int opaque(int v) { asm volatile("" : "+v"(v)); return v; }
DI int lane_id() { int v; asm volatile("v_mbcnt_lo_u32_b32 %0, -1, 0\n\tv_mbcnt_hi_u32_b32 %0, -1, %0" : "=v"(v)); return v; }
#define LDS_WAIT() asm volatile("s_waitcnt lgkmcnt(0)" ::: "memory")

namespace pg8 {
constexpr int BM = 256, BK = 64, HALF = 128, HTB = HALF * BK * 2, STAGE_BYTES = 8 * HTB, NXCD = 8, WGM = 8;
DI int lds_byte(int r, int c) { const int st = (r >> 4) * 2 + (c >> 5), rr = r & 15, cc = c & 31, ob = rr * 64 + cc * 2; return st * 1024 + (ob ^ (((ob >> 9) & 1) << 5)); }
DI void stage_rc(int b, int& R, int& C) { const int st = b / 1024, sb = b % 1024, swz = sb ^ (((sb >> 9) & 1) << 5); R = (st >> 1) * 16 + swz / 64; C = (st & 1) * 32 + (swz % 64) / 2; }
DI int perm32(int rho) { const int n = rho >> 4, i = rho & 15; return 8 * (i >> 2) + 4 * n + (i & 3); }

struct Unit { int pm, pn, seg; const bf16_t* A; const bf16_t* Bt; };

struct TileOrder {
    int nM, nN, nwg, G, c, nseg;
    const bf16_t* A0; const bf16_t* B0; size_t segA, segB;
    DI void init(int M, int N, int G_, int c_, const bf16_t* A, const bf16_t* B) { nM = M / BM; nN = N / BM; nwg = nM * nN; G = G_; c = c_; nseg = 1; A0 = A; B0 = B; segA = 0; segB = 0; }
    DI bool next(int i, Unit& u) const {
        const int seg = i % nseg, ti = i / nseg;
        const long L = (long)ti * G + c; if (L >= nwg) return false;
        int wgid = (int)L; { const int q = nwg / NXCD, r = nwg % NXCD, xcd = wgid % NXCD, off = wgid / NXCD; wgid = (xcd < r ? xcd * (q + 1) : r * (q + 1) + (xcd - r) * q) + off; }
        const int nig = WGM * nN, gid = wgid / nig, fm = gid * WGM, gsz = (nM - fm) < WGM ? (nM - fm) : WGM;
        u.pm = fm + ((wgid % nig) % gsz); u.pn = (wgid % nig) / gsz; u.seg = seg;
        u.A = A0 + (size_t)seg * segA; u.Bt = B0 + (size_t)seg * segB;
        return true;
    }
};

template <class Epi, class Sched>
DI void gemm_phase(LAS unsigned char* lds, const int K, const int lda, const Sched& S, const Epi& E, const int wid) {
    const int lane = opaque(lane_id()), tid = wid * 64 + lane, wr = wid >> 2, wc = wid & 3, fr = lane & 15, fq = lane >> 4;
    const int nt = K / BK;
    unsigned voffA[2], voffB[2];
#pragma unroll
    for (int i = 0; i < 2; ++i) { int R, C; stage_rc(tid * 16 + i * 8192, R, C); const int Rb = (R & ~31) + perm32(R & 31);
        voffA[i] = (unsigned)(R * lda + C) * 2u; voffB[i] = (unsigned)(Rb * K + C) * 2u; }
    const size_t kstep = (size_t)(BK * 2);
    const size_t hstepA = (size_t)HALF * lda * 2, hstepB = (size_t)HALF * K * 2;
    const size_t tstepA = 2 * hstepA, tstepB = 2 * hstepB;
    const unsigned ldsw = (unsigned)wid * 1024u;
    const int aoff = lds_byte(wr * 64 + fr, fq * 8), boff = lds_byte(wc * 32 + fr, fq * 8);
#define PG8_SA(b, h) (((b) * 2 + (h)) * HTB)
#define PG8_SB(b, h) ((4 + (b) * 2 + (h)) * HTB)
#define PG8_STAGE(bufoff, gbase, voff) do { _Pragma("unroll") for (int _i = 0; _i < 2; ++_i) \
        __builtin_amdgcn_global_load_lds((const unsigned*)((const char*)(gbase) + (voff)[_i]), (LAS unsigned*)(lds + (bufoff) + ldsw + _i * 8192), 16, 0, 0); } while (0)
#define PG8_LDA(dst, b, h) do { _Pragma("unroll") for (int m = 0; m < 4; ++m) _Pragma("unroll") for (int k = 0; k < 2; ++k) dst[m][k] = *(const LAS bf16x8*)(lds + PG8_SA(b, h) + aoff + m * 2048 + k * 1024); } while (0)
#define PG8_LDB(dst, b, h) do { _Pragma("unroll") for (int n = 0; n < 2; ++n) _Pragma("unroll") for (int k = 0; k < 2; ++k) dst[n][k] = *(const LAS bf16x8*)(lds + PG8_SB(b, h) + boff + n * 2048 + k * 1024); } while (0)
#define PG8_MMA(ai, bj, At, Bt) do { __builtin_amdgcn_s_setprio(1); _Pragma("unroll") for (int m = 0; m < 4; ++m) _Pragma("unroll") for (int n = 0; n < 2; ++n) _Pragma("unroll") for (int k = 0; k < 2; ++k) \
        acc[ai][bj][m][n] = __builtin_amdgcn_mfma_f32_16x16x32_bf16(Bt[n][k], At[m][k], acc[ai][bj][m][n], 0, 0, 0); __builtin_amdgcn_s_setprio(0); } while (0)
#define PG8_WAIT_V(n) asm volatile("s_waitcnt vmcnt(" #n ")" ::: "memory")
#define PG8_WAIT_L(n) asm volatile("s_waitcnt lgkmcnt(" #n ")" ::: "memory")
#define PG8_BAR __builtin_amdgcn_s_barrier()
#define PG8_SCHED __builtin_amdgcn_sched_barrier(0)
    Unit cur, nxt; int ui = 0;
    if (!S.next(0, cur)) return;
    f32x4 acc[2][2][4][2];
#pragma unroll
    for (int a = 0; a < 2; ++a)
#pragma unroll
        for (int b = 0; b < 2; ++b)
#pragma unroll
            for (int m = 0; m < 4; ++m)
#pragma unroll
                for (int n = 0; n < 2; ++n) acc[a][b][m][n] = (f32x4){0.f, 0.f, 0.f, 0.f};
    bf16x8 At[4][2], B0[2][2], B1[2][2];
    const char* cA = (const char*)cur.A + (size_t)cur.pm * tstepA; const char* cB = (const char*)cur.Bt + (size_t)cur.pn * tstepB;
    PG8_STAGE(PG8_SB(0, 0), cB, voffB); PG8_STAGE(PG8_SB(0, 1), cB + hstepB, voffB); PG8_STAGE(PG8_SA(0, 0), cA, voffA); PG8_STAGE(PG8_SA(0, 1), cA + hstepA, voffA);
    if (wr == 1) PG8_BAR;
    PG8_WAIT_V(2); PG8_BAR;
    PG8_STAGE(PG8_SB(1, 0), cB + kstep, voffB); PG8_STAGE(PG8_SA(1, 0), cA + kstep, voffA); PG8_STAGE(PG8_SB(1, 1), cB + hstepB + kstep, voffB);
    PG8_WAIT_V(6); PG8_BAR;
    for (;;) {
        const bool has_next = S.next(ui + 1, nxt);
        const char* nA = has_next ? (const char*)nxt.A + (size_t)nxt.pm * tstepA : cA; const char* nB = has_next ? (const char*)nxt.Bt + (size_t)nxt.pn * tstepB : cB;
#pragma unroll 1
        for (int t = 0; t < nt; t += 2) {
            const bool last = (t == nt - 2);
            const char* a1 = cA + (size_t)(t + 1) * kstep;
            const char* a2 = last ? nA : cA + (size_t)(t + 2) * kstep; const char* b2 = last ? nB : cB + (size_t)(t + 2) * kstep;
            const char* a3 = a2 + kstep; const char* b3 = b2 + kstep;
            PG8_LDB(B0, 0, 0); PG8_LDB(B1, 0, 1); PG8_SCHED; PG8_LDA(At, 0, 0); PG8_STAGE(PG8_SA(1, 1), a1 + hstepA, voffA);
            PG8_WAIT_V(8); PG8_WAIT_L(0); PG8_BAR; PG8_MMA(0, 0, At, B0); PG8_MMA(0, 1, At, B1); PG8_BAR; PG8_SCHED;
            PG8_LDA(At, 0, 1); PG8_STAGE(PG8_SB(0, 0), b2, voffB); PG8_STAGE(PG8_SB(0, 1), b2 + hstepB, voffB); PG8_STAGE(PG8_SA(0, 0), a2, voffA);
            PG8_WAIT_V(8); PG8_WAIT_L(0); PG8_BAR; PG8_MMA(1, 0, At, B0); PG8_MMA(1, 1, At, B1); PG8_BAR; PG8_SCHED;
            PG8_LDB(B0, 1, 0); PG8_LDB(B1, 1, 1); PG8_SCHED; PG8_LDA(At, 1, 0); PG8_STAGE(PG8_SA(0, 1), a2 + hstepA, voffA);
            PG8_WAIT_V(8); PG8_WAIT_L(0); PG8_BAR; PG8_MMA(0, 0, At, B0); PG8_MMA(0, 1, At, B1); PG8_BAR; PG8_SCHED;
            PG8_LDA(At, 1, 1); PG8_STAGE(PG8_SB(1, 0), b3, voffB); PG8_STAGE(PG8_SB(1, 1), b3 + hstepB, voffB); PG8_STAGE(PG8_SA(1, 0), a3, voffA);
            PG8_WAIT_V(8); PG8_WAIT_L(0); PG8_BAR; PG8_MMA(1, 0, At, B0); PG8_MMA(1, 1, At, B1); PG8_BAR; PG8_SCHED;
        }
        if (wr == 0) PG8_BAR;
        E(acc, cur, wr, wc, fr, fq);
        if (!has_next) break;
#pragma unroll
        for (int a = 0; a < 2; ++a)
#pragma unroll
            for (int b = 0; b < 2; ++b)
#pragma unroll
                for (int m = 0; m < 4; ++m)
#pragma unroll
                    for (int n = 0; n < 2; ++n) acc[a][b][m][n] = (f32x4){0.f, 0.f, 0.f, 0.f};
        cur = nxt; cA = nA; cB = nB; ++ui;
        if (wr == 1) PG8_BAR;
    }
    PG8_WAIT_V(0);
    PG8_BAR;
#undef PG8_SA
#undef PG8_SB
#undef PG8_STAGE
#undef PG8_LDA
#undef PG8_LDB
#undef PG8_MMA
#undef PG8_WAIT_V
#undef PG8_WAIT_L
#undef PG8_BAR
#undef PG8_SCHED
}
}

struct RowScale {
    const float* part; int stride; int cnt; float inv_n;
    DI float get(int row) const {
        if (!part) return 1.f;
        float s = 0.f;
        const float* p = part + (size_t)row * stride;
        for (int i = 0; i < cnt; i += 4) { const f32x4 v = *(const f32x4*)(p + i); s += (v.x + v.y) + (v.z + v.w); }
        return __builtin_amdgcn_rsqf(s * inv_n + EPS);
    }
};

DI void rs_preload(const RowScale& rs, int rowbase, int fq, float (&out)[8]) {
    if (!rs.part) {
#pragma unroll
        for (int i = 0; i < 8; ++i) out[i] = 1.f;
        return;
    }
#pragma unroll
    for (int hb = 0; hb < 2; ++hb) {
        float s[4];
#pragma unroll
        for (int i = 0; i < 4; ++i) { s[i] = 0.f;
            if (4 * fq < rs.cnt) { const f32x4 v = *(const f32x4*)(rs.part + (size_t)(rowbase + hb * 128 + i * 16) * rs.stride + 4 * fq);
                s[i] = v.x + (4 * fq + 1 < rs.cnt ? v.y : 0.f) + (4 * fq + 2 < rs.cnt ? v.z : 0.f) + (4 * fq + 3 < rs.cnt ? v.w : 0.f); } }
#pragma unroll
        for (int i = 0; i < 4; ++i) { float t = s[i]; t += __shfl_xor(t, 16); t += __shfl_xor(t, 32); out[hb * 4 + i] = __builtin_amdgcn_rsqf(t * rs.inv_n + EPS); }
        asm volatile("" ::: "memory");
    }
}
enum { SK_SKIP = 0, SK_RAW = 1, SK_HEAD = 2, SK_ROPE32 = 3, SK_GATE = 4 };
struct SlotDesc { int kind; bf16_t* dst; int ld; int col; const float* gain; float scale; int rope; float* part; int pstride; int pidx; const float* bias; };


template <class Cfg>
struct EpiSlot {
    Cfg cfg; RowScale rs; int rs_off; RopeTabs rt; int tok_off;
    DI void operator()(const f32x4 (&acc)[2][2][4][2], const pg8::Unit& u, int wr, int wc, int fr, int fq) const {
        const SlotDesc d = cfg.get(u.pn * 4 + wc);
        if (d.kind == SK_SKIP) return;
        const int d0 = 8 * fq;
        float rsv[8]; rs_preload(rs, u.pm * 256 + wr * 64 + fr + rs_off, fq, rsv);
        float g0[8], g1[8];
        if (d.kind == SK_HEAD) {
#pragma unroll
            for (int i = 0; i < 8; ++i) { g0[i] = d.gain[d0 + i] * d.scale; g1[i] = d.gain[32 + d0 + i] * d.scale; }
        } else if (d.kind == SK_ROPE32) {
#pragma unroll
            for (int i = 0; i < 8; ++i) { g0[i] = fq < 2 ? d.gain[d0 + i] * d.scale : 0.f; g1[i] = fq < 2 ? d.gain[16 + d0 + i] * d.scale : 0.f; }
        } else if (d.kind == SK_GATE) {
#pragma unroll
            for (int i = 0; i < 8; ++i) { g0[i] = d.bias[d.col + d0 + i]; g1[i] = d.bias[d.col + 32 + d0 + i]; }
        } else {
#pragma unroll
            for (int i = 0; i < 8; ++i) { g0[i] = 0.f; g1[i] = 0.f; }
        }
#pragma unroll
        for (int ai = 0; ai < 2; ++ai)
#pragma unroll
            for (int m = 0; m < 4; ++m) {
                const int row = u.pm * 256 + ai * 128 + wr * 64 + m * 16 + fr;
                const float r = rsv[ai * 4 + m];
                float v0[8], v1[8];
#pragma unroll
                for (int n = 0; n < 2; ++n)
#pragma unroll
                    for (int j = 0; j < 4; ++j) { v0[4 * n + j] = acc[ai][0][m][n][j] * r; v1[4 * n + j] = acc[ai][1][m][n][j] * r; }
                bf16_t* dp = d.dst + (size_t)row * d.ld + d.col;
                if (d.kind == SK_RAW) {
                    if (d.part) {
                        float ss = 0.f;
#pragma unroll
                        for (int i = 0; i < 8; ++i) ss += v0[i] * v0[i] + v1[i] * v1[i];
                        ss += __shfl_xor(ss, 16); ss += __shfl_xor(ss, 32);
                        if (fq == 0) d.part[(size_t)row * d.pstride + d.pidx] = ss;
                    }
                    *(u32x4*)(dp + d0) = pack8(v0); *(u32x4*)(dp + 32 + d0) = pack8(v1);
                } else if (d.kind == SK_GATE) {
#pragma unroll
                    for (int i = 0; i < 8; ++i) { v0[i] = __builtin_amdgcn_rcpf(1.f + __builtin_amdgcn_exp2f(-(v0[i] + g0[i]) * LOG2E)); v1[i] = __builtin_amdgcn_rcpf(1.f + __builtin_amdgcn_exp2f(-(v1[i] + g1[i]) * LOG2E)); }
                    *(u32x4*)(dp + d0) = pack8(v0); *(u32x4*)(dp + 32 + d0) = pack8(v1);
                } else if (d.kind == SK_HEAD) {
                    float ss = 0.f;
#pragma unroll
                    for (int i = 0; i < 8; ++i) ss += v0[i] * v0[i] + v1[i] * v1[i];
                    ss += __shfl_xor(ss, 16); ss += __shfl_xor(ss, 32);
                    const float inv = __builtin_amdgcn_rsqf(ss * (1.f / 64.f) + EPS);
#pragma unroll
                    for (int i = 0; i < 8; ++i) { v0[i] *= inv * g0[i]; v1[i] *= inv * g1[i]; }
                    if (d.rope) {
                        const float* cp = rt.cosh + (size_t)(row + tok_off) * 32 + d0; const float* sp = rt.sinh + (size_t)(row + tok_off) * 32 + d0;
                        const f32x4 c0 = *(const f32x4*)cp, c1 = *(const f32x4*)(cp + 4), s0 = *(const f32x4*)sp, s1 = *(const f32x4*)(sp + 4);
#pragma unroll
                        for (int i = 0; i < 8; ++i) { const float c = i < 4 ? c0[i & 3] : c1[i & 3], s = i < 4 ? s0[i & 3] : s1[i & 3];
                            const float a = v0[i], b = v1[i]; v0[i] = a * c - b * s; v1[i] = b * c + a * s; }
                    }
                    *(u32x4*)(dp + d0) = pack8(v0); *(u32x4*)(dp + 32 + d0) = pack8(v1);
                } else {
                    float ss = 0.f;
#pragma unroll
                    for (int i = 0; i < 8; ++i) ss += v0[i] * v0[i] + v1[i] * v1[i];
                    ss += __shfl_xor(ss, 16); ss += __shfl_xor(ss, 32);
                    const float inv = __builtin_amdgcn_rsqf(ss * (1.f / 32.f) + EPS);
                    if (fq < 2) {
#pragma unroll
                        for (int i = 0; i < 8; ++i) { v0[i] *= inv * g0[i]; v1[i] *= inv * g1[i]; }
                        const float* cp = rt.cosr + (size_t)(row + tok_off) * 16 + d0; const float* sp = rt.sinr + (size_t)(row + tok_off) * 16 + d0;
                        const f32x4 c0 = *(const f32x4*)cp, c1 = *(const f32x4*)(cp + 4), s0 = *(const f32x4*)sp, s1 = *(const f32x4*)(sp + 4);
#pragma unroll
                        for (int i = 0; i < 8; ++i) { const float c = i < 4 ? c0[i & 3] : c1[i & 3], s = i < 4 ? s0[i & 3] : s1[i & 3];
                            const float a = v0[i], b = v1[i]; v0[i] = a * c - b * s; v1[i] = b * c + a * s; }
                        *(u32x4*)(dp + d0) = pack8(v0); *(u32x4*)(dp + 16 + d0) = pack8(v1);
                    }
                }
            }
    }
};

struct CfgIn {
    unsigned char* ws; const float* a_qn; const float* a_kn; const float* b_kn; const float* c_qn; const float* c_kn; const float* b_gate;
    DI SlotDesc get(int s) const {
        SlotDesc d; d.kind = SK_SKIP; d.dst = nullptr; d.ld = 0; d.col = 0; d.gain = nullptr; d.scale = 1.f; d.rope = 0; d.part = nullptr; d.pstride = 0; d.pidx = 0; d.bias = nullptr;
        if (s < 8) { d.kind = SK_HEAD; d.dst = (bf16_t*)(ws + WS_QA); d.ld = 512; d.col = 64 * s; d.gain = a_qn; d.scale = 0.125f * LOG2E; d.rope = 1; }
        else if (s < 10) { d.kind = SK_HEAD; d.dst = (bf16_t*)(ws + WS_KA); d.ld = 128; d.col = 64 * (s - 8); d.gain = a_kn; d.rope = 1; }
        else if (s < 12) { d.kind = SK_RAW; d.dst = (bf16_t*)(ws + WS_VA); d.ld = 128; d.col = 64 * (s - 10); }
        else if (s < 18) { d.kind = SK_RAW; d.dst = (bf16_t*)(ws + WS_CQ); d.ld = 384; d.col = 64 * (s - 12); d.part = (float*)(ws + WS_PCQ); d.pstride = 8; d.pidx = s - 12; }
        else if (s < 22) { d.kind = SK_RAW; d.dst = (bf16_t*)(ws + WS_CKV); d.ld = 256; d.col = 64 * (s - 18); d.part = (float*)(ws + WS_PCKV); d.pstride = 4; d.pidx = s - 18; }
        else if (s == 22) { d.kind = SK_ROPE32; d.dst = (bf16_t*)(ws + WS_KR); d.ld = 32; d.col = 0; d.gain = b_kn + 64; }
        else if (s < 95) { const int p = (s - 23) >> 3, h = (s - 23) & 7, g = p / 3, t = p % 3;
            d.dst = (bf16_t*)(ws + WS_CB + (size_t)p * 16 * MiB); d.ld = 512; d.col = 64 * h;
            if (t == 0) { d.kind = SK_HEAD; d.gain = c_qn + 64 * g; d.scale = 0.125f * LOG2E; d.rope = 1; }
            else if (t == 1) { d.kind = SK_HEAD; d.gain = c_kn + 64 * g; d.rope = 1; }
            else d.kind = SK_RAW; }
        else if (s < 103) { d.kind = SK_RAW; d.dst = (bf16_t*)(ws + WS_MQ); d.ld = 512; d.col = 64 * (s - 95); }
        else if (s < 167) { d.kind = SK_GATE; d.dst = (bf16_t*)(ws + WS_GATES); d.ld = 4096; d.col = 64 * (s - 103); d.bias = b_gate; }
        return d;
    }
};
DI void in_slot_src(int s, int& src, int& kind) {
    kind = 0;
    if (s < 22) src = 64 * s;
    else if (s == 22) { src = 1408; kind = 1; }
    else if (s < 167) src = 1440 + 64 * (s - 23);
    else { src = 0; kind = 2; }
}
struct CfgUq {
    unsigned char* ws; const float* b_qn;
    DI SlotDesc get(int s) const {
        SlotDesc d; d.dst = (bf16_t*)(ws + WS_QB); d.ld = 768; d.scale = 0.10206207261596575f * LOG2E; d.rope = 0; d.part = nullptr; d.pstride = 0; d.pidx = 0; d.bias = nullptr;
        if (s < 8) { d.kind = SK_HEAD; d.col = 96 * s; d.gain = b_qn; }
        else { d.kind = SK_ROPE32; d.col = 96 * (s - 8) + 64; d.gain = b_qn + 64; }
        return d;
    }
};
struct CfgUkv {
    unsigned char* ws; const float* b_kn;
    DI SlotDesc get(int s) const {
        SlotDesc d; d.ld = 512; d.scale = 1.f; d.rope = 0; d.part = nullptr; d.pstride = 0; d.pidx = 0; d.bias = nullptr; d.gain = b_kn;
        if (s < 8) { d.kind = SK_HEAD; d.dst = (bf16_t*)(ws + WS_KN); d.col = 64 * s; }
        else { d.kind = SK_RAW; d.dst = (bf16_t*)(ws + WS_VB); d.col = 64 * (s - 8); }
        return d;
    }
};
struct CfgMkv {
    unsigned char* ws;
    DI SlotDesc get(int s) const {
        SlotDesc d; d.kind = SK_RAW; d.ld = 512; d.scale = 1.f; d.rope = 0; d.part = nullptr; d.pstride = 0; d.pidx = 0; d.bias = nullptr; d.gain = nullptr;
        if (s < 8) { d.dst = (bf16_t*)(ws + WS_MK); d.col = 64 * s; } else { d.dst = (bf16_t*)(ws + WS_MV); d.col = 64 * (s - 8); }
        return d;
    }
};

struct EpiMerge {
    const bf16_t* gates; bf16_t* gy;
    DI void operator()(const f32x4 (&acc)[2][2][4][2], const pg8::Unit& u, int wr, int wc, int fr, int fq) const {
#pragma unroll
        for (int ai = 0; ai < 2; ++ai)
#pragma unroll
            for (int m = 0; m < 4; ++m) {
                const int row = u.pm * 256 + ai * 128 + wr * 64 + m * 16 + fr;
#pragma unroll
                for (int bj = 0; bj < 2; ++bj) {
                    const int col = u.pn * 256 + bj * 128 + wc * 32 + 8 * fq;
                    float g[8], o[8];
                    unpack8(*(const u32x4*)(gates + (size_t)row * 4096 + u.seg * 1024 + col), g);
                    bf16_t* gp = gy + (size_t)row * 1024 + col;
                    if (u.seg == 0) {
#pragma unroll
                        for (int i = 0; i < 8; ++i) o[i] = 0.f;
                    } else unpack8(*(const u32x4*)gp, o);
#pragma unroll
                    for (int n = 0; n < 2; ++n)
#pragma unroll
                        for (int j = 0; j < 4; ++j) o[4 * n + j] += g[4 * n + j] * acc[ai][bj][m][n][j];
                    *(u32x4*)gp = pack8(o);
                }
            }
    }
};
struct EpiRes {
    const float* xsrc; float* xdst; bf16_t* xb; float* px;
    DI void operator()(const f32x4 (&acc)[2][2][4][2], const pg8::Unit& u, int wr, int wc, int fr, int fq) const {
#pragma unroll
        for (int ai = 0; ai < 2; ++ai)
#pragma unroll
            for (int m = 0; m < 4; ++m) {
                const int row = u.pm * 256 + ai * 128 + wr * 64 + m * 16 + fr;
                float ss = 0.f;
#pragma unroll
                for (int bj = 0; bj < 2; ++bj) {
                    const size_t off = (size_t)row * 1024 + u.pn * 256 + bj * 128 + wc * 32 + 8 * fq;
                    float o[8];
#pragma unroll
                    for (int n = 0; n < 2; ++n) { const f32x4 xs = *(const f32x4*)(xsrc + off + 4 * n); const f32x4 xn = xs + acc[ai][bj][m][n]; *(f32x4*)(xdst + off + 4 * n) = xn;
#pragma unroll
                        for (int j = 0; j < 4; ++j) { o[4 * n + j] = xn[j]; ss += xn[j] * xn[j]; } }
                    *(u32x4*)(xb + off) = pack8(o);
                }
                ss += __shfl_xor(ss, 16); ss += __shfl_xor(ss, 32);
                if (fq == 0) px[(size_t)row * 16 + u.pn * 4 + wc] = ss;
            }
    }
};
struct EpiUp {
    bf16_t* U; RowScale rs; int rs_off;
    DI void operator()(const f32x4 (&acc)[2][2][4][2], const pg8::Unit& u, int wr, int wc, int fr, int fq) const {
        float rsv[8]; rs_preload(rs, u.pm * 256 + wr * 64 + fr + rs_off, fq, rsv);
#pragma unroll
        for (int ai = 0; ai < 2; ++ai)
#pragma unroll
            for (int m = 0; m < 4; ++m) {
                const int row = u.pm * 256 + ai * 128 + wr * 64 + m * 16 + fr;
                const float r = rsv[ai * 4 + m];
#pragma unroll
                for (int bj = 0; bj < 2; ++bj) {
                    float o[8];
#pragma unroll
                    for (int n = 0; n < 2; ++n)
#pragma unroll
                        for (int j = 0; j < 4; ++j) { const float v = fmaxf(acc[ai][bj][m][n][j] * r, 0.f); o[4 * n + j] = v * v; }
                    *(u32x4*)(U + (size_t)row * DFF + u.pn * 256 + bj * 128 + wc * 32 + 8 * fq) = pack8(o);
                }
            }
    }
};

DI void transpose_item(const float* W, int K, int N, const float* gk, bf16_t* WT, int rho0, int k0, int src0, int nvalid, LAS float* scr, int lane) {
#pragma unroll 8
    for (int i = 0; i < 32; ++i) { const int kk = 2 * i + (lane >> 5), c = lane & 31;
        float v = (c < nvalid) ? W[(size_t)(k0 + kk) * N + src0 + c] : 0.f;
        if (gk) v *= gk[k0 + kk];
        scr[kk * 33 + c] = v; }
    LDS_WAIT();
    const int c8 = lane & 7;
#pragma unroll
    for (int j = 0; j < 4; ++j) { const int n = (lane >> 3) + 8 * j; const LAS float* s = scr + (8 * c8) * 33 + n;
        u32x4 o; o.x = cvtpk(s[0 * 33], s[1 * 33]); o.y = cvtpk(s[2 * 33], s[3 * 33]); o.z = cvtpk(s[4 * 33], s[5 * 33]); o.w = cvtpk(s[6 * 33], s[7 * 33]);
        *(u32x4*)(WT + (size_t)(rho0 + n) * K + k0 + 8 * c8) = o; }
    LDS_WAIT();
}
DI void block_src(int mapk, int q  , int& src0, int& nvalid) {
    if (mapk == 0) { src0 = 32 * q; nvalid = 32; return; }
    const int pn = q >> 3, bj = (q >> 2) & 1, wc = q & 3, s = 4 * pn + wc;
    if (mapk == 1) { int src, kind; in_slot_src(s, src, kind);
        if (kind == 0) { src0 = src + 32 * bj; nvalid = 32; } else if (kind == 1) { src0 = src + 16 * bj; nvalid = 16; } else { src0 = 0; nvalid = 0; } }
    else if (mapk == 2) { if (s < 8) { src0 = 96 * s + 32 * bj; nvalid = 32; } else { src0 = 96 * (s - 8) + 64 + 16 * bj; nvalid = 16; } }
    else if (mapk == 3) { if (s < 8) { src0 = 128 * s + 32 * bj; nvalid = 32; } else { src0 = 128 * (s - 8) + 64 + 32 * bj; nvalid = 32; } }
    else { src0 = 64 * s + 32 * bj; nvalid = 32; }
}
DI void convert_matrix(const float* W, int K, int N, int Nt, const float* gk, bf16_t* WT, int mapk, LAS float* scr, int gw, int NGW, int lane) {
    const int nblk = Nt / 32, items = (K / 64) * nblk;
    for (int it = gw; it < items; it += NGW) {
        const int kb = it / nblk, q = it % nblk; int src0, nvalid; block_src(mapk, q, src0, nvalid);
        transpose_item(W, K, N, gk, WT, 32 * q, 64 * kb, src0, nvalid, scr, lane);
    }
}
DI void convert_layer(int l, LAS unsigned char* lds, int gw, int NGW, int wave) {
    const int lane = lane_id();
    CParams* q = fresh_params();
    LAS float* scr = (LAS float*)(lds + wave * 16384);
    unsigned char* ws = q->ws;
    convert_matrix(q->in[4] + (size_t)l * D * N_IN, D, N_IN, NT_IN, q->in[3] + l * D, (bf16_t*)(ws + WS_WIN), 1, scr, gw, NGW, lane);
    convert_matrix(q->in[11] + (size_t)l * 384 * 768, 384, 768, 1024, q->in[9] + l * 384, (bf16_t*)(ws + WS_WUQ), 2, scr, gw, NGW, lane);
    convert_matrix(q->in[12] + (size_t)l * 256 * 1024, 256, 1024, 1024, q->in[10] + l * 256, (bf16_t*)(ws + WS_WUKV), 3, scr, gw, NGW, lane);
    convert_matrix(q->in[18] + (size_t)l * D * 1024, D, 1024, 1024, q->in[17] + l * D, (bf16_t*)(ws + WS_WMKV), 4, scr, gw, NGW, lane);
    for (int n = 0; n < 4; ++n)
        convert_matrix(q->in[21] + ((size_t)l * 4 + n) * 512 * D, 512, D, D, nullptr, (bf16_t*)(ws + WS_WBR) + (size_t)n * D * 512, 0, scr, gw, NGW, lane);
    convert_matrix(q->in[22] + (size_t)l * D * D, D, D, D, nullptr, (bf16_t*)(ws + WS_WOUT), 0, scr, gw, NGW, lane);
    convert_matrix(q->in[24] + (size_t)l * D * DFF, D, DFF, DFF, q->in[23] + l * D, (bf16_t*)(ws + WS_WUP), 0, scr, gw, NGW, lane);
    convert_matrix(q->in[25] + (size_t)l * DFF * D, DFF, D, D, nullptr, (bf16_t*)(ws + WS_WDN), 0, scr, gw, NGW, lane);
}

DI int crow(int i, int h) { return (i & 3) + 8 * (i >> 2) + 4 * h; }
DI f32x16 mfma32(bf16x8 a, bf16x8 b, f32x16 c) { return __builtin_amdgcn_mfma_f32_32x32x16_bf16(a, b, c, 0, 0, 0); }
DI bf16x8 packp(const f32x16& x, int s) { u32x4 w; w.x = cvtpk(x[8 * s], x[8 * s + 1]); w.y = cvtpk(x[8 * s + 2], x[8 * s + 3]); w.z = cvtpk(x[8 * s + 4], x[8 * s + 5]); w.w = cvtpk(x[8 * s + 6], x[8 * s + 7]); return __builtin_bit_cast(bf16x8, w); }
DI s16x4 vtr(const LAS char* p) { return __builtin_bit_cast(s16x4, __builtin_amdgcn_ds_read_tr16_b64_v4i16((LAS s16x4*)p)); }

DI float xhalf_max(float v) { auto rr = __builtin_amdgcn_permlane32_swap(__float_as_uint(v), __float_as_uint(v), false, false); return fmaxf(__uint_as_float(rr[0]), __uint_as_float(rr[1])); }
DI float xhalf_sum(float v) { auto rr = __builtin_amdgcn_permlane32_swap(__float_as_uint(v), __float_as_uint(v), false, false); return __uint_as_float(rr[0]) + __uint_as_float(rr[1]); }
DI f32x16 splat16(float v) { f32x16 p;
#pragma unroll
    for (int i = 0; i < 16; ++i) p[i] = v;
    return p; }
template <int DQK, int NT, int TSTRIDE> DI void st_tiles(unsigned kaddr, const bf16x8* qf, const f32x16& init, f32x16* p) {
    bf16x8 a[NT][DQK / 16];
#pragma unroll
    for (int j = 0; j < NT; ++j)
#pragma unroll
        for (int ks = 0; ks < DQK / 16; ++ks) asm volatile("ds_read_b128 %0, %1 offset:%2" : "=v"(a[j][ks]) : "v"(kaddr), "i"(j * TSTRIDE + ks * 32));
    asm volatile("s_waitcnt lgkmcnt(0)" ::: "memory");
#pragma unroll
    for (int j = 0; j < NT; ++j)
#pragma unroll
        for (int ks = 0; ks < DQK / 16; ++ks) asm volatile("" : "+v"(a[j][ks]));
#pragma unroll
    for (int j = 0; j < NT; ++j) p[j] = init;
#pragma unroll
    for (int ks = 0; ks < DQK / 16; ++ks)
#pragma unroll
        for (int j = 0; j < NT; ++j) p[j] = mfma32(a[j][ks], qf[ks], p[j]);
}
template <int DV, int VP> DI void pv_tile(f32x16* o, const LAS char* vp, const f32x16& p, int h) {
#pragma unroll
    for (int s = 0; s < 2; ++s) {
        const bf16x8 pa = packp(p, s);
#pragma unroll
        for (int db = 0; db < DV / 32; ++db) {
            const s16x4 lo = vtr(vp + (16 * s + 4 * h) * VP + db * 64);
            const s16x4 hi = vtr(vp + (16 * s + 8 + 4 * h) * VP + db * 64);
            const bf16x8 vb = __builtin_shufflevector(lo, hi, 0, 1, 2, 3, 4, 5, 6, 7);
            o[db] = mfma32(pa, vb, o[db]);
        }
    }
}
template <int NDB> DI void scale_o(f32x16* o, float f, LAS float* sc, int r, int h) {
    if (h == 0) sc[r] = f;
    LDS_WAIT();
#pragma unroll
    for (int g = 0; g < 4; ++g) { const f32x4 f4 = *(const LAS f32x4*)(sc + 8 * g + 4 * h);
#pragma unroll
        for (int db = 0; db < NDB; ++db)
#pragma unroll
            for (int j = 0; j < 4; ++j) o[db][4 * g + j] *= f4[j]; }
    LDS_WAIT();
}
template <int NDB> DI void store_o(const f32x16* o, bf16_t* obase  , long rstride, int r, int h) {
#pragma unroll
    for (int i = 0; i < 16; ++i) { bf16_t* rp = obase + (long)crow(i, h) * rstride + r;
#pragma unroll
        for (int db = 0; db < NDB; ++db) rp[32 * db] = (bf16_t)(cvtpk(o[db][i], 0.f) & 0xffffu); }
}

constexpr int BKP = 144, BVP = 144;
constexpr int BSLOT = 256 * BKP + 256 * BVP;

DI void banded_load(LAS char* dst, int pitch, const bf16_t* src  , int ld, long row0  , int dil, int gi0, int tid) {
#pragma unroll
    for (int it = 0; it < 4; ++it) {
        const int c = tid + it * NTHREADS, key = c >> 3, cc = c & 7, gi = gi0 + key;
        u32x4 v = (u32x4){0u, 0u, 0u, 0u};
        if (gi >= 0) v = *(const u32x4*)(src + (row0 + (long)gi * dil) * ld + cc * 8);
        *(LAS u32x4*)(dst + key * pitch + cc * 16) = v;
    }
}
template <bool SINK, bool WANT_LSE>
DI void banded_task(const bf16_t* qrow  , bf16_t* obase, long rstride, const LAS char* Ks, const LAS char* Vs,
                    int wq, int jblk, int maxd, float sink2, float* lsep, LAS float* sc, int lane) {
    const int r = lane & 31, h = lane >> 5;
    bf16x8 qf[4];
#pragma unroll
    for (int ks = 0; ks < 4; ++ks) qf[ks] = *(const bf16x8*)(qrow + 16 * ks + 8 * h);
    f32x16 p[5];
    const f32x16 zero16 = splat16(0.f);
    { const unsigned ka = (unsigned)(uintptr_t)(Ks + (32 * wq + r) * BKP + 16 * h);
      st_tiles<64, 3, 32 * BKP>(ka, qf, zero16, p); st_tiles<64, 2, 32 * BKP>(ka + 96 * BKP, qf, zero16, p + 3); }
    const int tmin = (jblk == 0) ? 4 - wq : 0, lo = r + 128 - maxd;
#pragma unroll
    for (int t = 0; t < 5; ++t) {
        if (t < tmin) { p[t] = splat16(NEGBIG); }
        else if (t == 0) {
#pragma unroll
            for (int i = 0; i < 16; ++i) p[t][i] = (crow(i, h) >= lo) ? p[t][i] : NEGBIG;
        } else if (t == 4) {
#pragma unroll
            for (int i = 0; i < 16; ++i) p[t][i] = (crow(i, h) <= r) ? p[t][i] : NEGBIG;
        }
    }
    float mx = NEGBIG;
#pragma unroll
    for (int t = 0; t < 5; ++t)
#pragma unroll
        for (int i = 0; i < 16; ++i) mx = fmaxf(mx, p[t][i]);
    mx = xhalf_max(mx);
    if (SINK) mx = fmaxf(mx, sink2);
    float l = 0.f;
#pragma unroll
    for (int t = 0; t < 5; ++t)
#pragma unroll
        for (int i = 0; i < 16; ++i) { const float e = __builtin_amdgcn_exp2f(p[t][i] - mx); p[t][i] = e; l += e; }
    l = xhalf_sum(l);
    if (SINK) l += __builtin_amdgcn_exp2f(sink2 - mx);
    f32x16 o[2];
#pragma unroll
    for (int i = 0; i < 16; ++i) { o[0][i] = 0.f; o[1][i] = 0.f; }
    const LAS char* vl = Vs + ((lane & 15) >> 2) * BVP + ((lane >> 4) & 1) * 32 + (lane & 3) * 8;
#pragma unroll
    for (int t = 0; t < 5; ++t) pv_tile<64, BVP>(o, vl + 32 * (wq + t) * BVP, p[t], h);
    scale_o<2>(o, 1.f / l, sc, r, h);
    store_o<2>(o, obase, rstride, r, h);
    if (WANT_LSE) { if (h == 0) *lsep = mx + __builtin_amdgcn_logf(l); }
}

template <int DQK, int DV, bool CAUSAL, bool SPLITK>
DI void dense_unit(const bf16_t* Q, int ldq, const bf16_t* K1, int ldk1, const bf16_t* K2, int ldk2, const bf16_t* V, int ldv, bf16_t* O, int ldo,
                   int q0  , int ntiles, LAS char* lds, LAS float* sc, int tid) {
    constexpr int KP = DQK * 2 + 16, VP = DV * 2 + 16, KCH = DQK / 8, VCH = DV / 8, NK = 64 * KCH, NCH = NK + 64 * VCH, NIT = (NCH + NTHREADS - 1) / NTHREADS;
    constexpr int KBUF = 64 * KP, VBUF = 64 * VP;
    const int lane = tid & 63, w = __builtin_amdgcn_readfirstlane(tid >> 6), r = lane & 31, h = lane >> 5;
    LAS char* kb0 = lds; LAS char* vb0 = lds + 2 * KBUF;
    bf16x8 qf[DQK / 16];
    { const bf16_t* qr = Q + (long)(32 * w + r) * ldq;
#pragma unroll
      for (int ks = 0; ks < DQK / 16; ++ks) { qf[ks] = *(const bf16x8*)(qr + 16 * ks + 8 * h); asm volatile("" : "+v"(qf[ks])); } }
    u32x4 pre[NIT];
    auto gload = [&](int t) {
        const int tid2 = opaque(tid);
#pragma unroll
        for (int it = 0; it < NIT; ++it) { const int c = tid2 + it * NTHREADS;
            if (c < NK) { const int key = c / KCH, cc = c % KCH; const long kr = (long)(64 * t + key);
                pre[it] = (SPLITK && cc >= 8) ? *(const u32x4*)(K2 + kr * ldk2 + (cc - 8) * 8) : *(const u32x4*)(K1 + kr * ldk1 + cc * 8); }
            else if (c < NCH) { const int c2 = c - NK, key = c2 / VCH, cc = c2 % VCH; pre[it] = *(const u32x4*)(V + (long)(64 * t + key) * ldv + cc * 8); } }
    };
    auto lstore = [&](int b) {
        const int tid2 = opaque(tid);
#pragma unroll
        for (int it = 0; it < NIT; ++it) { const int c = tid2 + it * NTHREADS;
            if (c < NK) { const int key = c / KCH, cc = c % KCH; *(LAS u32x4*)(kb0 + b * KBUF + key * KP + cc * 16) = pre[it]; }
            else if (c < NCH) { const int c2 = c - NK, key = c2 / VCH, cc = c2 % VCH; *(LAS u32x4*)(vb0 + b * VBUF + key * VP + cc * 16) = pre[it]; } }
    };
    gload(0); lstore(0);
    __syncthreads();
    float m = 0.f, l = 0.f; bool first = true;
    f32x16 negm = splat16(0.f);
    f32x16 o[DV / 32];
#pragma unroll
    for (int db = 0; db < DV / 32; ++db)
#pragma unroll
        for (int i = 0; i < 16; ++i) o[db][i] = 0.f;
    const int qpos = q0 + 32 * w + r;
    for (int t = 0; t < ntiles; ++t) {
        const int b = t & 1;
        if (t + 1 < ntiles) gload(t + 1);
        if (!CAUSAL || 64 * t <= q0 + 32 * w) {
            const LAS char* kp = kb0 + b * KBUF + r * KP + 16 * h;
            f32x16 pp[2]; st_tiles<DQK, 2, 32 * KP>((unsigned)(uintptr_t)kp, qf, negm, pp);
            f32x16& p0 = pp[0]; f32x16& p1 = pp[1];
            if (CAUSAL && 64 * t + 63 > q0 + 32 * w) {
#pragma unroll
                for (int i = 0; i < 16; ++i) { const int key = 64 * t + crow(i, h); if (key > qpos) p0[i] = NEGBIG; if (key + 32 > qpos) p1[i] = NEGBIG; }
            }
            float mx = NEGBIG;
#pragma unroll
            for (int i = 0; i < 16; ++i) mx = fmaxf(mx, fmaxf(p0[i], p1[i]));
            mx = xhalf_max(mx);
            if (first || __any(mx > 8.f)) {
                const float dl = first ? mx : (mx > 8.f ? mx : 0.f);
                m += dl;
                const float f = __builtin_amdgcn_exp2f(-dl);
                l *= f;
#pragma unroll
                for (int i = 0; i < 16; ++i) { p0[i] -= dl; p1[i] -= dl; }
                if (!first) scale_o<DV / 32>(o, f, sc, r, h);
                negm = splat16(-m);
                first = false;
            }
#pragma unroll
            for (int i = 0; i < 16; ++i) { p0[i] = __builtin_amdgcn_exp2f(p0[i]); p1[i] = __builtin_amdgcn_exp2f(p1[i]); l += p0[i] + p1[i]; }
            const LAS char* vl = vb0 + b * VBUF + ((lane & 15) >> 2) * VP + ((lane >> 4) & 1) * 32 + (lane & 3) * 8;
            pv_tile<DV, VP>(o, vl, p0, h);
            pv_tile<DV, VP>(o, vl + 32 * VP, p1, h);
        }
        if (t + 1 < ntiles) lstore(b ^ 1);
        __syncthreads();
    }
    l = xhalf_sum(l);
    scale_o<DV / 32>(o, 1.f / l, sc, r, h);
    store_o<DV / 32>(o, O + (long)(32 * w) * ldo, ldo, r, h);
}


#define XB_TMO      128
#define XB_XCNT(j)  (256  + 64 * (j))
#define XB_XSUB(j)  (1280 + 64 * (j))
#define XB_XGEN(j)  (2304 + 64 * (j))
#define XB_TOP      3328
#define XB_TOPGEN   3392
#define XCD_BAR_WORDS 3456
#define XB_SPIN_CAP (1u << 22)
DI unsigned xb_ld(unsigned* p)              { return __hip_atomic_load(p, __ATOMIC_RELAXED, __HIP_MEMORY_SCOPE_AGENT); }
DI unsigned xb_add(unsigned* p, unsigned v) { return __hip_atomic_fetch_add(p, v, __ATOMIC_RELAXED, __HIP_MEMORY_SCOPE_AGENT); }
DI unsigned xb_xcc_id() { return (unsigned)__builtin_amdgcn_s_getreg((3 << 11) | 20) & 0xFu; }
#define XB_SPIN(cond, bar) do { unsigned _sp = 0; while (cond) { __builtin_amdgcn_s_sleep(1); \
    if ((++_sp & 255u) == 0u) { if (xb_ld(&(bar)[XB_TMO])) break; if (_sp > XB_SPIN_CAP) { atomicAdd(&(bar)[XB_TMO], 1u); break; } } } } while (0)
struct XcdBarrier { unsigned* bar; unsigned x; volatile LAS unsigned* st; };
DI XcdBarrier xcd_barrier_post(unsigned* bar, volatile LAS unsigned* st) {
    XcdBarrier b; b.bar = bar; b.x = xb_xcc_id(); b.st = st;
    if (threadIdx.x == 0) (void)xb_add(&bar[XB_XCNT(b.x)], 1u);
    return b;
}
DI void xcd_barrier_complete(unsigned* bar, unsigned x, unsigned& nloc, unsigned& nx) {
    const unsigned G = gridDim.x * gridDim.y * gridDim.z;
    unsigned sum, cnt, mine, sp = 0u;
    for (;;) {
        sum = 0u; cnt = 0u; mine = 0u;
#pragma unroll
        for (unsigned j = 0; j < 16; ++j) { const unsigned c = xb_ld(&bar[XB_XCNT(j)]); sum += c; cnt += (c > 0u) ? 1u : 0u; mine = (j == x) ? c : mine; }
        if (sum == G) break;
        __builtin_amdgcn_s_sleep(1);
        if ((++sp & 255u) == 0u) { if (xb_ld(&bar[XB_TMO])) break; if (sp > XB_SPIN_CAP) { atomicAdd(&bar[XB_TMO], 1u); break; } }
    }
    nloc = mine > 0u ? mine : 1u; nx = cnt > 0u ? cnt : 1u;
}
DI void xcd_barrier(unsigned* bar, unsigned x, volatile LAS unsigned* st) {
    asm volatile("s_waitcnt vmcnt(0)" ::: "memory");
    __syncthreads();
    if (threadIdx.x == 0) {
        __builtin_amdgcn_s_waitcnt(0);
        unsigned nloc = st[0], nx = st[1];
        if (nloc == 0u) { xcd_barrier_complete(bar, x, nloc, nx); st[0] = nloc; st[1] = nx; }
        const unsigned old = xb_add(&bar[XB_XSUB(x)], 1u);
        const unsigned gen = old / nloc;
        if (old + 1u == (gen + 1u) * nloc) {
            __builtin_amdgcn_fence(__ATOMIC_RELEASE, "agent");
            asm volatile("s_waitcnt vmcnt(0)" ::: "memory");
            const unsigned og = xb_add(&bar[XB_TOP], 1u);
            const unsigned tg = og / nx;
            if (og + 1u == (tg + 1u) * nx) xb_add(&bar[XB_TOPGEN], 1u);
            else XB_SPIN(xb_ld(&bar[XB_TOPGEN]) == tg, bar);
            __builtin_amdgcn_fence(__ATOMIC_ACQUIRE, "agent");
            xb_add(&bar[XB_XGEN(x)], 1u);
            asm volatile("s_waitcnt vmcnt(0)" ::: "memory");
        } else {
            XB_SPIN(xb_ld(&bar[XB_XGEN(x)]) == gen, bar);
            __builtin_amdgcn_fence(__ATOMIC_ACQUIRE, "agent");
            asm volatile("s_waitcnt vmcnt(0)" ::: "memory");
        }
    }
    __syncthreads();
}

DI void sincos_acc(float ang, float& c, float& s) {
    const double x = (double)ang;
    const double n = __builtin_rint(x * 0.63661977236758134308);
    double rr = __builtin_fma(-n, 1.57079632679489655800e+00, x); rr = __builtin_fma(-n, 6.12323399573676603587e-17, rr);
    const double r2 = rr * rr;
    const double sn = rr * (1.0 + r2 * (-1.0 / 6 + r2 * (1.0 / 120 + r2 * (-1.0 / 5040 + r2 * (1.0 / 362880 + r2 * (-1.0 / 39916800 + r2 * (1.0 / 6227020800.0)))))));
    const double cs = 1.0 + r2 * (-0.5 + r2 * (1.0 / 24 + r2 * (-1.0 / 720 + r2 * (1.0 / 40320 + r2 * (-1.0 / 3628800 + r2 * (1.0 / 479001600.0))))));
    const int q = ((int)n) & 3;
    const double cc = (q == 0) ? cs : (q == 1) ? -sn : (q == 2) ? -cs : sn;
    const double ss = (q == 0) ? sn : (q == 1) ? cs : (q == 2) ? -sn : -cs;
    c = (float)cc; s = (float)ss;
}

#ifndef PH
#define PH 255
#endif
#ifndef REP_P1
#define REP_P1 1
#endif
#ifndef REP_B
#define REP_B 1
#endif
#ifndef REP_CONV
#define REP_CONV 1
#endif
#ifndef REP_P7
#define REP_P7 1
#endif
#define GRID_SYNC() do { CParams* qb_ = fresh_params(); xcd_barrier((unsigned*)(qb_->ws + WS_CTL), xcc, MISC); } while (0)

__global__ void __launch_bounds__(NTHREADS, 2) fwd_megakernel(Params p) {
    extern __shared__ __attribute__((aligned(16))) unsigned char lds_raw[];
    cg::grid_group grid = cg::this_grid();
    LAS unsigned char* lds = (LAS unsigned char*)lds_raw;
    const int wave = __builtin_amdgcn_readfirstlane((int)threadIdx.x >> 6);
    const int G = gridDim.x, bid = blockIdx.x;
    const int gw = bid * NWAVES + wave, NGW = G * NWAVES;
    LAS float* sc = (LAS float*)(lds + LDS_SCR) + wave * 64;
    volatile LAS unsigned* MISC = (volatile LAS unsigned*)(lds + LDS_SCR + 2048);
    if (threadIdx.x < 4) MISC[threadIdx.x] = 0u;
    __syncthreads();
    unsigned xcc;
    { CParams* q0 = fresh_params(); const XcdBarrier xb = xcd_barrier_post((unsigned*)(q0->ws + WS_CTL), MISC); xcc = xb.x; }

#ifndef NOPRO
    {
        PHASE_CTX
        float* COSH = (float*)(ws + WS_COSH); float* SINH = (float*)(ws + WS_SINH); float* COSR = (float*)(ws + WS_COSR); float* SINR = (float*)(ws + WS_SINR);
        const float* x = q->in[0]; const int* pos = (const int*)q->in[2];
        const int lane = lane_id(), tid = wave * 64 + lane;
        for (int i = bid * NTHREADS + tid; i < TT * 32; i += G * NTHREADS) { const int t = i >> 5, k = i & 31; float c, s; sincos_acc((float)pos[t] * q->inv_h[k], c, s); COSH[i] = c; SINH[i] = s; }
        for (int i = bid * NTHREADS + tid; i < TT * 16; i += G * NTHREADS) { const int t = i >> 4, k = i & 15; float c, s; sincos_acc((float)pos[t] * q->inv_r[k], c, s); COSR[i] = c; SINR[i] = s; }
        for (int row = gw; row < TT; row += NGW) {
            const f32x4* xr = (const f32x4*)(x + (size_t)row * D) + lane; float ss = 0.f;
            u32x2* o8 = (u32x2*)(XB + (size_t)row * D) + lane;
#pragma unroll
            for (int j = 0; j < 4; ++j) { const f32x4 v = xr[64 * j]; ss += (v.x * v.x + v.y * v.y) + (v.z * v.z + v.w * v.w); u32x2 w; w.x = cvtpk(v.x, v.y); w.y = cvtpk(v.z, v.w); o8[64 * j] = w; }
            ss = wave_sum(ss);
            if (lane < 16) PX[(size_t)row * 16 + lane] = lane == 0 ? ss : 0.f;
        }
        const float* mem = q->in[1]; bf16_t* MEMN = (bf16_t*)(ws + WS_MEMN);
        for (int row = gw; row < BATCH * NMEM; row += NGW) {
            const f32x4* xr = (const f32x4*)(mem + (size_t)row * D) + lane; f32x4 v[4]; float ss = 0.f;
#pragma unroll
            for (int j = 0; j < 4; ++j) { v[j] = xr[64 * j]; ss += (v[j].x * v[j].x + v[j].y * v[j].y) + (v[j].z * v[j].z + v[j].w * v[j].w); }
            const float rstd = __builtin_amdgcn_rsqf(wave_sum(ss) * (1.f / D) + EPS);
            u32x2* o8 = (u32x2*)(MEMN + (size_t)row * D) + lane;
#pragma unroll
            for (int j = 0; j < 4; ++j) { u32x2 w; w.x = cvtpk(v[j].x * rstd, v[j].y * rstd); w.y = cvtpk(v[j].z * rstd, v[j].w * rstd); o8[64 * j] = w; }
        }
    }

#endif
    for (int l = 0; l < DEPTH; ++l) {
#ifndef NOCONV
#pragma unroll 1
        for (int rep = 0; rep < REP_CONV; ++rep) convert_layer(l, lds, gw, NGW, wave);
#endif
        if (l == 0) grid.sync(); else GRID_SYNC();
        for (int ch = 0; ch < NCHUNK; ++ch) {
            const int tok0 = ch * TC;
#if PH & 1
            {
                PHASE_CTX
                pg8::TileOrder S; S.init(TC, NT_IN, G, bid, XB + (size_t)tok0 * D, (const bf16_t*)(ws + WS_WIN));
                EpiSlot<CfgIn> E{CfgIn{ws, q->in[6] + l * 64, q->in[7] + l * 64, q->in[14] + l * 96, q->in[15] + l * 192, q->in[16] + l * 192, q->in[5] + l * 4096},
                                 RowScale{PX, 16, 16, 1.f / D}, tok0, rt, tok0};
#pragma unroll 1
                for (int rep = 0; rep < REP_P1; ++rep) pg8::gemm_phase(lds, D, D, S, E, wave);
                if (ch == 0) {
                    pg8::TileOrder S2; S2.init(BATCH * NMEM, 1024, G, (bid + 128) % G, (const bf16_t*)(ws + WS_MEMN), (const bf16_t*)(ws + WS_WMKV));
                    EpiSlot<CfgMkv> E2{CfgMkv{ws}, RowScale{nullptr, 0, 0, 0.f}, 0, rt, 0};
                    pg8::gemm_phase(lds, D, D, S2, E2, wave);
                }
            }

#endif
            GRID_SYNC();
#if PH & 2
            {
                PHASE_CTX
                pg8::TileOrder S; S.init(TC, 1024, G, bid, (const bf16_t*)(ws + WS_CQ), (const bf16_t*)(ws + WS_WUQ));
                EpiSlot<CfgUq> E{CfgUq{ws, q->in[13] + l * 96}, RowScale{(const float*)(ws + WS_PCQ), 8, 6, 1.f / 384.f}, 0, rt, tok0};
                pg8::gemm_phase(lds, 384, 384, S, E, wave);
                pg8::TileOrder S2; S2.init(TC, 1024, G, bid, (const bf16_t*)(ws + WS_CKV), (const bf16_t*)(ws + WS_WUKV));
                EpiSlot<CfgUkv> E2{CfgUkv{ws, q->in[14] + l * 96}, RowScale{(const float*)(ws + WS_PCKV), 4, 4, 1.f / 256.f}, 0, rt, tok0};
                pg8::gemm_phase(lds, 256, 256, S2, E2, wave);
                const int lane = opaque(lane_id());
                const int nrows = TC + (ch == 0 ? BATCH * NMEM : 0);
                for (int rw = gw; rw < nrows; rw += NGW) {
                    const bool isq = rw < TC;
                    bf16_t* rp = isq ? (bf16_t*)(ws + WS_MQ) + (size_t)rw * 512 : (bf16_t*)(ws + WS_MK) + (size_t)(rw - TC) * 512;
                    const float* gn = (isq ? q->in[19] : q->in[20]) + l * 128 + (lane & 15) * 8;
                    const float scl = isq ? 0.08838834764831845f * LOG2E : 1.f;
                    float v[8]; unpack8(*(const u32x4*)(rp + lane * 8), v);
                    float ss = 0.f;
#pragma unroll
                    for (int i = 0; i < 8; ++i) ss += v[i] * v[i];
                    ss += __shfl_xor(ss, 1); ss += __shfl_xor(ss, 2); ss += __shfl_xor(ss, 4); ss += __shfl_xor(ss, 8);
                    const float inv = __builtin_amdgcn_rsqf(ss * (1.f / 128.f) + EPS) * scl;
#pragma unroll
                    for (int i = 0; i < 8; ++i) v[i] *= inv * gn[i];
                    *(u32x4*)(rp + lane * 8) = pack8(v);
                }
            }

#endif
            GRID_SYNC();
#if PH & 4
            {
                PHASE_CTX
                LAS char* al = (LAS char*)lds;
                const int lane = opaque(lane_id()), tid = wave * 64 + lane;
#pragma unroll 1
                for (int rep = 0; rep < REP_B; ++rep)
                for (int idx = bid; idx < BC * 8 * 16; idx += G) {
                    const int half = idx / (BC * 64), rem = idx % (BC * 64), bh = rem / 8, s = rem % 8;
                    const int qb = half == 0 ? s : 15 - s, b = bh / 8, hh = bh % 8;
                    const long r0 = (long)b * SEQ;
                    dense_unit<96, 64, true, true>((const bf16_t*)(ws + WS_QB) + (r0 + 256 * qb) * 768 + 96 * hh, 768,
                        (const bf16_t*)(ws + WS_KN) + r0 * 512 + 64 * hh, 512, (const bf16_t*)(ws + WS_KR) + r0 * 32, 32,
                        (const bf16_t*)(ws + WS_VB) + r0 * 512 + 64 * hh, 512, (bf16_t*)(ws + WS_OB) + (r0 + 256 * qb) * 512 + 64 * hh, 512,
                        256 * qb, 4 * (qb + 1), al, sc, tid);
                }
                for (int idx = bid; idx < 3 * BC * 32 * 4; idx += G) {
                    const int g = idx / (BC * 128), rem = idx % (BC * 128), hp = rem & 3, sj = rem >> 2;
                    const int dil = g == 0 ? 1 : g == 1 ? 4 : 16, nb = 32 / dil;
                    const int n = sj / nb, j = sj % nb, b = n / dil, res = n % dil;
                    const long row0 = (long)b * SEQ + res;
                    const bf16_t* Qg = (const bf16_t*)(ws + WS_CB + (size_t)(3 * g) * 16 * MiB); const bf16_t* Kg = (const bf16_t*)(ws + WS_CB + (size_t)(3 * g + 1) * 16 * MiB); const bf16_t* Vg = (const bf16_t*)(ws + WS_CB + (size_t)(3 * g + 2) * 16 * MiB);
#pragma unroll
                    for (int sl = 0; sl < 2; ++sl) {
                        banded_load(al + sl * BSLOT, BKP, Kg + 64 * (2 * hp + sl), 512, row0, dil, 128 * (j - 1), tid);
                        banded_load(al + sl * BSLOT + 256 * BKP, BVP, Vg + 64 * (2 * hp + sl), 512, row0, dil, 128 * (j - 1), tid);
                    }
                    __syncthreads();
                    { const int sl = wave >> 2, wq = wave & 3, hd = 2 * hp + sl, r = lane & 31;
                      const long qtok = row0 + (long)(128 * j + 32 * wq + r) * dil;
                      bf16_t* ob = (bf16_t*)Qg + (row0 + (long)(128 * j + 32 * wq) * dil) * 512 + 64 * hd;
                      banded_task<false, true>(Qg + qtok * 512 + 64 * hd, ob, (long)dil * 512, al + sl * BSLOT, al + sl * BSLOT + 256 * BKP, wq, j, 128, 0.f,
                                               (float*)(ws + WS_LSE) + (qtok * 8 + hd) * 4 + g, sc, lane); }
                    __syncthreads();
                }
                for (int idx = bid; idx < BC * 32 * 2; idx += G) {
                    const int kvh = idx & 1, j = (idx >> 1) & 31, b = idx >> 6;
                    const long row0 = (long)b * SEQ;
                    banded_load(al, BKP, (const bf16_t*)(ws + WS_KA) + 64 * kvh, 128, row0, 1, 128 * (j - 1), tid);
                    banded_load(al + 256 * BKP, BVP, (const bf16_t*)(ws + WS_VA) + 64 * kvh, 128, row0, 1, 128 * (j - 1), tid);
                    __syncthreads();
#pragma unroll 1
                    for (int pass = 0; pass < 2; ++pass) {
                        const int hq = kvh * 4 + (wave >> 2) + 2 * pass, wq = wave & 3, r = lane & 31;
                        const long qtok = row0 + 128 * j + 32 * wq + r;
                        bf16_t* QA = (bf16_t*)(ws + WS_QA);
                        banded_task<true, false>(QA + qtok * 512 + 64 * hq, QA + (row0 + 128 * j + 32 * wq) * 512 + 64 * hq, 512, al, al + 256 * BKP, wq, j, 127,
                                                 (q->in[8] + l * 8)[hq] * LOG2E, nullptr, sc, lane);
                    }
                    __syncthreads();
                }
                for (int idx = bid; idx < BC * 4 * 16; idx += G) {
                    const int qb = idx & 15, hh = (idx >> 4) & 3, b = idx >> 6;
                    const long r0 = (long)b * SEQ + 256 * qb; const long m0 = (long)(ch * BC + b) * NMEM;
                    bf16_t* MQ = (bf16_t*)(ws + WS_MQ);
                    dense_unit<128, 128, false, false>(MQ + r0 * 512 + 128 * hh, 512, (const bf16_t*)(ws + WS_MK) + m0 * 512 + 128 * hh, 512, nullptr, 0,
                        (const bf16_t*)(ws + WS_MV) + m0 * 512 + 128 * hh, 512, MQ + r0 * 512 + 128 * hh, 512, 0, 4, al, sc, tid);
                }
            }

#endif
            GRID_SYNC();
#if PH & 8
            {
                PHASE_CTX
                const float* LSE = (const float*)(ws + WS_LSE); bf16_t* OC = (bf16_t*)(ws + WS_OC);
                const int tid = wave * 64 + opaque(lane_id());
                for (int i = bid * NTHREADS + tid; i < TC * 64; i += G * NTHREADS) {
                    const int tok = i >> 6, c8 = i & 63, hd = c8 >> 3;
                    const f32x4 ls = *(const f32x4*)(LSE + ((size_t)tok * 8 + hd) * 4);
                    const float mx = fmaxf(ls.x, fmaxf(ls.y, ls.z));
                    float w0 = __builtin_amdgcn_exp2f(ls.x - mx), w1 = __builtin_amdgcn_exp2f(ls.y - mx), w2 = __builtin_amdgcn_exp2f(ls.z - mx);
                    const float inv = 1.f / (w0 + w1 + w2); w0 *= inv; w1 *= inv; w2 *= inv;
                    float a[8], b[8], c[8], o[8];
                    unpack8(*(const u32x4*)((const bf16_t*)(ws + WS_CB) + (size_t)tok * 512 + c8 * 8), a);
                    unpack8(*(const u32x4*)((const bf16_t*)(ws + WS_CB + 48 * MiB) + (size_t)tok * 512 + c8 * 8), b);
                    unpack8(*(const u32x4*)((const bf16_t*)(ws + WS_CB + 96 * MiB) + (size_t)tok * 512 + c8 * 8), c);
#pragma unroll
                    for (int k = 0; k < 8; ++k) o[k] = w0 * a[k] + w1 * b[k] + w2 * c[k];
                    *(u32x4*)(OC + (size_t)tok * 512 + c8 * 8) = pack8(o);
                }
            }

#endif
            GRID_SYNC();
#if PH & 16
            {
                PHASE_CTX
                pg8::TileOrder S; S.init(TC, D, G, bid, (const bf16_t*)(ws + WS_QA), (const bf16_t*)(ws + WS_WBR)); S.nseg = 4;
                S.segA = 8 * MiB; S.segB = (size_t)D * 512;
                EpiMerge E{(const bf16_t*)(ws + WS_GATES), (bf16_t*)(ws + WS_GY) + (size_t)tok0 * D};
                pg8::gemm_phase(lds, 512, 512, S, E, wave);
            }

#endif
            GRID_SYNC();
        }
        {
            const int tok0 = 0;
#if PH & 32
            {
                PHASE_CTX
                pg8::TileOrder S; S.init(TT, D, G, bid, (const bf16_t*)(ws + WS_GY), (const bf16_t*)(ws + WS_WOUT));
                EpiRes E{((l == 0) ? q->in[0] : q->out) + (size_t)tok0 * D, q->out + (size_t)tok0 * D, XB + (size_t)tok0 * D, PX + (size_t)tok0 * 16};
                pg8::gemm_phase(lds, D, D, S, E, wave);
            }

#endif
            GRID_SYNC();
#if PH & 64
            {
                PHASE_CTX
                pg8::TileOrder S; S.init(TT, DFF, G, bid, XB + (size_t)tok0 * D, (const bf16_t*)(ws + WS_WUP));
                EpiUp E{(bf16_t*)(ws + WS_U), RowScale{PX, 16, 16, 1.f / D}, tok0};
#pragma unroll 1
                for (int rep = 0; rep < REP_P7; ++rep) pg8::gemm_phase(lds, D, D, S, E, wave);
            }

#endif
            GRID_SYNC();
#if PH & 128
            {
                PHASE_CTX
                pg8::TileOrder S; S.init(TT, D, G, bid, (const bf16_t*)(ws + WS_U), (const bf16_t*)(ws + WS_WDN));
                EpiRes E{q->out + (size_t)tok0 * D, q->out + (size_t)tok0 * D, XB + (size_t)tok0 * D, PX + (size_t)tok0 * 16};
                pg8::gemm_phase(lds, DFF, DFF, S, E, wave);
            }

#endif
            GRID_SYNC();
        }
    }
}

extern "C" void kernel_launch(void* const* d_in, const int* in_sizes, int n_in, void* d_out, int out_size, void* d_ws, size_t ws_size, hipStream_t stream) {
    static int grid = 0;
    if (grid == 0) {
        if (n_in != 26 || out_size != TT * D || ws_size < WS_END) { fprintf(stderr, "kernel_launch: unexpected shapes (n_in %d out %d ws %zu)\n", n_in, out_size, ws_size); grid = -1; return; }
        int dev = 0, cus = 0, per_cu = 0;
        hipGetDevice(&dev); hipDeviceGetAttribute(&cus, hipDeviceAttributeMultiprocessorCount, dev);
        hipFuncSetAttribute((const void*)fwd_megakernel, hipFuncAttributeMaxDynamicSharedMemorySize, LDS_BYTES);
        hipOccupancyMaxActiveBlocksPerMultiprocessor(&per_cu, (const void*)fwd_megakernel, NTHREADS, LDS_BYTES);
        if (per_cu < 1) { fprintf(stderr, "kernel_launch: occupancy query says %d blocks per CU\n", per_cu); per_cu = 1; }
        (void)hipGetLastError();
        grid = cus;
    }
    if (grid < 0) return;
    if (hipMemsetAsync((char*)d_ws + WS_CTL, 0, XCD_BAR_WORDS * 4, stream) != hipSuccess) { fprintf(stderr, "kernel_launch: memset failed\n"); return; }
    Params p{};
    for (int i = 0; i < 26; ++i) p.in[i] = (const float*)d_in[i];
    p.out = (float*)d_out; p.ws = (unsigned char*)d_ws;
    for (int i = 0; i < 32; ++i) p.inv_h[i] = (float)std::pow(10000.0, -(double)(2 * i) / 64.0);
    for (int i = 0; i < 16; ++i) p.inv_r[i] = (float)std::pow(10000.0, -(double)(2 * i) / 32.0);
    void* args[] = {&p};
    hipError_t e = hipLaunchCooperativeKernel((const void*)fwd_megakernel, dim3(grid), dim3(NTHREADS), args, LDS_BYTES, stream);
    if (e != hipSuccess) fprintf(stderr, "cooperative launch failed: %s (grid %d)\n", hipGetErrorString(e), grid);
}
```

```cpp
#include <hip/hip_runtime.h>
#include <hip/hip_cooperative_groups.h>
#include <cstdio>
#include <cstdint>
#include <cmath>
namespace cg = cooperative_groups;

#define LAS __attribute__((address_space(3)))
#define DI __device__ __forceinline__
typedef unsigned short bf16_t;
typedef short bf16x8 __attribute__((ext_vector_type(8)));
typedef short s16x4 __attribute__((ext_vector_type(4)));
typedef float f32x4 __attribute__((ext_vector_type(4)));
typedef float f32x16 __attribute__((ext_vector_type(16)));
typedef unsigned u32x4 __attribute__((ext_vector_type(4)));
typedef unsigned u32x2 __attribute__((ext_vector_type(2)));
typedef float f32x2_t __attribute__((ext_vector_type(2)));
typedef __bf16 bf16x2_t __attribute__((ext_vector_type(2)));

constexpr int D = 1024, BATCH = 8, SEQ = 4096, DEPTH = 4, TT = BATCH * SEQ;
constexpr int NCHUNK = 2, BC = BATCH / NCHUNK, TC = BC * SEQ;
constexpr int N_IN = 10656, NT_IN = 10752;
constexpr int DFF = 4096, NMEM = 256;
constexpr float EPS = 1e-6f;
constexpr float LOG2E = 1.4426950408889634f;
constexpr float NEGBIG = -1e30f;
constexpr int NTHREADS = 512, NWAVES = 8;

constexpr size_t MiB = 1u << 20;
constexpr size_t WS_CTL = 0;
constexpr size_t WS_WIN = 1 * MiB, WS_WUQ = 22 * MiB, WS_WUKV = 23 * MiB, WS_WMKV = 24 * MiB, WS_WBR = 26 * MiB, WS_WOUT = 30 * MiB, WS_WUP = 32 * MiB, WS_WDN = 40 * MiB;
constexpr size_t WS_XB = 48 * MiB, WS_PX = 112 * MiB, WS_COSH = 114 * MiB, WS_SINH = 118 * MiB, WS_COSR = 122 * MiB, WS_SINR = 124 * MiB;
constexpr size_t WS_MEMN = 126 * MiB, WS_MK = 130 * MiB, WS_MV = 132 * MiB;
constexpr size_t WS_QA = 134 * MiB, WS_OB = 150 * MiB, WS_OC = 166 * MiB, WS_MQ = 182 * MiB;
constexpr size_t WS_KA = 198 * MiB, WS_VA = 202 * MiB, WS_CQ = 206 * MiB, WS_CKV = 218 * MiB, WS_KR = 226 * MiB, WS_PCQ = 227 * MiB, WS_PCKV = 227 * MiB + 512 * 1024;
constexpr size_t WS_CB = 228 * MiB;
constexpr size_t WS_GATES = 372 * MiB, WS_U = WS_CB;
constexpr size_t WS_QB = 500 * MiB, WS_KN = 524 * MiB, WS_VB = 540 * MiB, WS_LSE = 556 * MiB, WS_GY = 558 * MiB;
constexpr size_t WS_END = 622 * MiB;

constexpr int LDS_BYTES = 155648;
constexpr int LDS_SCR = 149504;

struct Params {
    const float* in[26];
    float* out;
    unsigned char* ws;
    float inv_h[32];
    float inv_r[16];
    int pad[2];
};

DI unsigned cvtpk(float lo, float hi) { f32x2_t v = {lo, hi}; bf16x2_t b = __builtin_convertvector(v, bf16x2_t); return __builtin_bit_cast(unsigned, b); }
DI float bf_lo(unsigned w) { return __uint_as_float(w << 16); }
DI float bf_hi(unsigned w) { return __uint_as_float(w & 0xffff0000u); }
DI u32x4 pack8(const float* v) { u32x4 w; w.x = cvtpk(v[0], v[1]); w.y = cvtpk(v[2], v[3]); w.z = cvtpk(v[4], v[5]); w.w = cvtpk(v[6], v[7]); return w; }
DI void unpack8(u32x4 w, float* v) { v[0] = bf_lo(w.x); v[1] = bf_hi(w.x); v[2] = bf_lo(w.y); v[3] = bf_hi(w.y); v[4] = bf_lo(w.z); v[5] = bf_hi(w.z); v[6] = bf_lo(w.w); v[7] = bf_hi(w.w); }
DI float wave_sum(float v) {
#pragma unroll
    for (int o = 1; o < 64; o <<= 1) v += __shfl_xor(v, o);
    return v;
}
struct RopeTabs { const float* cosh; const float* sinh; const float* cosr; const float* sinr; };
typedef const struct Params __attribute__((address_space(4))) CParams;
DI CParams* fresh_params() { unsigned long long k = (unsigned long long)__builtin_amdgcn_kernarg_segment_ptr(); asm volatile("" : "+s"(k)); return (CParams*)k; }
#define PHASE_CTX \
    CParams* q = fresh_params(); unsigned char* ws = q->ws; (void)ws; \
    bf16_t* XB = (bf16_t*)(ws + WS_XB); float* PX = (float*)(ws + WS_PX); (void)XB; (void)PX; \
    const RopeTabs rt{(const float*)(ws + WS_COSH), (const float*)(ws + WS_SINH), (const float*)(ws + WS_COSR), (const float*)(ws + WS_SINR)}; (void)rt;
DI int opaque(int v) { asm volatile("" : "+v"(v)); return v; }
DI int lane_id() { int v; asm volatile("v_mbcnt_lo_u32_b32 %0, -1, 0\n\tv_mbcnt_hi_u32_b32 %0, -1, %0" : "=v"(v)); return v; }
#define LDS_WAIT() asm volatile("s_waitcnt lgkmcnt(0)" ::: "memory")

namespace pg8 {
constexpr int BM = 256, BK = 64, HALF = 128, HTB = HALF * BK * 2, STAGE_BYTES = 8 * HTB, NXCD = 8, WGM = 8;
DI int lds_byte(int r, int c) { const int st = (r >> 4) * 2 + (c >> 5), rr = r & 15, cc = c & 31, ob = rr * 64 + cc * 2; return st * 1024 + (ob ^ (((ob >> 9) & 1) << 5)); }
DI void stage_rc(int b, int& R, int& C) { const int st = b / 1024, sb = b % 1024, swz = sb ^ (((sb >> 9) & 1) << 5); R = (st >> 1) * 16 + swz / 64; C = (st & 1) * 32 + (swz % 64) / 2; }
DI int perm32(int rho) { const int n = rho >> 4, i = rho & 15; return 8 * (i >> 2) + 4 * n + (i & 3); }

struct Unit { int pm, pn, seg; const bf16_t* A; const bf16_t* Bt; };

struct TileOrder {
    int nM, nN, nwg, G, c, nseg;
    const bf16_t* A0; const bf16_t* B0; size_t segA, segB;
    DI void init(int M, int N, int G_, int c_, const bf16_t* A, const bf16_t* B) { nM = M / BM; nN = N / BM; nwg = nM * nN; G = G_; c = c_; nseg = 1; A0 = A; B0 = B; segA = 0; segB = 0; }
    DI bool next(int i, Unit& u) const {
        const int seg = i % nseg, ti = i / nseg;
        const long L = (long)ti * G + c; if (L >= nwg) return false;
        int wgid = (int)L; { const int q = nwg / NXCD, r = nwg % NXCD, xcd = wgid % NXCD, off = wgid / NXCD; wgid = (xcd < r ? xcd * (q + 1) : r * (q + 1) + (xcd - r) * q) + off; }
        const int nig = WGM * nN, gid = wgid / nig, fm = gid * WGM, gsz = (nM - fm) < WGM ? (nM - fm) : WGM;
        u.pm = fm + ((wgid % nig) % gsz); u.pn = (wgid % nig) / gsz; u.seg = seg;
        u.A = A0 + (size_t)seg * segA; u.Bt = B0 + (size_t)seg * segB;
        return true;
    }
};

template <class Epi, class Sched>
DI void gemm_phase(LAS unsigned char* lds, const int K, const int lda, const Sched& S, const Epi& E, const int wid) {
    const int lane = opaque(lane_id()), tid = wid * 64 + lane, wr = wid >> 2, wc = wid & 3, fr = lane & 15, fq = lane >> 4;
    const int nt = K / BK;
    unsigned voffA[2], voffB[2];
#pragma unroll
    for (int i = 0; i < 2; ++i) { int R, C; stage_rc(tid * 16 + i * 8192, R, C); const int Rb = (R & ~31) + perm32(R & 31);
        voffA[i] = (unsigned)(R * lda + C) * 2u; voffB[i] = (unsigned)(Rb * K + C) * 2u; }
    const size_t kstep = (size_t)(BK * 2);
    const size_t hstepA = (size_t)HALF * lda * 2, hstepB = (size_t)HALF * K * 2;
    const size_t tstepA = 2 * hstepA, tstepB = 2 * hstepB;
    const unsigned ldsw = (unsigned)wid * 1024u;
    const int aoff = lds_byte(wr * 64 + fr, fq * 8), boff = lds_byte(wc * 32 + fr, fq * 8);
#define PG8_SA(b, h) (((b) * 2 + (h)) * HTB)
#define PG8_SB(b, h) ((4 + (b) * 2 + (h)) * HTB)
#define PG8_STAGE(bufoff, gbase, voff) do { _Pragma("unroll") for (int _i = 0; _i < 2; ++_i) \
        __builtin_amdgcn_global_load_lds((const unsigned*)((const char*)(gbase) + (voff)[_i]), (LAS unsigned*)(lds + (bufoff) + ldsw + _i * 8192), 16, 0, 0); } while (0)
#define PG8_LDA(dst, b, h) do { _Pragma("unroll") for (int m = 0; m < 4; ++m) _Pragma("unroll") for (int k = 0; k < 2; ++k) dst[m][k] = *(const LAS bf16x8*)(lds + PG8_SA(b, h) + aoff + m * 2048 + k * 1024); } while (0)
#define PG8_LDB(dst, b, h) do { _Pragma("unroll") for (int n = 0; n < 2; ++n) _Pragma("unroll") for (int k = 0; k < 2; ++k) dst[n][k] = *(const LAS bf16x8*)(lds + PG8_SB(b, h) + boff + n * 2048 + k * 1024); } while (0)
#define PG8_MMA(ai, bj, At, Bt) do { __builtin_amdgcn_s_setprio(1); _Pragma("unroll") for (int m = 0; m < 4; ++m) _Pragma("unroll") for (int n = 0; n < 2; ++n) _Pragma("unroll") for (int k = 0; k < 2; ++k) \
        acc[ai][bj][m][n] = __builtin_amdgcn_mfma_f32_16x16x32_bf16(Bt[n][k], At[m][k], acc[ai][bj][m][n], 0, 0, 0); __builtin_amdgcn_s_setprio(0); } while (0)
#define PG8_WAIT_V(n) asm volatile("s_waitcnt vmcnt(" #n ")" ::: "memory")
#define PG8_WAIT_L(n) asm volatile("s_waitcnt lgkmcnt(" #n ")" ::: "memory")
#define PG8_BAR __builtin_amdgcn_s_barrier()
#define PG8_SCHED __builtin_amdgcn_sched_barrier(0)
    Unit cur, nxt; int ui = 0;
    if (!S.next(0, cur)) return;
    f32x4 acc[2][2][4][2];
#pragma unroll
    for (int a = 0; a < 2; ++a)
#pragma unroll
        for (int b = 0; b < 2; ++b)
#pragma unroll
            for (int m = 0; m < 4; ++m)
#pragma unroll
                for (int n = 0; n < 2; ++n) acc[a][b][m][n] = (f32x4){0.f, 0.f, 0.f, 0.f};
    bf16x8 At[4][2], B0[2][2], B1[2][2];
    const char* cA = (const char*)cur.A + (size_t)cur.pm * tstepA; const char* cB = (const char*)cur.Bt + (size_t)cur.pn * tstepB;
    PG8_STAGE(PG8_SB(0, 0), cB, voffB); PG8_STAGE(PG8_SB(0, 1), cB + hstepB, voffB); PG8_STAGE(PG8_SA(0, 0), cA, voffA); PG8_STAGE(PG8_SA(0, 1), cA + hstepA, voffA);
    if (wr == 1) PG8_BAR;
    PG8_WAIT_V(2); PG8_BAR;
    PG8_STAGE(PG8_SB(1, 0), cB + kstep, voffB); PG8_STAGE(PG8_SA(1, 0), cA + kstep, voffA); PG8_STAGE(PG8_SB(1, 1), cB + hstepB + kstep, voffB);
    PG8_WAIT_V(6); PG8_BAR;
    for (;;) {
        const bool has_next = S.next(ui + 1, nxt);
        const char* nA = has_next ? (const char*)nxt.A + (size_t)nxt.pm * tstepA : cA; const char* nB = has_next ? (const char*)nxt.Bt + (size_t)nxt.pn * tstepB : cB;
#pragma unroll 1
        for (int t = 0; t < nt; t += 2) {
            const bool last = (t == nt - 2);
            const char* a1 = cA + (size_t)(t + 1) * kstep;
            const char* a2 = last ? nA : cA + (size_t)(t + 2) * kstep; const char* b2 = last ? nB : cB + (size_t)(t + 2) * kstep;
            const char* a3 = a2 + kstep; const char* b3 = b2 + kstep;
            PG8_LDB(B0, 0, 0); PG8_LDB(B1, 0, 1); PG8_SCHED; PG8_LDA(At, 0, 0); PG8_STAGE(PG8_SA(1, 1), a1 + hstepA, voffA);
            PG8_WAIT_V(8); PG8_WAIT_L(0); PG8_BAR; PG8_MMA(0, 0, At, B0); PG8_MMA(0, 1, At, B1); PG8_BAR; PG8_SCHED;
            PG8_LDA(At, 0, 1); PG8_STAGE(PG8_SB(0, 0), b2, voffB); PG8_STAGE(PG8_SB(0, 1), b2 + hstepB, voffB); PG8_STAGE(PG8_SA(0, 0), a2, voffA);
            PG8_WAIT_V(8); PG8_WAIT_L(0); PG8_BAR; PG8_MMA(1, 0, At, B0); PG8_MMA(1, 1, At, B1); PG8_BAR; PG8_SCHED;
            PG8_LDB(B0, 1, 0); PG8_LDB(B1, 1, 1); PG8_SCHED; PG8_LDA(At, 1, 0); PG8_STAGE(PG8_SA(0, 1), a2 + hstepA, voffA);
            PG8_WAIT_V(8); PG8_WAIT_L(0); PG8_BAR; PG8_MMA(0, 0, At, B0); PG8_MMA(0, 1, At, B1); PG8_BAR; PG8_SCHED;
            PG8_LDA(At, 1, 1); PG8_STAGE(PG8_SB(1, 0), b3, voffB); PG8_STAGE(PG8_SB(1, 1), b3 + hstepB, voffB); PG8_STAGE(PG8_SA(1, 0), a3, voffA);
            PG8_WAIT_V(8); PG8_WAIT_L(0); PG8_BAR; PG8_MMA(1, 0, At, B0); PG8_MMA(1, 1, At, B1); PG8_BAR; PG8_SCHED;
        }
        if (wr == 0) PG8_BAR;
        E(acc, cur, wr, wc, fr, fq);
        if (!has_next) break;
#pragma unroll
        for (int a = 0; a < 2; ++a)
#pragma unroll
            for (int b = 0; b < 2; ++b)
#pragma unroll
                for (int m = 0; m < 4; ++m)
#pragma unroll
                    for (int n = 0; n < 2; ++n) acc[a][b][m][n] = (f32x4){0.f, 0.f, 0.f, 0.f};
        cur = nxt; cA = nA; cB = nB; ++ui;
        if (wr == 1) PG8_BAR;
    }
    PG8_WAIT_V(0);
    PG8_BAR;
#undef PG8_SA
#undef PG8_SB
#undef PG8_STAGE
#undef PG8_LDA
#undef PG8_LDB
#undef PG8_MMA
#undef PG8_WAIT_V
#undef PG8_WAIT_L
#undef PG8_BAR
#undef PG8_SCHED
}
}

struct RowScale {
    const float* part; int stride; int cnt; float inv_n;
    DI float get(int row) const {
        if (!part) return 1.f;
        float s = 0.f;
        const float* p = part + (size_t)row * stride;
        for (int i = 0; i < cnt; i += 4) { const f32x4 v = *(const f32x4*)(p + i); s += (v.x + v.y) + (v.z + v.w); }
        return __builtin_amdgcn_rsqf(s * inv_n + EPS);
    }
};

DI void rs_preload(const RowScale& rs, int rowbase, int fq, float (&out)[8]) {
    if (!rs.part) {
#pragma unroll
        for (int i = 0; i < 8; ++i) out[i] = 1.f;
        return;
    }
#pragma unroll
    for (int hb = 0; hb < 2; ++hb) {
        float s[4];
#pragma unroll
        for (int i = 0; i < 4; ++i) { s[i] = 0.f;
            if (4 * fq < rs.cnt) { const f32x4 v = *(const f32x4*)(rs.part + (size_t)(rowbase + hb * 128 + i * 16) * rs.stride + 4 * fq);
                s[i] = v.x + (4 * fq + 1 < rs.cnt ? v.y : 0.f) + (4 * fq + 2 < rs.cnt ? v.z : 0.f) + (4 * fq + 3 < rs.cnt ? v.w : 0.f); } }
#pragma unroll
        for (int i = 0; i < 4; ++i) { float t = s[i]; t += __shfl_xor(t, 16); t += __shfl_xor(t, 32); out[hb * 4 + i] = __builtin_amdgcn_rsqf(t * rs.inv_n + EPS); }
        asm volatile("" ::: "memory");
    }
}
enum { SK_SKIP = 0, SK_RAW = 1, SK_HEAD = 2, SK_ROPE32 = 3, SK_GATE = 4 };
struct SlotDesc { int kind; bf16_t* dst; int ld; int col; const float* gain; float scale; int rope; float* part; int pstride; int pidx; const float* bias; };


template <class Cfg>
struct EpiSlot {
    Cfg cfg; RowScale rs; int rs_off; RopeTabs rt; int tok_off;
    DI void operator()(const f32x4 (&acc)[2][2][4][2], const pg8::Unit& u, int wr, int wc, int fr, int fq) const {
        const SlotDesc d = cfg.get(u.pn * 4 + wc);
        if (d.kind == SK_SKIP) return;
        const int d0 = 8 * fq;
        float rsv[8]; rs_preload(rs, u.pm * 256 + wr * 64 + fr + rs_off, fq, rsv);
        float g0[8], g1[8];
        if (d.kind == SK_HEAD) {
#pragma unroll
            for (int i = 0; i < 8; ++i) { g0[i] = d.gain[d0 + i] * d.scale; g1[i] = d.gain[32 + d0 + i] * d.scale; }
        } else if (d.kind == SK_ROPE32) {
#pragma unroll
            for (int i = 0; i < 8; ++i) { g0[i] = fq < 2 ? d.gain[d0 + i] * d.scale : 0.f; g1[i] = fq < 2 ? d.gain[16 + d0 + i] * d.scale : 0.f; }
        } else if (d.kind == SK_GATE) {
#pragma unroll
            for (int i = 0; i < 8; ++i) { g0[i] = d.bias[d.col + d0 + i]; g1[i] = d.bias[d.col + 32 + d0 + i]; }
        } else {
#pragma unroll
            for (int i = 0; i < 8; ++i) { g0[i] = 0.f; g1[i] = 0.f; }
        }
#pragma unroll
        for (int ai = 0; ai < 2; ++ai)
#pragma unroll
            for (int m = 0; m < 4; ++m) {
                const int row = u.pm * 256 + ai * 128 + wr * 64 + m * 16 + fr;
                const float r = rsv[ai * 4 + m];
                float v0[8], v1[8];
#pragma unroll
                for (int n = 0; n < 2; ++n)
#pragma unroll
                    for (int j = 0; j < 4; ++j) { v0[4 * n + j] = acc[ai][0][m][n][j] * r; v1[4 * n + j] = acc[ai][1][m][n][j] * r; }
                bf16_t* dp = d.dst + (size_t)row * d.ld + d.col;
                if (d.kind == SK_RAW) {
                    if (d.part) {
                        float ss = 0.f;
#pragma unroll
                        for (int i = 0; i < 8; ++i) ss += v0[i] * v0[i] + v1[i] * v1[i];
                        ss += __shfl_xor(ss, 16); ss += __shfl_xor(ss, 32);
                        if (fq == 0) d.part[(size_t)row * d.pstride + d.pidx] = ss;
                    }
                    *(u32x4*)(dp + d0) = pack8(v0); *(u32x4*)(dp + 32 + d0) = pack8(v1);
                } else if (d.kind == SK_GATE) {
#pragma unroll
                    for (int i = 0; i < 8; ++i) { v0[i] = __builtin_amdgcn_rcpf(1.f + __builtin_amdgcn_exp2f(-(v0[i] + g0[i]) * LOG2E)); v1[i] = __builtin_amdgcn_rcpf(1.f + __builtin_amdgcn_exp2f(-(v1[i] + g1[i]) * LOG2E)); }
                    *(u32x4*)(dp + d0) = pack8(v0); *(u32x4*)(dp + 32 + d0) = pack8(v1);
                } else if (d.kind == SK_HEAD) {
                    float ss = 0.f;
#pragma unroll
                    for (int i = 0; i < 8; ++i) ss += v0[i] * v0[i] + v1[i] * v1[i];
                    ss += __shfl_xor(ss, 16); ss += __shfl_xor(ss, 32);
                    const float inv = __builtin_amdgcn_rsqf(ss * (1.f / 64.f) + EPS);
#pragma unroll
                    for (int i = 0; i < 8; ++i) { v0[i] *= inv * g0[i]; v1[i] *= inv * g1[i]; }
                    if (d.rope) {
                        const float* cp = rt.cosh + (size_t)(row + tok_off) * 32 + d0; const float* sp = rt.sinh + (size_t)(row + tok_off) * 32 + d0;
                        const f32x4 c0 = *(const f32x4*)cp, c1 = *(const f32x4*)(cp + 4), s0 = *(const f32x4*)sp, s1 = *(const f32x4*)(sp + 4);
#pragma unroll
                        for (int i = 0; i < 8; ++i) { const float c = i < 4 ? c0[i & 3] : c1[i & 3], s = i < 4 ? s0[i & 3] : s1[i & 3];
                            const float a = v0[i], b = v1[i]; v0[i] = a * c - b * s; v1[i] = b * c + a * s; }
                    }
                    *(u32x4*)(dp + d0) = pack8(v0); *(u32x4*)(dp + 32 + d0) = pack8(v1);
                } else {
                    float ss = 0.f;
#pragma unroll
                    for (int i = 0; i < 8; ++i) ss += v0[i] * v0[i] + v1[i] * v1[i];
                    ss += __shfl_xor(ss, 16); ss += __shfl_xor(ss, 32);
                    const float inv = __builtin_amdgcn_rsqf(ss * (1.f / 32.f) + EPS);
                    if (fq < 2) {
#pragma unroll
                        for (int i = 0; i < 8; ++i) { v0[i] *= inv * g0[i]; v1[i] *= inv * g1[i]; }
                        const float* cp = rt.cosr + (size_t)(row + tok_off) * 16 + d0; const float* sp = rt.sinr + (size_t)(row + tok_off) * 16 + d0;
                        const f32x4 c0 = *(const f32x4*)cp, c1 = *(const f32x4*)(cp + 4), s0 = *(const f32x4*)sp, s1 = *(const f32x4*)(sp + 4);
#pragma unroll
                        for (int i = 0; i < 8; ++i) { const float c = i < 4 ? c0[i & 3] : c1[i & 3], s = i < 4 ? s0[i & 3] : s1[i & 3];
                            const float a = v0[i], b = v1[i]; v0[i] = a * c - b * s; v1[i] = b * c + a * s; }
                        *(u32x4*)(dp + d0) = pack8(v0); *(u32x4*)(dp + 16 + d0) = pack8(v1);
                    }
                }
            }
    }
};

struct CfgIn {
    unsigned char* ws; const float* a_qn; const float* a_kn; const float* b_kn; const float* c_qn; const float* c_kn; const float* b_gate;
    DI SlotDesc get(int s) const {
        SlotDesc d; d.kind = SK_SKIP; d.dst = nullptr; d.ld = 0; d.col = 0; d.gain = nullptr; d.scale = 1.f; d.rope = 0; d.part = nullptr; d.pstride = 0; d.pidx = 0; d.bias = nullptr;
        if (s < 8) { d.kind = SK_HEAD; d.dst = (bf16_t*)(ws + WS_QA); d.ld = 512; d.col = 64 * s; d.gain = a_qn; d.scale = 0.125f * LOG2E; d.rope = 1; }
        else if (s < 10) { d.kind = SK_HEAD; d.dst = (bf16_t*)(ws + WS_KA); d.ld = 128; d.col = 64 * (s - 8); d.gain = a_kn; d.rope = 1; }
        else if (s < 12) { d.kind = SK_RAW; d.dst = (bf16_t*)(ws + WS_VA); d.ld = 128; d.col = 64 * (s - 10); }
        else if (s < 18) { d.kind = SK_RAW; d.dst = (bf16_t*)(ws + WS_CQ); d.ld = 384; d.col = 64 * (s - 12); d.part = (float*)(ws + WS_PCQ); d.pstride = 8; d.pidx = s - 12; }
        else if (s < 22) { d.kind = SK_RAW; d.dst = (bf16_t*)(ws + WS_CKV); d.ld = 256; d.col = 64 * (s - 18); d.part = (float*)(ws + WS_PCKV); d.pstride = 4; d.pidx = s - 18; }
        else if (s == 22) { d.kind = SK_ROPE32; d.dst = (bf16_t*)(ws + WS_KR); d.ld = 32; d.col = 0; d.gain = b_kn + 64; }
        else if (s < 95) { const int p = (s - 23) >> 3, h = (s - 23) & 7, g = p / 3, t = p % 3;
            d.dst = (bf16_t*)(ws + WS_CB + (size_t)p * 16 * MiB); d.ld = 512; d.col = 64 * h;
            if (t == 0) { d.kind = SK_HEAD; d.gain = c_qn + 64 * g; d.scale = 0.125f * LOG2E; d.rope = 1; }
            else if (t == 1) { d.kind = SK_HEAD; d.gain = c_kn + 64 * g; d.rope = 1; }
            else d.kind = SK_RAW; }
        else if (s < 103) { d.kind = SK_RAW; d.dst = (bf16_t*)(ws + WS_MQ); d.ld = 512; d.col = 64 * (s - 95); }
        else if (s < 167) { d.kind = SK_GATE; d.dst = (bf16_t*)(ws + WS_GATES); d.ld = 4096; d.col = 64 * (s - 103); d.bias = b_gate; }
        return d;
    }
};
DI void in_slot_src(int s, int& src, int& kind) {
    kind = 0;
    if (s < 22) src = 64 * s;
    else if (s == 22) { src = 1408; kind = 1; }
    else if (s < 167) src = 1440 + 64 * (s - 23);
    else { src = 0; kind = 2; }
}
struct CfgUq {
    unsigned char* ws; const float* b_qn;
    DI SlotDesc get(int s) const {
        SlotDesc d; d.dst = (bf16_t*)(ws + WS_QB); d.ld = 768; d.scale = 0.10206207261596575f * LOG2E; d.rope = 0; d.part = nullptr; d.pstride = 0; d.pidx = 0; d.bias = nullptr;
        if (s < 8) { d.kind = SK_HEAD; d.col = 96 * s; d.gain = b_qn; }
        else { d.kind = SK_ROPE32; d.col = 96 * (s - 8) + 64; d.gain = b_qn + 64; }
        return d;
    }
};
struct CfgUkv {
    unsigned char* ws; const float* b_kn;
    DI SlotDesc get(int s) const {
        SlotDesc d; d.ld = 512; d.scale = 1.f; d.rope = 0; d.part = nullptr; d.pstride = 0; d.pidx = 0; d.bias = nullptr; d.gain = b_kn;
        if (s < 8) { d.kind = SK_HEAD; d.dst = (bf16_t*)(ws + WS_KN); d.col = 64 * s; }
        else { d.kind = SK_RAW; d.dst = (bf16_t*)(ws + WS_VB); d.col = 64 * (s - 8); }
        return d;
    }
};
struct CfgMkv {
    unsigned char* ws;
    DI SlotDesc get(int s) const {
        SlotDesc d; d.kind = SK_RAW; d.ld = 512; d.scale = 1.f; d.rope = 0; d.part = nullptr; d.pstride = 0; d.pidx = 0; d.bias = nullptr; d.gain = nullptr;
        if (s < 8) { d.dst = (bf16_t*)(ws + WS_MK); d.col = 64 * s; } else { d.dst = (bf16_t*)(ws + WS_MV); d.col = 64 * (s - 8); }
        return d;
    }
};

struct EpiMerge {
    const bf16_t* gates; bf16_t* gy;
    DI void operator()(const f32x4 (&acc)[2][2][4][2], const pg8::Unit& u, int wr, int wc, int fr, int fq) const {
#pragma unroll
        for (int ai = 0; ai < 2; ++ai)
#pragma unroll
            for (int m = 0; m < 4; ++m) {
                const int row = u.pm * 256 + ai * 128 + wr * 64 + m * 16 + fr;
#pragma unroll
                for (int bj = 0; bj < 2; ++bj) {
                    const int col = u.pn * 256 + bj * 128 + wc * 32 + 8 * fq;
                    float g[8], o[8];
                    unpack8(*(const u32x4*)(gates + (size_t)row * 4096 + u.seg * 1024 + col), g);
                    bf16_t* gp = gy + (size_t)row * 1024 + col;
                    if (u.seg == 0) {
#pragma unroll
                        for (int i = 0; i < 8; ++i) o[i] = 0.f;
                    } else unpack8(*(const u32x4*)gp, o);
#pragma unroll
                    for (int n = 0; n < 2; ++n)
#pragma unroll
                        for (int j = 0; j < 4; ++j) o[4 * n + j] += g[4 * n + j] * acc[ai][bj][m][n][j];
                    *(u32x4*)gp = pack8(o);
                }
            }
    }
};
struct EpiRes {
    const float* xsrc; float* xdst; bf16_t* xb; float* px;
    DI void operator()(const f32x4 (&acc)[2][2][4][2], const pg8::Unit& u, int wr, int wc, int fr, int fq) const {
#pragma unroll
        for (int ai = 0; ai < 2; ++ai)
#pragma unroll
            for (int m = 0; m < 4; ++m) {
                const int row = u.pm * 256 + ai * 128 + wr * 64 + m * 16 + fr;
                float ss = 0.f;
#pragma unroll
                for (int bj = 0; bj < 2; ++bj) {
                    const size_t off = (size_t)row * 1024 + u.pn * 256 + bj * 128 + wc * 32 + 8 * fq;
                    float o[8];
#pragma unroll
                    for (int n = 0; n < 2; ++n) { const f32x4 xs = *(const f32x4*)(xsrc + off + 4 * n); const f32x4 xn = xs + acc[ai][bj][m][n]; *(f32x4*)(xdst + off + 4 * n) = xn;
#pragma unroll
                        for (int j = 0; j < 4; ++j) { o[4 * n + j] = xn[j]; ss += xn[j] * xn[j]; } }
                    *(u32x4*)(xb + off) = pack8(o);
                }
                ss += __shfl_xor(ss, 16); ss += __shfl_xor(ss, 32);
                if (fq == 0) px[(size_t)row * 16 + u.pn * 4 + wc] = ss;
            }
    }
};
struct EpiUp {
    bf16_t* U; RowScale rs; int rs_off;
    DI void operator()(const f32x4 (&acc)[2][2][4][2], const pg8::Unit& u, int wr, int wc, int fr, int fq) const {
        float rsv[8]; rs_preload(rs, u.pm * 256 + wr * 64 + fr + rs_off, fq, rsv);
#pragma unroll
        for (int ai = 0; ai < 2; ++ai)
#pragma unroll
            for (int m = 0; m < 4; ++m) {
                const int row = u.pm * 256 + ai * 128 + wr * 64 + m * 16 + fr;
                const float r = rsv[ai * 4 + m];
#pragma unroll
                for (int bj = 0; bj < 2; ++bj) {
                    float o[8];
#pragma unroll
                    for (int n = 0; n < 2; ++n)
#pragma unroll
                        for (int j = 0; j < 4; ++j) { const float v = fmaxf(acc[ai][bj][m][n][j] * r, 0.f); o[4 * n + j] = v * v; }
                    *(u32x4*)(U + (size_t)row * DFF + u.pn * 256 + bj * 128 + wc * 32 + 8 * fq) = pack8(o);
                }
            }
    }
};

DI void transpose_item(const float* W, int K, int N, const float* gk, bf16_t* WT, int rho0, int k0, int src0, int nvalid, LAS float* scr, int lane) {
    { const int c4 = (lane & 7) * 4;
#pragma unroll
      for (int i = 0; i < 8; ++i) { const int kk = 8 * i + (lane >> 3);
        f32x4 v = (f32x4){0.f, 0.f, 0.f, 0.f};
        if (c4 < nvalid) v = *(const f32x4*)(W + (size_t)(k0 + kk) * N + src0 + c4);
        if (gk) v = v * gk[k0 + kk];
        scr[kk * 33 + c4] = v.x; scr[kk * 33 + c4 + 1] = v.y; scr[kk * 33 + c4 + 2] = v.z; scr[kk * 33 + c4 + 3] = v.w; } }
    LDS_WAIT();
    const int c8 = lane & 7;
#pragma unroll
    for (int j = 0; j < 4; ++j) { const int n = (lane >> 3) + 8 * j; const LAS float* s = scr + (8 * c8) * 33 + n;
        u32x4 o; o.x = cvtpk(s[0 * 33], s[1 * 33]); o.y = cvtpk(s[2 * 33], s[3 * 33]); o.z = cvtpk(s[4 * 33], s[5 * 33]); o.w = cvtpk(s[6 * 33], s[7 * 33]);
        *(u32x4*)(WT + (size_t)(rho0 + n) * K + k0 + 8 * c8) = o; }
    LDS_WAIT();
}
DI void block_src(int mapk, int q  , int& src0, int& nvalid) {
    if (mapk == 0) { src0 = 32 * q; nvalid = 32; return; }
    const int pn = q >> 3, bj = (q >> 2) & 1, wc = q & 3, s = 4 * pn + wc;
    if (mapk == 1) { int src, kind; in_slot_src(s, src, kind);
        if (kind == 0) { src0 = src + 32 * bj; nvalid = 32; } else if (kind == 1) { src0 = src + 16 * bj; nvalid = 16; } else { src0 = 0; nvalid = 0; } }
    else if (mapk == 2) { if (s < 8) { src0 = 96 * s + 32 * bj; nvalid = 32; } else { src0 = 96 * (s - 8) + 64 + 16 * bj; nvalid = 16; } }
    else if (mapk == 3) { if (s < 8) { src0 = 128 * s + 32 * bj; nvalid = 32; } else { src0 = 128 * (s - 8) + 64 + 32 * bj; nvalid = 32; } }
    else { src0 = 64 * s + 32 * bj; nvalid = 32; }
}
DI void convert_matrix(const float* W, int K, int N, int Nt, const float* gk, bf16_t* WT, int mapk, LAS float* scr, int gw, int NGW, int lane) {
    const int nblk = Nt / 32, items = (K / 64) * nblk;
    for (int it = gw; it < items; it += NGW) {
        const int kb = it / nblk, q = it % nblk; int src0, nvalid; block_src(mapk, q, src0, nvalid);
        transpose_item(W, K, N, gk, WT, 32 * q, 64 * kb, src0, nvalid, scr, lane);
    }
}
DI void convert_layer(int l, LAS unsigned char* lds, int gw, int NGW, int wave) {
    const int lane = lane_id();
    CParams* q = fresh_params();
    LAS float* scr = (LAS float*)(lds + wave * 16384);
    unsigned char* ws = q->ws;
    convert_matrix(q->in[4] + (size_t)l * D * N_IN, D, N_IN, NT_IN, q->in[3] + l * D, (bf16_t*)(ws + WS_WIN), 1, scr, gw, NGW, lane);
    convert_matrix(q->in[11] + (size_t)l * 384 * 768, 384, 768, 1024, q->in[9] + l * 384, (bf16_t*)(ws + WS_WUQ), 2, scr, gw, NGW, lane);
    convert_matrix(q->in[12] + (size_t)l * 256 * 1024, 256, 1024, 1024, q->in[10] + l * 256, (bf16_t*)(ws + WS_WUKV), 3, scr, gw, NGW, lane);
    convert_matrix(q->in[18] + (size_t)l * D * 1024, D, 1024, 1024, q->in[17] + l * D, (bf16_t*)(ws + WS_WMKV), 4, scr, gw, NGW, lane);
    for (int n = 0; n < 4; ++n)
        convert_matrix(q->in[21] + ((size_t)l * 4 + n) * 512 * D, 512, D, D, nullptr, (bf16_t*)(ws + WS_WBR) + (size_t)n * D * 512, 0, scr, gw, NGW, lane);
    convert_matrix(q->in[22] + (size_t)l * D * D, D, D, D, nullptr, (bf16_t*)(ws + WS_WOUT), 0, scr, gw, NGW, lane);
    convert_matrix(q->in[24] + (size_t)l * D * DFF, D, DFF, DFF, q->in[23] + l * D, (bf16_t*)(ws + WS_WUP), 0, scr, gw, NGW, lane);
    convert_matrix(q->in[25] + (size_t)l * DFF * D, DFF, D, D, nullptr, (bf16_t*)(ws + WS_WDN), 0, scr, gw, NGW, lane);
}

DI int crow(int i, int h) { return (i & 3) + 8 * (i >> 2) + 4 * h; }
DI f32x16 mfma32(bf16x8 a, bf16x8 b, f32x16 c) { return __builtin_amdgcn_mfma_f32_32x32x16_bf16(a, b, c, 0, 0, 0); }
DI bf16x8 packp(const f32x16& x, int s) { u32x4 w; w.x = cvtpk(x[8 * s], x[8 * s + 1]); w.y = cvtpk(x[8 * s + 2], x[8 * s + 3]); w.z = cvtpk(x[8 * s + 4], x[8 * s + 5]); w.w = cvtpk(x[8 * s + 6], x[8 * s + 7]); return __builtin_bit_cast(bf16x8, w); }
DI s16x4 vtr(const LAS char* p) { return __builtin_bit_cast(s16x4, __builtin_amdgcn_ds_read_tr16_b64_v4i16((LAS s16x4*)p)); }

DI float xhalf_max(float v) { auto rr = __builtin_amdgcn_permlane32_swap(__float_as_uint(v), __float_as_uint(v), false, false); return fmaxf(__uint_as_float(rr[0]), __uint_as_float(rr[1])); }
DI float xhalf_sum(float v) { auto rr = __builtin_amdgcn_permlane32_swap(__float_as_uint(v), __float_as_uint(v), false, false); return __uint_as_float(rr[0]) + __uint_as_float(rr[1]); }
DI f32x16 splat16(float v) { f32x16 p;
#pragma unroll
    for (int i = 0; i < 16; ++i) p[i] = v;
    return p; }
template <int DQK, int NT, int TSTRIDE> DI void st_tiles(unsigned kaddr, const bf16x8* qf, const f32x16& init, f32x16* p) {
    bf16x8 a[NT][DQK / 16];
#pragma unroll
    for (int j = 0; j < NT; ++j)
#pragma unroll
        for (int ks = 0; ks < DQK / 16; ++ks) asm volatile("ds_read_b128 %0, %1 offset:%2" : "=v"(a[j][ks]) : "v"(kaddr), "i"(j * TSTRIDE + ks * 32));
    asm volatile("s_waitcnt lgkmcnt(0)" ::: "memory");
#pragma unroll
    for (int j = 0; j < NT; ++j)
#pragma unroll
        for (int ks = 0; ks < DQK / 16; ++ks) asm volatile("" : "+v"(a[j][ks]));
#pragma unroll
    for (int j = 0; j < NT; ++j) p[j] = init;
#pragma unroll
    for (int ks = 0; ks < DQK / 16; ++ks)
#pragma unroll
        for (int j = 0; j < NT; ++j) p[j] = mfma32(a[j][ks], qf[ks], p[j]);
}
template <int DV, int VP> DI void pv_tile(f32x16* o, const LAS char* vp, const f32x16& p, int h) {
#pragma unroll
    for (int s = 0; s < 2; ++s) {
        const bf16x8 pa = packp(p, s);
#pragma unroll
        for (int db = 0; db < DV / 32; ++db) {
            const s16x4 lo = vtr(vp + (16 * s + 4 * h) * VP + db * 64);
            const s16x4 hi = vtr(vp + (16 * s + 8 + 4 * h) * VP + db * 64);
            const bf16x8 vb = __builtin_shufflevector(lo, hi, 0, 1, 2, 3, 4, 5, 6, 7);
            o[db] = mfma32(pa, vb, o[db]);
        }
    }
}
template <int NDB> DI void scale_o(f32x16* o, float f, LAS float* sc, int r, int h) {
    if (h == 0) sc[r] = f;
    LDS_WAIT();
#pragma unroll
    for (int g = 0; g < 4; ++g) { const f32x4 f4 = *(const LAS f32x4*)(sc + 8 * g + 4 * h);
#pragma unroll
        for (int db = 0; db < NDB; ++db)
#pragma unroll
            for (int j = 0; j < 4; ++j) o[db][4 * g + j] *= f4[j]; }
    LDS_WAIT();
}
template <int NDB> DI void store_o(const f32x16* o, bf16_t* obase  , long rstride, int r, int h) {
#pragma unroll
    for (int i = 0; i < 16; ++i) { bf16_t* rp = obase + (long)crow(i, h) * rstride + r;
#pragma unroll
        for (int db = 0; db < NDB; ++db) rp[32 * db] = (bf16_t)(cvtpk(o[db][i], 0.f) & 0xffffu); }
}

constexpr int BKP = 144, BVP = 144;
constexpr int BSLOT = 256 * BKP + 256 * BVP;

DI void banded_load(LAS char* dst, int pitch, const bf16_t* src  , int ld, long row0  , int dil, int gi0, int tid) {
#pragma unroll
    for (int it = 0; it < 4; ++it) {
        const int c = tid + it * NTHREADS, key = c >> 3, cc = c & 7, gi = gi0 + key;
        u32x4 v = (u32x4){0u, 0u, 0u, 0u};
        if (gi >= 0) v = *(const u32x4*)(src + (row0 + (long)gi * dil) * ld + cc * 8);
        *(LAS u32x4*)(dst + key * pitch + cc * 16) = v;
    }
}
template <bool SINK, bool WANT_LSE>
DI void banded_task(const bf16_t* qrow  , bf16_t* obase, long rstride, const LAS char* Ks, const LAS char* Vs,
                    int wq, int jblk, int maxd, float sink2, float* lsep, LAS float* sc, int lane) {
    const int r = lane & 31, h = lane >> 5;
    bf16x8 qf[4];
#pragma unroll
    for (int ks = 0; ks < 4; ++ks) qf[ks] = *(const bf16x8*)(qrow + 16 * ks + 8 * h);
    f32x16 p[5];
    const f32x16 zero16 = splat16(0.f);
    { const unsigned ka = (unsigned)(uintptr_t)(Ks + (32 * wq + r) * BKP + 16 * h);
      st_tiles<64, 3, 32 * BKP>(ka, qf, zero16, p); st_tiles<64, 2, 32 * BKP>(ka + 96 * BKP, qf, zero16, p + 3); }
    const int tmin = (jblk == 0) ? 4 - wq : 0, lo = r + 128 - maxd;
#pragma unroll
    for (int t = 0; t < 5; ++t) {
        if (t < tmin) { p[t] = splat16(NEGBIG); }
        else if (t == 0) {
#pragma unroll
            for (int i = 0; i < 16; ++i) p[t][i] = (crow(i, h) >= lo) ? p[t][i] : NEGBIG;
        } else if (t == 4) {
#pragma unroll
            for (int i = 0; i < 16; ++i) p[t][i] = (crow(i, h) <= r) ? p[t][i] : NEGBIG;
        }
    }
    float mx = NEGBIG;
#pragma unroll
    for (int t = 0; t < 5; ++t)
#pragma unroll
        for (int i = 0; i < 16; ++i) mx = fmaxf(mx, p[t][i]);
    mx = xhalf_max(mx);
    if (SINK) mx = fmaxf(mx, sink2);
    float l = 0.f;
#pragma unroll
    for (int t = 0; t < 5; ++t)
#pragma unroll
        for (int i = 0; i < 16; ++i) { const float e = __builtin_amdgcn_exp2f(p[t][i] - mx); p[t][i] = e; l += e; }
    l = xhalf_sum(l);
    if (SINK) l += __builtin_amdgcn_exp2f(sink2 - mx);
    f32x16 o[2];
#pragma unroll
    for (int i = 0; i < 16; ++i) { o[0][i] = 0.f; o[1][i] = 0.f; }
    const LAS char* vl = Vs + ((lane & 15) >> 2) * BVP + ((lane >> 4) & 1) * 32 + (lane & 3) * 8;
#pragma unroll
    for (int t = 0; t < 5; ++t) pv_tile<64, BVP>(o, vl + 32 * (wq + t) * BVP, p[t], h);
    scale_o<2>(o, 1.f / l, sc, r, h);
    store_o<2>(o, obase, rstride, r, h);
    if (WANT_LSE) { if (h == 0) *lsep = mx + __builtin_amdgcn_logf(l); }
}

template <int DQK, int DV, bool CAUSAL, bool SPLITK>
DI void dense_unit(const bf16_t* Q, int ldq, const bf16_t* K1, int ldk1, const bf16_t* K2, int ldk2, const bf16_t* V, int ldv, bf16_t* O, int ldo,
                   int q0  , int ntiles, LAS char* lds, LAS float* sc, int tid) {
    constexpr int KP = DQK * 2 + 16, VP = DV * 2 + 16, KCH = DQK / 8, VCH = DV / 8, NK = 64 * KCH, NCH = NK + 64 * VCH, NIT = (NCH + NTHREADS - 1) / NTHREADS;
    constexpr int KBUF = 64 * KP, VBUF = 64 * VP;
    const int lane = tid & 63, w = __builtin_amdgcn_readfirstlane(tid >> 6), r = lane & 31, h = lane >> 5;
    LAS char* kb0 = lds; LAS char* vb0 = lds + 2 * KBUF;
    bf16x8 qf[DQK / 16];
    { const bf16_t* qr = Q + (long)(32 * w + r) * ldq;
#pragma unroll
      for (int ks = 0; ks < DQK / 16; ++ks) { qf[ks] = *(const bf16x8*)(qr + 16 * ks + 8 * h); asm volatile("" : "+v"(qf[ks])); } }
    u32x4 pre[NIT];
    auto gload = [&](int t) {
        const int tid2 = opaque(tid);
#pragma unroll
        for (int it = 0; it < NIT; ++it) { const int c = tid2 + it * NTHREADS;
            if (c < NK) { const int key = c / KCH, cc = c % KCH; const long kr = (long)(64 * t + key);
                pre[it] = (SPLITK && cc >= 8) ? *(const u32x4*)(K2 + kr * ldk2 + (cc - 8) * 8) : *(const u32x4*)(K1 + kr * ldk1 + cc * 8); }
            else if (c < NCH) { const int c2 = c - NK, key = c2 / VCH, cc = c2 % VCH; pre[it] = *(const u32x4*)(V + (long)(64 * t + key) * ldv + cc * 8); } }
    };
    auto lstore = [&](int b) {
        const int tid2 = opaque(tid);
#pragma unroll
        for (int it = 0; it < NIT; ++it) { const int c = tid2 + it * NTHREADS;
            if (c < NK) { const int key = c / KCH, cc = c % KCH; *(LAS u32x4*)(kb0 + b * KBUF + key * KP + cc * 16) = pre[it]; }
            else if (c < NCH) { const int c2 = c - NK, key = c2 / VCH, cc = c2 % VCH; *(LAS u32x4*)(vb0 + b * VBUF + key * VP + cc * 16) = pre[it]; } }
    };
    gload(0); lstore(0);
    __syncthreads();
    float m = 0.f, l = 0.f; bool first = true;
    f32x16 negm = splat16(0.f);
    f32x16 o[DV / 32];
#pragma unroll
    for (int db = 0; db < DV / 32; ++db)
#pragma unroll
        for (int i = 0; i < 16; ++i) o[db][i] = 0.f;
    const int qpos = q0 + 32 * w + r;
    for (int t = 0; t < ntiles; ++t) {
        const int b = t & 1;
        if (t + 1 < ntiles) gload(t + 1);
        if (!CAUSAL || 64 * t <= q0 + 32 * w) {
            const LAS char* kp = kb0 + b * KBUF + r * KP + 16 * h;
            f32x16 pp[2]; st_tiles<DQK, 2, 32 * KP>((unsigned)(uintptr_t)kp, qf, negm, pp);
            f32x16& p0 = pp[0]; f32x16& p1 = pp[1];
            if (CAUSAL && 64 * t + 63 > q0 + 32 * w) {
#pragma unroll
                for (int i = 0; i < 16; ++i) { const int key = 64 * t + crow(i, h); if (key > qpos) p0[i] = NEGBIG; if (key + 32 > qpos) p1[i] = NEGBIG; }
            }
            float mx = NEGBIG;
#pragma unroll
            for (int i = 0; i < 16; ++i) mx = fmaxf(mx, fmaxf(p0[i], p1[i]));
            mx = xhalf_max(mx);
            if (first || __any(mx > 8.f)) {
                const float dl = first ? mx : (mx > 8.f ? mx : 0.f);
                m += dl;
                const float f = __builtin_amdgcn_exp2f(-dl);
                l *= f;
#pragma unroll
                for (int i = 0; i < 16; ++i) { p0[i] -= dl; p1[i] -= dl; }
                if (!first) scale_o<DV / 32>(o, f, sc, r, h);
                negm = splat16(-m);
                first = false;
            }
#pragma unroll
            for (int i = 0; i < 16; ++i) { p0[i] = __builtin_amdgcn_exp2f(p0[i]); p1[i] = __builtin_amdgcn_exp2f(p1[i]); l += p0[i] + p1[i]; }
            const LAS char* vl = vb0 + b * VBUF + ((lane & 15) >> 2) * VP + ((lane >> 4) & 1) * 32 + (lane & 3) * 8;
            pv_tile<DV, VP>(o, vl, p0, h);
            pv_tile<DV, VP>(o, vl + 32 * VP, p1, h);
        }
        if (t + 1 < ntiles) lstore(b ^ 1);
        __syncthreads();
    }
    l = xhalf_sum(l);
    scale_o<DV / 32>(o, 1.f / l, sc, r, h);
    store_o<DV / 32>(o, O + (long)(32 * w) * ldo, ldo, r, h);
}


#define XB_TMO      128
#define XB_XCNT(j)  (256  + 64 * (j))
#define XB_XSUB(j)  (1280 + 64 * (j))
#define XB_XGEN(j)  (2304 + 64 * (j))
#define XB_TOP      3328
#define XB_TOPGEN   3392
#define XCD_BAR_WORDS 3456
#define XB_SPIN_CAP (1u << 22)
DI unsigned xb_ld(unsigned* p)              { return __hip_atomic_load(p, __ATOMIC_RELAXED, __HIP_MEMORY_SCOPE_AGENT); }
DI unsigned xb_add(unsigned* p, unsigned v) { return __hip_atomic_fetch_add(p, v, __ATOMIC_RELAXED, __HIP_MEMORY_SCOPE_AGENT); }
DI unsigned xb_xcc_id() { return (unsigned)__builtin_amdgcn_s_getreg((3 << 11) | 20) & 0xFu; }
#define XB_SPIN(cond, bar) do { unsigned _sp = 0; while (cond) { __builtin_amdgcn_s_sleep(1); \
    if ((++_sp & 255u) == 0u) { if (xb_ld(&(bar)[XB_TMO])) break; if (_sp > XB_SPIN_CAP) { atomicAdd(&(bar)[XB_TMO], 1u); break; } } } } while (0)
struct XcdBarrier { unsigned* bar; unsigned x; volatile LAS unsigned* st; };
DI XcdBarrier xcd_barrier_post(unsigned* bar, volatile LAS unsigned* st) {
    XcdBarrier b; b.bar = bar; b.x = xb_xcc_id(); b.st = st;
    if (threadIdx.x == 0) (void)xb_add(&bar[XB_XCNT(b.x)], 1u);
    return b;
}
DI void xcd_barrier_complete(unsigned* bar, unsigned x, unsigned& nloc, unsigned& nx) {
    const unsigned G = gridDim.x * gridDim.y * gridDim.z;
    unsigned sum, cnt, mine, sp = 0u;
    for (;;) {
        sum = 0u; cnt = 0u; mine = 0u;
#pragma unroll
        for (unsigned j = 0; j < 16; ++j) { const unsigned c = xb_ld(&bar[XB_XCNT(j)]); sum += c; cnt += (c > 0u) ? 1u : 0u; mine = (j == x) ? c : mine; }
        if (sum == G) break;
        __builtin_amdgcn_s_sleep(1);
        if ((++sp & 255u) == 0u) { if (xb_ld(&bar[XB_TMO])) break; if (sp > XB_SPIN_CAP) { atomicAdd(&bar[XB_TMO], 1u); break; } }
    }
    nloc = mine > 0u ? mine : 1u; nx = cnt > 0u ? cnt : 1u;
}
DI void xcd_barrier(unsigned* bar, unsigned x, volatile LAS unsigned* st) {
    asm volatile("s_waitcnt vmcnt(0)" ::: "memory");
    __syncthreads();
    if (threadIdx.x == 0) {
        __builtin_amdgcn_s_waitcnt(0);
        unsigned nloc = st[0], nx = st[1];
        if (nloc == 0u) { xcd_barrier_complete(bar, x, nloc, nx); st[0] = nloc; st[1] = nx; }
        const unsigned old = xb_add(&bar[XB_XSUB(x)], 1u);
        const unsigned gen = old / nloc;
        if (old + 1u == (gen + 1u) * nloc) {
            __builtin_amdgcn_fence(__ATOMIC_RELEASE, "agent");
            asm volatile("s_waitcnt vmcnt(0)" ::: "memory");
            const unsigned og = xb_add(&bar[XB_TOP], 1u);
            const unsigned tg = og / nx;
            if (og + 1u == (tg + 1u) * nx) xb_add(&bar[XB_TOPGEN], 1u);
            else XB_SPIN(xb_ld(&bar[XB_TOPGEN]) == tg, bar);
            __builtin_amdgcn_fence(__ATOMIC_ACQUIRE, "agent");
            xb_add(&bar[XB_XGEN(x)], 1u);
            asm volatile("s_waitcnt vmcnt(0)" ::: "memory");
        } else {
            XB_SPIN(xb_ld(&bar[XB_XGEN(x)]) == gen, bar);
            __builtin_amdgcn_fence(__ATOMIC_ACQUIRE, "agent");
            asm volatile("s_waitcnt vmcnt(0)" ::: "memory");
        }
    }
    __syncthreads();
}

DI void sincos_acc(float ang, float& c, float& s) {
    const double x = (double)ang;
    const double n = __builtin_rint(x * 0.63661977236758134308);
    double rr = __builtin_fma(-n, 1.57079632679489655800e+00, x); rr = __builtin_fma(-n, 6.12323399573676603587e-17, rr);
    const double r2 = rr * rr;
    const double sn = rr * (1.0 + r2 * (-1.0 / 6 + r2 * (1.0 / 120 + r2 * (-1.0 / 5040 + r2 * (1.0 / 362880 + r2 * (-1.0 / 39916800 + r2 * (1.0 / 6227020800.0)))))));
    const double cs = 1.0 + r2 * (-0.5 + r2 * (1.0 / 24 + r2 * (-1.0 / 720 + r2 * (1.0 / 40320 + r2 * (-1.0 / 3628800 + r2 * (1.0 / 479001600.0))))));
    const int q = ((int)n) & 3;
    const double cc = (q == 0) ? cs : (q == 1) ? -sn : (q == 2) ? -cs : sn;
    const double ss = (q == 0) ? sn : (q == 1) ? cs : (q == 2) ? -sn : -cs;
    c = (float)cc; s = (float)ss;
}

#ifndef PH
#define PH 255
#endif
#ifndef REP_P1
#define REP_P1 1
#endif
#ifndef REP_B
#define REP_B 1
#endif
#ifndef REP_CONV
#define REP_CONV 1
#endif
#ifndef REP_P7
#define REP_P7 1
#endif
#define GRID_SYNC() do { CParams* qb_ = fresh_params(); xcd_barrier((unsigned*)(qb_->ws + WS_CTL), xcc, MISC); } while (0)

__global__ void __launch_bounds__(NTHREADS, 2) fwd_megakernel(Params p) {
    extern __shared__ __attribute__((aligned(16))) unsigned char lds_raw[];
    cg::grid_group grid = cg::this_grid();
    LAS unsigned char* lds = (LAS unsigned char*)lds_raw;
    const int wave = __builtin_amdgcn_readfirstlane((int)threadIdx.x >> 6);
    const int G = gridDim.x, bid = blockIdx.x;
    const int gw = bid * NWAVES + wave, NGW = G * NWAVES;
    LAS float* sc = (LAS float*)(lds + LDS_SCR) + wave * 64;
    volatile LAS unsigned* MISC = (volatile LAS unsigned*)(lds + LDS_SCR + 2048);
    if (threadIdx.x < 4) MISC[threadIdx.x] = 0u;
    __syncthreads();
    unsigned xcc;
    { CParams* q0 = fresh_params(); const XcdBarrier xb = xcd_barrier_post((unsigned*)(q0->ws + WS_CTL), MISC); xcc = xb.x; }

#ifndef NOPRO
    {
        PHASE_CTX
        float* COSH = (float*)(ws + WS_COSH); float* SINH = (float*)(ws + WS_SINH); float* COSR = (float*)(ws + WS_COSR); float* SINR = (float*)(ws + WS_SINR);
        const float* x = q->in[0]; const int* pos = (const int*)q->in[2];
        const int lane = lane_id(), tid = wave * 64 + lane;
        for (int i = bid * NTHREADS + tid; i < TT * 32; i += G * NTHREADS) { const int t = i >> 5, k = i & 31; float c, s; sincos_acc((float)pos[t] * q->inv_h[k], c, s); COSH[i] = c; SINH[i] = s; }
        for (int i = bid * NTHREADS + tid; i < TT * 16; i += G * NTHREADS) { const int t = i >> 4, k = i & 15; float c, s; sincos_acc((float)pos[t] * q->inv_r[k], c, s); COSR[i] = c; SINR[i] = s; }
        for (int row = gw; row < TT; row += NGW) {
            const f32x4* xr = (const f32x4*)(x + (size_t)row * D) + lane; float ss = 0.f;
            u32x2* o8 = (u32x2*)(XB + (size_t)row * D) + lane;
#pragma unroll
            for (int j = 0; j < 4; ++j) { const f32x4 v = xr[64 * j]; ss += (v.x * v.x + v.y * v.y) + (v.z * v.z + v.w * v.w); u32x2 w; w.x = cvtpk(v.x, v.y); w.y = cvtpk(v.z, v.w); o8[64 * j] = w; }
            ss = wave_sum(ss);
            if (lane < 16) PX[(size_t)row * 16 + lane] = lane == 0 ? ss : 0.f;
        }
        const float* mem = q->in[1]; bf16_t* MEMN = (bf16_t*)(ws + WS_MEMN);
        for (int row = gw; row < BATCH * NMEM; row += NGW) {
            const f32x4* xr = (const f32x4*)(mem + (size_t)row * D) + lane; f32x4 v[4]; float ss = 0.f;
#pragma unroll
            for (int j = 0; j < 4; ++j) { v[j] = xr[64 * j]; ss += (v[j].x * v[j].x + v[j].y * v[j].y) + (v[j].z * v[j].z + v[j].w * v[j].w); }
            const float rstd = __builtin_amdgcn_rsqf(wave_sum(ss) * (1.f / D) + EPS);
            u32x2* o8 = (u32x2*)(MEMN + (size_t)row * D) + lane;
#pragma unroll
            for (int j = 0; j < 4; ++j) { u32x2 w; w.x = cvtpk(v[j].x * rstd, v[j].y * rstd); w.y = cvtpk(v[j].z * rstd, v[j].w * rstd); o8[64 * j] = w; }
        }
    }

#endif
    for (int l = 0; l < DEPTH; ++l) {
#ifndef NOCONV
#pragma unroll 1
        for (int rep = 0; rep < REP_CONV; ++rep) convert_layer(l, lds, gw, NGW, wave);
#endif
        if (l == 0) grid.sync(); else GRID_SYNC();
        for (int ch = 0; ch < NCHUNK; ++ch) {
            const int tok0 = ch * TC;
#if PH & 1
            {
                PHASE_CTX
                pg8::TileOrder S; S.init(TC, NT_IN, G, bid, XB + (size_t)tok0 * D, (const bf16_t*)(ws + WS_WIN));
                EpiSlot<CfgIn> E{CfgIn{ws, q->in[6] + l * 64, q->in[7] + l * 64, q->in[14] + l * 96, q->in[15] + l * 192, q->in[16] + l * 192, q->in[5] + l * 4096},
                                 RowScale{PX, 16, 16, 1.f / D}, tok0, rt, tok0};
#pragma unroll 1
                for (int rep = 0; rep < REP_P1; ++rep) pg8::gemm_phase(lds, D, D, S, E, wave);
                if (ch == 0) {
                    pg8::TileOrder S2; S2.init(BATCH * NMEM, 1024, G, (bid + 128) % G, (const bf16_t*)(ws + WS_MEMN), (const bf16_t*)(ws + WS_WMKV));
                    EpiSlot<CfgMkv> E2{CfgMkv{ws}, RowScale{nullptr, 0, 0, 0.f}, 0, rt, 0};
                    pg8::gemm_phase(lds, D, D, S2, E2, wave);
                }
            }

#endif
            GRID_SYNC();
#if PH & 2
            {
                PHASE_CTX
                pg8::TileOrder S; S.init(TC, 1024, G, bid, (const bf16_t*)(ws + WS_CQ), (const bf16_t*)(ws + WS_WUQ));
                EpiSlot<CfgUq> E{CfgUq{ws, q->in[13] + l * 96}, RowScale{(const float*)(ws + WS_PCQ), 8, 6, 1.f / 384.f}, 0, rt, tok0};
                pg8::gemm_phase(lds, 384, 384, S, E, wave);
                pg8::TileOrder S2; S2.init(TC, 1024, G, bid, (const bf16_t*)(ws + WS_CKV), (const bf16_t*)(ws + WS_WUKV));
                EpiSlot<CfgUkv> E2{CfgUkv{ws, q->in[14] + l * 96}, RowScale{(const float*)(ws + WS_PCKV), 4, 4, 1.f / 256.f}, 0, rt, tok0};
                pg8::gemm_phase(lds, 256, 256, S2, E2, wave);
                const int lane = opaque(lane_id());
                const int nrows = TC + (ch == 0 ? BATCH * NMEM : 0);
                for (int rw = gw; rw < nrows; rw += NGW) {
                    const bool isq = rw < TC;
                    bf16_t* rp = isq ? (bf16_t*)(ws + WS_MQ) + (size_t)rw * 512 : (bf16_t*)(ws + WS_MK) + (size_t)(rw - TC) * 512;
                    const float* gn = (isq ? q->in[19] : q->in[20]) + l * 128 + (lane & 15) * 8;
                    const float scl = isq ? 0.08838834764831845f * LOG2E : 1.f;
                    float v[8]; unpack8(*(const u32x4*)(rp + lane * 8), v);
                    float ss = 0.f;
#pragma unroll
                    for (int i = 0; i < 8; ++i) ss += v[i] * v[i];
                    ss += __shfl_xor(ss, 1); ss += __shfl_xor(ss, 2); ss += __shfl_xor(ss, 4); ss += __shfl_xor(ss, 8);
                    const float inv = __builtin_amdgcn_rsqf(ss * (1.f / 128.f) + EPS) * scl;
#pragma unroll
                    for (int i = 0; i < 8; ++i) v[i] *= inv * gn[i];
                    *(u32x4*)(rp + lane * 8) = pack8(v);
                }
            }

#endif
            GRID_SYNC();
#if PH & 4
            {
                PHASE_CTX
                LAS char* al = (LAS char*)lds;
                const int lane = opaque(lane_id()), tid = wave * 64 + lane;
#pragma unroll 1
                for (int rep = 0; rep < REP_B; ++rep)
                for (int idx = bid; idx < BC * 8 * 16; idx += G) {
                    const int half = idx / (BC * 64), rem = idx % (BC * 64), bh = rem / 8, s = rem % 8;
                    const int qb = half == 0 ? s : 15 - s, b = bh / 8, hh = bh % 8;
                    const long r0 = (long)b * SEQ;
                    dense_unit<96, 64, true, true>((const bf16_t*)(ws + WS_QB) + (r0 + 256 * qb) * 768 + 96 * hh, 768,
                        (const bf16_t*)(ws + WS_KN) + r0 * 512 + 64 * hh, 512, (const bf16_t*)(ws + WS_KR) + r0 * 32, 32,
                        (const bf16_t*)(ws + WS_VB) + r0 * 512 + 64 * hh, 512, (bf16_t*)(ws + WS_OB) + (r0 + 256 * qb) * 512 + 64 * hh, 512,
                        256 * qb, 4 * (qb + 1), al, sc, tid);
                }
                for (int idx = bid; idx < 3 * BC * 32 * 4; idx += G) {
                    const int g = idx / (BC * 128), rem = idx % (BC * 128), hp = rem & 3, sj = rem >> 2;
                    const int dil = g == 0 ? 1 : g == 1 ? 4 : 16, nb = 32 / dil;
                    const int n = sj / nb, j = sj % nb, b = n / dil, res = n % dil;
                    const long row0 = (long)b * SEQ + res;
                    const bf16_t* Qg = (const bf16_t*)(ws + WS_CB + (size_t)(3 * g) * 16 * MiB); const bf16_t* Kg = (const bf16_t*)(ws + WS_CB + (size_t)(3 * g + 1) * 16 * MiB); const bf16_t* Vg = (const bf16_t*)(ws + WS_CB + (size_t)(3 * g + 2) * 16 * MiB);
#pragma unroll
                    for (int sl = 0; sl < 2; ++sl) {
                        banded_load(al + sl * BSLOT, BKP, Kg + 64 * (2 * hp + sl), 512, row0, dil, 128 * (j - 1), tid);
                        banded_load(al + sl * BSLOT + 256 * BKP, BVP, Vg + 64 * (2 * hp + sl), 512, row0, dil, 128 * (j - 1), tid);
                    }
                    __syncthreads();
                    { const int sl = wave >> 2, wq = wave & 3, hd = 2 * hp + sl, r = lane & 31;
                      const long qtok = row0 + (long)(128 * j + 32 * wq + r) * dil;
                      bf16_t* ob = (bf16_t*)Qg + (row0 + (long)(128 * j + 32 * wq) * dil) * 512 + 64 * hd;
                      banded_task<false, true>(Qg + qtok * 512 + 64 * hd, ob, (long)dil * 512, al + sl * BSLOT, al + sl * BSLOT + 256 * BKP, wq, j, 128, 0.f,
                                               (float*)(ws + WS_LSE) + (qtok * 8 + hd) * 4 + g, sc, lane); }
                    __syncthreads();
                }
                for (int idx = bid; idx < BC * 32 * 2; idx += G) {
                    const int kvh = idx & 1, j = (idx >> 1) & 31, b = idx >> 6;
                    const long row0 = (long)b * SEQ;
                    banded_load(al, BKP, (const bf16_t*)(ws + WS_KA) + 64 * kvh, 128, row0, 1, 128 * (j - 1), tid);
                    banded_load(al + 256 * BKP, BVP, (const bf16_t*)(ws + WS_VA) + 64 * kvh, 128, row0, 1, 128 * (j - 1), tid);
                    __syncthreads();
#pragma unroll 1
                    for (int pass = 0; pass < 2; ++pass) {
                        const int hq = kvh * 4 + (wave >> 2) + 2 * pass, wq = wave & 3, r = lane & 31;
                        const long qtok = row0 + 128 * j + 32 * wq + r;
                        bf16_t* QA = (bf16_t*)(ws + WS_QA);
                        banded_task<true, false>(QA + qtok * 512 + 64 * hq, QA + (row0 + 128 * j + 32 * wq) * 512 + 64 * hq, 512, al, al + 256 * BKP, wq, j, 127,
                                                 (q->in[8] + l * 8)[hq] * LOG2E, nullptr, sc, lane);
                    }
                    __syncthreads();
                }
                for (int idx = bid; idx < BC * 4 * 16; idx += G) {
                    const int qb = idx & 15, hh = (idx >> 4) & 3, b = idx >> 6;
                    const long r0 = (long)b * SEQ + 256 * qb; const long m0 = (long)(ch * BC + b) * NMEM;
                    bf16_t* MQ = (bf16_t*)(ws + WS_MQ);
                    dense_unit<128, 128, false, false>(MQ + r0 * 512 + 128 * hh, 512, (const bf16_t*)(ws + WS_MK) + m0 * 512 + 128 * hh, 512, nullptr, 0,
                        (const bf16_t*)(ws + WS_MV) + m0 * 512 + 128 * hh, 512, MQ + r0 * 512 + 128 * hh, 512, 0, 4, al, sc, tid);
                }
            }

#endif
            GRID_SYNC();
#if PH & 8
            {
                PHASE_CTX
                const float* LSE = (const float*)(ws + WS_LSE); bf16_t* OC = (bf16_t*)(ws + WS_OC);
                const int tid = wave * 64 + opaque(lane_id());
                for (int i = bid * NTHREADS + tid; i < TC * 64; i += G * NTHREADS) {
                    const int tok = i >> 6, c8 = i & 63, hd = c8 >> 3;
                    const f32x4 ls = *(const f32x4*)(LSE + ((size_t)tok * 8 + hd) * 4);
                    const float mx = fmaxf(ls.x, fmaxf(ls.y, ls.z));
                    float w0 = __builtin_amdgcn_exp2f(ls.x - mx), w1 = __builtin_amdgcn_exp2f(ls.y - mx), w2 = __builtin_amdgcn_exp2f(ls.z - mx);
                    const float inv = 1.f / (w0 + w1 + w2); w0 *= inv; w1 *= inv; w2 *= inv;
                    float a[8], b[8], c[8], o[8];
                    unpack8(*(const u32x4*)((const bf16_t*)(ws + WS_CB) + (size_t)tok * 512 + c8 * 8), a);
                    unpack8(*(const u32x4*)((const bf16_t*)(ws + WS_CB + 48 * MiB) + (size_t)tok * 512 + c8 * 8), b);
                    unpack8(*(const u32x4*)((const bf16_t*)(ws + WS_CB + 96 * MiB) + (size_t)tok * 512 + c8 * 8), c);
#pragma unroll
                    for (int k = 0; k < 8; ++k) o[k] = w0 * a[k] + w1 * b[k] + w2 * c[k];
                    *(u32x4*)(OC + (size_t)tok * 512 + c8 * 8) = pack8(o);
                }
            }

#endif
            GRID_SYNC();
#if PH & 16
            {
                PHASE_CTX
                pg8::TileOrder S; S.init(TC, D, G, bid, (const bf16_t*)(ws + WS_QA), (const bf16_t*)(ws + WS_WBR)); S.nseg = 4;
                S.segA = 8 * MiB; S.segB = (size_t)D * 512;
                EpiMerge E{(const bf16_t*)(ws + WS_GATES), (bf16_t*)(ws + WS_GY) + (size_t)tok0 * D};
                pg8::gemm_phase(lds, 512, 512, S, E, wave);
            }

#endif
            GRID_SYNC();
        }
        {
            const int tok0 = 0;
#if PH & 32
            {
                PHASE_CTX
                pg8::TileOrder S; S.init(TT, D, G, bid, (const bf16_t*)(ws + WS_GY), (const bf16_t*)(ws + WS_WOUT));
                EpiRes E{((l == 0) ? q->in[0] : q->out) + (size_t)tok0 * D, q->out + (size_t)tok0 * D, XB + (size_t)tok0 * D, PX + (size_t)tok0 * 16};
                pg8::gemm_phase(lds, D, D, S, E, wave);
            }

#endif
            GRID_SYNC();
#if PH & 64
            {
                PHASE_CTX
                pg8::TileOrder S; S.init(TT, DFF, G, bid, XB + (size_t)tok0 * D, (const bf16_t*)(ws + WS_WUP));
                EpiUp E{(bf16_t*)(ws + WS_U), RowScale{PX, 16, 16, 1.f / D}, tok0};
#pragma unroll 1
                for (int rep = 0; rep < REP_P7; ++rep) pg8::gemm_phase(lds, D, D, S, E, wave);
            }

#endif
            GRID_SYNC();
#if PH & 128
            {
                PHASE_CTX
                pg8::TileOrder S; S.init(TT, D, G, bid, (const bf16_t*)(ws + WS_U), (const bf16_t*)(ws + WS_WDN));
                EpiRes E{q->out + (size_t)tok0 * D, q->out + (size_t)tok0 * D, XB + (size_t)tok0 * D, PX + (size_t)tok0 * 16};
                pg8::gemm_phase(lds, DFF, DFF, S, E, wave);
            }

#endif
            GRID_SYNC();
        }
    }
}

extern "C" void kernel_launch(void* const* d_in, const int* in_sizes, int n_in, void* d_out, int out_size, void* d_ws, size_t ws_size, hipStream_t stream) {
    static int grid = 0;
    if (grid == 0) {
        if (n_in != 26 || out_size != TT * D || ws_size < WS_END) { fprintf(stderr, "kernel_launch: unexpected shapes (n_in %d out %d ws %zu)\n", n_in, out_size, ws_size); grid = -1; return; }
        int dev = 0, cus = 0, per_cu = 0;
        hipGetDevice(&dev); hipDeviceGetAttribute(&cus, hipDeviceAttributeMultiprocessorCount, dev);
        hipFuncSetAttribute((const void*)fwd_megakernel, hipFuncAttributeMaxDynamicSharedMemorySize, LDS_BYTES);
        hipOccupancyMaxActiveBlocksPerMultiprocessor(&per_cu, (const void*)fwd_megakernel, NTHREADS, LDS_BYTES);
        if (per_cu < 1) { fprintf(stderr, "kernel_launch: occupancy query says %d blocks per CU\n", per_cu); per_cu = 1; }
        (void)hipGetLastError();
        grid = cus;
    }
    if (grid < 0) return;
    if (hipMemsetAsync((char*)d_ws + WS_CTL, 0, XCD_BAR_WORDS * 4, stream) != hipSuccess) { fprintf(stderr, "kernel_launch: memset failed\n"); return; }
    Params p{};
    for (int i = 0; i < 26; ++i) p.in[i] = (const float*)d_in[i];
    p.out = (float*)d_out; p.ws = (unsigned char*)d_ws;
    for (int i = 0; i < 32; ++i) p.inv_h[i] = (float)std::pow(10000.0, -(double)(2 * i) / 64.0);
    for (int i = 0; i < 16; ++i) p.inv_r[i] = (float)std::pow(10000.0, -(double)(2 * i) / 32.0);
    void* args[] = {&p};
    hipError_t e = hipLaunchCooperativeKernel((const void*)fwd_megakernel, dim3(grid), dim3(NTHREADS), args, LDS_BYTES, stream);
    if (e != hipSuccess) fprintf(stderr, "cooperative launch failed: %s (grid %d)\n", hipGetErrorString(e), grid);
}
```

```cpp
#include <hip/hip_runtime.h>
#include <hip/hip_cooperative_groups.h>
#include <cstdio>
#include <cstdint>
#include <cmath>
namespace cg = cooperative_groups;

#define LAS __attribute__((address_space(3)))
#define DI __device__ __forceinline__
typedef unsigned short bf16_t;
typedef short bf16x8 __attribute__((ext_vector_type(8)));
typedef short s16x4 __attribute__((ext_vector_type(4)));
typedef float f32x4 __attribute__((ext_vector_type(4)));
typedef float f32x16 __attribute__((ext_vector_type(16)));
typedef unsigned u32x4 __attribute__((ext_vector_type(4)));
typedef unsigned u32x2 __attribute__((ext_vector_type(2)));
typedef float f32x2_t __attribute__((ext_vector_type(2)));
typedef __bf16 bf16x2_t __attribute__((ext_vector_type(2)));

constexpr int D = 1024, BATCH = 8, SEQ = 4096, DEPTH = 4, TT = BATCH * SEQ;
constexpr int NCHUNK = 2, BC = BATCH / NCHUNK, TC = BC * SEQ;
constexpr int N_IN = 10656, NT_IN = 10752;
constexpr int DFF = 4096, NMEM = 256;
constexpr float EPS = 1e-6f;
constexpr float LOG2E = 1.4426950408889634f;
constexpr float NEGBIG = -1e30f;
constexpr int NTHREADS = 512, NWAVES = 8;

constexpr size_t MiB = 1u << 20;
constexpr size_t WS_CTL = 0;
constexpr size_t WS_WIN = 1 * MiB, WS_WUQ = 22 * MiB, WS_WUKV = 23 * MiB, WS_WMKV = 24 * MiB, WS_WBR = 26 * MiB, WS_WOUT = 30 * MiB, WS_WUP = 32 * MiB, WS_WDN = 40 * MiB;
constexpr size_t WS_XB = 48 * MiB, WS_PX = 112 * MiB, WS_COSH = 114 * MiB, WS_SINH = 118 * MiB, WS_COSR = 122 * MiB, WS_SINR = 124 * MiB;
constexpr size_t WS_MEMN = 126 * MiB, WS_MK = 130 * MiB, WS_MV = 132 * MiB;
constexpr size_t WS_QA = 134 * MiB, WS_OB = 150 * MiB, WS_OC = 166 * MiB, WS_MQ = 182 * MiB;
constexpr size_t WS_KA = 198 * MiB, WS_VA = 202 * MiB, WS_CQ = 206 * MiB, WS_CKV = 218 * MiB, WS_KR = 226 * MiB, WS_PCQ = 227 * MiB, WS_PCKV = 227 * MiB + 512 * 1024;
constexpr size_t WS_CB = 228 * MiB;
constexpr size_t WS_GATES = 372 * MiB, WS_U = WS_CB;
constexpr size_t WS_QB = 500 * MiB, WS_KN = 524 * MiB, WS_VB = 540 * MiB, WS_LSE = 556 * MiB, WS_GY = 558 * MiB;
constexpr size_t WS_END = 622 * MiB;

constexpr int LDS_BYTES = 155648;
constexpr int LDS_SCR = 149504;

struct Params {
    const float* in[26];
    float* out;
    unsigned char* ws;
    float inv_h[32];
    float inv_r[16];
    int pad[2];
};

DI unsigned cvtpk(float lo, float hi) { f32x2_t v = {lo, hi}; bf16x2_t b = __builtin_convertvector(v, bf16x2_t); return __builtin_bit_cast(unsigned, b); }
DI float bf_lo(unsigned w) { return __uint_as_float(w << 16); }
DI float bf_hi(unsigned w) { return __uint_as_float(w & 0xffff0000u); }
DI u32x4 pack8(const float* v) { u32x4 w; w.x = cvtpk(v[0], v[1]); w.y = cvtpk(v[2], v[3]); w.z = cvtpk(v[4], v[5]); w.w = cvtpk(v[6], v[7]); return w; }
DI void unpack8(u32x4 w, float* v) { v[0] = bf_lo(w.x); v[1] = bf_hi(w.x); v[2] = bf_lo(w.y); v[3] = bf_hi(w.y); v[4] = bf_lo(w.z); v[5] = bf_hi(w.z); v[6] = bf_lo(w.w); v[7] = bf_hi(w.w); }
DI float wave_sum(float v) {
#pragma unroll
    for (int o = 1; o < 64; o <<= 1) v += __shfl_xor(v, o);
    return v;
}
struct RopeTabs { const float* cosh; const float* sinh; const float* cosr; const float* sinr; };
typedef const struct Params __attribute__((address_space(4))) CParams;
DI CParams* fresh_params() { unsigned long long k = (unsigned long long)__builtin_amdgcn_kernarg_segment_ptr(); asm volatile("" : "+s"(k)); return (CParams*)k; }
#define PHASE_CTX \
    CParams* q = fresh_params(); unsigned char* ws = q->ws; (void)ws; \
    bf16_t* XB = (bf16_t*)(ws + WS_XB); float* PX = (float*)(ws + WS_PX); (void)XB; (void)PX; \
    const RopeTabs rt{(const float*)(ws + WS_COSH), (const float*)(ws + WS_SINH), (const float*)(ws + WS_COSR), (const float*)(ws + WS_SINR)}; (void)rt;
DI int opaque(int v) { asm volatile("" : "+v"(v)); return v; }
DI int lane_id() { int v; asm volatile("v_mbcnt_lo_u32_b32 %0, -1, 0\n\tv_mbcnt_hi_u32_b32 %0, -1, %0" : "=v"(v)); return v; }
#define LDS_WAIT() asm volatile("s_waitcnt lgkmcnt(0)" ::: "memory")

namespace pg8 {
constexpr int BM = 256, BK = 64, HALF = 128, HTB = HALF * BK * 2, STAGE_BYTES = 8 * HTB, NXCD = 8, WGM = 8;
DI int lds_byte(int r, int c) { const int st = (r >> 4) * 2 + (c >> 5), rr = r & 15, cc = c & 31, ob = rr * 64 + cc * 2; return st * 1024 + (ob ^ (((ob >> 9) & 1) << 5)); }
DI void stage_rc(int b, int& R, int& C) { const int st = b / 1024, sb = b % 1024, swz = sb ^ (((sb >> 9) & 1) << 5); R = (st >> 1) * 16 + swz / 64; C = (st & 1) * 32 + (swz % 64) / 2; }
DI int perm32(int rho) { const int n = rho >> 4, i = rho & 15; return 8 * (i >> 2) + 4 * n + (i & 3); }

struct Unit { int pm, pn, seg; const bf16_t* A; const bf16_t* Bt; };

struct TileOrder {
    int nM, nN, nwg, G, c, nseg;
    const bf16_t* A0; const bf16_t* B0; size_t segA, segB;
    DI void init(int M, int N, int G_, int c_, const bf16_t* A, const bf16_t* B) { nM = M / BM; nN = N / BM; nwg = nM * nN; G = G_; c = c_; nseg = 1; A0 = A; B0 = B; segA = 0; segB = 0; }
    DI bool next(int i, Unit& u) const {
        const int seg = i % nseg, ti = i / nseg;
        const long L = (long)ti * G + c; if (L >= nwg) return false;
        int wgid = (int)L; { const int q = nwg / NXCD, r = nwg % NXCD, xcd = wgid % NXCD, off = wgid / NXCD; wgid = (xcd < r ? xcd * (q + 1) : r * (q + 1) + (xcd - r) * q) + off; }
        const int nig = WGM * nN, gid = wgid / nig, fm = gid * WGM, gsz = (nM - fm) < WGM ? (nM - fm) : WGM;
        u.pm = fm + ((wgid % nig) % gsz); u.pn = (wgid % nig) / gsz; u.seg = seg;
        u.A = A0 + (size_t)seg * segA; u.Bt = B0 + (size_t)seg * segB;
        return true;
    }
};

template <class Epi, class Sched>
DI void gemm_phase(LAS unsigned char* lds, const int K, const int lda, const Sched& S, const Epi& E, const int wid) {
    const int lane = opaque(lane_id()), tid = wid * 64 + lane, wr = wid >> 2, wc = wid & 3, fr = lane & 15, fq = lane >> 4;
    const int nt = K / BK;
    unsigned voffA[2], voffB[2];
#pragma unroll
    for (int i = 0; i < 2; ++i) { int R, C; stage_rc(tid * 16 + i * 8192, R, C); const int Rb = (R & ~31) + perm32(R & 31);
        voffA[i] = (unsigned)(R * lda + C) * 2u; voffB[i] = (unsigned)(Rb * K + C) * 2u; }
    const size_t kstep = (size_t)(BK * 2);
    const size_t hstepA = (size_t)HALF * lda * 2, hstepB = (size_t)HALF * K * 2;
    const size_t tstepA = 2 * hstepA, tstepB = 2 * hstepB;
    const unsigned ldsw = (unsigned)wid * 1024u;
    const int aoff = lds_byte(wr * 64 + fr, fq * 8), boff = lds_byte(wc * 32 + fr, fq * 8);
#define PG8_SA(b, h) (((b) * 2 + (h)) * HTB)
#define PG8_SB(b, h) ((4 + (b) * 2 + (h)) * HTB)
#define PG8_STAGE(bufoff, gbase, voff) do { _Pragma("unroll") for (int _i = 0; _i < 2; ++_i) \
        __builtin_amdgcn_global_load_lds((const unsigned*)((const char*)(gbase) + (voff)[_i]), (LAS unsigned*)(lds + (bufoff) + ldsw + _i * 8192), 16, 0, 0); } while (0)
#define PG8_LDA(dst, b, h) do { _Pragma("unroll") for (int m = 0; m < 4; ++m) _Pragma("unroll") for (int k = 0; k < 2; ++k) dst[m][k] = *(const LAS bf16x8*)(lds + PG8_SA(b, h) + aoff + m * 2048 + k * 1024); } while (0)
#define PG8_LDB(dst, b, h) do { _Pragma("unroll") for (int n = 0; n < 2; ++n) _Pragma("unroll") for (int k = 0; k < 2; ++k) dst[n][k] = *(const LAS bf16x8*)(lds + PG8_SB(b, h) + boff + n * 2048 + k * 1024); } while (0)
#define PG8_MMA(ai, bj, At, Bt) do { __builtin_amdgcn_s_setprio(1); _Pragma("unroll") for (int m = 0; m < 4; ++m) _Pragma("unroll") for (int n = 0; n < 2; ++n) _Pragma("unroll") for (int k = 0; k < 2; ++k) \
        acc[ai][bj][m][n] = __builtin_amdgcn_mfma_f32_16x16x32_bf16(Bt[n][k], At[m][k], acc[ai][bj][m][n], 0, 0, 0); __builtin_amdgcn_s_setprio(0); } while (0)
#define PG8_WAIT_V(n) asm volatile("s_waitcnt vmcnt(" #n ")" ::: "memory")
#define PG8_WAIT_L(n) asm volatile("s_waitcnt lgkmcnt(" #n ")" ::: "memory")
#define PG8_BAR __builtin_amdgcn_s_barrier()
#define PG8_SCHED __builtin_amdgcn_sched_barrier(0)
    Unit cur, nxt; int ui = 0;
    if (!S.next(0, cur)) return;
    f32x4 acc[2][2][4][2];
#pragma unroll
    for (int a = 0; a < 2; ++a)
#pragma unroll
        for (int b = 0; b < 2; ++b)
#pragma unroll
            for (int m = 0; m < 4; ++m)
#pragma unroll
                for (int n = 0; n < 2; ++n) acc[a][b][m][n] = (f32x4){0.f, 0.f, 0.f, 0.f};
    bf16x8 At[4][2], B0[2][2], B1[2][2];
    const char* cA = (const char*)cur.A + (size_t)cur.pm * tstepA; const char* cB = (const char*)cur.Bt + (size_t)cur.pn * tstepB;
    PG8_STAGE(PG8_SB(0, 0), cB, voffB); PG8_STAGE(PG8_SB(0, 1), cB + hstepB, voffB); PG8_STAGE(PG8_SA(0, 0), cA, voffA); PG8_STAGE(PG8_SA(0, 1), cA + hstepA, voffA);
    if (wr == 1) PG8_BAR;
    PG8_WAIT_V(2); PG8_BAR;
    PG8_STAGE(PG8_SB(1, 0), cB + kstep, voffB); PG8_STAGE(PG8_SA(1, 0), cA + kstep, voffA); PG8_STAGE(PG8_SB(1, 1), cB + hstepB + kstep, voffB);
    PG8_WAIT_V(6); PG8_BAR;
    for (;;) {
        const bool has_next = S.next(ui + 1, nxt);
        const char* nA = has_next ? (const char*)nxt.A + (size_t)nxt.pm * tstepA : cA; const char* nB = has_next ? (const char*)nxt.Bt + (size_t)nxt.pn * tstepB : cB;
#pragma unroll 1
        for (int t = 0; t < nt; t += 2) {
            const bool last = (t == nt - 2);
            const char* a1 = cA + (size_t)(t + 1) * kstep;
            const char* a2 = last ? nA : cA + (size_t)(t + 2) * kstep; const char* b2 = last ? nB : cB + (size_t)(t + 2) * kstep;
            const char* a3 = a2 + kstep; const char* b3 = b2 + kstep;
            PG8_LDB(B0, 0, 0); PG8_LDB(B1, 0, 1); PG8_SCHED; PG8_LDA(At, 0, 0); PG8_STAGE(PG8_SA(1, 1), a1 + hstepA, voffA);
            PG8_WAIT_V(8); PG8_WAIT_L(0); PG8_BAR; PG8_MMA(0, 0, At, B0); PG8_MMA(0, 1, At, B1); PG8_BAR; PG8_SCHED;
            PG8_LDA(At, 0, 1); PG8_STAGE(PG8_SB(0, 0), b2, voffB); PG8_STAGE(PG8_SB(0, 1), b2 + hstepB, voffB); PG8_STAGE(PG8_SA(0, 0), a2, voffA);
            PG8_WAIT_V(8); PG8_WAIT_L(0); PG8_BAR; PG8_MMA(1, 0, At, B0); PG8_MMA(1, 1, At, B1); PG8_BAR; PG8_SCHED;
            PG8_LDB(B0, 1, 0); PG8_LDB(B1, 1, 1); PG8_SCHED; PG8_LDA(At, 1, 0); PG8_STAGE(PG8_SA(0, 1), a2 + hstepA, voffA);
            PG8_WAIT_V(8); PG8_WAIT_L(0); PG8_BAR; PG8_MMA(0, 0, At, B0); PG8_MMA(0, 1, At, B1); PG8_BAR; PG8_SCHED;
            PG8_LDA(At, 1, 1); PG8_STAGE(PG8_SB(1, 0), b3, voffB); PG8_STAGE(PG8_SB(1, 1), b3 + hstepB, voffB); PG8_STAGE(PG8_SA(1, 0), a3, voffA);
            PG8_WAIT_V(8); PG8_WAIT_L(0); PG8_BAR; PG8_MMA(1, 0, At, B0); PG8_MMA(1, 1, At, B1); PG8_BAR; PG8_SCHED;
        }
        if (wr == 0) PG8_BAR;
        E(acc, cur, wr, wc, fr, fq);
        if (!has_next) break;
#pragma unroll
        for (int a = 0; a < 2; ++a)
#pragma unroll
            for (int b = 0; b < 2; ++b)
#pragma unroll
                for (int m = 0; m < 4; ++m)
#pragma unroll
                    for (int n = 0; n < 2; ++n) acc[a][b][m][n] = (f32x4){0.f, 0.f, 0.f, 0.f};
        cur = nxt; cA = nA; cB = nB; ++ui;
        if (wr == 1) PG8_BAR;
    }
    PG8_WAIT_V(0);
    PG8_BAR;
#undef PG8_SA
#undef PG8_SB
#undef PG8_STAGE
#undef PG8_LDA
#undef PG8_LDB
#undef PG8_MMA
#undef PG8_WAIT_V
#undef PG8_WAIT_L
#undef PG8_BAR
#undef PG8_SCHED
}
}

struct RowScale {
    const float* part; int stride; int cnt; float inv_n;
    DI float get(int row) const {
        if (!part) return 1.f;
        float s = 0.f;
        const float* p = part + (size_t)row * stride;
        for (int i = 0; i < cnt; i += 4) { const f32x4 v = *(const f32x4*)(p + i); s += (v.x + v.y) + (v.z + v.w); }
        return __builtin_amdgcn_rsqf(s * inv_n + EPS);
    }
};

DI void rs_preload(const RowScale& rs, int rowbase, int fq, float (&out)[8]) {
    if (!rs.part) {
#pragma unroll
        for (int i = 0; i < 8; ++i) out[i] = 1.f;
        return;
    }
#pragma unroll
    for (int hb = 0; hb < 2; ++hb) {
        float s[4];
#pragma unroll
        for (int i = 0; i < 4; ++i) { s[i] = 0.f;
            if (4 * fq < rs.cnt) { const f32x4 v = *(const f32x4*)(rs.part + (size_t)(rowbase + hb * 128 + i * 16) * rs.stride + 4 * fq);
                s[i] = v.x + (4 * fq + 1 < rs.cnt ? v.y : 0.f) + (4 * fq + 2 < rs.cnt ? v.z : 0.f) + (4 * fq + 3 < rs.cnt ? v.w : 0.f); } }
#pragma unroll
        for (int i = 0; i < 4; ++i) { float t = s[i]; t += __shfl_xor(t, 16); t += __shfl_xor(t, 32); out[hb * 4 + i] = __builtin_amdgcn_rsqf(t * rs.inv_n + EPS); }
        asm volatile("" ::: "memory");
    }
}
enum { SK_SKIP = 0, SK_RAW = 1, SK_HEAD = 2, SK_ROPE32 = 3, SK_GATE = 4 };
struct SlotDesc { int kind; bf16_t* dst; int ld; int col; const float* gain; float scale; int rope; float* part; int pstride; int pidx; const float* bias; };


template <class Cfg>
struct EpiSlot {
    Cfg cfg; RowScale rs; int rs_off; RopeTabs rt; int tok_off;
    template <int KIND>
    DI void run(const f32x4 (&acc)[2][2][4][2], const pg8::Unit& u, const SlotDesc& d, int wr, int fr, int fq) const {
        const int d0 = 8 * fq;
        float rsv[8]; rs_preload(rs, u.pm * 256 + wr * 64 + fr + rs_off, fq, rsv);
        float g0[8], g1[8];
        if (KIND == 2 || KIND == 5) {
#pragma unroll
            for (int i = 0; i < 8; ++i) { g0[i] = d.gain[d0 + i] * d.scale; g1[i] = d.gain[32 + d0 + i] * d.scale; }
        } else if (KIND == 3) {
#pragma unroll
            for (int i = 0; i < 8; ++i) { g0[i] = fq < 2 ? d.gain[d0 + i] * d.scale : 0.f; g1[i] = fq < 2 ? d.gain[16 + d0 + i] * d.scale : 0.f; }
        } else if (KIND == 4) {
#pragma unroll
            for (int i = 0; i < 8; ++i) { g0[i] = d.bias[d.col + d0 + i]; g1[i] = d.bias[d.col + 32 + d0 + i]; }
        }
#pragma unroll
        for (int ai = 0; ai < 2; ++ai)
#pragma unroll
            for (int m = 0; m < 4; ++m) {
                const int row = u.pm * 256 + ai * 128 + wr * 64 + m * 16 + fr;
                const float r = rsv[ai * 4 + m];
                float v0[8], v1[8];
#pragma unroll
                for (int n = 0; n < 2; ++n)
#pragma unroll
                    for (int j = 0; j < 4; ++j) { v0[4 * n + j] = acc[ai][0][m][n][j] * r; v1[4 * n + j] = acc[ai][1][m][n][j] * r; }
                bf16_t* dp = d.dst + (size_t)row * d.ld + d.col;
                if (KIND == 1) {
                    if (d.part) {
                        float ss = 0.f;
#pragma unroll
                        for (int i = 0; i < 8; ++i) ss += v0[i] * v0[i] + v1[i] * v1[i];
                        ss += __shfl_xor(ss, 16); ss += __shfl_xor(ss, 32);
                        if (fq == 0) d.part[(size_t)row * d.pstride + d.pidx] = ss;
                    }
                    *(u32x4*)(dp + d0) = pack8(v0); *(u32x4*)(dp + 32 + d0) = pack8(v1);
                } else if (KIND == 4) {
#pragma unroll
                    for (int i = 0; i < 8; ++i) { v0[i] = __builtin_amdgcn_rcpf(1.f + __builtin_amdgcn_exp2f(-(v0[i] + g0[i]) * LOG2E)); v1[i] = __builtin_amdgcn_rcpf(1.f + __builtin_amdgcn_exp2f(-(v1[i] + g1[i]) * LOG2E)); }
                    *(u32x4*)(dp + d0) = pack8(v0); *(u32x4*)(dp + 32 + d0) = pack8(v1);
                } else if (KIND == 2 || KIND == 5) {
                    float ss = 0.f;
#pragma unroll
                    for (int i = 0; i < 8; ++i) ss += v0[i] * v0[i] + v1[i] * v1[i];
                    ss += __shfl_xor(ss, 16); ss += __shfl_xor(ss, 32);
                    const float inv = __builtin_amdgcn_rsqf(ss * (1.f / 64.f) + EPS);
#pragma unroll
                    for (int i = 0; i < 8; ++i) { v0[i] *= inv * g0[i]; v1[i] *= inv * g1[i]; }
                    if (KIND == 5) {
                        const float* cp = rt.cosh + (size_t)(row + tok_off) * 32 + d0; const float* sp = rt.sinh + (size_t)(row + tok_off) * 32 + d0;
                        const f32x4 c0 = *(const f32x4*)cp, c1 = *(const f32x4*)(cp + 4), s0 = *(const f32x4*)sp, s1 = *(const f32x4*)(sp + 4);
#pragma unroll
                        for (int i = 0; i < 8; ++i) { const float c = i < 4 ? c0[i & 3] : c1[i & 3], sn = i < 4 ? s0[i & 3] : s1[i & 3];
                            const float a = v0[i], b = v1[i]; v0[i] = a * c - b * sn; v1[i] = b * c + a * sn; }
                    }
                    *(u32x4*)(dp + d0) = pack8(v0); *(u32x4*)(dp + 32 + d0) = pack8(v1);
                } else {
                    float ss = 0.f;
#pragma unroll
                    for (int i = 0; i < 8; ++i) ss += v0[i] * v0[i] + v1[i] * v1[i];
                    ss += __shfl_xor(ss, 16); ss += __shfl_xor(ss, 32);
                    const float inv = __builtin_amdgcn_rsqf(ss * (1.f / 32.f) + EPS);
                    if (fq < 2) {
#pragma unroll
                        for (int i = 0; i < 8; ++i) { v0[i] *= inv * g0[i]; v1[i] *= inv * g1[i]; }
                        const float* cp = rt.cosr + (size_t)(row + tok_off) * 16 + d0; const float* sp = rt.sinr + (size_t)(row + tok_off) * 16 + d0;
                        const f32x4 c0 = *(const f32x4*)cp, c1 = *(const f32x4*)(cp + 4), s0 = *(const f32x4*)sp, s1 = *(const f32x4*)(sp + 4);
#pragma unroll
                        for (int i = 0; i < 8; ++i) { const float c = i < 4 ? c0[i & 3] : c1[i & 3], sn = i < 4 ? s0[i & 3] : s1[i & 3];
                            const float a = v0[i], b = v1[i]; v0[i] = a * c - b * sn; v1[i] = b * c + a * sn; }
                        *(u32x4*)(dp + d0) = pack8(v0); *(u32x4*)(dp + 16 + d0) = pack8(v1);
                    }
                }
            }
    }
    DI void operator()(const f32x4 (&acc)[2][2][4][2], const pg8::Unit& u, int wr, int wc, int fr, int fq) const {
        const SlotDesc d = cfg.get(u.pn * 4 + wc);
        if (d.kind == SK_RAW) run<1>(acc, u, d, wr, fr, fq);
        else if (d.kind == SK_GATE) run<4>(acc, u, d, wr, fr, fq);
        else if (d.kind == SK_HEAD) { if (d.rope) run<5>(acc, u, d, wr, fr, fq); else run<2>(acc, u, d, wr, fr, fq); }
        else if (d.kind == SK_ROPE32) run<3>(acc, u, d, wr, fr, fq);
    }
};

struct CfgIn {
    unsigned char* ws; const float* a_qn; const float* a_kn; const float* b_kn; const float* c_qn; const float* c_kn; const float* b_gate;
    DI SlotDesc get(int s) const {
        SlotDesc d; d.kind = SK_SKIP; d.dst = nullptr; d.ld = 0; d.col = 0; d.gain = nullptr; d.scale = 1.f; d.rope = 0; d.part = nullptr; d.pstride = 0; d.pidx = 0; d.bias = nullptr;
        if (s < 8) { d.kind = SK_HEAD; d.dst = (bf16_t*)(ws + WS_QA); d.ld = 512; d.col = 64 * s; d.gain = a_qn; d.scale = 0.125f * LOG2E; d.rope = 1; }
        else if (s < 10) { d.kind = SK_HEAD; d.dst = (bf16_t*)(ws + WS_KA); d.ld = 128; d.col = 64 * (s - 8); d.gain = a_kn; d.rope = 1; }
        else if (s < 12) { d.kind = SK_RAW; d.dst = (bf16_t*)(ws + WS_VA); d.ld = 128; d.col = 64 * (s - 10); }
        else if (s < 18) { d.kind = SK_RAW; d.dst = (bf16_t*)(ws + WS_CQ); d.ld = 384; d.col = 64 * (s - 12); d.part = (float*)(ws + WS_PCQ); d.pstride = 8; d.pidx = s - 12; }
        else if (s < 22) { d.kind = SK_RAW; d.dst = (bf16_t*)(ws + WS_CKV); d.ld = 256; d.col = 64 * (s - 18); d.part = (float*)(ws + WS_PCKV); d.pstride = 4; d.pidx = s - 18; }
        else if (s == 22) { d.kind = SK_ROPE32; d.dst = (bf16_t*)(ws + WS_KR); d.ld = 32; d.col = 0; d.gain = b_kn + 64; }
        else if (s < 95) { const int p = (s - 23) >> 3, h = (s - 23) & 7, g = p / 3, t = p % 3;
            d.dst = (bf16_t*)(ws + WS_CB + (size_t)p * 16 * MiB); d.ld = 512; d.col = 64 * h;
            if (t == 0) { d.kind = SK_HEAD; d.gain = c_qn + 64 * g; d.scale = 0.125f * LOG2E; d.rope = 1; }
            else if (t == 1) { d.kind = SK_HEAD; d.gain = c_kn + 64 * g; d.rope = 1; }
            else d.kind = SK_RAW; }
        else if (s < 103) { d.kind = SK_RAW; d.dst = (bf16_t*)(ws + WS_MQ); d.ld = 512; d.col = 64 * (s - 95); }
        else if (s < 167) { d.kind = SK_GATE; d.dst = (bf16_t*)(ws + WS_GATES); d.ld = 4096; d.col = 64 * (s - 103); d.bias = b_gate; }
        return d;
    }
};
DI void in_slot_src(int s, int& src, int& kind) {
    kind = 0;
    if (s < 22) src = 64 * s;
    else if (s == 22) { src = 1408; kind = 1; }
    else if (s < 167) src = 1440 + 64 * (s - 23);
    else { src = 0; kind = 2; }
}
struct CfgUq {
    unsigned char* ws; const float* b_qn;
    DI SlotDesc get(int s) const {
        SlotDesc d; d.dst = (bf16_t*)(ws + WS_QB); d.ld = 768; d.scale = 0.10206207261596575f * LOG2E; d.rope = 0; d.part = nullptr; d.pstride = 0; d.pidx = 0; d.bias = nullptr;
        if (s < 8) { d.kind = SK_HEAD; d.col = 96 * s; d.gain = b_qn; }
        else { d.kind = SK_ROPE32; d.col = 96 * (s - 8) + 64; d.gain = b_qn + 64; }
        return d;
    }
};
struct CfgUkv {
    unsigned char* ws; const float* b_kn;
    DI SlotDesc get(int s) const {
        SlotDesc d; d.ld = 512; d.scale = 1.f; d.rope = 0; d.part = nullptr; d.pstride = 0; d.pidx = 0; d.bias = nullptr; d.gain = b_kn;
        if (s < 8) { d.kind = SK_HEAD; d.dst = (bf16_t*)(ws + WS_KN); d.col = 64 * s; }
        else { d.kind = SK_RAW; d.dst = (bf16_t*)(ws + WS_VB); d.col = 64 * (s - 8); }
        return d;
    }
};
struct CfgMkv {
    unsigned char* ws;
    DI SlotDesc get(int s) const {
        SlotDesc d; d.kind = SK_RAW; d.ld = 512; d.scale = 1.f; d.rope = 0; d.part = nullptr; d.pstride = 0; d.pidx = 0; d.bias = nullptr; d.gain = nullptr;
        if (s < 8) { d.dst = (bf16_t*)(ws + WS_MK); d.col = 64 * s; } else { d.dst = (bf16_t*)(ws + WS_MV); d.col = 64 * (s - 8); }
        return d;
    }
};

struct EpiMerge {
    const bf16_t* gates; bf16_t* gy;
    DI void operator()(const f32x4 (&acc)[2][2][4][2], const pg8::Unit& u, int wr, int wc, int fr, int fq) const {
#pragma unroll
        for (int ai = 0; ai < 2; ++ai)
#pragma unroll
            for (int m = 0; m < 4; ++m) {
                const int row = u.pm * 256 + ai * 128 + wr * 64 + m * 16 + fr;
#pragma unroll
                for (int bj = 0; bj < 2; ++bj) {
                    const int col = u.pn * 256 + bj * 128 + wc * 32 + 8 * fq;
                    float g[8], o[8];
                    unpack8(*(const u32x4*)(gates + (size_t)row * 4096 + u.seg * 1024 + col), g);
                    bf16_t* gp = gy + (size_t)row * 1024 + col;
                    if (u.seg == 0) {
#pragma unroll
                        for (int i = 0; i < 8; ++i) o[i] = 0.f;
                    } else unpack8(*(const u32x4*)gp, o);
#pragma unroll
                    for (int n = 0; n < 2; ++n)
#pragma unroll
                        for (int j = 0; j < 4; ++j) o[4 * n + j] += g[4 * n + j] * acc[ai][bj][m][n][j];
                    *(u32x4*)gp = pack8(o);
                }
            }
    }
};
struct EpiRes {
    const float* xsrc; float* xdst; bf16_t* xb; float* px;
    DI void operator()(const f32x4 (&acc)[2][2][4][2], const pg8::Unit& u, int wr, int wc, int fr, int fq) const {
#pragma unroll
        for (int ai = 0; ai < 2; ++ai)
#pragma unroll
            for (int m = 0; m < 4; ++m) {
                const int row = u.pm * 256 + ai * 128 + wr * 64 + m * 16 + fr;
                float ss = 0.f;
#pragma unroll
                for (int bj = 0; bj < 2; ++bj) {
                    const size_t off = (size_t)row * 1024 + u.pn * 256 + bj * 128 + wc * 32 + 8 * fq;
                    float o[8];
#pragma unroll
                    for (int n = 0; n < 2; ++n) { const f32x4 xs = *(const f32x4*)(xsrc + off + 4 * n); const f32x4 xn = xs + acc[ai][bj][m][n]; *(f32x4*)(xdst + off + 4 * n) = xn;
#pragma unroll
                        for (int j = 0; j < 4; ++j) { o[4 * n + j] = xn[j]; ss += xn[j] * xn[j]; } }
                    *(u32x4*)(xb + off) = pack8(o);
                }
                ss += __shfl_xor(ss, 16); ss += __shfl_xor(ss, 32);
                if (fq == 0) px[(size_t)row * 16 + u.pn * 4 + wc] = ss;
            }
    }
};
struct EpiUp {
    bf16_t* U; RowScale rs; int rs_off;
    DI void operator()(const f32x4 (&acc)[2][2][4][2], const pg8::Unit& u, int wr, int wc, int fr, int fq) const {
        float rsv[8]; rs_preload(rs, u.pm * 256 + wr * 64 + fr + rs_off, fq, rsv);
#pragma unroll
        for (int ai = 0; ai < 2; ++ai)
#pragma unroll
            for (int m = 0; m < 4; ++m) {
                const int row = u.pm * 256 + ai * 128 + wr * 64 + m * 16 + fr;
                const float r = rsv[ai * 4 + m];
#pragma unroll
                for (int bj = 0; bj < 2; ++bj) {
                    float o[8];
#pragma unroll
                    for (int n = 0; n < 2; ++n)
#pragma unroll
                        for (int j = 0; j < 4; ++j) { const float v = fmaxf(acc[ai][bj][m][n][j] * r, 0.f); o[4 * n + j] = v * v; }
                    *(u32x4*)(U + (size_t)row * DFF + u.pn * 256 + bj * 128 + wc * 32 + 8 * fq) = pack8(o);
                }
            }
    }
};

DI void transpose_item(const float* W, int K, int N, const float* gk, bf16_t* WT, int rho0, int k0, int src0, int nvalid, LAS float* scr, int lane) {
    { const int c4 = (lane & 7) * 4;
#pragma unroll
      for (int i = 0; i < 8; ++i) { const int kk = 8 * i + (lane >> 3);
        f32x4 v = (f32x4){0.f, 0.f, 0.f, 0.f};
        if (c4 < nvalid) v = *(const f32x4*)(W + (size_t)(k0 + kk) * N + src0 + c4);
        if (gk) v = v * gk[k0 + kk];
        scr[kk * 33 + c4] = v.x; scr[kk * 33 + c4 + 1] = v.y; scr[kk * 33 + c4 + 2] = v.z; scr[kk * 33 + c4 + 3] = v.w; } }
    LDS_WAIT();
    const int c8 = lane & 7;
#pragma unroll
    for (int j = 0; j < 4; ++j) { const int n = (lane >> 3) + 8 * j; const LAS float* s = scr + (8 * c8) * 33 + n;
        u32x4 o; o.x = cvtpk(s[0 * 33], s[1 * 33]); o.y = cvtpk(s[2 * 33], s[3 * 33]); o.z = cvtpk(s[4 * 33], s[5 * 33]); o.w = cvtpk(s[6 * 33], s[7 * 33]);
        *(u32x4*)(WT + (size_t)(rho0 + n) * K + k0 + 8 * c8) = o; }
    LDS_WAIT();
}
DI void block_src(int mapk, int q  , int& src0, int& nvalid) {
    if (mapk == 0) { src0 = 32 * q; nvalid = 32; return; }
    const int pn = q >> 3, bj = (q >> 2) & 1, wc = q & 3, s = 4 * pn + wc;
    if (mapk == 1) { int src, kind; in_slot_src(s, src, kind);
        if (kind == 0) { src0 = src + 32 * bj; nvalid = 32; } else if (kind == 1) { src0 = src + 16 * bj; nvalid = 16; } else { src0 = 0; nvalid = 0; } }
    else if (mapk == 2) { if (s < 8) { src0 = 96 * s + 32 * bj; nvalid = 32; } else { src0 = 96 * (s - 8) + 64 + 16 * bj; nvalid = 16; } }
    else if (mapk == 3) { if (s < 8) { src0 = 128 * s + 32 * bj; nvalid = 32; } else { src0 = 128 * (s - 8) + 64 + 32 * bj; nvalid = 32; } }
    else { src0 = 64 * s + 32 * bj; nvalid = 32; }
}
DI void convert_matrix(const float* W, int K, int N, int Nt, const float* gk, bf16_t* WT, int mapk, LAS float* scr, int gw, int NGW, int lane) {
    const int nblk = Nt / 32, items = (K / 64) * nblk;
    for (int it = gw; it < items; it += NGW) {
        const int kb = it / nblk, q = it % nblk; int src0, nvalid; block_src(mapk, q, src0, nvalid);
        transpose_item(W, K, N, gk, WT, 32 * q, 64 * kb, src0, nvalid, scr, lane);
    }
}
DI void convert_layer(int l, LAS unsigned char* lds, int gw, int NGW, int wave) {
    const int lane = lane_id();
    CParams* q = fresh_params();
    LAS float* scr = (LAS float*)(lds + wave * 16384);
    unsigned char* ws = q->ws;
    convert_matrix(q->in[4] + (size_t)l * D * N_IN, D, N_IN, NT_IN, q->in[3] + l * D, (bf16_t*)(ws + WS_WIN), 1, scr, gw, NGW, lane);
    convert_matrix(q->in[11] + (size_t)l * 384 * 768, 384, 768, 1024, q->in[9] + l * 384, (bf16_t*)(ws + WS_WUQ), 2, scr, gw, NGW, lane);
    convert_matrix(q->in[12] + (size_t)l * 256 * 1024, 256, 1024, 1024, q->in[10] + l * 256, (bf16_t*)(ws + WS_WUKV), 3, scr, gw, NGW, lane);
    convert_matrix(q->in[18] + (size_t)l * D * 1024, D, 1024, 1024, q->in[17] + l * D, (bf16_t*)(ws + WS_WMKV), 4, scr, gw, NGW, lane);
    for (int n = 0; n < 4; ++n)
        convert_matrix(q->in[21] + ((size_t)l * 4 + n) * 512 * D, 512, D, D, nullptr, (bf16_t*)(ws + WS_WBR) + (size_t)n * D * 512, 0, scr, gw, NGW, lane);
    convert_matrix(q->in[22] + (size_t)l * D * D, D, D, D, nullptr, (bf16_t*)(ws + WS_WOUT), 0, scr, gw, NGW, lane);
    convert_matrix(q->in[24] + (size_t)l * D * DFF, D, DFF, DFF, q->in[23] + l * D, (bf16_t*)(ws + WS_WUP), 0, scr, gw, NGW, lane);
    convert_matrix(q->in[25] + (size_t)l * DFF * D, DFF, D, D, nullptr, (bf16_t*)(ws + WS_WDN), 0, scr, gw, NGW, lane);
}

DI int crow(int i, int h) { return (i & 3) + 8 * (i >> 2) + 4 * h; }
DI f32x16 mfma32(bf16x8 a, bf16x8 b, f32x16 c) { return __builtin_amdgcn_mfma_f32_32x32x16_bf16(a, b, c, 0, 0, 0); }
DI bf16x8 packp(const f32x16& x, int s) { u32x4 w; w.x = cvtpk(x[8 * s], x[8 * s + 1]); w.y = cvtpk(x[8 * s + 2], x[8 * s + 3]); w.z = cvtpk(x[8 * s + 4], x[8 * s + 5]); w.w = cvtpk(x[8 * s + 6], x[8 * s + 7]); return __builtin_bit_cast(bf16x8, w); }
DI s16x4 vtr(const LAS char* p) { return __builtin_bit_cast(s16x4, __builtin_amdgcn_ds_read_tr16_b64_v4i16((LAS s16x4*)p)); }

DI float xhalf_max(float v) { auto rr = __builtin_amdgcn_permlane32_swap(__float_as_uint(v), __float_as_uint(v), false, false); return fmaxf(__uint_as_float(rr[0]), __uint_as_float(rr[1])); }
DI float xhalf_sum(float v) { auto rr = __builtin_amdgcn_permlane32_swap(__float_as_uint(v), __float_as_uint(v), false, false); return __uint_as_float(rr[0]) + __uint_as_float(rr[1]); }
DI f32x16 splat16(float v) { f32x16 p;
#pragma unroll
    for (int i = 0; i < 16; ++i) p[i] = v;
    return p; }
template <int DQK, int NT, int TSTRIDE> DI void st_tiles(unsigned kaddr, const bf16x8* qf, const f32x16& init, f32x16* p) {
    bf16x8 a[NT][DQK / 16];
#pragma unroll
    for (int j = 0; j < NT; ++j)
#pragma unroll
        for (int ks = 0; ks < DQK / 16; ++ks) asm volatile("ds_read_b128 %0, %1 offset:%2" : "=v"(a[j][ks]) : "v"(kaddr), "i"(j * TSTRIDE + ks * 32));
    asm volatile("s_waitcnt lgkmcnt(0)" ::: "memory");
#pragma unroll
    for (int j = 0; j < NT; ++j)
#pragma unroll
        for (int ks = 0; ks < DQK / 16; ++ks) asm volatile("" : "+v"(a[j][ks]));
#pragma unroll
    for (int j = 0; j < NT; ++j) p[j] = init;
#pragma unroll
    for (int ks = 0; ks < DQK / 16; ++ks)
#pragma unroll
        for (int j = 0; j < NT; ++j) p[j] = mfma32(a[j][ks], qf[ks], p[j]);
}
template <int DV, int VP> DI void pv_tile(f32x16* o, const LAS char* vp, const f32x16& p, int h) {
#pragma unroll
    for (int s = 0; s < 2; ++s) {
        const bf16x8 pa = packp(p, s);
#pragma unroll
        for (int db = 0; db < DV / 32; ++db) {
            const s16x4 lo = vtr(vp + (16 * s + 4 * h) * VP + db * 64);
            const s16x4 hi = vtr(vp + (16 * s + 8 + 4 * h) * VP + db * 64);
            const bf16x8 vb = __builtin_shufflevector(lo, hi, 0, 1, 2, 3, 4, 5, 6, 7);
            o[db] = mfma32(pa, vb, o[db]);
        }
    }
}
template <int NDB> DI void scale_o(f32x16* o, float f, LAS float* sc, int r, int h) {
    if (h == 0) sc[r] = f;
    LDS_WAIT();
#pragma unroll
    for (int g = 0; g < 4; ++g) { const f32x4 f4 = *(const LAS f32x4*)(sc + 8 * g + 4 * h);
#pragma unroll
        for (int db = 0; db < NDB; ++db)
#pragma unroll
            for (int j = 0; j < 4; ++j) o[db][4 * g + j] *= f4[j]; }
    LDS_WAIT();
}
template <int NDB> DI void store_o(const f32x16* o, bf16_t* obase  , long rstride, int r, int h) {
#pragma unroll
    for (int i = 0; i < 16; ++i) { bf16_t* rp = obase + (long)crow(i, h) * rstride + r;
#pragma unroll
        for (int db = 0; db < NDB; ++db) rp[32 * db] = (bf16_t)(cvtpk(o[db][i], 0.f) & 0xffffu); }
}

constexpr int BKP = 144, BVP = 144;
constexpr int BSLOT = 256 * BKP + 256 * BVP;

DI void banded_load(LAS char* dst, int pitch, const bf16_t* src  , int ld, long row0  , int dil, int gi0, int tid) {
#pragma unroll
    for (int it = 0; it < 4; ++it) {
        const int c = tid + it * NTHREADS, key = c >> 3, cc = c & 7, gi = gi0 + key;
        u32x4 v = (u32x4){0u, 0u, 0u, 0u};
        if (gi >= 0) v = *(const u32x4*)(src + (row0 + (long)gi * dil) * ld + cc * 8);
        *(LAS u32x4*)(dst + key * pitch + cc * 16) = v;
    }
}
template <bool SINK, bool WANT_LSE>
DI void banded_task(const bf16_t* qrow  , bf16_t* obase, long rstride, const LAS char* Ks, const LAS char* Vs,
                    int wq, int jblk, int maxd, float sink2, float* lsep, LAS float* sc, int lane) {
    const int r = lane & 31, h = lane >> 5;
    bf16x8 qf[4];
#pragma unroll
    for (int ks = 0; ks < 4; ++ks) qf[ks] = *(const bf16x8*)(qrow + 16 * ks + 8 * h);
    f32x16 p[5];
    const f32x16 zero16 = splat16(0.f);
    { const unsigned ka = (unsigned)(uintptr_t)(Ks + (32 * wq + r) * BKP + 16 * h);
      st_tiles<64, 3, 32 * BKP>(ka, qf, zero16, p); st_tiles<64, 2, 32 * BKP>(ka + 96 * BKP, qf, zero16, p + 3); }
    const int tmin = (jblk == 0) ? 4 - wq : 0, lo = r + 128 - maxd;
#pragma unroll
    for (int t = 0; t < 5; ++t) {
        if (t < tmin) { p[t] = splat16(NEGBIG); }
        else if (t == 0) {
#pragma unroll
            for (int i = 0; i < 16; ++i) p[t][i] = (crow(i, h) >= lo) ? p[t][i] : NEGBIG;
        } else if (t == 4) {
#pragma unroll
            for (int i = 0; i < 16; ++i) p[t][i] = (crow(i, h) <= r) ? p[t][i] : NEGBIG;
        }
    }
    float mx = NEGBIG;
#pragma unroll
    for (int t = 0; t < 5; ++t)
#pragma unroll
        for (int i = 0; i < 16; ++i) mx = fmaxf(mx, p[t][i]);
    mx = xhalf_max(mx);
    if (SINK) mx = fmaxf(mx, sink2);
    float l = 0.f;
#pragma unroll
    for (int t = 0; t < 5; ++t)
#pragma unroll
        for (int i = 0; i < 16; ++i) { const float e = __builtin_amdgcn_exp2f(p[t][i] - mx); p[t][i] = e; l += e; }
    l = xhalf_sum(l);
    if (SINK) l += __builtin_amdgcn_exp2f(sink2 - mx);
    f32x16 o[2];
#pragma unroll
    for (int i = 0; i < 16; ++i) { o[0][i] = 0.f; o[1][i] = 0.f; }
    const LAS char* vl = Vs + ((lane & 15) >> 2) * BVP + ((lane >> 4) & 1) * 32 + (lane & 3) * 8;
#pragma unroll
    for (int t = 0; t < 5; ++t) pv_tile<64, BVP>(o, vl + 32 * (wq + t) * BVP, p[t], h);
    scale_o<2>(o, 1.f / l, sc, r, h);
    store_o<2>(o, obase, rstride, r, h);
    if (WANT_LSE) { if (h == 0) *lsep = mx + __builtin_amdgcn_logf(l); }
}

template <int DQK, int DV, bool CAUSAL, bool SPLITK>
DI void dense_unit(const bf16_t* Q, int ldq, const bf16_t* K1, int ldk1, const bf16_t* K2, int ldk2, const bf16_t* V, int ldv, bf16_t* O, int ldo,
                   int q0  , int ntiles, LAS char* lds, LAS float* sc, int tid) {
    constexpr int KP = DQK * 2 + 16, VP = DV * 2 + 16, KCH = DQK / 8, VCH = DV / 8, NK = 64 * KCH, NCH = NK + 64 * VCH, NIT = (NCH + NTHREADS - 1) / NTHREADS;
    constexpr int KBUF = 64 * KP, VBUF = 64 * VP;
    const int lane = tid & 63, w = __builtin_amdgcn_readfirstlane(tid >> 6), r = lane & 31, h = lane >> 5;
    LAS char* kb0 = lds; LAS char* vb0 = lds + 2 * KBUF;
    bf16x8 qf[DQK / 16];
    { const bf16_t* qr = Q + (long)(32 * w + r) * ldq;
#pragma unroll
      for (int ks = 0; ks < DQK / 16; ++ks) { qf[ks] = *(const bf16x8*)(qr + 16 * ks + 8 * h); asm volatile("" : "+v"(qf[ks])); } }
    u32x4 pre[NIT];
    auto gload = [&](int t) {
        const int tid2 = opaque(tid);
#pragma unroll
        for (int it = 0; it < NIT; ++it) { const int c = tid2 + it * NTHREADS;
            if (c < NK) { const int key = c / KCH, cc = c % KCH; const long kr = (long)(64 * t + key);
                pre[it] = (SPLITK && cc >= 8) ? *(const u32x4*)(K2 + kr * ldk2 + (cc - 8) * 8) : *(const u32x4*)(K1 + kr * ldk1 + cc * 8); }
            else if (c < NCH) { const int c2 = c - NK, key = c2 / VCH, cc = c2 % VCH; pre[it] = *(const u32x4*)(V + (long)(64 * t + key) * ldv + cc * 8); } }
    };
    auto lstore = [&](int b) {
        const int tid2 = opaque(tid);
#pragma unroll
        for (int it = 0; it < NIT; ++it) { const int c = tid2 + it * NTHREADS;
            if (c < NK) { const int key = c / KCH, cc = c % KCH; *(LAS u32x4*)(kb0 + b * KBUF + key * KP + cc * 16) = pre[it]; }
            else if (c < NCH) { const int c2 = c - NK, key = c2 / VCH, cc = c2 % VCH; *(LAS u32x4*)(vb0 + b * VBUF + key * VP + cc * 16) = pre[it]; } }
    };
    gload(0); lstore(0);
    __syncthreads();
    float m = 0.f, l = 0.f; bool first = true;
    f32x16 negm = splat16(0.f);
    f32x16 o[DV / 32];
#pragma unroll
    for (int db = 0; db < DV / 32; ++db)
#pragma unroll
        for (int i = 0; i < 16; ++i) o[db][i] = 0.f;
    const int qpos = q0 + 32 * w + r;
    for (int t = 0; t < ntiles; ++t) {
        const int b = t & 1;
        if (t + 1 < ntiles) gload(t + 1);
        if (!CAUSAL || 64 * t <= q0 + 32 * w) {
            const LAS char* kp = kb0 + b * KBUF + r * KP + 16 * h;
            f32x16 pp[2]; st_tiles<DQK, 2, 32 * KP>((unsigned)(uintptr_t)kp, qf, negm, pp);
            f32x16& p0 = pp[0]; f32x16& p1 = pp[1];
            if (CAUSAL && 64 * t + 63 > q0 + 32 * w) {
#pragma unroll
                for (int i = 0; i < 16; ++i) { const int key = 64 * t + crow(i, h); if (key > qpos) p0[i] = NEGBIG; if (key + 32 > qpos) p1[i] = NEGBIG; }
            }
            float mx = NEGBIG;
#pragma unroll
            for (int i = 0; i < 16; ++i) mx = fmaxf(mx, fmaxf(p0[i], p1[i]));
            mx = xhalf_max(mx);
            if (first || __any(mx > 8.f)) {
                const float dl = first ? mx : (mx > 8.f ? mx : 0.f);
                m += dl;
                const float f = __builtin_amdgcn_exp2f(-dl);
                l *= f;
#pragma unroll
                for (int i = 0; i < 16; ++i) { p0[i] -= dl; p1[i] -= dl; }
                if (!first) scale_o<DV / 32>(o, f, sc, r, h);
                negm = splat16(-m);
                first = false;
            }
#pragma unroll
            for (int i = 0; i < 16; ++i) { p0[i] = __builtin_amdgcn_exp2f(p0[i]); p1[i] = __builtin_amdgcn_exp2f(p1[i]); l += p0[i] + p1[i]; }
            const LAS char* vl = vb0 + b * VBUF + ((lane & 15) >> 2) * VP + ((lane >> 4) & 1) * 32 + (lane & 3) * 8;
            pv_tile<DV, VP>(o, vl, p0, h);
            pv_tile<DV, VP>(o, vl + 32 * VP, p1, h);
        }
        if (t + 1 < ntiles) lstore(b ^ 1);
        __syncthreads();
    }
    l = xhalf_sum(l);
    scale_o<DV / 32>(o, 1.f / l, sc, r, h);
    store_o<DV / 32>(o, O + (long)(32 * w) * ldo, ldo, r, h);
}


#define XB_TMO      128
#define XB_XCNT(j)  (256  + 64 * (j))
#define XB_XSUB(j)  (1280 + 64 * (j))
#define XB_XGEN(j)  (2304 + 64 * (j))
#define XB_TOP      3328
#define XB_TOPGEN   3392
#define XCD_BAR_WORDS 3456
#define XB_SPIN_CAP (1u << 22)
DI unsigned xb_ld(unsigned* p)              { return __hip_atomic_load(p, __ATOMIC_RELAXED, __HIP_MEMORY_SCOPE_AGENT); }
DI unsigned xb_add(unsigned* p, unsigned v) { return __hip_atomic_fetch_add(p, v, __ATOMIC_RELAXED, __HIP_MEMORY_SCOPE_AGENT); }
DI unsigned xb_xcc_id() { return (unsigned)__builtin_amdgcn_s_getreg((3 << 11) | 20) & 0xFu; }
#define XB_SPIN(cond, bar) do { unsigned _sp = 0; while (cond) { __builtin_amdgcn_s_sleep(1); \
    if ((++_sp & 255u) == 0u) { if (xb_ld(&(bar)[XB_TMO])) break; if (_sp > XB_SPIN_CAP) { atomicAdd(&(bar)[XB_TMO], 1u); break; } } } } while (0)
struct XcdBarrier { unsigned* bar; unsigned x; volatile LAS unsigned* st; };
DI XcdBarrier xcd_barrier_post(unsigned* bar, volatile LAS unsigned* st) {
    XcdBarrier b; b.bar = bar; b.x = xb_xcc_id(); b.st = st;
    if (threadIdx.x == 0) (void)xb_add(&bar[XB_XCNT(b.x)], 1u);
    return b;
}
DI void xcd_barrier_complete(unsigned* bar, unsigned x, unsigned& nloc, unsigned& nx) {
    const unsigned G = gridDim.x * gridDim.y * gridDim.z;
    unsigned sum, cnt, mine, sp = 0u;
    for (;;) {
        sum = 0u; cnt = 0u; mine = 0u;
#pragma unroll
        for (unsigned j = 0; j < 16; ++j) { const unsigned c = xb_ld(&bar[XB_XCNT(j)]); sum += c; cnt += (c > 0u) ? 1u : 0u; mine = (j == x) ? c : mine; }
        if (sum == G) break;
        __builtin_amdgcn_s_sleep(1);
        if ((++sp & 255u) == 0u) { if (xb_ld(&bar[XB_TMO])) break; if (sp > XB_SPIN_CAP) { atomicAdd(&bar[XB_TMO], 1u); break; } }
    }
    nloc = mine > 0u ? mine : 1u; nx = cnt > 0u ? cnt : 1u;
}
DI void xcd_barrier(unsigned* bar, unsigned x, volatile LAS unsigned* st) {
    asm volatile("s_waitcnt vmcnt(0)" ::: "memory");
    __syncthreads();
    if (threadIdx.x == 0) {
        __builtin_amdgcn_s_waitcnt(0);
        unsigned nloc = st[0], nx = st[1];
        if (nloc == 0u) { xcd_barrier_complete(bar, x, nloc, nx); st[0] = nloc; st[1] = nx; }
        const unsigned old = xb_add(&bar[XB_XSUB(x)], 1u);
        const unsigned gen = old / nloc;
        if (old + 1u == (gen + 1u) * nloc) {
            __builtin_amdgcn_fence(__ATOMIC_RELEASE, "agent");
            asm volatile("s_waitcnt vmcnt(0)" ::: "memory");
            const unsigned og = xb_add(&bar[XB_TOP], 1u);
            const unsigned tg = og / nx;
            if (og + 1u == (tg + 1u) * nx) xb_add(&bar[XB_TOPGEN], 1u);
            else XB_SPIN(xb_ld(&bar[XB_TOPGEN]) == tg, bar);
            __builtin_amdgcn_fence(__ATOMIC_ACQUIRE, "agent");
            xb_add(&bar[XB_XGEN(x)], 1u);
            asm volatile("s_waitcnt vmcnt(0)" ::: "memory");
        } else {
            XB_SPIN(xb_ld(&bar[XB_XGEN(x)]) == gen, bar);
            __builtin_amdgcn_fence(__ATOMIC_ACQUIRE, "agent");
            asm volatile("s_waitcnt vmcnt(0)" ::: "memory");
        }
    }
    __syncthreads();
}

DI void sincos_acc(float ang, float& c, float& s) {
    const double x = (double)ang;
    const double n = __builtin_rint(x * 0.63661977236758134308);
    double rr = __builtin_fma(-n, 1.57079632679489655800e+00, x); rr = __builtin_fma(-n, 6.12323399573676603587e-17, rr);
    const double r2 = rr * rr;
    const double sn = rr * (1.0 + r2 * (-1.0 / 6 + r2 * (1.0 / 120 + r2 * (-1.0 / 5040 + r2 * (1.0 / 362880 + r2 * (-1.0 / 39916800 + r2 * (1.0 / 6227020800.0)))))));
    const double cs = 1.0 + r2 * (-0.5 + r2 * (1.0 / 24 + r2 * (-1.0 / 720 + r2 * (1.0 / 40320 + r2 * (-1.0 / 3628800 + r2 * (1.0 / 479001600.0))))));
    const int q = ((int)n) & 3;
    const double cc = (q == 0) ? cs : (q == 1) ? -sn : (q == 2) ? -cs : sn;
    const double ss = (q == 0) ? sn : (q == 1) ? cs : (q == 2) ? -sn : -cs;
    c = (float)cc; s = (float)ss;
}

#ifndef PH
#define PH 255
#endif
#ifndef REP_P1
#define REP_P1 1
#endif
#ifndef REP_B
#define REP_B 1
#endif
#ifndef REP_CONV
#define REP_CONV 1
#endif
#ifndef REP_P7
#define REP_P7 1
#endif
#define GRID_SYNC() do { CParams* qb_ = fresh_params(); xcd_barrier((unsigned*)(qb_->ws + WS_CTL), xcc, MISC); } while (0)

__global__ void __launch_bounds__(NTHREADS, 2) fwd_megakernel(Params p) {
    extern __shared__ __attribute__((aligned(16))) unsigned char lds_raw[];
    cg::grid_group grid = cg::this_grid();
    LAS unsigned char* lds = (LAS unsigned char*)lds_raw;
    const int wave = __builtin_amdgcn_readfirstlane((int)threadIdx.x >> 6);
    const int G = gridDim.x, bid = blockIdx.x;
    const int gw = bid * NWAVES + wave, NGW = G * NWAVES;
    LAS float* sc = (LAS float*)(lds + LDS_SCR) + wave * 64;
    volatile LAS unsigned* MISC = (volatile LAS unsigned*)(lds + LDS_SCR + 2048);
    if (threadIdx.x < 4) MISC[threadIdx.x] = 0u;
    __syncthreads();
    unsigned xcc;
    { CParams* q0 = fresh_params(); const XcdBarrier xb = xcd_barrier_post((unsigned*)(q0->ws + WS_CTL), MISC); xcc = xb.x; }

#ifndef NOPRO
    {
        PHASE_CTX
        float* COSH = (float*)(ws + WS_COSH); float* SINH = (float*)(ws + WS_SINH); float* COSR = (float*)(ws + WS_COSR); float* SINR = (float*)(ws + WS_SINR);
        const float* x = q->in[0]; const int* pos = (const int*)q->in[2];
        const int lane = lane_id(), tid = wave * 64 + lane;
        for (int i = bid * NTHREADS + tid; i < TT * 32; i += G * NTHREADS) { const int t = i >> 5, k = i & 31; float c, s; sincos_acc((float)pos[t] * q->inv_h[k], c, s); COSH[i] = c; SINH[i] = s; }
        for (int i = bid * NTHREADS + tid; i < TT * 16; i += G * NTHREADS) { const int t = i >> 4, k = i & 15; float c, s; sincos_acc((float)pos[t] * q->inv_r[k], c, s); COSR[i] = c; SINR[i] = s; }
        for (int row = gw; row < TT; row += NGW) {
            const f32x4* xr = (const f32x4*)(x + (size_t)row * D) + lane; float ss = 0.f;
            u32x2* o8 = (u32x2*)(XB + (size_t)row * D) + lane;
#pragma unroll
            for (int j = 0; j < 4; ++j) { const f32x4 v = xr[64 * j]; ss += (v.x * v.x + v.y * v.y) + (v.z * v.z + v.w * v.w); u32x2 w; w.x = cvtpk(v.x, v.y); w.y = cvtpk(v.z, v.w); o8[64 * j] = w; }
            ss = wave_sum(ss);
            if (lane < 16) PX[(size_t)row * 16 + lane] = lane == 0 ? ss : 0.f;
        }
        const float* mem = q->in[1]; bf16_t* MEMN = (bf16_t*)(ws + WS_MEMN);
        for (int row = gw; row < BATCH * NMEM; row += NGW) {
            const f32x4* xr = (const f32x4*)(mem + (size_t)row * D) + lane; f32x4 v[4]; float ss = 0.f;
#pragma unroll
            for (int j = 0; j < 4; ++j) { v[j] = xr[64 * j]; ss += (v[j].x * v[j].x + v[j].y * v[j].y) + (v[j].z * v[j].z + v[j].w * v[j].w); }
            const float rstd = __builtin_amdgcn_rsqf(wave_sum(ss) * (1.f / D) + EPS);
            u32x2* o8 = (u32x2*)(MEMN + (size_t)row * D) + lane;
#pragma unroll
            for (int j = 0; j < 4; ++j) { u32x2 w; w.x = cvtpk(v[j].x * rstd, v[j].y * rstd); w.y = cvtpk(v[j].z * rstd, v[j].w * rstd); o8[64 * j] = w; }
        }
    }

#endif
    for (int l = 0; l < DEPTH; ++l) {
#ifndef NOCONV
#pragma unroll 1
        for (int rep = 0; rep < REP_CONV; ++rep) convert_layer(l, lds, gw, NGW, wave);
#endif
        if (l == 0) grid.sync(); else GRID_SYNC();
        for (int ch = 0; ch < NCHUNK; ++ch) {
            const int tok0 = ch * TC;
#if PH & 1
            {
                PHASE_CTX
                pg8::TileOrder S; S.init(TC, NT_IN, G, bid, XB + (size_t)tok0 * D, (const bf16_t*)(ws + WS_WIN));
                EpiSlot<CfgIn> E{CfgIn{ws, q->in[6] + l * 64, q->in[7] + l * 64, q->in[14] + l * 96, q->in[15] + l * 192, q->in[16] + l * 192, q->in[5] + l * 4096},
                                 RowScale{PX, 16, 16, 1.f / D}, tok0, rt, tok0};
#pragma unroll 1
                for (int rep = 0; rep < REP_P1; ++rep) pg8::gemm_phase(lds, D, D, S, E, wave);
                if (ch == 0) {
                    pg8::TileOrder S2; S2.init(BATCH * NMEM, 1024, G, (bid + 128) % G, (const bf16_t*)(ws + WS_MEMN), (const bf16_t*)(ws + WS_WMKV));
                    EpiSlot<CfgMkv> E2{CfgMkv{ws}, RowScale{nullptr, 0, 0, 0.f}, 0, rt, 0};
                    pg8::gemm_phase(lds, D, D, S2, E2, wave);
                }
            }

#endif
            GRID_SYNC();
#if PH & 2
            {
                PHASE_CTX
                pg8::TileOrder S; S.init(TC, 1024, G, bid, (const bf16_t*)(ws + WS_CQ), (const bf16_t*)(ws + WS_WUQ));
                EpiSlot<CfgUq> E{CfgUq{ws, q->in[13] + l * 96}, RowScale{(const float*)(ws + WS_PCQ), 8, 6, 1.f / 384.f}, 0, rt, tok0};
                pg8::gemm_phase(lds, 384, 384, S, E, wave);
                pg8::TileOrder S2; S2.init(TC, 1024, G, bid, (const bf16_t*)(ws + WS_CKV), (const bf16_t*)(ws + WS_WUKV));
                EpiSlot<CfgUkv> E2{CfgUkv{ws, q->in[14] + l * 96}, RowScale{(const float*)(ws + WS_PCKV), 4, 4, 1.f / 256.f}, 0, rt, tok0};
                pg8::gemm_phase(lds, 256, 256, S2, E2, wave);
                const int lane = opaque(lane_id());
                const int nrows = TC + (ch == 0 ? BATCH * NMEM : 0);
                for (int rw = gw; rw < nrows; rw += NGW) {
                    const bool isq = rw < TC;
                    bf16_t* rp = isq ? (bf16_t*)(ws + WS_MQ) + (size_t)rw * 512 : (bf16_t*)(ws + WS_MK) + (size_t)(rw - TC) * 512;
                    const float* gn = (isq ? q->in[19] : q->in[20]) + l * 128 + (lane & 15) * 8;
                    const float scl = isq ? 0.08838834764831845f * LOG2E : 1.f;
                    float v[8]; unpack8(*(const u32x4*)(rp + lane * 8), v);
                    float ss = 0.f;
#pragma unroll
                    for (int i = 0; i < 8; ++i) ss += v[i] * v[i];
                    ss += __shfl_xor(ss, 1); ss += __shfl_xor(ss, 2); ss += __shfl_xor(ss, 4); ss += __shfl_xor(ss, 8);
                    const float inv = __builtin_amdgcn_rsqf(ss * (1.f / 128.f) + EPS) * scl;
#pragma unroll
                    for (int i = 0; i < 8; ++i) v[i] *= inv * gn[i];
                    *(u32x4*)(rp + lane * 8) = pack8(v);
                }
            }

#endif
            GRID_SYNC();
#if PH & 4
            {
                PHASE_CTX
                LAS char* al = (LAS char*)lds;
                const int lane = opaque(lane_id()), tid = wave * 64 + lane;
#pragma unroll 1
                for (int rep = 0; rep < REP_B; ++rep)
                for (int idx = bid; idx < BC * 8 * 16; idx += G) {
                    const int half = idx / (BC * 64), rem = idx % (BC * 64), bh = rem / 8, s = rem % 8;
                    const int qb = half == 0 ? s : 15 - s, b = bh / 8, hh = bh % 8;
                    const long r0 = (long)b * SEQ;
                    dense_unit<96, 64, true, true>((const bf16_t*)(ws + WS_QB) + (r0 + 256 * qb) * 768 + 96 * hh, 768,
                        (const bf16_t*)(ws + WS_KN) + r0 * 512 + 64 * hh, 512, (const bf16_t*)(ws + WS_KR) + r0 * 32, 32,
                        (const bf16_t*)(ws + WS_VB) + r0 * 512 + 64 * hh, 512, (bf16_t*)(ws + WS_OB) + (r0 + 256 * qb) * 512 + 64 * hh, 512,
                        256 * qb, 4 * (qb + 1), al, sc, tid);
                }
                for (int idx = bid; idx < 3 * BC * 32 * 4; idx += G) {
                    const int g = idx / (BC * 128), rem = idx % (BC * 128), hp = rem & 3, sj = rem >> 2;
                    const int dil = g == 0 ? 1 : g == 1 ? 4 : 16, nb = 32 / dil;
                    const int n = sj / nb, j = sj % nb, b = n / dil, res = n % dil;
                    const long row0 = (long)b * SEQ + res;
                    const bf16_t* Qg = (const bf16_t*)(ws + WS_CB + (size_t)(3 * g) * 16 * MiB); const bf16_t* Kg = (const bf16_t*)(ws + WS_CB + (size_t)(3 * g + 1) * 16 * MiB); const bf16_t* Vg = (const bf16_t*)(ws + WS_CB + (size_t)(3 * g + 2) * 16 * MiB);
#pragma unroll
                    for (int sl = 0; sl < 2; ++sl) {
                        banded_load(al + sl * BSLOT, BKP, Kg + 64 * (2 * hp + sl), 512, row0, dil, 128 * (j - 1), tid);
                        banded_load(al + sl * BSLOT + 256 * BKP, BVP, Vg + 64 * (2 * hp + sl), 512, row0, dil, 128 * (j - 1), tid);
                    }
                    __syncthreads();
                    { const int sl = wave >> 2, wq = wave & 3, hd = 2 * hp + sl, r = lane & 31;
                      const long qtok = row0 + (long)(128 * j + 32 * wq + r) * dil;
                      bf16_t* ob = (bf16_t*)Qg + (row0 + (long)(128 * j + 32 * wq) * dil) * 512 + 64 * hd;
                      banded_task<false, true>(Qg + qtok * 512 + 64 * hd, ob, (long)dil * 512, al + sl * BSLOT, al + sl * BSLOT + 256 * BKP, wq, j, 128, 0.f,
                                               (float*)(ws + WS_LSE) + (qtok * 8 + hd) * 4 + g, sc, lane); }
                    __syncthreads();
                }
                for (int idx = bid; idx < BC * 32 * 2; idx += G) {
                    const int kvh = idx & 1, j = (idx >> 1) & 31, b = idx >> 6;
                    const long row0 = (long)b * SEQ;
                    banded_load(al, BKP, (const bf16_t*)(ws + WS_KA) + 64 * kvh, 128, row0, 1, 128 * (j - 1), tid);
                    banded_load(al + 256 * BKP, BVP, (const bf16_t*)(ws + WS_VA) + 64 * kvh, 128, row0, 1, 128 * (j - 1), tid);
                    __syncthreads();
#pragma unroll 1
                    for (int pass = 0; pass < 2; ++pass) {
                        const int hq = kvh * 4 + (wave >> 2) + 2 * pass, wq = wave & 3, r = lane & 31;
                        const long qtok = row0 + 128 * j + 32 * wq + r;
                        bf16_t* QA = (bf16_t*)(ws + WS_QA);
                        banded_task<true, false>(QA + qtok * 512 + 64 * hq, QA + (row0 + 128 * j + 32 * wq) * 512 + 64 * hq, 512, al, al + 256 * BKP, wq, j, 127,
                                                 (q->in[8] + l * 8)[hq] * LOG2E, nullptr, sc, lane);
                    }
                    __syncthreads();
                }
                for (int idx = bid; idx < BC * 4 * 16; idx += G) {
                    const int qb = idx & 15, hh = (idx >> 4) & 3, b = idx >> 6;
                    const long r0 = (long)b * SEQ + 256 * qb; const long m0 = (long)(ch * BC + b) * NMEM;
                    bf16_t* MQ = (bf16_t*)(ws + WS_MQ);
                    dense_unit<128, 128, false, false>(MQ + r0 * 512 + 128 * hh, 512, (const bf16_t*)(ws + WS_MK) + m0 * 512 + 128 * hh, 512, nullptr, 0,
                        (const bf16_t*)(ws + WS_MV) + m0 * 512 + 128 * hh, 512, MQ + r0 * 512 + 128 * hh, 512, 0, 4, al, sc, tid);
                }
            }

#endif
            GRID_SYNC();
#if PH & 8
            {
                PHASE_CTX
                const float* LSE = (const float*)(ws + WS_LSE); bf16_t* OC = (bf16_t*)(ws + WS_OC);
                const int tid = wave * 64 + opaque(lane_id());
                for (int i = bid * NTHREADS + tid; i < TC * 64; i += G * NTHREADS) {
                    const int tok = i >> 6, c8 = i & 63, hd = c8 >> 3;
                    const f32x4 ls = *(const f32x4*)(LSE + ((size_t)tok * 8 + hd) * 4);
                    const float mx = fmaxf(ls.x, fmaxf(ls.y, ls.z));
                    float w0 = __builtin_amdgcn_exp2f(ls.x - mx), w1 = __builtin_amdgcn_exp2f(ls.y - mx), w2 = __builtin_amdgcn_exp2f(ls.z - mx);
                    const float inv = 1.f / (w0 + w1 + w2); w0 *= inv; w1 *= inv; w2 *= inv;
                    float a[8], b[8], c[8], o[8];
                    unpack8(*(const u32x4*)((const bf16_t*)(ws + WS_CB) + (size_t)tok * 512 + c8 * 8), a);
                    unpack8(*(const u32x4*)((const bf16_t*)(ws + WS_CB + 48 * MiB) + (size_t)tok * 512 + c8 * 8), b);
                    unpack8(*(const u32x4*)((const bf16_t*)(ws + WS_CB + 96 * MiB) + (size_t)tok * 512 + c8 * 8), c);
#pragma unroll
                    for (int k = 0; k < 8; ++k) o[k] = w0 * a[k] + w1 * b[k] + w2 * c[k];
                    *(u32x4*)(OC + (size_t)tok * 512 + c8 * 8) = pack8(o);
                }
            }

#endif
            GRID_SYNC();
#if PH & 16
            {
                PHASE_CTX
                pg8::TileOrder S; S.init(TC, D, G, bid, (const bf16_t*)(ws + WS_QA), (const bf16_t*)(ws + WS_WBR)); S.nseg = 4;
                S.segA = 8 * MiB; S.segB = (size_t)D * 512;
                EpiMerge E{(const bf16_t*)(ws + WS_GATES), (bf16_t*)(ws + WS_GY) + (size_t)tok0 * D};
                pg8::gemm_phase(lds, 512, 512, S, E, wave);
            }

#endif
            GRID_SYNC();
        }
        {
            const int tok0 = 0;
#if PH & 32
            {
                PHASE_CTX
                pg8::TileOrder S; S.init(TT, D, G, bid, (const bf16_t*)(ws + WS_GY), (const bf16_t*)(ws + WS_WOUT));
                EpiRes E{((l == 0) ? q->in[0] : q->out) + (size_t)tok0 * D, q->out + (size_t)tok0 * D, XB + (size_t)tok0 * D, PX + (size_t)tok0 * 16};
                pg8::gemm_phase(lds, D, D, S, E, wave);
            }

#endif
            GRID_SYNC();
#if PH & 64
            {
                PHASE_CTX
                pg8::TileOrder S; S.init(TT, DFF, G, bid, XB + (size_t)tok0 * D, (const bf16_t*)(ws + WS_WUP));
                EpiUp E{(bf16_t*)(ws + WS_U), RowScale{PX, 16, 16, 1.f / D}, tok0};
#pragma unroll 1
                for (int rep = 0; rep < REP_P7; ++rep) pg8::gemm_phase(lds, D, D, S, E, wave);
            }

#endif
            GRID_SYNC();
#if PH & 128
            {
                PHASE_CTX
                pg8::TileOrder S; S.init(TT, D, G, bid, (const bf16_t*)(ws + WS_U), (const bf16_t*)(ws + WS_WDN));
                EpiRes E{q->out + (size_t)tok0 * D, q->out + (size_t)tok0 * D, XB + (size_t)tok0 * D, PX + (size_t)tok0 * 16};
                pg8::gemm_phase(lds, DFF, DFF, S, E, wave);
            }

#endif
            GRID_SYNC();
        }
    }
}

extern "C" void kernel_launch(void* const* d_in, const int* in_sizes, int n_in, void* d_out, int out_size, void* d_ws, size_t ws_size, hipStream_t stream) {
    static int grid = 0;
    if (grid == 0) {
        if (n_in != 26 || out_size != TT * D || ws_size < WS_END) { fprintf(stderr, "kernel_launch: unexpected shapes (n_in %d out %d ws %zu)\n", n_in, out_size, ws_size); grid = -1; return; }
        int dev = 0, cus = 0, per_cu = 0;
        hipGetDevice(&dev); hipDeviceGetAttribute(&cus, hipDeviceAttributeMultiprocessorCount, dev);
        hipFuncSetAttribute((const void*)fwd_megakernel, hipFuncAttributeMaxDynamicSharedMemorySize, LDS_BYTES);
        hipOccupancyMaxActiveBlocksPerMultiprocessor(&per_cu, (const void*)fwd_megakernel, NTHREADS, LDS_BYTES);
        if (per_cu < 1) { fprintf(stderr, "kernel_launch: occupancy query says %d blocks per CU\n", per_cu); per_cu = 1; }
        (void)hipGetLastError();
        grid = cus;
    }
    if (grid < 0) return;
    if (hipMemsetAsync((char*)d_ws + WS_CTL, 0, XCD_BAR_WORDS * 4, stream) != hipSuccess) { fprintf(stderr, "kernel_launch: memset failed\n"); return; }
    Params p{};
    for (int i = 0; i < 26; ++i) p.in[i] = (const float*)d_in[i];
    p.out = (float*)d_out; p.ws = (unsigned char*)d_ws;
    for (int i = 0; i < 32; ++i) p.inv_h[i] = (float)std::pow(10000.0, -(double)(2 * i) / 64.0);
    for (int i = 0; i < 16; ++i) p.inv_r[i] = (float)std::pow(10000.0, -(double)(2 * i) / 32.0);
    void* args[] = {&p};
    hipError_t e = hipLaunchCooperativeKernel((const void*)fwd_megakernel, dim3(grid), dim3(NTHREADS), args, LDS_BYTES, stream);
    if (e != hipSuccess) fprintf(stderr, "cooperative launch failed: %s (grid %d)\n", hipGetErrorString(e), grid);
}
```

```cpp
#include <hip/hip_runtime.h>
#include <hip/hip_cooperative_groups.h>
#include <cstdio>
#include <cstdint>
#include <cmath>
namespace cg = cooperative_groups;

#define LAS __attribute__((address_space(3)))
#define DI __device__ __forceinline__
typedef unsigned short bf16_t;
typedef short bf16x8 __attribute__((ext_vector_type(8)));
typedef short s16x4 __attribute__((ext_vector_type(4)));
typedef float f32x4 __attribute__((ext_vector_type(4)));
typedef float f32x16 __attribute__((ext_vector_type(16)));
typedef unsigned u32x4 __attribute__((ext_vector_type(4)));
typedef unsigned u32x2 __attribute__((ext_vector_type(2)));
typedef float f32x2_t __attribute__((ext_vector_type(2)));
typedef __bf16 bf16x2_t __attribute__((ext_vector_type(2)));

constexpr int D = 1024, BATCH = 8, SEQ = 4096, DEPTH = 4, TT = BATCH * SEQ;
constexpr int NCHUNK = 2, BC = BATCH / NCHUNK, TC = BC * SEQ;
constexpr int N_IN = 10656, NT_IN = 10752;
constexpr int DFF = 4096, NMEM = 256;
constexpr float EPS = 1e-6f;
constexpr float LOG2E = 1.4426950408889634f;
constexpr float NEGBIG = -1e30f;
constexpr int NTHREADS = 512, NWAVES = 8;

constexpr size_t MiB = 1u << 20;
constexpr size_t WS_CTL = 0;
constexpr size_t WS_WIN = 1 * MiB, WS_WUQ = 22 * MiB, WS_WUKV = 23 * MiB, WS_WMKV = 24 * MiB, WS_WBR = 26 * MiB, WS_WOUT = 30 * MiB, WS_WUP = 32 * MiB, WS_WDN = 40 * MiB;
constexpr size_t WS_XB = 48 * MiB, WS_PX = 112 * MiB, WS_COSH = 114 * MiB, WS_SINH = 118 * MiB, WS_COSR = 122 * MiB, WS_SINR = 124 * MiB;
constexpr size_t WS_MEMN = 126 * MiB, WS_MK = 130 * MiB, WS_MV = 132 * MiB;
constexpr size_t WS_QA = 134 * MiB, WS_OB = 150 * MiB, WS_OC = 166 * MiB, WS_MQ = 182 * MiB;
constexpr size_t WS_KA = 198 * MiB, WS_VA = 202 * MiB, WS_CQ = 206 * MiB, WS_CKV = 218 * MiB, WS_KR = 226 * MiB, WS_PCQ = 227 * MiB, WS_PCKV = 227 * MiB + 512 * 1024;
constexpr size_t WS_CB = 228 * MiB;
constexpr size_t WS_GATES = 372 * MiB, WS_U = WS_CB;
constexpr size_t WS_QB = 500 * MiB, WS_KN = 524 * MiB, WS_VB = 540 * MiB, WS_LSE = 556 * MiB, WS_GY = 558 * MiB;
constexpr size_t WS_END = 622 * MiB;

constexpr int LDS_BYTES = 155648;
constexpr int LDS_SCR = 149504;

struct Params {
    const float* in[26];
    float* out;
    unsigned char* ws;
    float inv_h[32];
    float inv_r[16];
    int pad[2];
};

DI unsigned cvtpk(float lo, float hi) { f32x2_t v = {lo, hi}; bf16x2_t b = __builtin_convertvector(v, bf16x2_t); return __builtin_bit_cast(unsigned, b); }
DI float bf_lo(unsigned w) { return __uint_as_float(w << 16); }
DI float bf_hi(unsigned w) { return __uint_as_float(w & 0xffff0000u); }
DI u32x4 pack8(const float* v) { u32x4 w; w.x = cvtpk(v[0], v[1]); w.y = cvtpk(v[2], v[3]); w.z = cvtpk(v[4], v[5]); w.w = cvtpk(v[6], v[7]); return w; }
DI void unpack8(u32x4 w, float* v) { v[0] = bf_lo(w.x); v[1] = bf_hi(w.x); v[2] = bf_lo(w.y); v[3] = bf_hi(w.y); v[4] = bf_lo(w.z); v[5] = bf_hi(w.z); v[6] = bf_lo(w.w); v[7] = bf_hi(w.w); }
DI float wave_sum(float v) {
#pragma unroll
    for (int o = 1; o < 64; o <<= 1) v += __shfl_xor(v, o);
    return v;
}
struct RopeTabs { const float* cosh; const float* sinh; const float* cosr; const float* sinr; };
typedef const struct Params __attribute__((address_space(4))) CParams;
DI CParams* fresh_params() { unsigned long long k = (unsigned long long)__builtin_amdgcn_kernarg_segment_ptr(); asm volatile("" : "+s"(k)); return (CParams*)k; }
#define PHASE_CTX \
    CParams* q = fresh_params(); unsigned char* ws = q->ws; (void)ws; \
    bf16_t* XB = (bf16_t*)(ws + WS_XB); float* PX = (float*)(ws + WS_PX); (void)XB; (void)PX; \
    const RopeTabs rt{(const float*)(ws + WS_COSH), (const float*)(ws + WS_SINH), (const float*)(ws + WS_COSR), (const float*)(ws + WS_SINR)}; (void)rt;
DI int opaque(int v) { asm volatile("" : "+v"(v)); return v; }
DI int lane_id() { int v; asm volatile("v_mbcnt_lo_u32_b32 %0, -1, 0\n\tv_mbcnt_hi_u32_b32 %0, -1, %0" : "=v"(v)); return v; }
#define LDS_WAIT() asm volatile("s_waitcnt lgkmcnt(0)" ::: "memory")

namespace pg8 {
constexpr int BM = 256, BK = 64, HALF = 128, HTB = HALF * BK * 2, STAGE_BYTES = 8 * HTB, NXCD = 8, WGM = 8;
DI int lds_byte(int r, int c) { const int st = (r >> 4) * 2 + (c >> 5), rr = r & 15, cc = c & 31, ob = rr * 64 + cc * 2; return st * 1024 + (ob ^ (((ob >> 9) & 1) << 5)); }
DI void stage_rc(int b, int& R, int& C) { const int st = b / 1024, sb = b % 1024, swz = sb ^ (((sb >> 9) & 1) << 5); R = (st >> 1) * 16 + swz / 64; C = (st & 1) * 32 + (swz % 64) / 2; }
DI int perm32(int rho) { const int n = rho >> 4, i = rho & 15; return 8 * (i >> 2) + 4 * n + (i & 3); }

struct Unit { int pm, pn, seg; const bf16_t* A; const bf16_t* Bt; };

struct TileOrder {
    int nM, nN, nwg, G, c, nseg;
    const bf16_t* A0; const bf16_t* B0; size_t segA, segB;
    DI void init(int M, int N, int G_, int c_, const bf16_t* A, const bf16_t* B) { nM = M / BM; nN = N / BM; nwg = nM * nN; G = G_; c = c_; nseg = 1; A0 = A; B0 = B; segA = 0; segB = 0; }
    DI bool next(int i, Unit& u) const {
        const int seg = i % nseg, ti = i / nseg;
        const long L = (long)ti * G + c; if (L >= nwg) return false;
        int wgid = (int)L; { const int q = nwg / NXCD, r = nwg % NXCD, xcd = wgid % NXCD, off = wgid / NXCD; wgid = (xcd < r ? xcd * (q + 1) : r * (q + 1) + (xcd - r) * q) + off; }
        const int nig = WGM * nN, gid = wgid / nig, fm = gid * WGM, gsz = (nM - fm) < WGM ? (nM - fm) : WGM;
        u.pm = fm + ((wgid % nig) % gsz); u.pn = (wgid % nig) / gsz; u.seg = seg;
        u.A = A0 + (size_t)seg * segA; u.Bt = B0 + (size_t)seg * segB;
        return true;
    }
};

template <class Epi, class Sched>
DI void gemm_phase(LAS unsigned char* lds, const int K, const int lda, const Sched& S, const Epi& E, const int wid) {
    const int lane = opaque(lane_id()), tid = wid * 64 + lane, wr = wid >> 2, wc = wid & 3, fr = lane & 15, fq = lane >> 4;
    const int nt = K / BK;
    unsigned voffA[2], voffB[2];
#pragma unroll
    for (int i = 0; i < 2; ++i) { int R, C; stage_rc(tid * 16 + i * 8192, R, C); const int Rb = (R & ~31) + perm32(R & 31);
        voffA[i] = (unsigned)(R * lda + C) * 2u; voffB[i] = (unsigned)(Rb * K + C) * 2u; }
    const size_t kstep = (size_t)(BK * 2);
    const size_t hstepA = (size_t)HALF * lda * 2, hstepB = (size_t)HALF * K * 2;
    const size_t tstepA = 2 * hstepA, tstepB = 2 * hstepB;
    const unsigned ldsw = (unsigned)wid * 1024u;
    const int aoff = lds_byte(wr * 64 + fr, fq * 8), boff = lds_byte(wc * 32 + fr, fq * 8);
#define PG8_SA(b, h) (((b) * 2 + (h)) * HTB)
#define PG8_SB(b, h) ((4 + (b) * 2 + (h)) * HTB)
#define PG8_STAGE(bufoff, gbase, voff) do { _Pragma("unroll") for (int _i = 0; _i < 2; ++_i) \
        __builtin_amdgcn_global_load_lds((const unsigned*)((const char*)(gbase) + (voff)[_i]), (LAS unsigned*)(lds + (bufoff) + ldsw + _i * 8192), 16, 0, 0); } while (0)
#define PG8_LDA(dst, b, h) do { _Pragma("unroll") for (int m = 0; m < 4; ++m) _Pragma("unroll") for (int k = 0; k < 2; ++k) dst[m][k] = *(const LAS bf16x8*)(lds + PG8_SA(b, h) + aoff + m * 2048 + k * 1024); } while (0)
#define PG8_LDB(dst, b, h) do { _Pragma("unroll") for (int n = 0; n < 2; ++n) _Pragma("unroll") for (int k = 0; k < 2; ++k) dst[n][k] = *(const LAS bf16x8*)(lds + PG8_SB(b, h) + boff + n * 2048 + k * 1024); } while (0)
#define PG8_MMA(ai, bj, At, Bt) do { __builtin_amdgcn_s_setprio(1); _Pragma("unroll") for (int m = 0; m < 4; ++m) _Pragma("unroll") for (int n = 0; n < 2; ++n) _Pragma("unroll") for (int k = 0; k < 2; ++k) \
        acc[ai][bj][m][n] = __builtin_amdgcn_mfma_f32_16x16x32_bf16(Bt[n][k], At[m][k], acc[ai][bj][m][n], 0, 0, 0); __builtin_amdgcn_s_setprio(0); } while (0)
#define PG8_WAIT_V(n) asm volatile("s_waitcnt vmcnt(" #n ")" ::: "memory")
#define PG8_WAIT_L(n) asm volatile("s_waitcnt lgkmcnt(" #n ")" ::: "memory")
#define PG8_BAR __builtin_amdgcn_s_barrier()
#define PG8_SCHED __builtin_amdgcn_sched_barrier(0)
    Unit cur, nxt; int ui = 0;
    if (!S.next(0, cur)) return;
    f32x4 acc[2][2][4][2];
#pragma unroll
    for (int a = 0; a < 2; ++a)
#pragma unroll
        for (int b = 0; b < 2; ++b)
#pragma unroll
            for (int m = 0; m < 4; ++m)
#pragma unroll
                for (int n = 0; n < 2; ++n) acc[a][b][m][n] = (f32x4){0.f, 0.f, 0.f, 0.f};
    bf16x8 At[4][2], B0[2][2], B1[2][2];
    const char* cA = (const char*)cur.A + (size_t)cur.pm * tstepA; const char* cB = (const char*)cur.Bt + (size_t)cur.pn * tstepB;
    PG8_STAGE(PG8_SB(0, 0), cB, voffB); PG8_STAGE(PG8_SB(0, 1), cB + hstepB, voffB); PG8_STAGE(PG8_SA(0, 0), cA, voffA); PG8_STAGE(PG8_SA(0, 1), cA + hstepA, voffA);
    if (wr == 1) PG8_BAR;
    PG8_WAIT_V(2); PG8_BAR;
    PG8_STAGE(PG8_SB(1, 0), cB + kstep, voffB); PG8_STAGE(PG8_SA(1, 0), cA + kstep, voffA); PG8_STAGE(PG8_SB(1, 1), cB + hstepB + kstep, voffB);
    PG8_WAIT_V(6); PG8_BAR;
    for (;;) {
        const bool has_next = S.next(ui + 1, nxt);
        const char* nA = has_next ? (const char*)nxt.A + (size_t)nxt.pm * tstepA : cA; const char* nB = has_next ? (const char*)nxt.Bt + (size_t)nxt.pn * tstepB : cB;
#pragma unroll 1
        for (int t = 0; t < nt; t += 2) {
            const bool last = (t == nt - 2);
            const char* a1 = cA + (size_t)(t + 1) * kstep;
            const char* a2 = last ? nA : cA + (size_t)(t + 2) * kstep; const char* b2 = last ? nB : cB + (size_t)(t + 2) * kstep;
            const char* a3 = a2 + kstep; const char* b3 = b2 + kstep;
            PG8_LDB(B0, 0, 0); PG8_LDB(B1, 0, 1); PG8_SCHED; PG8_LDA(At, 0, 0); PG8_STAGE(PG8_SA(1, 1), a1 + hstepA, voffA);
            PG8_WAIT_V(8); PG8_WAIT_L(0); PG8_BAR; PG8_MMA(0, 0, At, B0); PG8_MMA(0, 1, At, B1); PG8_BAR; PG8_SCHED;
            PG8_LDA(At, 0, 1); PG8_STAGE(PG8_SB(0, 0), b2, voffB); PG8_STAGE(PG8_SB(0, 1), b2 + hstepB, voffB); PG8_STAGE(PG8_SA(0, 0), a2, voffA);
            PG8_WAIT_V(8); PG8_WAIT_L(0); PG8_BAR; PG8_MMA(1, 0, At, B0); PG8_MMA(1, 1, At, B1); PG8_BAR; PG8_SCHED;
            PG8_LDB(B0, 1, 0); PG8_LDB(B1, 1, 1); PG8_SCHED; PG8_LDA(At, 1, 0); PG8_STAGE(PG8_SA(0, 1), a2 + hstepA, voffA);
            PG8_WAIT_V(8); PG8_WAIT_L(0); PG8_BAR; PG8_MMA(0, 0, At, B0); PG8_MMA(0, 1, At, B1); PG8_BAR; PG8_SCHED;
            PG8_LDA(At, 1, 1); PG8_STAGE(PG8_SB(1, 0), b3, voffB); PG8_STAGE(PG8_SB(1, 1), b3 + hstepB, voffB); PG8_STAGE(PG8_SA(1, 0), a3, voffA);
            PG8_WAIT_V(8); PG8_WAIT_L(0); PG8_BAR; PG8_MMA(1, 0, At, B0); PG8_MMA(1, 1, At, B1); PG8_BAR; PG8_SCHED;
        }
        if (wr == 0) PG8_BAR;
        E(acc, cur, wr, wc, fr, fq);
        if (!has_next) break;
#pragma unroll
        for (int a = 0; a < 2; ++a)
#pragma unroll
            for (int b = 0; b < 2; ++b)
#pragma unroll
                for (int m = 0; m < 4; ++m)
#pragma unroll
                    for (int n = 0; n < 2; ++n) acc[a][b][m][n] = (f32x4){0.f, 0.f, 0.f, 0.f};
        cur = nxt; cA = nA; cB = nB; ++ui;
        if (wr == 1) PG8_BAR;
    }
    PG8_WAIT_V(0);
    PG8_BAR;
#undef PG8_SA
#undef PG8_SB
#undef PG8_STAGE
#undef PG8_LDA
#undef PG8_LDB
#undef PG8_MMA
#undef PG8_WAIT_V
#undef PG8_WAIT_L
#undef PG8_BAR
#undef PG8_SCHED
}
}

struct RowScale {
    const float* part; int stride; int cnt; float inv_n;
    DI float get(int row) const {
        if (!part) return 1.f;
        float s = 0.f;
        const float* p = part + (size_t)row * stride;
        for (int i = 0; i < cnt; i += 4) { const f32x4 v = *(const f32x4*)(p + i); s += (v.x + v.y) + (v.z + v.w); }
        return __builtin_amdgcn_rsqf(s * inv_n + EPS);
    }
};

DI void rs_preload(const RowScale& rs, int rowbase, int fq, float (&out)[8]) {
    if (!rs.part) {
#pragma unroll
        for (int i = 0; i < 8; ++i) out[i] = 1.f;
        return;
    }
#pragma unroll
    for (int hb = 0; hb < 2; ++hb) {
        float s[4];
#pragma unroll
        for (int i = 0; i < 4; ++i) { s[i] = 0.f;
            if (4 * fq < rs.cnt) { const f32x4 v = *(const f32x4*)(rs.part + (size_t)(rowbase + hb * 128 + i * 16) * rs.stride + 4 * fq);
                s[i] = v.x + (4 * fq + 1 < rs.cnt ? v.y : 0.f) + (4 * fq + 2 < rs.cnt ? v.z : 0.f) + (4 * fq + 3 < rs.cnt ? v.w : 0.f); } }
#pragma unroll
        for (int i = 0; i < 4; ++i) { float t = s[i]; t += __shfl_xor(t, 16); t += __shfl_xor(t, 32); out[hb * 4 + i] = __builtin_amdgcn_rsqf(t * rs.inv_n + EPS); }
        asm volatile("" ::: "memory");
    }
}
enum { SK_SKIP = 0, SK_RAW = 1, SK_HEAD = 2, SK_ROPE32 = 3, SK_GATE = 4 };
struct SlotDesc { int kind; bf16_t* dst; int ld; int col; const float* gain; float scale; int rope; float* part; int pstride; int pidx; const float* bias; };


template <class Cfg>
struct EpiSlot {
    Cfg cfg; RowScale rs; int rs_off; RopeTabs rt; int tok_off;
    template <int KIND>
    DI void run(const f32x4 (&acc)[2][2][4][2], const pg8::Unit& u, const SlotDesc& d, int wr, int fr, int fq) const {
        const int d0 = 8 * fq;
        float rsv[8]; rs_preload(rs, u.pm * 256 + wr * 64 + fr + rs_off, fq, rsv);
        float g0[8], g1[8];
        if (KIND == 2 || KIND == 5) {
#pragma unroll
            for (int i = 0; i < 8; ++i) { g0[i] = d.gain[d0 + i] * d.scale; g1[i] = d.gain[32 + d0 + i] * d.scale; }
        } else if (KIND == 3) {
#pragma unroll
            for (int i = 0; i < 8; ++i) { g0[i] = fq < 2 ? d.gain[d0 + i] * d.scale : 0.f; g1[i] = fq < 2 ? d.gain[16 + d0 + i] * d.scale : 0.f; }
        } else if (KIND == 4) {
#pragma unroll
            for (int i = 0; i < 8; ++i) { g0[i] = d.bias[d.col + d0 + i]; g1[i] = d.bias[d.col + 32 + d0 + i]; }
        }
#pragma unroll
        for (int ai = 0; ai < 2; ++ai)
#pragma unroll
            for (int m = 0; m < 4; ++m) {
                const int row = u.pm * 256 + ai * 128 + wr * 64 + m * 16 + fr;
                const float r = rsv[ai * 4 + m];
                float v0[8], v1[8];
#pragma unroll
                for (int n = 0; n < 2; ++n)
#pragma unroll
                    for (int j = 0; j < 4; ++j) { v0[4 * n + j] = acc[ai][0][m][n][j] * r; v1[4 * n + j] = acc[ai][1][m][n][j] * r; }
                bf16_t* dp = d.dst + (size_t)row * d.ld + d.col;
                if (KIND == 1) {
                    if (d.part) {
                        float ss = 0.f;
#pragma unroll
                        for (int i = 0; i < 8; ++i) ss += v0[i] * v0[i] + v1[i] * v1[i];
                        ss += __shfl_xor(ss, 16); ss += __shfl_xor(ss, 32);
                        if (fq == 0) d.part[(size_t)row * d.pstride + d.pidx] = ss;
                    }
                    *(u32x4*)(dp + d0) = pack8(v0); *(u32x4*)(dp + 32 + d0) = pack8(v1);
                } else if (KIND == 4) {
#pragma unroll
                    for (int i = 0; i < 8; ++i) { v0[i] = __builtin_amdgcn_rcpf(1.f + __builtin_amdgcn_exp2f(-(v0[i] + g0[i]) * LOG2E)); v1[i] = __builtin_amdgcn_rcpf(1.f + __builtin_amdgcn_exp2f(-(v1[i] + g1[i]) * LOG2E)); }
                    *(u32x4*)(dp + d0) = pack8(v0); *(u32x4*)(dp + 32 + d0) = pack8(v1);
                } else if (KIND == 2 || KIND == 5) {
                    float ss = 0.f;
#pragma unroll
                    for (int i = 0; i < 8; ++i) ss += v0[i] * v0[i] + v1[i] * v1[i];
                    ss += __shfl_xor(ss, 16); ss += __shfl_xor(ss, 32);
                    const float inv = __builtin_amdgcn_rsqf(ss * (1.f / 64.f) + EPS);
#pragma unroll
                    for (int i = 0; i < 8; ++i) { v0[i] *= inv * g0[i]; v1[i] *= inv * g1[i]; }
                    if (KIND == 5) {
                        const float* cp = rt.cosh + (size_t)(row + tok_off) * 32 + d0; const float* sp = rt.sinh + (size_t)(row + tok_off) * 32 + d0;
                        const f32x4 c0 = *(const f32x4*)cp, c1 = *(const f32x4*)(cp + 4), s0 = *(const f32x4*)sp, s1 = *(const f32x4*)(sp + 4);
#pragma unroll
                        for (int i = 0; i < 8; ++i) { const float c = i < 4 ? c0[i & 3] : c1[i & 3], sn = i < 4 ? s0[i & 3] : s1[i & 3];
                            const float a = v0[i], b = v1[i]; v0[i] = a * c - b * sn; v1[i] = b * c + a * sn; }
                    }
                    *(u32x4*)(dp + d0) = pack8(v0); *(u32x4*)(dp + 32 + d0) = pack8(v1);
                } else {
                    float ss = 0.f;
#pragma unroll
                    for (int i = 0; i < 8; ++i) ss += v0[i] * v0[i] + v1[i] * v1[i];
                    ss += __shfl_xor(ss, 16); ss += __shfl_xor(ss, 32);
                    const float inv = __builtin_amdgcn_rsqf(ss * (1.f / 32.f) + EPS);
                    if (fq < 2) {
#pragma unroll
                        for (int i = 0; i < 8; ++i) { v0[i] *= inv * g0[i]; v1[i] *= inv * g1[i]; }
                        const float* cp = rt.cosr + (size_t)(row + tok_off) * 16 + d0; const float* sp = rt.sinr + (size_t)(row + tok_off) * 16 + d0;
                        const f32x4 c0 = *(const f32x4*)cp, c1 = *(const f32x4*)(cp + 4), s0 = *(const f32x4*)sp, s1 = *(const f32x4*)(sp + 4);
#pragma unroll
                        for (int i = 0; i < 8; ++i) { const float c = i < 4 ? c0[i & 3] : c1[i & 3], sn = i < 4 ? s0[i & 3] : s1[i & 3];
                            const float a = v0[i], b = v1[i]; v0[i] = a * c - b * sn; v1[i] = b * c + a * sn; }
                        *(u32x4*)(dp + d0) = pack8(v0); *(u32x4*)(dp + 16 + d0) = pack8(v1);
                    }
                }
            }
    }
    DI void operator()(const f32x4 (&acc)[2][2][4][2], const pg8::Unit& u, int wr, int wc, int fr, int fq) const {
        const SlotDesc d = cfg.get(u.pn * 4 + wc);
        if (d.kind == SK_RAW) run<1>(acc, u, d, wr, fr, fq);
        else if (d.kind == SK_GATE) run<4>(acc, u, d, wr, fr, fq);
        else if (d.kind == SK_HEAD) { if (d.rope) run<5>(acc, u, d, wr, fr, fq); else run<2>(acc, u, d, wr, fr, fq); }
        else if (d.kind == SK_ROPE32) run<3>(acc, u, d, wr, fr, fq);
    }
};

struct CfgIn {
    unsigned char* ws; const float* a_qn; const float* a_kn; const float* b_kn; const float* c_qn; const float* c_kn; const float* b_gate;
    DI SlotDesc get(int s) const {
        SlotDesc d; d.kind = SK_SKIP; d.dst = nullptr; d.ld = 0; d.col = 0; d.gain = nullptr; d.scale = 1.f; d.rope = 0; d.part = nullptr; d.pstride = 0; d.pidx = 0; d.bias = nullptr;
        if (s < 8) { d.kind = SK_HEAD; d.dst = (bf16_t*)(ws + WS_QA); d.ld = 512; d.col = 64 * s; d.gain = a_qn; d.scale = 0.125f * LOG2E; d.rope = 1; }
        else if (s < 10) { d.kind = SK_HEAD; d.dst = (bf16_t*)(ws + WS_KA); d.ld = 128; d.col = 64 * (s - 8); d.gain = a_kn; d.rope = 1; }
        else if (s < 12) { d.kind = SK_RAW; d.dst = (bf16_t*)(ws + WS_VA); d.ld = 128; d.col = 64 * (s - 10); }
        else if (s < 18) { d.kind = SK_RAW; d.dst = (bf16_t*)(ws + WS_CQ); d.ld = 384; d.col = 64 * (s - 12); d.part = (float*)(ws + WS_PCQ); d.pstride = 8; d.pidx = s - 12; }
        else if (s < 22) { d.kind = SK_RAW; d.dst = (bf16_t*)(ws + WS_CKV); d.ld = 256; d.col = 64 * (s - 18); d.part = (float*)(ws + WS_PCKV); d.pstride = 4; d.pidx = s - 18; }
        else if (s == 22) { d.kind = SK_ROPE32; d.dst = (bf16_t*)(ws + WS_KR); d.ld = 32; d.col = 0; d.gain = b_kn + 64; }
        else if (s < 95) { const int p = (s - 23) >> 3, h = (s - 23) & 7, g = p / 3, t = p % 3;
            d.dst = (bf16_t*)(ws + WS_CB + (size_t)p * 16 * MiB); d.ld = 512; d.col = 64 * h;
            if (t == 0) { d.kind = SK_HEAD; d.gain = c_qn + 64 * g; d.scale = 0.125f * LOG2E; d.rope = 1; }
            else if (t == 1) { d.kind = SK_HEAD; d.gain = c_kn + 64 * g; d.rope = 1; }
            else d.kind = SK_RAW; }
        else if (s < 103) { d.kind = SK_RAW; d.dst = (bf16_t*)(ws + WS_MQ); d.ld = 512; d.col = 64 * (s - 95); }
        else if (s < 167) { d.kind = SK_GATE; d.dst = (bf16_t*)(ws + WS_GATES); d.ld = 4096; d.col = 64 * (s - 103); d.bias = b_gate; }
        return d;
    }
};
DI void in_slot_src(int s, int& src, int& kind) {
    kind = 0;
    if (s < 22) src = 64 * s;
    else if (s == 22) { src = 1408; kind = 1; }
    else if (s < 167) src = 1440 + 64 * (s - 23);
    else { src = 0; kind = 2; }
}
struct CfgUq {
    unsigned char* ws; const float* b_qn;
    DI SlotDesc get(int s) const {
        SlotDesc d; d.dst = (bf16_t*)(ws + WS_QB); d.ld = 768; d.scale = 0.10206207261596575f * LOG2E; d.rope = 0; d.part = nullptr; d.pstride = 0; d.pidx = 0; d.bias = nullptr;
        if (s < 8) { d.kind = SK_HEAD; d.col = 96 * s; d.gain = b_qn; }
        else { d.kind = SK_ROPE32; d.col = 96 * (s - 8) + 64; d.gain = b_qn + 64; }
        return d;
    }
};
struct CfgUkv {
    unsigned char* ws; const float* b_kn;
    DI SlotDesc get(int s) const {
        SlotDesc d; d.ld = 512; d.scale = 1.f; d.rope = 0; d.part = nullptr; d.pstride = 0; d.pidx = 0; d.bias = nullptr; d.gain = b_kn;
        if (s < 8) { d.kind = SK_HEAD; d.dst = (bf16_t*)(ws + WS_KN); d.col = 64 * s; }
        else { d.kind = SK_RAW; d.dst = (bf16_t*)(ws + WS_VB); d.col = 64 * (s - 8); }
        return d;
    }
};
struct CfgMkv {
    unsigned char* ws;
    DI SlotDesc get(int s) const {
        SlotDesc d; d.kind = SK_RAW; d.ld = 512; d.scale = 1.f; d.rope = 0; d.part = nullptr; d.pstride = 0; d.pidx = 0; d.bias = nullptr; d.gain = nullptr;
        if (s < 8) { d.dst = (bf16_t*)(ws + WS_MK); d.col = 64 * s; } else { d.dst = (bf16_t*)(ws + WS_MV); d.col = 64 * (s - 8); }
        return d;
    }
};

struct EpiMerge {
    const bf16_t* gates; bf16_t* gy;
    DI void operator()(const f32x4 (&acc)[2][2][4][2], const pg8::Unit& u, int wr, int wc, int fr, int fq) const {
#pragma unroll
        for (int ai = 0; ai < 2; ++ai)
#pragma unroll
            for (int m = 0; m < 4; ++m) {
                const int row = u.pm * 256 + ai * 128 + wr * 64 + m * 16 + fr;
#pragma unroll
                for (int bj = 0; bj < 2; ++bj) {
                    const int col = u.pn * 256 + bj * 128 + wc * 32 + 8 * fq;
                    float g[8], o[8];
                    unpack8(*(const u32x4*)(gates + (size_t)row * 4096 + u.seg * 1024 + col), g);
                    bf16_t* gp = gy + (size_t)row * 1024 + col;
                    if (u.seg == 0) {
#pragma unroll
                        for (int i = 0; i < 8; ++i) o[i] = 0.f;
                    } else unpack8(*(const u32x4*)gp, o);
#pragma unroll
                    for (int n = 0; n < 2; ++n)
#pragma unroll
                        for (int j = 0; j < 4; ++j) o[4 * n + j] += g[4 * n + j] * acc[ai][bj][m][n][j];
                    *(u32x4*)gp = pack8(o);
                }
            }
    }
};
struct EpiRes {
    const float* xsrc; float* xdst; bf16_t* xb; float* px;
    DI void operator()(const f32x4 (&acc)[2][2][4][2], const pg8::Unit& u, int wr, int wc, int fr, int fq) const {
#pragma unroll
        for (int ai = 0; ai < 2; ++ai)
#pragma unroll
            for (int m = 0; m < 4; ++m) {
                const int row = u.pm * 256 + ai * 128 + wr * 64 + m * 16 + fr;
                float ss = 0.f;
#pragma unroll
                for (int bj = 0; bj < 2; ++bj) {
                    const size_t off = (size_t)row * 1024 + u.pn * 256 + bj * 128 + wc * 32 + 8 * fq;
                    float o[8];
#pragma unroll
                    for (int n = 0; n < 2; ++n) { const f32x4 xs = *(const f32x4*)(xsrc + off + 4 * n); const f32x4 xn = xs + acc[ai][bj][m][n]; *(f32x4*)(xdst + off + 4 * n) = xn;
#pragma unroll
                        for (int j = 0; j < 4; ++j) { o[4 * n + j] = xn[j]; ss += xn[j] * xn[j]; } }
                    *(u32x4*)(xb + off) = pack8(o);
                }
                ss += __shfl_xor(ss, 16); ss += __shfl_xor(ss, 32);
                if (fq == 0) px[(size_t)row * 16 + u.pn * 4 + wc] = ss;
            }
    }
};
struct EpiUp {
    bf16_t* U; RowScale rs; int rs_off;
    DI void operator()(const f32x4 (&acc)[2][2][4][2], const pg8::Unit& u, int wr, int wc, int fr, int fq) const {
        float rsv[8]; rs_preload(rs, u.pm * 256 + wr * 64 + fr + rs_off, fq, rsv);
#pragma unroll
        for (int ai = 0; ai < 2; ++ai)
#pragma unroll
            for (int m = 0; m < 4; ++m) {
                const int row = u.pm * 256 + ai * 128 + wr * 64 + m * 16 + fr;
                const float r = rsv[ai * 4 + m];
#pragma unroll
                for (int bj = 0; bj < 2; ++bj) {
                    float o[8];
#pragma unroll
                    for (int n = 0; n < 2; ++n)
#pragma unroll
                        for (int j = 0; j < 4; ++j) { const float v = fmaxf(acc[ai][bj][m][n][j] * r, 0.f); o[4 * n + j] = v * v; }
                    *(u32x4*)(U + (size_t)row * DFF + u.pn * 256 + bj * 128 + wc * 32 + 8 * fq) = pack8(o);
                }
            }
    }
};

DI void transpose_item(const float* W, int K, int N, const float* gk, bf16_t* WT, int rho0, int k0, int src0, int nvalid, LAS float* scr, int lane) {
    { const int c4 = (lane & 7) * 4;
#pragma unroll
      for (int i = 0; i < 8; ++i) { const int kk = 8 * i + (lane >> 3);
        f32x4 v = (f32x4){0.f, 0.f, 0.f, 0.f};
        if (c4 < nvalid) v = *(const f32x4*)(W + (size_t)(k0 + kk) * N + src0 + c4);
        if (gk) v = v * gk[k0 + kk];
        scr[kk * 33 + c4] = v.x; scr[kk * 33 + c4 + 1] = v.y; scr[kk * 33 + c4 + 2] = v.z; scr[kk * 33 + c4 + 3] = v.w; } }
    LDS_WAIT();
    const int c8 = lane & 7;
#pragma unroll
    for (int j = 0; j < 4; ++j) { const int n = (lane >> 3) + 8 * j; const LAS float* s = scr + (8 * c8) * 33 + n;
        u32x4 o; o.x = cvtpk(s[0 * 33], s[1 * 33]); o.y = cvtpk(s[2 * 33], s[3 * 33]); o.z = cvtpk(s[4 * 33], s[5 * 33]); o.w = cvtpk(s[6 * 33], s[7 * 33]);
        *(u32x4*)(WT + (size_t)(rho0 + n) * K + k0 + 8 * c8) = o; }
    LDS_WAIT();
}
DI void block_src(int mapk, int q  , int& src0, int& nvalid) {
    if (mapk == 0) { src0 = 32 * q; nvalid = 32; return; }
    const int pn = q >> 3, bj = (q >> 2) & 1, wc = q & 3, s = 4 * pn + wc;
    if (mapk == 1) { int src, kind; in_slot_src(s, src, kind);
        if (kind == 0) { src0 = src + 32 * bj; nvalid = 32; } else if (kind == 1) { src0 = src + 16 * bj; nvalid = 16; } else { src0 = 0; nvalid = 0; } }
    else if (mapk == 2) { if (s < 8) { src0 = 96 * s + 32 * bj; nvalid = 32; } else { src0 = 96 * (s - 8) + 64 + 16 * bj; nvalid = 16; } }
    else if (mapk == 3) { if (s < 8) { src0 = 128 * s + 32 * bj; nvalid = 32; } else { src0 = 128 * (s - 8) + 64 + 32 * bj; nvalid = 32; } }
    else { src0 = 64 * s + 32 * bj; nvalid = 32; }
}
DI void convert_matrix(const float* W, int K, int N, int Nt, const float* gk, bf16_t* WT, int mapk, LAS float* scr, int gw, int NGW, int lane) {
    const int nblk = Nt / 32, items = (K / 64) * nblk;
    for (int it = gw; it < items; it += NGW) {
        const int kb = it / nblk, q = it % nblk; int src0, nvalid; block_src(mapk, q, src0, nvalid);
        transpose_item(W, K, N, gk, WT, 32 * q, 64 * kb, src0, nvalid, scr, lane);
    }
}
DI void convert_layer(int l, LAS unsigned char* lds, int gw, int NGW, int wave) {
    const int lane = lane_id();
    CParams* q = fresh_params();
    LAS float* scr = (LAS float*)(lds + wave * 16384);
    unsigned char* ws = q->ws;
    convert_matrix(q->in[4] + (size_t)l * D * N_IN, D, N_IN, NT_IN, q->in[3] + l * D, (bf16_t*)(ws + WS_WIN), 1, scr, gw, NGW, lane);
    convert_matrix(q->in[11] + (size_t)l * 384 * 768, 384, 768, 1024, q->in[9] + l * 384, (bf16_t*)(ws + WS_WUQ), 2, scr, gw, NGW, lane);
    convert_matrix(q->in[12] + (size_t)l * 256 * 1024, 256, 1024, 1024, q->in[10] + l * 256, (bf16_t*)(ws + WS_WUKV), 3, scr, gw, NGW, lane);
    convert_matrix(q->in[18] + (size_t)l * D * 1024, D, 1024, 1024, q->in[17] + l * D, (bf16_t*)(ws + WS_WMKV), 4, scr, gw, NGW, lane);
    for (int n = 0; n < 4; ++n)
        convert_matrix(q->in[21] + ((size_t)l * 4 + n) * 512 * D, 512, D, D, nullptr, (bf16_t*)(ws + WS_WBR) + (size_t)n * D * 512, 0, scr, gw, NGW, lane);
    convert_matrix(q->in[22] + (size_t)l * D * D, D, D, D, nullptr, (bf16_t*)(ws + WS_WOUT), 0, scr, gw, NGW, lane);
    convert_matrix(q->in[24] + (size_t)l * D * DFF, D, DFF, DFF, q->in[23] + l * D, (bf16_t*)(ws + WS_WUP), 0, scr, gw, NGW, lane);
    convert_matrix(q->in[25] + (size_t)l * DFF * D, DFF, D, D, nullptr, (bf16_t*)(ws + WS_WDN), 0, scr, gw, NGW, lane);
}

DI int crow(int i, int h) { return (i & 3) + 8 * (i >> 2) + 4 * h; }
DI f32x16 mfma32(bf16x8 a, bf16x8 b, f32x16 c) { return __builtin_amdgcn_mfma_f32_32x32x16_bf16(a, b, c, 0, 0, 0); }
DI bf16x8 packp(const f32x16& x, int s) { u32x4 w; w.x = cvtpk(x[8 * s], x[8 * s + 1]); w.y = cvtpk(x[8 * s + 2], x[8 * s + 3]); w.z = cvtpk(x[8 * s + 4], x[8 * s + 5]); w.w = cvtpk(x[8 * s + 6], x[8 * s + 7]); return __builtin_bit_cast(bf16x8, w); }
DI s16x4 vtr(const LAS char* p) { return __builtin_bit_cast(s16x4, __builtin_amdgcn_ds_read_tr16_b64_v4i16((LAS s16x4*)p)); }

DI float max3f(float a, float b, float c) { float r; asm("v_max3_f32 %0, %1, %2, %3" : "=v"(r) : "v"(a), "v"(b), "v"(c)); return r; }
DI float xhalf_max(float v) { auto rr = __builtin_amdgcn_permlane32_swap(__float_as_uint(v), __float_as_uint(v), false, false); return fmaxf(__uint_as_float(rr[0]), __uint_as_float(rr[1])); }
DI float xhalf_sum(float v) { auto rr = __builtin_amdgcn_permlane32_swap(__float_as_uint(v), __float_as_uint(v), false, false); return __uint_as_float(rr[0]) + __uint_as_float(rr[1]); }
DI f32x16 splat16(float v) { f32x16 p;
#pragma unroll
    for (int i = 0; i < 16; ++i) p[i] = v;
    return p; }
template <int DQK, int NT, int TSTRIDE> DI void st_tiles(unsigned kaddr, const bf16x8* qf, const f32x16& init, f32x16* p) {
    bf16x8 a[NT][DQK / 16];
#pragma unroll
    for (int j = 0; j < NT; ++j)
#pragma unroll
        for (int ks = 0; ks < DQK / 16; ++ks) asm volatile("ds_read_b128 %0, %1 offset:%2" : "=v"(a[j][ks]) : "v"(kaddr), "i"(j * TSTRIDE + ks * 32));
    asm volatile("s_waitcnt lgkmcnt(0)" ::: "memory");
#pragma unroll
    for (int j = 0; j < NT; ++j)
#pragma unroll
        for (int ks = 0; ks < DQK / 16; ++ks) asm volatile("" : "+v"(a[j][ks]));
#pragma unroll
    for (int j = 0; j < NT; ++j) p[j] = init;
#pragma unroll
    for (int ks = 0; ks < DQK / 16; ++ks)
#pragma unroll
        for (int j = 0; j < NT; ++j) p[j] = mfma32(a[j][ks], qf[ks], p[j]);
}
template <int DV, int VP> DI void pv_tile(f32x16* o, const LAS char* vp, const f32x16& p, int h) {
#pragma unroll
    for (int s = 0; s < 2; ++s) {
        const bf16x8 pa = packp(p, s);
#pragma unroll
        for (int db = 0; db < DV / 32; ++db) {
            const s16x4 lo = vtr(vp + (16 * s + 4 * h) * VP + db * 64);
            const s16x4 hi = vtr(vp + (16 * s + 8 + 4 * h) * VP + db * 64);
            const bf16x8 vb = __builtin_shufflevector(lo, hi, 0, 1, 2, 3, 4, 5, 6, 7);
            o[db] = mfma32(pa, vb, o[db]);
        }
    }
}
template <int NDB> DI void scale_o(f32x16* o, float f, LAS float* sc, int r, int h) {
    if (h == 0) sc[r] = f;
    LDS_WAIT();
#pragma unroll
    for (int g = 0; g < 4; ++g) { const f32x4 f4 = *(const LAS f32x4*)(sc + 8 * g + 4 * h);
#pragma unroll
        for (int db = 0; db < NDB; ++db)
#pragma unroll
            for (int j = 0; j < 4; ++j) o[db][4 * g + j] *= f4[j]; }
    LDS_WAIT();
}
template <int NDB> DI void store_o(const f32x16* o, bf16_t* obase  , long rstride, int r, int h) {
#pragma unroll
    for (int i = 0; i < 16; ++i) { bf16_t* rp = obase + (long)crow(i, h) * rstride + r;
#pragma unroll
        for (int db = 0; db < NDB; ++db) rp[32 * db] = (bf16_t)(cvtpk(o[db][i], 0.f) & 0xffffu); }
}

constexpr int BKP = 144, BVP = 144;
constexpr int BSLOT = 256 * BKP + 256 * BVP;

DI void banded_load(LAS char* dst, int pitch, const bf16_t* src  , int ld, long row0  , int dil, int gi0, int tid) {
#pragma unroll
    for (int it = 0; it < 4; ++it) {
        const int c = tid + it * NTHREADS, key = c >> 3, cc = c & 7, gi = gi0 + key;
        u32x4 v = (u32x4){0u, 0u, 0u, 0u};
        if (gi >= 0) v = *(const u32x4*)(src + (row0 + (long)gi * dil) * ld + cc * 8);
        *(LAS u32x4*)(dst + key * pitch + cc * 16) = v;
    }
}
template <bool SINK, bool WANT_LSE>
DI void banded_task(const bf16_t* qrow  , bf16_t* obase, long rstride, const LAS char* Ks, const LAS char* Vs,
                    int wq, int jblk, int maxd, float sink2, float* lsep, LAS float* sc, int lane) {
    const int r = lane & 31, h = lane >> 5;
    bf16x8 qf[4];
#pragma unroll
    for (int ks = 0; ks < 4; ++ks) qf[ks] = *(const bf16x8*)(qrow + 16 * ks + 8 * h);
    f32x16 p[5];
    const f32x16 zero16 = splat16(0.f);
    { const unsigned ka = (unsigned)(uintptr_t)(Ks + (32 * wq + r) * BKP + 16 * h);
      st_tiles<64, 3, 32 * BKP>(ka, qf, zero16, p); st_tiles<64, 2, 32 * BKP>(ka + 96 * BKP, qf, zero16, p + 3); }
    const int tmin = (jblk == 0) ? 4 - wq : 0, lo = r + 128 - maxd;
#pragma unroll
    for (int t = 0; t < 5; ++t) {
        if (t < tmin) { p[t] = splat16(NEGBIG); }
        else if (t == 0) {
#pragma unroll
            for (int i = 0; i < 16; ++i) p[t][i] = (crow(i, h) >= lo) ? p[t][i] : NEGBIG;
        } else if (t == 4) {
#pragma unroll
            for (int i = 0; i < 16; ++i) p[t][i] = (crow(i, h) <= r) ? p[t][i] : NEGBIG;
        }
    }
    asm volatile("s_nop 15\n\ts_nop 7" : "+v"(p[0]), "+v"(p[1]), "+v"(p[2]), "+v"(p[3]), "+v"(p[4]));
    float mx = NEGBIG;
#pragma unroll
    for (int t = 0; t < 5; ++t)
#pragma unroll
        for (int i = 0; i < 16; i += 2) mx = max3f(mx, p[t][i], p[t][i + 1]);
    mx = xhalf_max(mx);
    if (SINK) mx = fmaxf(mx, sink2);
    float l = 0.f;
#pragma unroll
    for (int t = 0; t < 5; ++t)
#pragma unroll
        for (int i = 0; i < 16; ++i) { const float e = __builtin_amdgcn_exp2f(p[t][i] - mx); p[t][i] = e; l += e; }
    l = xhalf_sum(l);
    if (SINK) l += __builtin_amdgcn_exp2f(sink2 - mx);
    f32x16 o[2];
#pragma unroll
    for (int i = 0; i < 16; ++i) { o[0][i] = 0.f; o[1][i] = 0.f; }
    const LAS char* vl = Vs + ((lane & 15) >> 2) * BVP + ((lane >> 4) & 1) * 32 + (lane & 3) * 8;
#pragma unroll
    for (int t = 0; t < 5; ++t) pv_tile<64, BVP>(o, vl + 32 * (wq + t) * BVP, p[t], h);
    scale_o<2>(o, 1.f / l, sc, r, h);
    store_o<2>(o, obase, rstride, r, h);
    if (WANT_LSE) { if (h == 0) *lsep = mx + __builtin_amdgcn_logf(l); }
}

template <int DQK, int DV, bool CAUSAL, bool SPLITK>
DI void dense_unit(const bf16_t* Q, int ldq, const bf16_t* K1, int ldk1, const bf16_t* K2, int ldk2, const bf16_t* V, int ldv, bf16_t* O, int ldo,
                   int q0  , int ntiles, LAS char* lds, LAS float* sc, int tid) {
    constexpr int KP = DQK * 2 + 16, VP = DV * 2 + 16, KCH = DQK / 8, VCH = DV / 8, NK = 64 * KCH, NCH = NK + 64 * VCH, NIT = (NCH + NTHREADS - 1) / NTHREADS;
    constexpr int KBUF = 64 * KP, VBUF = 64 * VP, TB = KBUF + VBUF;
    const int lane = tid & 63, w = __builtin_amdgcn_readfirstlane(tid >> 6), r = lane & 31, h = lane >> 5;
    LAS char* kb0 = lds; LAS char* vb0 = lds + KBUF;
    bf16x8 qf[DQK / 16];
    { const bf16_t* qr = Q + (long)(32 * w + r) * ldq;
#pragma unroll
      for (int ks = 0; ks < DQK / 16; ++ks) { qf[ks] = *(const bf16x8*)(qr + 16 * ks + 8 * h); asm volatile("" : "+v"(qf[ks])); } }
    int gb[NIT], gs[NIT], lo[NIT];
    if (SPLITK)
#pragma unroll
    for (int it = 0; it < NIT; ++it) { const int c = tid + it * NTHREADS;
        if (c < NK) { const int key = c / KCH, cc = c % KCH;
            if (SPLITK && cc >= 8) { gb[it] = (int)((const char*)K2 - (const char*)K1) + (key * ldk2 + (cc - 8) * 8) * 2; gs[it] = 64 * ldk2 * 2; }
            else { gb[it] = (key * ldk1 + cc * 8) * 2; gs[it] = 64 * ldk1 * 2; }
            lo[it] = key * KP + cc * 16; }
        else { const int c2 = (c < NCH ? c : NK) - NK, key = c2 / VCH, cc = c2 % VCH;
            gb[it] = (int)((const char*)V - (const char*)K1) + (key * ldv + cc * 8) * 2; gs[it] = 64 * ldv * 2; lo[it] = KBUF + key * VP + cc * 16; }
        asm volatile("" : "+v"(gb[it]), "+v"(gs[it]), "+v"(lo[it])); }
    u32x4 pre[NIT];
    auto gload = [&](int t) {
        if (SPLITK) {
#pragma unroll
            for (int it = 0; it < NIT; ++it) if ((it + 1) * NTHREADS <= NCH || tid + it * NTHREADS < NCH) pre[it] = *(const u32x4*)((const char*)K1 + (long)(gb[it] + t * gs[it]));
        } else {
            const int tid2 = opaque(tid);
#pragma unroll
            for (int it = 0; it < NIT; ++it) { const int c = tid2 + it * NTHREADS;
                if (c < NK) { const int key = c / KCH, cc = c % KCH; pre[it] = *(const u32x4*)(K1 + (long)(64 * t + key) * ldk1 + cc * 8); }
                else if (c < NCH) { const int c2 = c - NK, key = c2 / VCH, cc = c2 % VCH; pre[it] = *(const u32x4*)(V + (long)(64 * t + key) * ldv + cc * 8); } }
        }
    };
    auto lstore = [&](int b) {
        if (SPLITK) {
#pragma unroll
            for (int it = 0; it < NIT; ++it) if ((it + 1) * NTHREADS <= NCH || tid + it * NTHREADS < NCH) *(LAS u32x4*)(lds + b * TB + lo[it]) = pre[it];
        } else {
            const int tid2 = opaque(tid);
#pragma unroll
            for (int it = 0; it < NIT; ++it) { const int c = tid2 + it * NTHREADS;
                if (c < NK) { const int key = c / KCH, cc = c % KCH; *(LAS u32x4*)(kb0 + b * TB + key * KP + cc * 16) = pre[it]; }
                else if (c < NCH) { const int c2 = c - NK, key = c2 / VCH, cc = c2 % VCH; *(LAS u32x4*)(vb0 + b * TB + key * VP + cc * 16) = pre[it]; } }
        }
    };
    gload(0); lstore(0);
    __syncthreads();
    float m = 0.f, l = 0.f; bool first = true;
    f32x16 negm = splat16(0.f);
    f32x16 o[DV / 32];
#pragma unroll
    for (int db = 0; db < DV / 32; ++db)
#pragma unroll
        for (int i = 0; i < 16; ++i) o[db][i] = 0.f;
    const int qpos = q0 + 32 * w + r;
    for (int t = 0; t < ntiles; ++t) {
        const int b = t & 1;
        if (t + 1 < ntiles) gload(t + 1);
        if (!CAUSAL || 64 * t <= q0 + 32 * w) {
            const LAS char* kp = kb0 + b * TB + r * KP + 16 * h;
            f32x16 pp[2]; st_tiles<DQK, 2, 32 * KP>((unsigned)(uintptr_t)kp, qf, negm, pp);
            f32x16& p0 = pp[0]; f32x16& p1 = pp[1];
            if (CAUSAL && 64 * t + 63 > q0 + 32 * w) {
#pragma unroll
                for (int i = 0; i < 16; ++i) { const int key = 64 * t + crow(i, h); if (key > qpos) p0[i] = NEGBIG; if (key + 32 > qpos) p1[i] = NEGBIG; }
            }
            asm volatile("s_nop 15\n\ts_nop 7" : "+v"(p0), "+v"(p1));
            float mx = NEGBIG;
#pragma unroll
            for (int i = 0; i < 16; ++i) mx = max3f(mx, p0[i], p1[i]);
            mx = xhalf_max(mx);
            if (first || __any(mx > 8.f)) {
                const float dl = first ? mx : (mx > 8.f ? mx : 0.f);
                m += dl;
                const float f = __builtin_amdgcn_exp2f(-dl);
                l *= f;
#pragma unroll
                for (int i = 0; i < 16; ++i) { p0[i] -= dl; p1[i] -= dl; }
                if (!first) scale_o<DV / 32>(o, f, sc, r, h);
                negm = splat16(-m);
                first = false;
            }
#pragma unroll
            for (int i = 0; i < 16; ++i) { p0[i] = __builtin_amdgcn_exp2f(p0[i]); p1[i] = __builtin_amdgcn_exp2f(p1[i]); l += p0[i] + p1[i]; }
            const LAS char* vl = vb0 + b * TB + ((lane & 15) >> 2) * VP + ((lane >> 4) & 1) * 32 + (lane & 3) * 8;
            pv_tile<DV, VP>(o, vl, p0, h);
            pv_tile<DV, VP>(o, vl + 32 * VP, p1, h);
        }
        if (t + 1 < ntiles) lstore(b ^ 1);
        __syncthreads();
    }
    l = xhalf_sum(l);
    scale_o<DV / 32>(o, 1.f / l, sc, r, h);
    store_o<DV / 32>(o, O + (long)(32 * w) * ldo, ldo, r, h);
}


#define XB_TMO      128
#define XB_XCNT(j)  (256  + 64 * (j))
#define XB_XSUB(j)  (1280 + 64 * (j))
#define XB_XGEN(j)  (2304 + 64 * (j))
#define XB_TOP      3328
#define XB_TOPGEN   3392
#define XCD_BAR_WORDS 3456
#define XB_SPIN_CAP (1u << 22)
DI unsigned xb_ld(unsigned* p)              { return __hip_atomic_load(p, __ATOMIC_RELAXED, __HIP_MEMORY_SCOPE_AGENT); }
DI unsigned xb_add(unsigned* p, unsigned v) { return __hip_atomic_fetch_add(p, v, __ATOMIC_RELAXED, __HIP_MEMORY_SCOPE_AGENT); }
DI unsigned xb_xcc_id() { return (unsigned)__builtin_amdgcn_s_getreg((3 << 11) | 20) & 0xFu; }
#define XB_SPIN(cond, bar) do { unsigned _sp = 0; while (cond) { __builtin_amdgcn_s_sleep(1); \
    if ((++_sp & 255u) == 0u) { if (xb_ld(&(bar)[XB_TMO])) break; if (_sp > XB_SPIN_CAP) { atomicAdd(&(bar)[XB_TMO], 1u); break; } } } } while (0)
struct XcdBarrier { unsigned* bar; unsigned x; volatile LAS unsigned* st; };
DI XcdBarrier xcd_barrier_post(unsigned* bar, volatile LAS unsigned* st) {
    XcdBarrier b; b.bar = bar; b.x = xb_xcc_id(); b.st = st;
    if (threadIdx.x == 0) (void)xb_add(&bar[XB_XCNT(b.x)], 1u);
    return b;
}
DI void xcd_barrier_complete(unsigned* bar, unsigned x, unsigned& nloc, unsigned& nx) {
    const unsigned G = gridDim.x * gridDim.y * gridDim.z;
    unsigned sum, cnt, mine, sp = 0u;
    for (;;) {
        sum = 0u; cnt = 0u; mine = 0u;
#pragma unroll
        for (unsigned j = 0; j < 16; ++j) { const unsigned c = xb_ld(&bar[XB_XCNT(j)]); sum += c; cnt += (c > 0u) ? 1u : 0u; mine = (j == x) ? c : mine; }
        if (sum == G) break;
        __builtin_amdgcn_s_sleep(1);
        if ((++sp & 255u) == 0u) { if (xb_ld(&bar[XB_TMO])) break; if (sp > XB_SPIN_CAP) { atomicAdd(&bar[XB_TMO], 1u); break; } }
    }
    nloc = mine > 0u ? mine : 1u; nx = cnt > 0u ? cnt : 1u;
}
DI void xcd_barrier(unsigned* bar, unsigned x, volatile LAS unsigned* st) {
    asm volatile("s_waitcnt vmcnt(0)" ::: "memory");
    __syncthreads();
    if (threadIdx.x == 0) {
        __builtin_amdgcn_s_waitcnt(0);
        unsigned nloc = st[0], nx = st[1];
        if (nloc == 0u) { xcd_barrier_complete(bar, x, nloc, nx); st[0] = nloc; st[1] = nx; }
        const unsigned old = xb_add(&bar[XB_XSUB(x)], 1u);
        const unsigned gen = old / nloc;
        if (old + 1u == (gen + 1u) * nloc) {
            __builtin_amdgcn_fence(__ATOMIC_RELEASE, "agent");
            asm volatile("s_waitcnt vmcnt(0)" ::: "memory");
            const unsigned og = xb_add(&bar[XB_TOP], 1u);
            const unsigned tg = og / nx;
            if (og + 1u == (tg + 1u) * nx) xb_add(&bar[XB_TOPGEN], 1u);
            else XB_SPIN(xb_ld(&bar[XB_TOPGEN]) == tg, bar);
            __builtin_amdgcn_fence(__ATOMIC_ACQUIRE, "agent");
            xb_add(&bar[XB_XGEN(x)], 1u);
            asm volatile("s_waitcnt vmcnt(0)" ::: "memory");
        } else {
            XB_SPIN(xb_ld(&bar[XB_XGEN(x)]) == gen, bar);
            __builtin_amdgcn_fence(__ATOMIC_ACQUIRE, "agent");
            asm volatile("s_waitcnt vmcnt(0)" ::: "memory");
        }
    }
    __syncthreads();
}

DI void sincos_acc(float ang, float& c, float& s) {
    const double x = (double)ang;
    const double n = __builtin_rint(x * 0.63661977236758134308);
    double rr = __builtin_fma(-n, 1.57079632679489655800e+00, x); rr = __builtin_fma(-n, 6.12323399573676603587e-17, rr);
    const double r2 = rr * rr;
    const double sn = rr * (1.0 + r2 * (-1.0 / 6 + r2 * (1.0 / 120 + r2 * (-1.0 / 5040 + r2 * (1.0 / 362880 + r2 * (-1.0 / 39916800 + r2 * (1.0 / 6227020800.0)))))));
    const double cs = 1.0 + r2 * (-0.5 + r2 * (1.0 / 24 + r2 * (-1.0 / 720 + r2 * (1.0 / 40320 + r2 * (-1.0 / 3628800 + r2 * (1.0 / 479001600.0))))));
    const int q = ((int)n) & 3;
    const double cc = (q == 0) ? cs : (q == 1) ? -sn : (q == 2) ? -cs : sn;
    const double ss = (q == 0) ? sn : (q == 1) ? cs : (q == 2) ? -sn : -cs;
    c = (float)cc; s = (float)ss;
}

#ifndef PH
#define PH 255
#endif
#ifndef REP_P1
#define REP_P1 1
#endif
#ifndef REP_B
#define REP_B 1
#endif
#ifndef REP_CONV
#define REP_CONV 1
#endif
#ifndef REP_P7
#define REP_P7 1
#endif
#define GRID_SYNC() do { CParams* qb_ = fresh_params(); xcd_barrier((unsigned*)(qb_->ws + WS_CTL), xcc, MISC); } while (0)

__global__ void __launch_bounds__(NTHREADS, 2) fwd_megakernel(Params p) {
    extern __shared__ __attribute__((aligned(16))) unsigned char lds_raw[];
    cg::grid_group grid = cg::this_grid();
    LAS unsigned char* lds = (LAS unsigned char*)lds_raw;
    const int wave = __builtin_amdgcn_readfirstlane((int)threadIdx.x >> 6);
    const int G = gridDim.x, bid = blockIdx.x;
    const int gw = bid * NWAVES + wave, NGW = G * NWAVES;
    LAS float* sc = (LAS float*)(lds + LDS_SCR) + wave * 64;
    volatile LAS unsigned* MISC = (volatile LAS unsigned*)(lds + LDS_SCR + 2048);
    if (threadIdx.x < 4) MISC[threadIdx.x] = 0u;
    __syncthreads();
    unsigned xcc;
    { CParams* q0 = fresh_params(); const XcdBarrier xb = xcd_barrier_post((unsigned*)(q0->ws + WS_CTL), MISC); xcc = xb.x; }

#ifndef NOPRO
    {
        PHASE_CTX
        float* COSH = (float*)(ws + WS_COSH); float* SINH = (float*)(ws + WS_SINH); float* COSR = (float*)(ws + WS_COSR); float* SINR = (float*)(ws + WS_SINR);
        const float* x = q->in[0]; const int* pos = (const int*)q->in[2];
        const int lane = lane_id(), tid = wave * 64 + lane;
        for (int i = bid * NTHREADS + tid; i < TT * 32; i += G * NTHREADS) { const int t = i >> 5, k = i & 31; float c, s; sincos_acc((float)pos[t] * q->inv_h[k], c, s); COSH[i] = c; SINH[i] = s; }
        for (int i = bid * NTHREADS + tid; i < TT * 16; i += G * NTHREADS) { const int t = i >> 4, k = i & 15; float c, s; sincos_acc((float)pos[t] * q->inv_r[k], c, s); COSR[i] = c; SINR[i] = s; }
        for (int row = gw; row < TT; row += NGW) {
            const f32x4* xr = (const f32x4*)(x + (size_t)row * D) + lane; float ss = 0.f;
            u32x2* o8 = (u32x2*)(XB + (size_t)row * D) + lane;
#pragma unroll
            for (int j = 0; j < 4; ++j) { const f32x4 v = xr[64 * j]; ss += (v.x * v.x + v.y * v.y) + (v.z * v.z + v.w * v.w); u32x2 w; w.x = cvtpk(v.x, v.y); w.y = cvtpk(v.z, v.w); o8[64 * j] = w; }
            ss = wave_sum(ss);
            if (lane < 16) PX[(size_t)row * 16 + lane] = lane == 0 ? ss : 0.f;
        }
        const float* mem = q->in[1]; bf16_t* MEMN = (bf16_t*)(ws + WS_MEMN);
        for (int row = gw; row < BATCH * NMEM; row += NGW) {
            const f32x4* xr = (const f32x4*)(mem + (size_t)row * D) + lane; f32x4 v[4]; float ss = 0.f;
#pragma unroll
            for (int j = 0; j < 4; ++j) { v[j] = xr[64 * j]; ss += (v[j].x * v[j].x + v[j].y * v[j].y) + (v[j].z * v[j].z + v[j].w * v[j].w); }
            const float rstd = __builtin_amdgcn_rsqf(wave_sum(ss) * (1.f / D) + EPS);
            u32x2* o8 = (u32x2*)(MEMN + (size_t)row * D) + lane;
#pragma unroll
            for (int j = 0; j < 4; ++j) { u32x2 w; w.x = cvtpk(v[j].x * rstd, v[j].y * rstd); w.y = cvtpk(v[j].z * rstd, v[j].w * rstd); o8[64 * j] = w; }
        }
    }

#endif
    for (int l = 0; l < DEPTH; ++l) {
#ifndef NOCONV
#pragma unroll 1
        for (int rep = 0; rep < REP_CONV; ++rep) convert_layer(l, lds, gw, NGW, wave);
#endif
        if (l == 0) grid.sync(); else GRID_SYNC();
        for (int ch = 0; ch < NCHUNK; ++ch) {
            const int tok0 = ch * TC;
#if PH & 1
            {
                PHASE_CTX
                pg8::TileOrder S; S.init(TC, NT_IN, G, bid, XB + (size_t)tok0 * D, (const bf16_t*)(ws + WS_WIN));
                EpiSlot<CfgIn> E{CfgIn{ws, q->in[6] + l * 64, q->in[7] + l * 64, q->in[14] + l * 96, q->in[15] + l * 192, q->in[16] + l * 192, q->in[5] + l * 4096},
                                 RowScale{PX, 16, 16, 1.f / D}, tok0, rt, tok0};
#pragma unroll 1
                for (int rep = 0; rep < REP_P1; ++rep) pg8::gemm_phase(lds, D, D, S, E, wave);
                if (ch == 0) {
                    pg8::TileOrder S2; S2.init(BATCH * NMEM, 1024, G, (bid + 128) % G, (const bf16_t*)(ws + WS_MEMN), (const bf16_t*)(ws + WS_WMKV));
                    EpiSlot<CfgMkv> E2{CfgMkv{ws}, RowScale{nullptr, 0, 0, 0.f}, 0, rt, 0};
                    pg8::gemm_phase(lds, D, D, S2, E2, wave);
                }
            }

#endif
            GRID_SYNC();
#if PH & 2
            {
                PHASE_CTX
                pg8::TileOrder S; S.init(TC, 1024, G, bid, (const bf16_t*)(ws + WS_CQ), (const bf16_t*)(ws + WS_WUQ));
                EpiSlot<CfgUq> E{CfgUq{ws, q->in[13] + l * 96}, RowScale{(const float*)(ws + WS_PCQ), 8, 6, 1.f / 384.f}, 0, rt, tok0};
                pg8::gemm_phase(lds, 384, 384, S, E, wave);
                pg8::TileOrder S2; S2.init(TC, 1024, G, bid, (const bf16_t*)(ws + WS_CKV), (const bf16_t*)(ws + WS_WUKV));
                EpiSlot<CfgUkv> E2{CfgUkv{ws, q->in[14] + l * 96}, RowScale{(const float*)(ws + WS_PCKV), 4, 4, 1.f / 256.f}, 0, rt, tok0};
                pg8::gemm_phase(lds, 256, 256, S2, E2, wave);
                const int lane = opaque(lane_id());
                const int nrows = TC + (ch == 0 ? BATCH * NMEM : 0);
                for (int rw = gw; rw < nrows; rw += NGW) {
                    const bool isq = rw < TC;
                    bf16_t* rp = isq ? (bf16_t*)(ws + WS_MQ) + (size_t)rw * 512 : (bf16_t*)(ws + WS_MK) + (size_t)(rw - TC) * 512;
                    const float* gn = (isq ? q->in[19] : q->in[20]) + l * 128 + (lane & 15) * 8;
                    const float scl = isq ? 0.08838834764831845f * LOG2E : 1.f;
                    float v[8]; unpack8(*(const u32x4*)(rp + lane * 8), v);
                    float ss = 0.f;
#pragma unroll
                    for (int i = 0; i < 8; ++i) ss += v[i] * v[i];
                    ss += __shfl_xor(ss, 1); ss += __shfl_xor(ss, 2); ss += __shfl_xor(ss, 4); ss += __shfl_xor(ss, 8);
                    const float inv = __builtin_amdgcn_rsqf(ss * (1.f / 128.f) + EPS) * scl;
#pragma unroll
                    for (int i = 0; i < 8; ++i) v[i] *= inv * gn[i];
                    *(u32x4*)(rp + lane * 8) = pack8(v);
                }
            }

#endif
            GRID_SYNC();
#if PH & 4
            {
                PHASE_CTX
                LAS char* al = (LAS char*)lds;
                const int lane = opaque(lane_id()), tid = wave * 64 + lane;
#pragma unroll 1
                for (int rep = 0; rep < REP_B; ++rep)
                for (int idx = bid; idx < BC * 8 * 16; idx += G) {
                    const int half = idx / (BC * 64), rem = idx % (BC * 64), bh = rem / 8, s = rem % 8;
                    const int qb = half == 0 ? s : 15 - s, b = bh / 8, hh = bh % 8;
                    const long r0 = (long)b * SEQ;
                    dense_unit<96, 64, true, true>((const bf16_t*)(ws + WS_QB) + (r0 + 256 * qb) * 768 + 96 * hh, 768,
                        (const bf16_t*)(ws + WS_KN) + r0 * 512 + 64 * hh, 512, (const bf16_t*)(ws + WS_KR) + r0 * 32, 32,
                        (const bf16_t*)(ws + WS_VB) + r0 * 512 + 64 * hh, 512, (bf16_t*)(ws + WS_OB) + (r0 + 256 * qb) * 512 + 64 * hh, 512,
                        256 * qb, 4 * (qb + 1), al, sc, tid);
                }
                for (int idx = bid; idx < 3 * BC * 32 * 4; idx += G) {
                    const int g = idx / (BC * 128), rem = idx % (BC * 128), hp = rem & 3, sj = rem >> 2;
                    const int dil = g == 0 ? 1 : g == 1 ? 4 : 16, nb = 32 / dil;
                    const int n = sj / nb, j = sj % nb, b = n / dil, res = n % dil;
                    const long row0 = (long)b * SEQ + res;
                    const bf16_t* Qg = (const bf16_t*)(ws + WS_CB + (size_t)(3 * g) * 16 * MiB); const bf16_t* Kg = (const bf16_t*)(ws + WS_CB + (size_t)(3 * g + 1) * 16 * MiB); const bf16_t* Vg = (const bf16_t*)(ws + WS_CB + (size_t)(3 * g + 2) * 16 * MiB);
#pragma unroll
                    for (int sl = 0; sl < 2; ++sl) {
                        banded_load(al + sl * BSLOT, BKP, Kg + 64 * (2 * hp + sl), 512, row0, dil, 128 * (j - 1), tid);
                        banded_load(al + sl * BSLOT + 256 * BKP, BVP, Vg + 64 * (2 * hp + sl), 512, row0, dil, 128 * (j - 1), tid);
                    }
                    __syncthreads();
                    { const int sl = wave >> 2, wq = wave & 3, hd = 2 * hp + sl, r = lane & 31;
                      const long qtok = row0 + (long)(128 * j + 32 * wq + r) * dil;
                      bf16_t* ob = (bf16_t*)Qg + (row0 + (long)(128 * j + 32 * wq) * dil) * 512 + 64 * hd;
                      banded_task<false, true>(Qg + qtok * 512 + 64 * hd, ob, (long)dil * 512, al + sl * BSLOT, al + sl * BSLOT + 256 * BKP, wq, j, 128, 0.f,
                                               (float*)(ws + WS_LSE) + (qtok * 8 + hd) * 4 + g, sc, lane); }
                    __syncthreads();
                }
                for (int idx = bid; idx < BC * 32 * 2; idx += G) {
                    const int kvh = idx & 1, j = (idx >> 1) & 31, b = idx >> 6;
                    const long row0 = (long)b * SEQ;
                    banded_load(al, BKP, (const bf16_t*)(ws + WS_KA) + 64 * kvh, 128, row0, 1, 128 * (j - 1), tid);
                    banded_load(al + 256 * BKP, BVP, (const bf16_t*)(ws + WS_VA) + 64 * kvh, 128, row0, 1, 128 * (j - 1), tid);
                    __syncthreads();
#pragma unroll 1
                    for (int pass = 0; pass < 2; ++pass) {
                        const int hq = kvh * 4 + (wave >> 2) + 2 * pass, wq = wave & 3, r = lane & 31;
                        const long qtok = row0 + 128 * j + 32 * wq + r;
                        bf16_t* QA = (bf16_t*)(ws + WS_QA);
                        banded_task<true, false>(QA + qtok * 512 + 64 * hq, QA + (row0 + 128 * j + 32 * wq) * 512 + 64 * hq, 512, al, al + 256 * BKP, wq, j, 127,
                                                 (q->in[8] + l * 8)[hq] * LOG2E, nullptr, sc, lane);
                    }
                    __syncthreads();
                }
                for (int idx = bid; idx < BC * 4 * 16; idx += G) {
                    const int qb = idx & 15, hh = (idx >> 4) & 3, b = idx >> 6;
                    const long r0 = (long)b * SEQ + 256 * qb; const long m0 = (long)(ch * BC + b) * NMEM;
                    bf16_t* MQ = (bf16_t*)(ws + WS_MQ);
                    dense_unit<128, 128, false, false>(MQ + r0 * 512 + 128 * hh, 512, (const bf16_t*)(ws + WS_MK) + m0 * 512 + 128 * hh, 512, nullptr, 0,
                        (const bf16_t*)(ws + WS_MV) + m0 * 512 + 128 * hh, 512, MQ + r0 * 512 + 128 * hh, 512, 0, 4, al, sc, tid);
                }
            }

#endif
            GRID_SYNC();
#if PH & 8
            {
                PHASE_CTX
                const float* LSE = (const float*)(ws + WS_LSE); bf16_t* OC = (bf16_t*)(ws + WS_OC);
                const int tid = wave * 64 + opaque(lane_id());
                for (int i = bid * NTHREADS + tid; i < TC * 64; i += G * NTHREADS) {
                    const int tok = i >> 6, c8 = i & 63, hd = c8 >> 3;
                    const f32x4 ls = *(const f32x4*)(LSE + ((size_t)tok * 8 + hd) * 4);
                    const float mx = fmaxf(ls.x, fmaxf(ls.y, ls.z));
                    float w0 = __builtin_amdgcn_exp2f(ls.x - mx), w1 = __builtin_amdgcn_exp2f(ls.y - mx), w2 = __builtin_amdgcn_exp2f(ls.z - mx);
                    const float inv = 1.f / (w0 + w1 + w2); w0 *= inv; w1 *= inv; w2 *= inv;
                    float a[8], b[8], c[8], o[8];
                    unpack8(*(const u32x4*)((const bf16_t*)(ws + WS_CB) + (size_t)tok * 512 + c8 * 8), a);
                    unpack8(*(const u32x4*)((const bf16_t*)(ws + WS_CB + 48 * MiB) + (size_t)tok * 512 + c8 * 8), b);
                    unpack8(*(const u32x4*)((const bf16_t*)(ws + WS_CB + 96 * MiB) + (size_t)tok * 512 + c8 * 8), c);
#pragma unroll
                    for (int k = 0; k < 8; ++k) o[k] = w0 * a[k] + w1 * b[k] + w2 * c[k];
                    *(u32x4*)(OC + (size_t)tok * 512 + c8 * 8) = pack8(o);
                }
            }

#endif
            GRID_SYNC();
#if PH & 16
            {
                PHASE_CTX
                pg8::TileOrder S; S.init(TC, D, G, bid, (const bf16_t*)(ws + WS_QA), (const bf16_t*)(ws + WS_WBR)); S.nseg = 4;
                S.segA = 8 * MiB; S.segB = (size_t)D * 512;
                EpiMerge E{(const bf16_t*)(ws + WS_GATES), (bf16_t*)(ws + WS_GY) + (size_t)tok0 * D};
                pg8::gemm_phase(lds, 512, 512, S, E, wave);
            }

#endif
            GRID_SYNC();
        }
        {
            const int tok0 = 0;
#if PH & 32
            {
                PHASE_CTX
                pg8::TileOrder S; S.init(TT, D, G, bid, (const bf16_t*)(ws + WS_GY), (const bf16_t*)(ws + WS_WOUT));
                EpiRes E{((l == 0) ? q->in[0] : q->out) + (size_t)tok0 * D, q->out + (size_t)tok0 * D, XB + (size_t)tok0 * D, PX + (size_t)tok0 * 16};
                pg8::gemm_phase(lds, D, D, S, E, wave);
            }

#endif
            GRID_SYNC();
#if PH & 64
            {
                PHASE_CTX
                pg8::TileOrder S; S.init(TT, DFF, G, bid, XB + (size_t)tok0 * D, (const bf16_t*)(ws + WS_WUP));
                EpiUp E{(bf16_t*)(ws + WS_U), RowScale{PX, 16, 16, 1.f / D}, tok0};
#pragma unroll 1
                for (int rep = 0; rep < REP_P7; ++rep) pg8::gemm_phase(lds, D, D, S, E, wave);
            }

#endif
            GRID_SYNC();
#if PH & 128
            {
                PHASE_CTX
                pg8::TileOrder S; S.init(TT, D, G, bid, (const bf16_t*)(ws + WS_U), (const bf16_t*)(ws + WS_WDN));
                EpiRes E{q->out + (size_t)tok0 * D, q->out + (size_t)tok0 * D, XB + (size_t)tok0 * D, PX + (size_t)tok0 * 16};
                pg8::gemm_phase(lds, DFF, DFF, S, E, wave);
            }

#endif
            GRID_SYNC();
        }
    }
}

extern "C" void kernel_launch(void* const* d_in, const int* in_sizes, int n_in, void* d_out, int out_size, void* d_ws, size_t ws_size, hipStream_t stream) {
    static int grid = 0;
    if (grid == 0) {
        if (n_in != 26 || out_size != TT * D || ws_size < WS_END) { fprintf(stderr, "kernel_launch: unexpected shapes (n_in %d out %d ws %zu)\n", n_in, out_size, ws_size); grid = -1; return; }
        int dev = 0, cus = 0, per_cu = 0;
        hipGetDevice(&dev); hipDeviceGetAttribute(&cus, hipDeviceAttributeMultiprocessorCount, dev);
        hipFuncSetAttribute((const void*)fwd_megakernel, hipFuncAttributeMaxDynamicSharedMemorySize, LDS_BYTES);
        hipOccupancyMaxActiveBlocksPerMultiprocessor(&per_cu, (const void*)fwd_megakernel, NTHREADS, LDS_BYTES);
        if (per_cu < 1) { fprintf(stderr, "kernel_launch: occupancy query says %d blocks per CU\n", per_cu); per_cu = 1; }
        (void)hipGetLastError();
        grid = cus;
    }
    if (grid < 0) return;
    if (hipMemsetAsync((char*)d_ws + WS_CTL, 0, XCD_BAR_WORDS * 4, stream) != hipSuccess) { fprintf(stderr, "kernel_launch: memset failed\n"); return; }
    Params p{};
    for (int i = 0; i < 26; ++i) p.in[i] = (const float*)d_in[i];
    p.out = (float*)d_out; p.ws = (unsigned char*)d_ws;
    for (int i = 0; i < 32; ++i) p.inv_h[i] = (float)std::pow(10000.0, -(double)(2 * i) / 64.0);
    for (int i = 0; i < 16; ++i) p.inv_r[i] = (float)std::pow(10000.0, -(double)(2 * i) / 32.0);
    void* args[] = {&p};
    hipError_t e = hipLaunchCooperativeKernel((const void*)fwd_megakernel, dim3(grid), dim3(NTHREADS), args, LDS_BYTES, stream);
    if (e != hipSuccess) fprintf(stderr, "cooperative launch failed: %s (grid %d)\n", hipGetErrorString(e), grid);
}
```

```cpp
#include <hip/hip_runtime.h>
#include <hip/hip_cooperative_groups.h>
#include <cstdio>
#include <cstdint>
#include <cmath>
namespace cg = cooperative_groups;

#define LAS __attribute__((address_space(3)))
#define DI __device__ __forceinline__
typedef unsigned short bf16_t;
typedef short bf16x8 __attribute__((ext_vector_type(8)));
typedef short s16x4 __attribute__((ext_vector_type(4)));
typedef float f32x4 __attribute__((ext_vector_type(4)));
typedef float f32x16 __attribute__((ext_vector_type(16)));
typedef unsigned u32x4 __attribute__((ext_vector_type(4)));
typedef unsigned u32x2 __attribute__((ext_vector_type(2)));
typedef float f32x2_t __attribute__((ext_vector_type(2)));
typedef __bf16 bf16x2_t __attribute__((ext_vector_type(2)));

constexpr int D = 1024, BATCH = 8, SEQ = 4096, DEPTH = 4, TT = BATCH * SEQ;
constexpr int NCHUNK = 2, BC = BATCH / NCHUNK, TC = BC * SEQ;
constexpr int N_IN = 10656, NT_IN = 10752;
constexpr int DFF = 4096, NMEM = 256;
constexpr float EPS = 1e-6f;
constexpr float LOG2E = 1.4426950408889634f;
constexpr float NEGBIG = -1e30f;
constexpr int NTHREADS = 512, NWAVES = 8;

constexpr size_t MiB = 1u << 20;
constexpr size_t WS_CTL = 0;
constexpr size_t WS_WIN = 1 * MiB, WS_WUQ = 22 * MiB, WS_WUKV = 23 * MiB, WS_WMKV = 24 * MiB, WS_WBR = 26 * MiB, WS_WOUT = 30 * MiB, WS_WUP = 32 * MiB, WS_WDN = 40 * MiB;
constexpr size_t WS_XB = 48 * MiB, WS_PX = 112 * MiB, WS_COSH = 114 * MiB, WS_SINH = 118 * MiB, WS_COSR = 122 * MiB, WS_SINR = 124 * MiB;
constexpr size_t WS_MEMN = 126 * MiB, WS_MK = 130 * MiB, WS_MV = 132 * MiB;
constexpr size_t WS_QA = 134 * MiB, WS_OB = 150 * MiB, WS_OC = 166 * MiB, WS_MQ = 182 * MiB;
constexpr size_t WS_KA = 198 * MiB, WS_VA = 202 * MiB, WS_CQ = 206 * MiB, WS_CKV = 218 * MiB, WS_KR = 226 * MiB, WS_PCQ = 227 * MiB, WS_PCKV = 227 * MiB + 512 * 1024;
constexpr size_t WS_CB = 228 * MiB;
constexpr size_t WS_GATES = 372 * MiB, WS_U = WS_CB;
constexpr size_t WS_QB = 500 * MiB, WS_KN = 524 * MiB, WS_VB = 540 * MiB, WS_LSE = 556 * MiB, WS_GY = 558 * MiB;
constexpr size_t WS_END = 622 * MiB;

constexpr int LDS_BYTES = 155648;
constexpr int LDS_SCR = 149504;

struct Params {
    const float* in[26];
    float* out;
    unsigned char* ws;
    float inv_h[32];
    float inv_r[16];
    int pad[2];
};

DI unsigned cvtpk(float lo, float hi) { f32x2_t v = {lo, hi}; bf16x2_t b = __builtin_convertvector(v, bf16x2_t); return __builtin_bit_cast(unsigned, b); }
DI float bf_lo(unsigned w) { return __uint_as_float(w << 16); }
DI float bf_hi(unsigned w) { return __uint_as_float(w & 0xffff0000u); }
DI u32x4 pack8(const float* v) { u32x4 w; w.x = cvtpk(v[0], v[1]); w.y = cvtpk(v[2], v[3]); w.z = cvtpk(v[4], v[5]); w.w = cvtpk(v[6], v[7]); return w; }
DI void unpack8(u32x4 w, float* v) { v[0] = bf_lo(w.x); v[1] = bf_hi(w.x); v[2] = bf_lo(w.y); v[3] = bf_hi(w.y); v[4] = bf_lo(w.z); v[5] = bf_hi(w.z); v[6] = bf_lo(w.w); v[7] = bf_hi(w.w); }
DI float wave_sum(float v) {
#pragma unroll
    for (int o = 1; o < 64; o <<= 1) v += __shfl_xor(v, o);
    return v;
}
struct RopeTabs { const float* cosh; const float* sinh; const float* cosr; const float* sinr; };
typedef const struct Params __attribute__((address_space(4))) CParams;
DI CParams* fresh_params() { unsigned long long k = (unsigned long long)__builtin_amdgcn_kernarg_segment_ptr(); asm volatile("" : "+s"(k)); return (CParams*)k; }
#define PHASE_CTX \
    CParams* q = fresh_params(); unsigned char* ws = q->ws; (void)ws; \
    bf16_t* XB = (bf16_t*)(ws + WS_XB); float* PX = (float*)(ws + WS_PX); (void)XB; (void)PX; \
    const RopeTabs rt{(const float*)(ws + WS_COSH), (const float*)(ws + WS_SINH), (const float*)(ws + WS_COSR), (const float*)(ws + WS_SINR)}; (void)rt;
DI int opaque(int v) { asm volatile("" : "+v"(v)); return v; }
DI int lane_id() { int v; asm volatile("v_mbcnt_lo_u32_b32 %0, -1, 0\n\tv_mbcnt_hi_u32_b32 %0, -1, %0" : "=v"(v)); return v; }
#define LDS_WAIT() asm volatile("s_waitcnt lgkmcnt(0)" ::: "memory")

namespace pg8 {
constexpr int BM = 256, BK = 64, HALF = 128, HTB = HALF * BK * 2, STAGE_BYTES = 8 * HTB, NXCD = 8, WGM = 8;
DI int lds_byte(int r, int c) { const int st = (r >> 4) * 2 + (c >> 5), rr = r & 15, cc = c & 31, ob = rr * 64 + cc * 2; return st * 1024 + (ob ^ (((ob >> 9) & 1) << 5)); }
DI void stage_rc(int b, int& R, int& C) { const int st = b / 1024, sb = b % 1024, swz = sb ^ (((sb >> 9) & 1) << 5); R = (st >> 1) * 16 + swz / 64; C = (st & 1) * 32 + (swz % 64) / 2; }
DI int perm32(int rho) { const int n = rho >> 4, i = rho & 15; return 8 * (i >> 2) + 4 * n + (i & 3); }

struct Unit { int pm, pn, seg; const bf16_t* A; const bf16_t* Bt; };

struct TileOrder {
    int nM, nN, nwg, G, c, nseg;
    const bf16_t* A0; const bf16_t* B0; size_t segA, segB;
    DI void init(int M, int N, int G_, int c_, const bf16_t* A, const bf16_t* B) { nM = M / BM; nN = N / BM; nwg = nM * nN; G = G_; c = c_; nseg = 1; A0 = A; B0 = B; segA = 0; segB = 0; }
    DI bool next(int i, Unit& u) const {
        const int seg = i % nseg, ti = i / nseg;
        const long L = (long)ti * G + c; if (L >= nwg) return false;
        int wgid = (int)L; { const int q = nwg / NXCD, r = nwg % NXCD, xcd = wgid % NXCD, off = wgid / NXCD; wgid = (xcd < r ? xcd * (q + 1) : r * (q + 1) + (xcd - r) * q) + off; }
        const int nig = WGM * nN, gid = wgid / nig, fm = gid * WGM, gsz = (nM - fm) < WGM ? (nM - fm) : WGM;
        u.pm = fm + ((wgid % nig) % gsz); u.pn = (wgid % nig) / gsz; u.seg = seg;
        u.A = A0 + (size_t)seg * segA; u.Bt = B0 + (size_t)seg * segB;
        return true;
    }
};

template <class Epi, class Sched>
DI void gemm_phase(LAS unsigned char* lds, const int K, const int lda, const Sched& S, const Epi& E, const int wid) {
    const int lane = opaque(lane_id()), tid = wid * 64 + lane, wr = wid >> 2, wc = wid & 3, fr = lane & 15, fq = lane >> 4;
    const int nt = K / BK;
    unsigned voffA[2], voffB[2];
#pragma unroll
    for (int i = 0; i < 2; ++i) { int R, C; stage_rc(tid * 16 + i * 8192, R, C); const int Rb = (R & ~31) + perm32(R & 31);
        voffA[i] = (unsigned)(R * lda + C) * 2u; voffB[i] = (unsigned)(Rb * K + C) * 2u; }
    const size_t kstep = (size_t)(BK * 2);
    const size_t hstepA = (size_t)HALF * lda * 2, hstepB = (size_t)HALF * K * 2;
    const size_t tstepA = 2 * hstepA, tstepB = 2 * hstepB;
    const unsigned ldsw = (unsigned)wid * 1024u;
    const int aoff = lds_byte(wr * 64 + fr, fq * 8), boff = lds_byte(wc * 32 + fr, fq * 8);
#define PG8_SA(b, h) (((b) * 2 + (h)) * HTB)
#define PG8_SB(b, h) ((4 + (b) * 2 + (h)) * HTB)
#define PG8_STAGE(bufoff, gbase, voff) do { _Pragma("unroll") for (int _i = 0; _i < 2; ++_i) \
        __builtin_amdgcn_global_load_lds((const unsigned*)((const char*)(gbase) + (voff)[_i]), (LAS unsigned*)(lds + (bufoff) + ldsw + _i * 8192), 16, 0, 0); } while (0)
#define PG8_LDA(dst, b, h) do { _Pragma("unroll") for (int m = 0; m < 4; ++m) _Pragma("unroll") for (int k = 0; k < 2; ++k) dst[m][k] = *(const LAS bf16x8*)(lds + PG8_SA(b, h) + aoff + m * 2048 + k * 1024); } while (0)
#define PG8_LDB(dst, b, h) do { _Pragma("unroll") for (int n = 0; n < 2; ++n) _Pragma("unroll") for (int k = 0; k < 2; ++k) dst[n][k] = *(const LAS bf16x8*)(lds + PG8_SB(b, h) + boff + n * 2048 + k * 1024); } while (0)
#define PG8_MMA(ai, bj, At, Bt) do { __builtin_amdgcn_s_setprio(1); _Pragma("unroll") for (int m = 0; m < 4; ++m) _Pragma("unroll") for (int n = 0; n < 2; ++n) _Pragma("unroll") for (int k = 0; k < 2; ++k) \
        acc[ai][bj][m][n] = __builtin_amdgcn_mfma_f32_16x16x32_bf16(Bt[n][k], At[m][k], acc[ai][bj][m][n], 0, 0, 0); __builtin_amdgcn_s_setprio(0); } while (0)
#define PG8_WAIT_V(n) asm volatile("s_waitcnt vmcnt(" #n ")" ::: "memory")
#define PG8_WAIT_L(n) asm volatile("s_waitcnt lgkmcnt(" #n ")" ::: "memory")
#define PG8_BAR __builtin_amdgcn_s_barrier()
#define PG8_SCHED __builtin_amdgcn_sched_barrier(0)
    Unit cur, nxt; int ui = 0;
    if (!S.next(0, cur)) return;
    f32x4 acc[2][2][4][2];
#pragma unroll
    for (int a = 0; a < 2; ++a)
#pragma unroll
        for (int b = 0; b < 2; ++b)
#pragma unroll
            for (int m = 0; m < 4; ++m)
#pragma unroll
                for (int n = 0; n < 2; ++n) acc[a][b][m][n] = (f32x4){0.f, 0.f, 0.f, 0.f};
    bf16x8 At[4][2], B0[2][2], B1[2][2];
    const char* cA = (const char*)cur.A + (size_t)cur.pm * tstepA; const char* cB = (const char*)cur.Bt + (size_t)cur.pn * tstepB;
    PG8_STAGE(PG8_SB(0, 0), cB, voffB); PG8_STAGE(PG8_SB(0, 1), cB + hstepB, voffB); PG8_STAGE(PG8_SA(0, 0), cA, voffA); PG8_STAGE(PG8_SA(0, 1), cA + hstepA, voffA);
    if (wr == 1) PG8_BAR;
    PG8_WAIT_V(2); PG8_BAR;
    PG8_STAGE(PG8_SB(1, 0), cB + kstep, voffB); PG8_STAGE(PG8_SA(1, 0), cA + kstep, voffA); PG8_STAGE(PG8_SB(1, 1), cB + hstepB + kstep, voffB);
    PG8_WAIT_V(6); PG8_BAR;
    for (;;) {
        const bool has_next = S.next(ui + 1, nxt);
        const char* nA = has_next ? (const char*)nxt.A + (size_t)nxt.pm * tstepA : cA; const char* nB = has_next ? (const char*)nxt.Bt + (size_t)nxt.pn * tstepB : cB;
#pragma unroll 1
        for (int t = 0; t < nt; t += 2) {
            const bool last = (t == nt - 2);
            const char* a1 = cA + (size_t)(t + 1) * kstep;
            const char* a2 = last ? nA : cA + (size_t)(t + 2) * kstep; const char* b2 = last ? nB : cB + (size_t)(t + 2) * kstep;
            const char* a3 = a2 + kstep; const char* b3 = b2 + kstep;
            PG8_LDB(B0, 0, 0); PG8_LDB(B1, 0, 1); PG8_SCHED; PG8_LDA(At, 0, 0); PG8_STAGE(PG8_SA(1, 1), a1 + hstepA, voffA);
            PG8_WAIT_V(8); PG8_WAIT_L(0); PG8_BAR; PG8_MMA(0, 0, At, B0); PG8_MMA(0, 1, At, B1); PG8_BAR; PG8_SCHED;
            PG8_LDA(At, 0, 1); PG8_STAGE(PG8_SB(0, 0), b2, voffB); PG8_STAGE(PG8_SB(0, 1), b2 + hstepB, voffB); PG8_STAGE(PG8_SA(0, 0), a2, voffA);
            PG8_WAIT_V(8); PG8_WAIT_L(0); PG8_BAR; PG8_MMA(1, 0, At, B0); PG8_MMA(1, 1, At, B1); PG8_BAR; PG8_SCHED;
            PG8_LDB(B0, 1, 0); PG8_LDB(B1, 1, 1); PG8_SCHED; PG8_LDA(At, 1, 0); PG8_STAGE(PG8_SA(0, 1), a2 + hstepA, voffA);
            PG8_WAIT_V(8); PG8_WAIT_L(0); PG8_BAR; PG8_MMA(0, 0, At, B0); PG8_MMA(0, 1, At, B1); PG8_BAR; PG8_SCHED;
            PG8_LDA(At, 1, 1); PG8_STAGE(PG8_SB(1, 0), b3, voffB); PG8_STAGE(PG8_SB(1, 1), b3 + hstepB, voffB); PG8_STAGE(PG8_SA(1, 0), a3, voffA);
            PG8_WAIT_V(8); PG8_WAIT_L(0); PG8_BAR; PG8_MMA(1, 0, At, B0); PG8_MMA(1, 1, At, B1); PG8_BAR; PG8_SCHED;
        }
        if (wr == 0) PG8_BAR;
        E(acc, cur, wr, wc, fr, fq);
        if (!has_next) break;
#pragma unroll
        for (int a = 0; a < 2; ++a)
#pragma unroll
            for (int b = 0; b < 2; ++b)
#pragma unroll
                for (int m = 0; m < 4; ++m)
#pragma unroll
                    for (int n = 0; n < 2; ++n) acc[a][b][m][n] = (f32x4){0.f, 0.f, 0.f, 0.f};
        cur = nxt; cA = nA; cB = nB; ++ui;
        if (wr == 1) PG8_BAR;
    }
    PG8_WAIT_V(0);
    PG8_BAR;
#undef PG8_SA
#undef PG8_SB
#undef PG8_STAGE
#undef PG8_LDA
#undef PG8_LDB
#undef PG8_MMA
#undef PG8_WAIT_V
#undef PG8_WAIT_L
#undef PG8_BAR
#undef PG8_SCHED
}
}

struct RowScale {
    const float* part; int stride; int cnt; float inv_n;
    DI float get(int row) const {
        if (!part) return 1.f;
        float s = 0.f;
        const float* p = part + (size_t)row * stride;
        for (int i = 0; i < cnt; i += 4) { const f32x4 v = *(const f32x4*)(p + i); s += (v.x + v.y) + (v.z + v.w); }
        return __builtin_amdgcn_rsqf(s * inv_n + EPS);
    }
};

DI void rs_preload(const RowScale& rs, int rowbase, int fq, float (&out)[8]) {
    if (!rs.part) {
#pragma unroll
        for (int i = 0; i < 8; ++i) out[i] = 1.f;
        return;
    }
#pragma unroll
    for (int hb = 0; hb < 2; ++hb) {
        float s[4];
#pragma unroll
        for (int i = 0; i < 4; ++i) { s[i] = 0.f;
            if (4 * fq < rs.cnt) { const f32x4 v = *(const f32x4*)(rs.part + (size_t)(rowbase + hb * 128 + i * 16) * rs.stride + 4 * fq);
                s[i] = v.x + (4 * fq + 1 < rs.cnt ? v.y : 0.f) + (4 * fq + 2 < rs.cnt ? v.z : 0.f) + (4 * fq + 3 < rs.cnt ? v.w : 0.f); } }
#pragma unroll
        for (int i = 0; i < 4; ++i) { float t = s[i]; t += __shfl_xor(t, 16); t += __shfl_xor(t, 32); out[hb * 4 + i] = __builtin_amdgcn_rsqf(t * rs.inv_n + EPS); }
        asm volatile("" ::: "memory");
    }
}
enum { SK_SKIP = 0, SK_RAW = 1, SK_HEAD = 2, SK_ROPE32 = 3, SK_GATE = 4 };
struct SlotDesc { int kind; bf16_t* dst; int ld; int col; const float* gain; float scale; int rope; float* part; int pstride; int pidx; const float* bias; };


template <class Cfg>
struct EpiSlot {
    Cfg cfg; RowScale rs; int rs_off; RopeTabs rt; int tok_off;
    template <int KIND>
    DI void run(const f32x4 (&acc)[2][2][4][2], const pg8::Unit& u, const SlotDesc& d, int wr, int fr, int fq) const {
        const int d0 = 8 * fq;
        float rsv[8]; rs_preload(rs, u.pm * 256 + wr * 64 + fr + rs_off, fq, rsv);
        float g0[8], g1[8];
        if (KIND == 2 || KIND == 5) {
#pragma unroll
            for (int i = 0; i < 8; ++i) { g0[i] = d.gain[d0 + i] * d.scale; g1[i] = d.gain[32 + d0 + i] * d.scale; }
        } else if (KIND == 3) {
#pragma unroll
            for (int i = 0; i < 8; ++i) { g0[i] = fq < 2 ? d.gain[d0 + i] * d.scale : 0.f; g1[i] = fq < 2 ? d.gain[16 + d0 + i] * d.scale : 0.f; }
        } else if (KIND == 4) {
#pragma unroll
            for (int i = 0; i < 8; ++i) { g0[i] = d.bias[d.col + d0 + i]; g1[i] = d.bias[d.col + 32 + d0 + i]; }
        }
#pragma unroll
        for (int ai = 0; ai < 2; ++ai)
#pragma unroll
            for (int m = 0; m < 4; ++m) {
                const int row = u.pm * 256 + ai * 128 + wr * 64 + m * 16 + fr;
                const float r = rsv[ai * 4 + m];
                float v0[8], v1[8];
#pragma unroll
                for (int n = 0; n < 2; ++n)
#pragma unroll
                    for (int j = 0; j < 4; ++j) { v0[4 * n + j] = acc[ai][0][m][n][j] * r; v1[4 * n + j] = acc[ai][1][m][n][j] * r; }
                bf16_t* dp = d.dst + (size_t)row * d.ld + d.col;
                if (KIND == 1) {
                    if (d.part) {
                        float ss = 0.f;
#pragma unroll
                        for (int i = 0; i < 8; ++i) ss += v0[i] * v0[i] + v1[i] * v1[i];
                        ss += __shfl_xor(ss, 16); ss += __shfl_xor(ss, 32);
                        if (fq == 0) d.part[(size_t)row * d.pstride + d.pidx] = ss;
                    }
                    *(u32x4*)(dp + d0) = pack8(v0); *(u32x4*)(dp + 32 + d0) = pack8(v1);
                } else if (KIND == 4) {
#pragma unroll
                    for (int i = 0; i < 8; ++i) { v0[i] = __builtin_amdgcn_rcpf(1.f + __builtin_amdgcn_exp2f(-(v0[i] + g0[i]) * LOG2E)); v1[i] = __builtin_amdgcn_rcpf(1.f + __builtin_amdgcn_exp2f(-(v1[i] + g1[i]) * LOG2E)); }
                    *(u32x4*)(dp + d0) = pack8(v0); *(u32x4*)(dp + 32 + d0) = pack8(v1);
                } else if (KIND == 2 || KIND == 5) {
                    float ss = 0.f;
#pragma unroll
                    for (int i = 0; i < 8; ++i) ss += v0[i] * v0[i] + v1[i] * v1[i];
                    ss += __shfl_xor(ss, 16); ss += __shfl_xor(ss, 32);
                    const float inv = __builtin_amdgcn_rsqf(ss * (1.f / 64.f) + EPS);
#pragma unroll
                    for (int i = 0; i < 8; ++i) { v0[i] *= inv * g0[i]; v1[i] *= inv * g1[i]; }
                    if (KIND == 5) {
                        const float* cp = rt.cosh + (size_t)(row + tok_off) * 32 + d0; const float* sp = rt.sinh + (size_t)(row + tok_off) * 32 + d0;
                        const f32x4 c0 = *(const f32x4*)cp, c1 = *(const f32x4*)(cp + 4), s0 = *(const f32x4*)sp, s1 = *(const f32x4*)(sp + 4);
#pragma unroll
                        for (int i = 0; i < 8; ++i) { const float c = i < 4 ? c0[i & 3] : c1[i & 3], sn = i < 4 ? s0[i & 3] : s1[i & 3];
                            const float a = v0[i], b = v1[i]; v0[i] = a * c - b * sn; v1[i] = b * c + a * sn; }
                    }
                    *(u32x4*)(dp + d0) = pack8(v0); *(u32x4*)(dp + 32 + d0) = pack8(v1);
                } else {
                    float ss = 0.f;
#pragma unroll
                    for (int i = 0; i < 8; ++i) ss += v0[i] * v0[i] + v1[i] * v1[i];
                    ss += __shfl_xor(ss, 16); ss += __shfl_xor(ss, 32);
                    const float inv = __builtin_amdgcn_rsqf(ss * (1.f / 32.f) + EPS);
                    if (fq < 2) {
#pragma unroll
                        for (int i = 0; i < 8; ++i) { v0[i] *= inv * g0[i]; v1[i] *= inv * g1[i]; }
                        const float* cp = rt.cosr + (size_t)(row + tok_off) * 16 + d0; const float* sp = rt.sinr + (size_t)(row + tok_off) * 16 + d0;
                        const f32x4 c0 = *(const f32x4*)cp, c1 = *(const f32x4*)(cp + 4), s0 = *(const f32x4*)sp, s1 = *(const f32x4*)(sp + 4);
#pragma unroll
                        for (int i = 0; i < 8; ++i) { const float c = i < 4 ? c0[i & 3] : c1[i & 3], sn = i < 4 ? s0[i & 3] : s1[i & 3];
                            const float a = v0[i], b = v1[i]; v0[i] = a * c - b * sn; v1[i] = b * c + a * sn; }
                        *(u32x4*)(dp + d0) = pack8(v0); *(u32x4*)(dp + 16 + d0) = pack8(v1);
                    }
                }
            }
    }
    DI void operator()(const f32x4 (&acc)[2][2][4][2], const pg8::Unit& u, int wr, int wc, int fr, int fq) const {
        const SlotDesc d = cfg.get(u.pn * 4 + wc);
        if (d.kind == SK_RAW) run<1>(acc, u, d, wr, fr, fq);
        else if (d.kind == SK_GATE) run<4>(acc, u, d, wr, fr, fq);
        else if (d.kind == SK_HEAD) { if (d.rope) run<5>(acc, u, d, wr, fr, fq); else run<2>(acc, u, d, wr, fr, fq); }
        else if (d.kind == SK_ROPE32) run<3>(acc, u, d, wr, fr, fq);
    }
};

struct CfgIn {
    unsigned char* ws; const float* a_qn; const float* a_kn; const float* b_kn; const float* c_qn; const float* c_kn; const float* b_gate;
    DI SlotDesc get(int s) const {
        SlotDesc d; d.kind = SK_SKIP; d.dst = nullptr; d.ld = 0; d.col = 0; d.gain = nullptr; d.scale = 1.f; d.rope = 0; d.part = nullptr; d.pstride = 0; d.pidx = 0; d.bias = nullptr;
        if (s < 8) { d.kind = SK_HEAD; d.dst = (bf16_t*)(ws + WS_QA); d.ld = 512; d.col = 64 * s; d.gain = a_qn; d.scale = 0.125f * LOG2E; d.rope = 1; }
        else if (s < 10) { d.kind = SK_HEAD; d.dst = (bf16_t*)(ws + WS_KA); d.ld = 128; d.col = 64 * (s - 8); d.gain = a_kn; d.rope = 1; }
        else if (s < 12) { d.kind = SK_RAW; d.dst = (bf16_t*)(ws + WS_VA); d.ld = 128; d.col = 64 * (s - 10); }
        else if (s < 18) { d.kind = SK_RAW; d.dst = (bf16_t*)(ws + WS_CQ); d.ld = 384; d.col = 64 * (s - 12); d.part = (float*)(ws + WS_PCQ); d.pstride = 8; d.pidx = s - 12; }
        else if (s < 22) { d.kind = SK_RAW; d.dst = (bf16_t*)(ws + WS_CKV); d.ld = 256; d.col = 64 * (s - 18); d.part = (float*)(ws + WS_PCKV); d.pstride = 4; d.pidx = s - 18; }
        else if (s == 22) { d.kind = SK_ROPE32; d.dst = (bf16_t*)(ws + WS_KR); d.ld = 32; d.col = 0; d.gain = b_kn + 64; }
        else if (s < 95) { const int p = (s - 23) >> 3, h = (s - 23) & 7, g = p / 3, t = p % 3;
            d.dst = (bf16_t*)(ws + WS_CB + (size_t)p * 16 * MiB); d.ld = 512; d.col = 64 * h;
            if (t == 0) { d.kind = SK_HEAD; d.gain = c_qn + 64 * g; d.scale = 0.125f * LOG2E; d.rope = 1; }
            else if (t == 1) { d.kind = SK_HEAD; d.gain = c_kn + 64 * g; d.rope = 1; }
            else d.kind = SK_RAW; }
        else if (s < 103) { d.kind = SK_RAW; d.dst = (bf16_t*)(ws + WS_MQ); d.ld = 512; d.col = 64 * (s - 95); }
        else if (s < 167) { d.kind = SK_GATE; d.dst = (bf16_t*)(ws + WS_GATES); d.ld = 4096; d.col = 64 * (s - 103); d.bias = b_gate; }
        return d;
    }
};
DI void in_slot_src(int s, int& src, int& kind) {
    kind = 0;
    if (s < 22) src = 64 * s;
    else if (s == 22) { src = 1408; kind = 1; }
    else if (s < 167) src = 1440 + 64 * (s - 23);
    else { src = 0; kind = 2; }
}
struct CfgUq {
    unsigned char* ws; const float* b_qn;
    DI SlotDesc get(int s) const {
        SlotDesc d; d.dst = (bf16_t*)(ws + WS_QB); d.ld = 768; d.scale = 0.10206207261596575f * LOG2E; d.rope = 0; d.part = nullptr; d.pstride = 0; d.pidx = 0; d.bias = nullptr;
        if (s < 8) { d.kind = SK_HEAD; d.col = 96 * s; d.gain = b_qn; }
        else { d.kind = SK_ROPE32; d.col = 96 * (s - 8) + 64; d.gain = b_qn + 64; }
        return d;
    }
};
struct CfgUkv {
    unsigned char* ws; const float* b_kn;
    DI SlotDesc get(int s) const {
        SlotDesc d; d.ld = 512; d.scale = 1.f; d.rope = 0; d.part = nullptr; d.pstride = 0; d.pidx = 0; d.bias = nullptr; d.gain = b_kn;
        if (s < 8) { d.kind = SK_HEAD; d.dst = (bf16_t*)(ws + WS_KN); d.col = 64 * s; }
        else { d.kind = SK_RAW; d.dst = (bf16_t*)(ws + WS_VB); d.col = 64 * (s - 8); }
        return d;
    }
};
struct CfgMkv {
    unsigned char* ws;
    DI SlotDesc get(int s) const {
        SlotDesc d; d.kind = SK_RAW; d.ld = 512; d.scale = 1.f; d.rope = 0; d.part = nullptr; d.pstride = 0; d.pidx = 0; d.bias = nullptr; d.gain = nullptr;
        if (s < 8) { d.dst = (bf16_t*)(ws + WS_MK); d.col = 64 * s; } else { d.dst = (bf16_t*)(ws + WS_MV); d.col = 64 * (s - 8); }
        return d;
    }
};

struct EpiMerge {
    const bf16_t* gates; bf16_t* gy;
    DI void operator()(const f32x4 (&acc)[2][2][4][2], const pg8::Unit& u, int wr, int wc, int fr, int fq) const {
#pragma unroll
        for (int ai = 0; ai < 2; ++ai)
#pragma unroll
            for (int m = 0; m < 4; ++m) {
                const int row = u.pm * 256 + ai * 128 + wr * 64 + m * 16 + fr;
#pragma unroll
                for (int bj = 0; bj < 2; ++bj) {
                    const int col = u.pn * 256 + bj * 128 + wc * 32 + 8 * fq;
                    float g[8], o[8];
                    unpack8(*(const u32x4*)(gates + (size_t)row * 4096 + u.seg * 1024 + col), g);
                    bf16_t* gp = gy + (size_t)row * 1024 + col;
                    if (u.seg == 0) {
#pragma unroll
                        for (int i = 0; i < 8; ++i) o[i] = 0.f;
                    } else unpack8(*(const u32x4*)gp, o);
#pragma unroll
                    for (int n = 0; n < 2; ++n)
#pragma unroll
                        for (int j = 0; j < 4; ++j) o[4 * n + j] += g[4 * n + j] * acc[ai][bj][m][n][j];
                    *(u32x4*)gp = pack8(o);
                }
            }
    }
};
struct EpiRes {
    const float* xsrc; float* xdst; bf16_t* xb; float* px;
    DI void operator()(const f32x4 (&acc)[2][2][4][2], const pg8::Unit& u, int wr, int wc, int fr, int fq) const {
#pragma unroll
        for (int ai = 0; ai < 2; ++ai)
#pragma unroll
            for (int m = 0; m < 4; ++m) {
                const int row = u.pm * 256 + ai * 128 + wr * 64 + m * 16 + fr;
                float ss = 0.f;
#pragma unroll
                for (int bj = 0; bj < 2; ++bj) {
                    const size_t off = (size_t)row * 1024 + u.pn * 256 + bj * 128 + wc * 32 + 8 * fq;
                    float o[8];
#pragma unroll
                    for (int n = 0; n < 2; ++n) { const f32x4 xs = *(const f32x4*)(xsrc + off + 4 * n); const f32x4 xn = xs + acc[ai][bj][m][n]; *(f32x4*)(xdst + off + 4 * n) = xn;
#pragma unroll
                        for (int j = 0; j < 4; ++j) { o[4 * n + j] = xn[j]; ss += xn[j] * xn[j]; } }
                    *(u32x4*)(xb + off) = pack8(o);
                }
                ss += __shfl_xor(ss, 16); ss += __shfl_xor(ss, 32);
                if (fq == 0) px[(size_t)row * 16 + u.pn * 4 + wc] = ss;
            }
    }
};
struct EpiUp {
    bf16_t* U; RowScale rs; int rs_off;
    DI void operator()(const f32x4 (&acc)[2][2][4][2], const pg8::Unit& u, int wr, int wc, int fr, int fq) const {
        float rsv[8]; rs_preload(rs, u.pm * 256 + wr * 64 + fr + rs_off, fq, rsv);
#pragma unroll
        for (int ai = 0; ai < 2; ++ai)
#pragma unroll
            for (int m = 0; m < 4; ++m) {
                const int row = u.pm * 256 + ai * 128 + wr * 64 + m * 16 + fr;
                const float r = rsv[ai * 4 + m];
#pragma unroll
                for (int bj = 0; bj < 2; ++bj) {
                    float o[8];
#pragma unroll
                    for (int n = 0; n < 2; ++n)
#pragma unroll
                        for (int j = 0; j < 4; ++j) { const float v = fmaxf(acc[ai][bj][m][n][j] * r, 0.f); o[4 * n + j] = v * v; }
                    *(u32x4*)(U + (size_t)row * DFF + u.pn * 256 + bj * 128 + wc * 32 + 8 * fq) = pack8(o);
                }
            }
    }
};

DI void transpose_item(const float* W, int K, int N, const float* gk, bf16_t* WT, int rho0, int k0, int src0, int nvalid, LAS float* scr, int lane) {
    { const int c4 = (lane & 7) * 4;
#pragma unroll
      for (int i = 0; i < 8; ++i) { const int kk = 8 * i + (lane >> 3);
        f32x4 v = (f32x4){0.f, 0.f, 0.f, 0.f};
        if (c4 < nvalid) v = *(const f32x4*)(W + (size_t)(k0 + kk) * N + src0 + c4);
        if (gk) v = v * gk[k0 + kk];
        scr[kk * 33 + c4] = v.x; scr[kk * 33 + c4 + 1] = v.y; scr[kk * 33 + c4 + 2] = v.z; scr[kk * 33 + c4 + 3] = v.w; } }
    LDS_WAIT();
    const int c8 = lane & 7;
#pragma unroll
    for (int j = 0; j < 4; ++j) { const int n = (lane >> 3) + 8 * j; const LAS float* s = scr + (8 * c8) * 33 + n;
        u32x4 o; o.x = cvtpk(s[0 * 33], s[1 * 33]); o.y = cvtpk(s[2 * 33], s[3 * 33]); o.z = cvtpk(s[4 * 33], s[5 * 33]); o.w = cvtpk(s[6 * 33], s[7 * 33]);
        *(u32x4*)(WT + (size_t)(rho0 + n) * K + k0 + 8 * c8) = o; }
    LDS_WAIT();
}
DI void block_src(int mapk, int q  , int& src0, int& nvalid) {
    if (mapk == 0) { src0 = 32 * q; nvalid = 32; return; }
    const int pn = q >> 3, bj = (q >> 2) & 1, wc = q & 3, s = 4 * pn + wc;
    if (mapk == 1) { int src, kind; in_slot_src(s, src, kind);
        if (kind == 0) { src0 = src + 32 * bj; nvalid = 32; } else if (kind == 1) { src0 = src + 16 * bj; nvalid = 16; } else { src0 = 0; nvalid = 0; } }
    else if (mapk == 2) { if (s < 8) { src0 = 96 * s + 32 * bj; nvalid = 32; } else { src0 = 96 * (s - 8) + 64 + 16 * bj; nvalid = 16; } }
    else if (mapk == 3) { if (s < 8) { src0 = 128 * s + 32 * bj; nvalid = 32; } else { src0 = 128 * (s - 8) + 64 + 32 * bj; nvalid = 32; } }
    else { src0 = 64 * s + 32 * bj; nvalid = 32; }
}
DI void convert_matrix(const float* W, int K, int N, int Nt, const float* gk, bf16_t* WT, int mapk, LAS float* scr, int gw, int NGW, int lane) {
    const int nblk = Nt / 32, items = (K / 64) * nblk;
    for (int it = gw; it < items; it += NGW) {
        const int kb = it / nblk, q = it % nblk; int src0, nvalid; block_src(mapk, q, src0, nvalid);
        transpose_item(W, K, N, gk, WT, 32 * q, 64 * kb, src0, nvalid, scr, lane);
    }
}
DI void convert_layer(int l, LAS unsigned char* lds, int gw, int NGW, int wave) {
    const int lane = lane_id();
    CParams* q = fresh_params();
    LAS float* scr = (LAS float*)(lds + wave * 16384);
    unsigned char* ws = q->ws;
    convert_matrix(q->in[4] + (size_t)l * D * N_IN, D, N_IN, NT_IN, q->in[3] + l * D, (bf16_t*)(ws + WS_WIN), 1, scr, gw, NGW, lane);
    convert_matrix(q->in[11] + (size_t)l * 384 * 768, 384, 768, 1024, q->in[9] + l * 384, (bf16_t*)(ws + WS_WUQ), 2, scr, gw, NGW, lane);
    convert_matrix(q->in[12] + (size_t)l * 256 * 1024, 256, 1024, 1024, q->in[10] + l * 256, (bf16_t*)(ws + WS_WUKV), 3, scr, gw, NGW, lane);
    convert_matrix(q->in[18] + (size_t)l * D * 1024, D, 1024, 1024, q->in[17] + l * D, (bf16_t*)(ws + WS_WMKV), 4, scr, gw, NGW, lane);
    for (int n = 0; n < 4; ++n)
        convert_matrix(q->in[21] + ((size_t)l * 4 + n) * 512 * D, 512, D, D, nullptr, (bf16_t*)(ws + WS_WBR) + (size_t)n * D * 512, 0, scr, gw, NGW, lane);
    convert_matrix(q->in[22] + (size_t)l * D * D, D, D, D, nullptr, (bf16_t*)(ws + WS_WOUT), 0, scr, gw, NGW, lane);
    convert_matrix(q->in[24] + (size_t)l * D * DFF, D, DFF, DFF, q->in[23] + l * D, (bf16_t*)(ws + WS_WUP), 0, scr, gw, NGW, lane);
    convert_matrix(q->in[25] + (size_t)l * DFF * D, DFF, D, D, nullptr, (bf16_t*)(ws + WS_WDN), 0, scr, gw, NGW, lane);
}

DI int crow(int i, int h) { return (i & 3) + 8 * (i >> 2) + 4 * h; }
DI f32x16 mfma32(bf16x8 a, bf16x8 b, f32x16 c) { return __builtin_amdgcn_mfma_f32_32x32x16_bf16(a, b, c, 0, 0, 0); }
DI bf16x8 packp(const f32x16& x, int s) { u32x4 w; w.x = cvtpk(x[8 * s], x[8 * s + 1]); w.y = cvtpk(x[8 * s + 2], x[8 * s + 3]); w.z = cvtpk(x[8 * s + 4], x[8 * s + 5]); w.w = cvtpk(x[8 * s + 6], x[8 * s + 7]); return __builtin_bit_cast(bf16x8, w); }
DI s16x4 vtr(const LAS char* p) { return __builtin_bit_cast(s16x4, __builtin_amdgcn_ds_read_tr16_b64_v4i16((LAS s16x4*)p)); }

DI float max3f(float a, float b, float c) { float r; asm("v_max3_f32 %0, %1, %2, %3" : "=v"(r) : "v"(a), "v"(b), "v"(c)); return r; }
DI float xhalf_max(float v) { auto rr = __builtin_amdgcn_permlane32_swap(__float_as_uint(v), __float_as_uint(v), false, false); return fmaxf(__uint_as_float(rr[0]), __uint_as_float(rr[1])); }
DI float xhalf_sum(float v) { auto rr = __builtin_amdgcn_permlane32_swap(__float_as_uint(v), __float_as_uint(v), false, false); return __uint_as_float(rr[0]) + __uint_as_float(rr[1]); }
DI f32x16 splat16(float v) { f32x16 p;
#pragma unroll
    for (int i = 0; i < 16; ++i) p[i] = v;
    return p; }
template <int DQK, int NT, int TSTRIDE> DI void st_tiles(unsigned kaddr, const bf16x8* qf, const f32x16& init, f32x16* p) {
    bf16x8 a[NT][DQK / 16];
#pragma unroll
    for (int j = 0; j < NT; ++j)
#pragma unroll
        for (int ks = 0; ks < DQK / 16; ++ks) asm volatile("ds_read_b128 %0, %1 offset:%2" : "=v"(a[j][ks]) : "v"(kaddr), "i"(j * TSTRIDE + ks * 32));
    asm volatile("s_waitcnt lgkmcnt(0)" ::: "memory");
#pragma unroll
    for (int j = 0; j < NT; ++j)
#pragma unroll
        for (int ks = 0; ks < DQK / 16; ++ks) asm volatile("" : "+v"(a[j][ks]));
#pragma unroll
    for (int j = 0; j < NT; ++j) p[j] = init;
#pragma unroll
    for (int ks = 0; ks < DQK / 16; ++ks)
#pragma unroll
        for (int j = 0; j < NT; ++j) p[j] = mfma32(a[j][ks], qf[ks], p[j]);
}
template <int DV, int VP> DI void pv_tile(f32x16* o, const LAS char* vp, const f32x16& p, int h) {
#pragma unroll
    for (int s = 0; s < 2; ++s) {
        const bf16x8 pa = packp(p, s);
#pragma unroll
        for (int db = 0; db < DV / 32; ++db) {
            const s16x4 lo = vtr(vp + (16 * s + 4 * h) * VP + db * 64);
            const s16x4 hi = vtr(vp + (16 * s + 8 + 4 * h) * VP + db * 64);
            const bf16x8 vb = __builtin_shufflevector(lo, hi, 0, 1, 2, 3, 4, 5, 6, 7);
            o[db] = mfma32(pa, vb, o[db]);
        }
    }
}
template <int NDB> DI void scale_o(f32x16* o, float f, LAS float* sc, int r, int h) {
    if (h == 0) sc[r] = f;
    LDS_WAIT();
#pragma unroll
    for (int g = 0; g < 4; ++g) { const f32x4 f4 = *(const LAS f32x4*)(sc + 8 * g + 4 * h);
#pragma unroll
        for (int db = 0; db < NDB; ++db)
#pragma unroll
            for (int j = 0; j < 4; ++j) o[db][4 * g + j] *= f4[j]; }
    LDS_WAIT();
}
template <int NDB> DI void store_o(const f32x16* o, bf16_t* obase  , long rstride, int r, int h) {
#pragma unroll
    for (int i = 0; i < 16; ++i) { bf16_t* rp = obase + (long)crow(i, h) * rstride + r;
#pragma unroll
        for (int db = 0; db < NDB; ++db) rp[32 * db] = (bf16_t)(cvtpk(o[db][i], 0.f) & 0xffffu); }
}

constexpr int BKP = 144, BVP = 144;
constexpr int BSLOT = 256 * BKP + 256 * BVP;

DI void banded_load(LAS char* dst, int pitch, const bf16_t* src  , int ld, long row0  , int dil, int gi0, int tid) {
#pragma unroll
    for (int it = 0; it < 4; ++it) {
        const int c = tid + it * NTHREADS, key = c >> 3, cc = c & 7, gi = gi0 + key;
        u32x4 v = (u32x4){0u, 0u, 0u, 0u};
        if (gi >= 0) v = *(const u32x4*)(src + (row0 + (long)gi * dil) * ld + cc * 8);
        *(LAS u32x4*)(dst + key * pitch + cc * 16) = v;
    }
}
template <bool SINK, bool WANT_LSE>
DI void banded_task(const bf16_t* qrow  , bf16_t* obase, long rstride, const LAS char* Ks, const LAS char* Vs,
                    int wq, int jblk, int maxd, float sink2, float* lsep, LAS float* sc, int lane) {
    const int r = lane & 31, h = lane >> 5;
    bf16x8 qf[4];
#pragma unroll
    for (int ks = 0; ks < 4; ++ks) qf[ks] = *(const bf16x8*)(qrow + 16 * ks + 8 * h);
    f32x16 p[5];
    const f32x16 zero16 = splat16(0.f);
    { const unsigned ka = (unsigned)(uintptr_t)(Ks + (32 * wq + r) * BKP + 16 * h);
      st_tiles<64, 3, 32 * BKP>(ka, qf, zero16, p); st_tiles<64, 2, 32 * BKP>(ka + 96 * BKP, qf, zero16, p + 3); }
    const int tmin = (jblk == 0) ? 4 - wq : 0, lo = r + 128 - maxd;
#pragma unroll
    for (int t = 0; t < 5; ++t) {
        if (t < tmin) { p[t] = splat16(NEGBIG); }
        else if (t == 0) {
#pragma unroll
            for (int i = 0; i < 16; ++i) p[t][i] = (crow(i, h) >= lo) ? p[t][i] : NEGBIG;
        } else if (t == 4) {
#pragma unroll
            for (int i = 0; i < 16; ++i) p[t][i] = (crow(i, h) <= r) ? p[t][i] : NEGBIG;
        }
    }
    asm volatile("s_nop 15\n\ts_nop 7" : "+v"(p[0]), "+v"(p[1]), "+v"(p[2]), "+v"(p[3]), "+v"(p[4]));
    float mx = NEGBIG;
#pragma unroll
    for (int t = 0; t < 5; ++t)
#pragma unroll
        for (int i = 0; i < 16; i += 2) mx = max3f(mx, p[t][i], p[t][i + 1]);
    mx = xhalf_max(mx);
    if (SINK) mx = fmaxf(mx, sink2);
    float l;
    { const f32x16 mx16 = splat16(mx); f32x16 acc = splat16(0.f);
#pragma unroll
      for (int t = 0; t < 5; ++t) { p[t] = p[t] - mx16;
#pragma unroll
          for (int i = 0; i < 16; ++i) p[t][i] = __builtin_amdgcn_exp2f(p[t][i]);
          acc = acc + p[t]; }
      float a8[8];
#pragma unroll
      for (int i = 0; i < 8; ++i) a8[i] = acc[i] + acc[i + 8];
      l = ((a8[0] + a8[1]) + (a8[2] + a8[3])) + ((a8[4] + a8[5]) + (a8[6] + a8[7])); }
    l = xhalf_sum(l);
    if (SINK) l += __builtin_amdgcn_exp2f(sink2 - mx);
    f32x16 o[2];
#pragma unroll
    for (int i = 0; i < 16; ++i) { o[0][i] = 0.f; o[1][i] = 0.f; }
    const LAS char* vl = Vs + ((lane & 15) >> 2) * BVP + ((lane >> 4) & 1) * 32 + (lane & 3) * 8;
#pragma unroll
    for (int t = 0; t < 5; ++t) pv_tile<64, BVP>(o, vl + 32 * (wq + t) * BVP, p[t], h);
    scale_o<2>(o, 1.f / l, sc, r, h);
    store_o<2>(o, obase, rstride, r, h);
    if (WANT_LSE) { if (h == 0) *lsep = mx + __builtin_amdgcn_logf(l); }
}

template <int DQK, int DV, bool CAUSAL, bool SPLITK>
DI void dense_unit(const bf16_t* Q, int ldq, const bf16_t* K1, int ldk1, const bf16_t* K2, int ldk2, const bf16_t* V, int ldv, bf16_t* O, int ldo,
                   int q0  , int ntiles, LAS char* lds, LAS float* sc, int tid) {
    constexpr int KP = DQK * 2 + 16, VP = DV * 2 + 16, KCH = DQK / 8, VCH = DV / 8, NK = 64 * KCH, NCH = NK + 64 * VCH, NIT = (NCH + NTHREADS - 1) / NTHREADS;
    constexpr int KBUF = 64 * KP, VBUF = 64 * VP, TB = KBUF + VBUF;
    const int lane = tid & 63, w = __builtin_amdgcn_readfirstlane(tid >> 6), r = lane & 31, h = lane >> 5;
    LAS char* kb0 = lds; LAS char* vb0 = lds + KBUF;
    bf16x8 qf[DQK / 16];
    { const bf16_t* qr = Q + (long)(32 * w + r) * ldq;
#pragma unroll
      for (int ks = 0; ks < DQK / 16; ++ks) { qf[ks] = *(const bf16x8*)(qr + 16 * ks + 8 * h); asm volatile("" : "+v"(qf[ks])); } }
    int gb[NIT], gs[NIT], lo[NIT];
    if (SPLITK)
#pragma unroll
    for (int it = 0; it < NIT; ++it) { const int c = tid + it * NTHREADS;
        if (c < NK) { const int key = c / KCH, cc = c % KCH;
            if (SPLITK && cc >= 8) { gb[it] = (int)((const char*)K2 - (const char*)K1) + (key * ldk2 + (cc - 8) * 8) * 2; gs[it] = 64 * ldk2 * 2; }
            else { gb[it] = (key * ldk1 + cc * 8) * 2; gs[it] = 64 * ldk1 * 2; }
            lo[it] = key * KP + cc * 16; }
        else { const int c2 = (c < NCH ? c : NK) - NK, key = c2 / VCH, cc = c2 % VCH;
            gb[it] = (int)((const char*)V - (const char*)K1) + (key * ldv + cc * 8) * 2; gs[it] = 64 * ldv * 2; lo[it] = KBUF + key * VP + cc * 16; }
        asm volatile("" : "+v"(gb[it]), "+v"(gs[it]), "+v"(lo[it])); }
    u32x4 pre[NIT];
    auto gload = [&](int t) {
        if (SPLITK) {
#pragma unroll
            for (int it = 0; it < NIT; ++it) if ((it + 1) * NTHREADS <= NCH || tid + it * NTHREADS < NCH) pre[it] = *(const u32x4*)((const char*)K1 + (long)(gb[it] + t * gs[it]));
        } else {
            const int tid2 = opaque(tid);
#pragma unroll
            for (int it = 0; it < NIT; ++it) { const int c = tid2 + it * NTHREADS;
                if (c < NK) { const int key = c / KCH, cc = c % KCH; pre[it] = *(const u32x4*)(K1 + (long)(64 * t + key) * ldk1 + cc * 8); }
                else if (c < NCH) { const int c2 = c - NK, key = c2 / VCH, cc = c2 % VCH; pre[it] = *(const u32x4*)(V + (long)(64 * t + key) * ldv + cc * 8); } }
        }
    };
    auto lstore = [&](int b) {
        if (SPLITK) {
#pragma unroll
            for (int it = 0; it < NIT; ++it) if ((it + 1) * NTHREADS <= NCH || tid + it * NTHREADS < NCH) *(LAS u32x4*)(lds + b * TB + lo[it]) = pre[it];
        } else {
            const int tid2 = opaque(tid);
#pragma unroll
            for (int it = 0; it < NIT; ++it) { const int c = tid2 + it * NTHREADS;
                if (c < NK) { const int key = c / KCH, cc = c % KCH; *(LAS u32x4*)(kb0 + b * TB + key * KP + cc * 16) = pre[it]; }
                else if (c < NCH) { const int c2 = c - NK, key = c2 / VCH, cc = c2 % VCH; *(LAS u32x4*)(vb0 + b * TB + key * VP + cc * 16) = pre[it]; } }
        }
    };
    gload(0); lstore(0);
    __syncthreads();
    float m = 0.f, l = 0.f; bool first = true;
    f32x16 negm = splat16(0.f);
    f32x16 o[DV / 32];
#pragma unroll
    for (int db = 0; db < DV / 32; ++db)
#pragma unroll
        for (int i = 0; i < 16; ++i) o[db][i] = 0.f;
    const int qpos = q0 + 32 * w + r;
    for (int t = 0; t < ntiles; ++t) {
        const int b = t & 1;
        if (t + 1 < ntiles) gload(t + 1);
        if (!CAUSAL || 64 * t <= q0 + 32 * w) {
            const LAS char* kp = kb0 + b * TB + r * KP + 16 * h;
            f32x16 pp[2]; st_tiles<DQK, 2, 32 * KP>((unsigned)(uintptr_t)kp, qf, negm, pp);
            f32x16& p0 = pp[0]; f32x16& p1 = pp[1];
            if (CAUSAL && 64 * t + 63 > q0 + 32 * w) {
#pragma unroll
                for (int i = 0; i < 16; ++i) { const int key = 64 * t + crow(i, h); if (key > qpos) p0[i] = NEGBIG; if (key + 32 > qpos) p1[i] = NEGBIG; }
            }
            asm volatile("s_nop 15\n\ts_nop 7" : "+v"(p0), "+v"(p1));
            float mx = NEGBIG;
#pragma unroll
            for (int i = 0; i < 16; ++i) mx = max3f(mx, p0[i], p1[i]);
            mx = xhalf_max(mx);
            if (first || __any(mx > 8.f)) {
                const float dl = first ? mx : (mx > 8.f ? mx : 0.f);
                m += dl;
                const float f = __builtin_amdgcn_exp2f(-dl);
                l *= f;
#pragma unroll
                for (int i = 0; i < 16; ++i) { p0[i] -= dl; p1[i] -= dl; }
                if (!first) scale_o<DV / 32>(o, f, sc, r, h);
                negm = splat16(-m);
                first = false;
            }
#pragma unroll
            for (int i = 0; i < 16; ++i) { p0[i] = __builtin_amdgcn_exp2f(p0[i]); p1[i] = __builtin_amdgcn_exp2f(p1[i]); l += p0[i] + p1[i]; }
            const LAS char* vl = vb0 + b * TB + ((lane & 15) >> 2) * VP + ((lane >> 4) & 1) * 32 + (lane & 3) * 8;
            pv_tile<DV, VP>(o, vl, p0, h);
            pv_tile<DV, VP>(o, vl + 32 * VP, p1, h);
        }
        if (t + 1 < ntiles) lstore(b ^ 1);
        __syncthreads();
    }
    l = xhalf_sum(l);
    scale_o<DV / 32>(o, 1.f / l, sc, r, h);
    store_o<DV / 32>(o, O + (long)(32 * w) * ldo, ldo, r, h);
}


#define XB_TMO      128
#define XB_XCNT(j)  (256  + 64 * (j))
#define XB_XSUB(j)  (1280 + 64 * (j))
#define XB_XGEN(j)  (2304 + 64 * (j))
#define XB_TOP      3328
#define XB_TOPGEN   3392
#define XCD_BAR_WORDS 3456
#define XB_SPIN_CAP (1u << 22)
DI unsigned xb_ld(unsigned* p)              { return __hip_atomic_load(p, __ATOMIC_RELAXED, __HIP_MEMORY_SCOPE_AGENT); }
DI unsigned xb_add(unsigned* p, unsigned v) { return __hip_atomic_fetch_add(p, v, __ATOMIC_RELAXED, __HIP_MEMORY_SCOPE_AGENT); }
DI unsigned xb_xcc_id() { return (unsigned)__builtin_amdgcn_s_getreg((3 << 11) | 20) & 0xFu; }
#define XB_SPIN(cond, bar) do { unsigned _sp = 0; while (cond) { __builtin_amdgcn_s_sleep(1); \
    if ((++_sp & 255u) == 0u) { if (xb_ld(&(bar)[XB_TMO])) break; if (_sp > XB_SPIN_CAP) { atomicAdd(&(bar)[XB_TMO], 1u); break; } } } } while (0)
struct XcdBarrier { unsigned* bar; unsigned x; volatile LAS unsigned* st; };
DI XcdBarrier xcd_barrier_post(unsigned* bar, volatile LAS unsigned* st) {
    XcdBarrier b; b.bar = bar; b.x = xb_xcc_id(); b.st = st;
    if (threadIdx.x == 0) (void)xb_add(&bar[XB_XCNT(b.x)], 1u);
    return b;
}
DI void xcd_barrier_complete(unsigned* bar, unsigned x, unsigned& nloc, unsigned& nx) {
    const unsigned G = gridDim.x * gridDim.y * gridDim.z;
    unsigned sum, cnt, mine, sp = 0u;
    for (;;) {
        sum = 0u; cnt = 0u; mine = 0u;
#pragma unroll
        for (unsigned j = 0; j < 16; ++j) { const unsigned c = xb_ld(&bar[XB_XCNT(j)]); sum += c; cnt += (c > 0u) ? 1u : 0u; mine = (j == x) ? c : mine; }
        if (sum == G) break;
        __builtin_amdgcn_s_sleep(1);
        if ((++sp & 255u) == 0u) { if (xb_ld(&bar[XB_TMO])) break; if (sp > XB_SPIN_CAP) { atomicAdd(&bar[XB_TMO], 1u); break; } }
    }
    nloc = mine > 0u ? mine : 1u; nx = cnt > 0u ? cnt : 1u;
}
DI void xcd_barrier(unsigned* bar, unsigned x, volatile LAS unsigned* st) {
    asm volatile("s_waitcnt vmcnt(0)" ::: "memory");
    __syncthreads();
    if (threadIdx.x == 0) {
        __builtin_amdgcn_s_waitcnt(0);
        unsigned nloc = st[0], nx = st[1];
        if (nloc == 0u) { xcd_barrier_complete(bar, x, nloc, nx); st[0] = nloc; st[1] = nx; }
        const unsigned old = xb_add(&bar[XB_XSUB(x)], 1u);
        const unsigned gen = old / nloc;
        if (old + 1u == (gen + 1u) * nloc) {
            __builtin_amdgcn_fence(__ATOMIC_RELEASE, "agent");
            asm volatile("s_waitcnt vmcnt(0)" ::: "memory");
            const unsigned og = xb_add(&bar[XB_TOP], 1u);
            const unsigned tg = og / nx;
            if (og + 1u == (tg + 1u) * nx) xb_add(&bar[XB_TOPGEN], 1u);
            else XB_SPIN(xb_ld(&bar[XB_TOPGEN]) == tg, bar);
            __builtin_amdgcn_fence(__ATOMIC_ACQUIRE, "agent");
            xb_add(&bar[XB_XGEN(x)], 1u);
            asm volatile("s_waitcnt vmcnt(0)" ::: "memory");
        } else {
            XB_SPIN(xb_ld(&bar[XB_XGEN(x)]) == gen, bar);
            __builtin_amdgcn_fence(__ATOMIC_ACQUIRE, "agent");
            asm volatile("s_waitcnt vmcnt(0)" ::: "memory");
        }
    }
    __syncthreads();
}

DI void sincos_acc(float ang, float& c, float& s) {
    const double x = (double)ang;
    const double n = __builtin_rint(x * 0.63661977236758134308);
    double rr = __builtin_fma(-n, 1.57079632679489655800e+00, x); rr = __builtin_fma(-n, 6.12323399573676603587e-17, rr);
    const double r2 = rr * rr;
    const double sn = rr * (1.0 + r2 * (-1.0 / 6 + r2 * (1.0 / 120 + r2 * (-1.0 / 5040 + r2 * (1.0 / 362880 + r2 * (-1.0 / 39916800 + r2 * (1.0 / 6227020800.0)))))));
    const double cs = 1.0 + r2 * (-0.5 + r2 * (1.0 / 24 + r2 * (-1.0 / 720 + r2 * (1.0 / 40320 + r2 * (-1.0 / 3628800 + r2 * (1.0 / 479001600.0))))));
    const int q = ((int)n) & 3;
    const double cc = (q == 0) ? cs : (q == 1) ? -sn : (q == 2) ? -cs : sn;
    const double ss = (q == 0) ? sn : (q == 1) ? cs : (q == 2) ? -sn : -cs;
    c = (float)cc; s = (float)ss;
}

#ifndef PH
#define PH 255
#endif
#ifndef REP_P1
#define REP_P1 1
#endif
#ifndef REP_B
#define REP_B 1
#endif
#ifndef REP_CONV
#define REP_CONV 1
#endif
#ifndef REP_P7
#define REP_P7 1
#endif
#define GRID_SYNC() do { CParams* qb_ = fresh_params(); xcd_barrier((unsigned*)(qb_->ws + WS_CTL), xcc, MISC); } while (0)

__global__ void __launch_bounds__(NTHREADS, 2) fwd_megakernel(Params p) {
    extern __shared__ __attribute__((aligned(16))) unsigned char lds_raw[];
    cg::grid_group grid = cg::this_grid();
    LAS unsigned char* lds = (LAS unsigned char*)lds_raw;
    const int wave = __builtin_amdgcn_readfirstlane((int)threadIdx.x >> 6);
    const int G = gridDim.x, bid = blockIdx.x;
    const int gw = bid * NWAVES + wave, NGW = G * NWAVES;
    LAS float* sc = (LAS float*)(lds + LDS_SCR) + wave * 64;
    volatile LAS unsigned* MISC = (volatile LAS unsigned*)(lds + LDS_SCR + 2048);
    if (threadIdx.x < 4) MISC[threadIdx.x] = 0u;
    __syncthreads();
    unsigned xcc;
    { CParams* q0 = fresh_params(); const XcdBarrier xb = xcd_barrier_post((unsigned*)(q0->ws + WS_CTL), MISC); xcc = xb.x; }

#ifndef NOPRO
    {
        PHASE_CTX
        float* COSH = (float*)(ws + WS_COSH); float* SINH = (float*)(ws + WS_SINH); float* COSR = (float*)(ws + WS_COSR); float* SINR = (float*)(ws + WS_SINR);
        const float* x = q->in[0]; const int* pos = (const int*)q->in[2];
        const int lane = lane_id(), tid = wave * 64 + lane;
        for (int i = bid * NTHREADS + tid; i < TT * 32; i += G * NTHREADS) { const int t = i >> 5, k = i & 31; float c, s; sincos_acc((float)pos[t] * q->inv_h[k], c, s); COSH[i] = c; SINH[i] = s; }
        for (int i = bid * NTHREADS + tid; i < TT * 16; i += G * NTHREADS) { const int t = i >> 4, k = i & 15; float c, s; sincos_acc((float)pos[t] * q->inv_r[k], c, s); COSR[i] = c; SINR[i] = s; }
        for (int row = gw; row < TT; row += NGW) {
            const f32x4* xr = (const f32x4*)(x + (size_t)row * D) + lane; float ss = 0.f;
            u32x2* o8 = (u32x2*)(XB + (size_t)row * D) + lane;
#pragma unroll
            for (int j = 0; j < 4; ++j) { const f32x4 v = xr[64 * j]; ss += (v.x * v.x + v.y * v.y) + (v.z * v.z + v.w * v.w); u32x2 w; w.x = cvtpk(v.x, v.y); w.y = cvtpk(v.z, v.w); o8[64 * j] = w; }
            ss = wave_sum(ss);
            if (lane < 16) PX[(size_t)row * 16 + lane] = lane == 0 ? ss : 0.f;
        }
        const float* mem = q->in[1]; bf16_t* MEMN = (bf16_t*)(ws + WS_MEMN);
        for (int row = gw; row < BATCH * NMEM; row += NGW) {
            const f32x4* xr = (const f32x4*)(mem + (size_t)row * D) + lane; f32x4 v[4]; float ss = 0.f;
#pragma unroll
            for (int j = 0; j < 4; ++j) { v[j] = xr[64 * j]; ss += (v[j].x * v[j].x + v[j].y * v[j].y) + (v[j].z * v[j].z + v[j].w * v[j].w); }
            const float rstd = __builtin_amdgcn_rsqf(wave_sum(ss) * (1.f / D) + EPS);
            u32x2* o8 = (u32x2*)(MEMN + (size_t)row * D) + lane;
#pragma unroll
            for (int j = 0; j < 4; ++j) { u32x2 w; w.x = cvtpk(v[j].x * rstd, v[j].y * rstd); w.y = cvtpk(v[j].z * rstd, v[j].w * rstd); o8[64 * j] = w; }
        }
    }

#endif
    for (int l = 0; l < DEPTH; ++l) {
#ifndef NOCONV
#pragma unroll 1
        for (int rep = 0; rep < REP_CONV; ++rep) convert_layer(l, lds, gw, NGW, wave);
#endif
        if (l == 0) grid.sync(); else GRID_SYNC();
        for (int ch = 0; ch < NCHUNK; ++ch) {
            const int tok0 = ch * TC;
#if PH & 1
            {
                PHASE_CTX
                pg8::TileOrder S; S.init(TC, NT_IN, G, bid, XB + (size_t)tok0 * D, (const bf16_t*)(ws + WS_WIN));
                EpiSlot<CfgIn> E{CfgIn{ws, q->in[6] + l * 64, q->in[7] + l * 64, q->in[14] + l * 96, q->in[15] + l * 192, q->in[16] + l * 192, q->in[5] + l * 4096},
                                 RowScale{PX, 16, 16, 1.f / D}, tok0, rt, tok0};
#pragma unroll 1
                for (int rep = 0; rep < REP_P1; ++rep) pg8::gemm_phase(lds, D, D, S, E, wave);
                if (ch == 0) {
                    pg8::TileOrder S2; S2.init(BATCH * NMEM, 1024, G, (bid + 128) % G, (const bf16_t*)(ws + WS_MEMN), (const bf16_t*)(ws + WS_WMKV));
                    EpiSlot<CfgMkv> E2{CfgMkv{ws}, RowScale{nullptr, 0, 0, 0.f}, 0, rt, 0};
                    pg8::gemm_phase(lds, D, D, S2, E2, wave);
                }
            }

#endif
            GRID_SYNC();
#if PH & 2
            {
                PHASE_CTX
                pg8::TileOrder S; S.init(TC, 1024, G, bid, (const bf16_t*)(ws + WS_CQ), (const bf16_t*)(ws + WS_WUQ));
                EpiSlot<CfgUq> E{CfgUq{ws, q->in[13] + l * 96}, RowScale{(const float*)(ws + WS_PCQ), 8, 6, 1.f / 384.f}, 0, rt, tok0};
                pg8::gemm_phase(lds, 384, 384, S, E, wave);
                pg8::TileOrder S2; S2.init(TC, 1024, G, bid, (const bf16_t*)(ws + WS_CKV), (const bf16_t*)(ws + WS_WUKV));
                EpiSlot<CfgUkv> E2{CfgUkv{ws, q->in[14] + l * 96}, RowScale{(const float*)(ws + WS_PCKV), 4, 4, 1.f / 256.f}, 0, rt, tok0};
                pg8::gemm_phase(lds, 256, 256, S2, E2, wave);
                const int lane = opaque(lane_id());
                const int nrows = TC + (ch == 0 ? BATCH * NMEM : 0);
                for (int rw = gw; rw < nrows; rw += NGW) {
                    const bool isq = rw < TC;
                    bf16_t* rp = isq ? (bf16_t*)(ws + WS_MQ) + (size_t)rw * 512 : (bf16_t*)(ws + WS_MK) + (size_t)(rw - TC) * 512;
                    const float* gn = (isq ? q->in[19] : q->in[20]) + l * 128 + (lane & 15) * 8;
                    const float scl = isq ? 0.08838834764831845f * LOG2E : 1.f;
                    float v[8]; unpack8(*(const u32x4*)(rp + lane * 8), v);
                    float ss = 0.f;
#pragma unroll
                    for (int i = 0; i < 8; ++i) ss += v[i] * v[i];
                    ss += __shfl_xor(ss, 1); ss += __shfl_xor(ss, 2); ss += __shfl_xor(ss, 4); ss += __shfl_xor(ss, 8);
                    const float inv = __builtin_amdgcn_rsqf(ss * (1.f / 128.f) + EPS) * scl;
#pragma unroll
                    for (int i = 0; i < 8; ++i) v[i] *= inv * gn[i];
                    *(u32x4*)(rp + lane * 8) = pack8(v);
                }
            }

#endif
            GRID_SYNC();
#if PH & 4
            {
                PHASE_CTX
                LAS char* al = (LAS char*)lds;
                const int lane = opaque(lane_id()), tid = wave * 64 + lane;
#pragma unroll 1
                for (int rep = 0; rep < REP_B; ++rep)
                for (int idx = bid; idx < BC * 8 * 16; idx += G) {
                    const int half = idx / (BC * 64), rem = idx % (BC * 64), bh = rem / 8, s = rem % 8;
                    const int qb = half == 0 ? s : 15 - s, b = bh / 8, hh = bh % 8;
                    const long r0 = (long)b * SEQ;
                    dense_unit<96, 64, true, true>((const bf16_t*)(ws + WS_QB) + (r0 + 256 * qb) * 768 + 96 * hh, 768,
                        (const bf16_t*)(ws + WS_KN) + r0 * 512 + 64 * hh, 512, (const bf16_t*)(ws + WS_KR) + r0 * 32, 32,
                        (const bf16_t*)(ws + WS_VB) + r0 * 512 + 64 * hh, 512, (bf16_t*)(ws + WS_OB) + (r0 + 256 * qb) * 512 + 64 * hh, 512,
                        256 * qb, 4 * (qb + 1), al, sc, tid);
                }
                for (int idx = bid; idx < 3 * BC * 32 * 4; idx += G) {
                    const int g = idx / (BC * 128), rem = idx % (BC * 128), hp = rem & 3, sj = rem >> 2;
                    const int dil = g == 0 ? 1 : g == 1 ? 4 : 16, nb = 32 / dil;
                    const int n = sj / nb, j = sj % nb, b = n / dil, res = n % dil;
                    const long row0 = (long)b * SEQ + res;
                    const bf16_t* Qg = (const bf16_t*)(ws + WS_CB + (size_t)(3 * g) * 16 * MiB); const bf16_t* Kg = (const bf16_t*)(ws + WS_CB + (size_t)(3 * g + 1) * 16 * MiB); const bf16_t* Vg = (const bf16_t*)(ws + WS_CB + (size_t)(3 * g + 2) * 16 * MiB);
#pragma unroll
                    for (int sl = 0; sl < 2; ++sl) {
                        banded_load(al + sl * BSLOT, BKP, Kg + 64 * (2 * hp + sl), 512, row0, dil, 128 * (j - 1), tid);
                        banded_load(al + sl * BSLOT + 256 * BKP, BVP, Vg + 64 * (2 * hp + sl), 512, row0, dil, 128 * (j - 1), tid);
                    }
                    __syncthreads();
                    { const int sl = wave >> 2, wq = wave & 3, hd = 2 * hp + sl, r = lane & 31;
                      const long qtok = row0 + (long)(128 * j + 32 * wq + r) * dil;
                      bf16_t* ob = (bf16_t*)Qg + (row0 + (long)(128 * j + 32 * wq) * dil) * 512 + 64 * hd;
                      banded_task<false, true>(Qg + qtok * 512 + 64 * hd, ob, (long)dil * 512, al + sl * BSLOT, al + sl * BSLOT + 256 * BKP, wq, j, 128, 0.f,
                                               (float*)(ws + WS_LSE) + (qtok * 8 + hd) * 4 + g, sc, lane); }
                    __syncthreads();
                }
                for (int idx = bid; idx < BC * 32 * 2; idx += G) {
                    const int kvh = idx & 1, j = (idx >> 1) & 31, b = idx >> 6;
                    const long row0 = (long)b * SEQ;
                    banded_load(al, BKP, (const bf16_t*)(ws + WS_KA) + 64 * kvh, 128, row0, 1, 128 * (j - 1), tid);
                    banded_load(al + 256 * BKP, BVP, (const bf16_t*)(ws + WS_VA) + 64 * kvh, 128, row0, 1, 128 * (j - 1), tid);
                    __syncthreads();
#pragma unroll 1
                    for (int pass = 0; pass < 2; ++pass) {
                        const int hq = kvh * 4 + (wave >> 2) + 2 * pass, wq = wave & 3, r = lane & 31;
                        const long qtok = row0 + 128 * j + 32 * wq + r;
                        bf16_t* QA = (bf16_t*)(ws + WS_QA);
                        banded_task<true, false>(QA + qtok * 512 + 64 * hq, QA + (row0 + 128 * j + 32 * wq) * 512 + 64 * hq, 512, al, al + 256 * BKP, wq, j, 127,
                                                 (q->in[8] + l * 8)[hq] * LOG2E, nullptr, sc, lane);
                    }
                    __syncthreads();
                }
                for (int idx = bid; idx < BC * 4 * 16; idx += G) {
                    const int qb = idx & 15, hh = (idx >> 4) & 3, b = idx >> 6;
                    const long r0 = (long)b * SEQ + 256 * qb; const long m0 = (long)(ch * BC + b) * NMEM;
                    bf16_t* MQ = (bf16_t*)(ws + WS_MQ);
                    dense_unit<128, 128, false, false>(MQ + r0 * 512 + 128 * hh, 512, (const bf16_t*)(ws + WS_MK) + m0 * 512 + 128 * hh, 512, nullptr, 0,
                        (const bf16_t*)(ws + WS_MV) + m0 * 512 + 128 * hh, 512, MQ + r0 * 512 + 128 * hh, 512, 0, 4, al, sc, tid);
                }
            }

#endif
            GRID_SYNC();
#if PH & 8
            {
                PHASE_CTX
                const float* LSE = (const float*)(ws + WS_LSE); bf16_t* OC = (bf16_t*)(ws + WS_OC);
                const int tid = wave * 64 + opaque(lane_id());
                for (int i = bid * NTHREADS + tid; i < TC * 64; i += G * NTHREADS) {
                    const int tok = i >> 6, c8 = i & 63, hd = c8 >> 3;
                    const f32x4 ls = *(const f32x4*)(LSE + ((size_t)tok * 8 + hd) * 4);
                    const float mx = fmaxf(ls.x, fmaxf(ls.y, ls.z));
                    float w0 = __builtin_amdgcn_exp2f(ls.x - mx), w1 = __builtin_amdgcn_exp2f(ls.y - mx), w2 = __builtin_amdgcn_exp2f(ls.z - mx);
                    const float inv = 1.f / (w0 + w1 + w2); w0 *= inv; w1 *= inv; w2 *= inv;
                    float a[8], b[8], c[8], o[8];
                    unpack8(*(const u32x4*)((const bf16_t*)(ws + WS_CB) + (size_t)tok * 512 + c8 * 8), a);
                    unpack8(*(const u32x4*)((const bf16_t*)(ws + WS_CB + 48 * MiB) + (size_t)tok * 512 + c8 * 8), b);
                    unpack8(*(const u32x4*)((const bf16_t*)(ws + WS_CB + 96 * MiB) + (size_t)tok * 512 + c8 * 8), c);
#pragma unroll
                    for (int k = 0; k < 8; ++k) o[k] = w0 * a[k] + w1 * b[k] + w2 * c[k];
                    *(u32x4*)(OC + (size_t)tok * 512 + c8 * 8) = pack8(o);
                }
            }

#endif
            GRID_SYNC();
#if PH & 16
            {
                PHASE_CTX
                pg8::TileOrder S; S.init(TC, D, G, bid, (const bf16_t*)(ws + WS_QA), (const bf16_t*)(ws + WS_WBR)); S.nseg = 4;
                S.segA = 8 * MiB; S.segB = (size_t)D * 512;
                EpiMerge E{(const bf16_t*)(ws + WS_GATES), (bf16_t*)(ws + WS_GY) + (size_t)tok0 * D};
                pg8::gemm_phase(lds, 512, 512, S, E, wave);
            }

#endif
            GRID_SYNC();
        }
        {
            const int tok0 = 0;
#if PH & 32
            {
                PHASE_CTX
                pg8::TileOrder S; S.init(TT, D, G, bid, (const bf16_t*)(ws + WS_GY), (const bf16_t*)(ws + WS_WOUT));
                EpiRes E{((l == 0) ? q->in[0] : q->out) + (size_t)tok0 * D, q->out + (size_t)tok0 * D, XB + (size_t)tok0 * D, PX + (size_t)tok0 * 16};
                pg8::gemm_phase(lds, D, D, S, E, wave);
            }

#endif
            GRID_SYNC();
#if PH & 64
            {
                PHASE_CTX
                pg8::TileOrder S; S.init(TT, DFF, G, bid, XB + (size_t)tok0 * D, (const bf16_t*)(ws + WS_WUP));
                EpiUp E{(bf16_t*)(ws + WS_U), RowScale{PX, 16, 16, 1.f / D}, tok0};
#pragma unroll 1
                for (int rep = 0; rep < REP_P7; ++rep) pg8::gemm_phase(lds, D, D, S, E, wave);
            }

#endif
            GRID_SYNC();
#if PH & 128
            {
                PHASE_CTX
                pg8::TileOrder S; S.init(TT, D, G, bid, (const bf16_t*)(ws + WS_U), (const bf16_t*)(ws + WS_WDN));
                EpiRes E{q->out + (size_t)tok0 * D, q->out + (size_t)tok0 * D, XB + (size_t)tok0 * D, PX + (size_t)tok0 * 16};
                pg8::gemm_phase(lds, DFF, DFF, S, E, wave);
            }

#endif
            GRID_SYNC();
        }
    }
}

extern "C" void kernel_launch(void* const* d_in, const int* in_sizes, int n_in, void* d_out, int out_size, void* d_ws, size_t ws_size, hipStream_t stream) {
    static int grid = 0;
    if (grid == 0) {
        if (n_in != 26 || out_size != TT * D || ws_size < WS_END) { fprintf(stderr, "kernel_launch: unexpected shapes (n_in %d out %d ws %zu)\n", n_in, out_size, ws_size); grid = -1; return; }
        int dev = 0, cus = 0, per_cu = 0;
        hipGetDevice(&dev); hipDeviceGetAttribute(&cus, hipDeviceAttributeMultiprocessorCount, dev);
        hipFuncSetAttribute((const void*)fwd_megakernel, hipFuncAttributeMaxDynamicSharedMemorySize, LDS_BYTES);
        hipOccupancyMaxActiveBlocksPerMultiprocessor(&per_cu, (const void*)fwd_megakernel, NTHREADS, LDS_BYTES);
        if (per_cu < 1) { fprintf(stderr, "kernel_launch: occupancy query says %d blocks per CU\n", per_cu); per_cu = 1; }
        (void)hipGetLastError();
        grid = cus;
    }
    if (grid < 0) return;
    if (hipMemsetAsync((char*)d_ws + WS_CTL, 0, XCD_BAR_WORDS * 4, stream) != hipSuccess) { fprintf(stderr, "kernel_launch: memset failed\n"); return; }
    Params p{};
    for (int i = 0; i < 26; ++i) p.in[i] = (const float*)d_in[i];
    p.out = (float*)d_out; p.ws = (unsigned char*)d_ws;
    for (int i = 0; i < 32; ++i) p.inv_h[i] = (float)std::pow(10000.0, -(double)(2 * i) / 64.0);
    for (int i = 0; i < 16; ++i) p.inv_r[i] = (float)std::pow(10000.0, -(double)(2 * i) / 32.0);
    void* args[] = {&p};
    hipError_t e = hipLaunchCooperativeKernel((const void*)fwd_megakernel, dim3(grid), dim3(NTHREADS), args, LDS_BYTES, stream);
    if (e != hipSuccess) fprintf(stderr, "cooperative launch failed: %s (grid %d)\n", hipGetErrorString(e), grid);
}
```

```cpp
#include <hip/hip_runtime.h>
#include <hip/hip_cooperative_groups.h>
#include <cstdio>
#include <cstdint>
#include <cmath>
namespace cg = cooperative_groups;

#define LAS __attribute__((address_space(3)))
#define DI __device__ __forceinline__
typedef unsigned short bf16_t;
typedef short bf16x8 __attribute__((ext_vector_type(8)));
typedef short s16x4 __attribute__((ext_vector_type(4)));
typedef float f32x4 __attribute__((ext_vector_type(4)));
typedef float f32x16 __attribute__((ext_vector_type(16)));
typedef unsigned u32x4 __attribute__((ext_vector_type(4)));
typedef unsigned u32x2 __attribute__((ext_vector_type(2)));
typedef float f32x2_t __attribute__((ext_vector_type(2)));
typedef __bf16 bf16x2_t __attribute__((ext_vector_type(2)));

constexpr int D = 1024, BATCH = 8, SEQ = 4096, DEPTH = 4, TT = BATCH * SEQ;
constexpr int NCHUNK = 2, BC = BATCH / NCHUNK, TC = BC * SEQ;
constexpr int N_IN = 10656, NT_IN = 10752;
constexpr int DFF = 4096, NMEM = 256;
constexpr float EPS = 1e-6f;
constexpr float LOG2E = 1.4426950408889634f;
constexpr float NEGBIG = -1e30f;
constexpr int NTHREADS = 512, NWAVES = 8;

constexpr size_t MiB = 1u << 20;
constexpr size_t WS_CTL = 0;
constexpr size_t WS_WIN = 1 * MiB, WS_WUQ = 22 * MiB, WS_WUKV = 23 * MiB, WS_WMKV = 24 * MiB, WS_WBR = 26 * MiB, WS_WOUT = 30 * MiB, WS_WUP = 32 * MiB, WS_WDN = 40 * MiB;
constexpr size_t WS_XB = 48 * MiB, WS_PX = 112 * MiB, WS_COSH = 114 * MiB, WS_SINH = 118 * MiB, WS_COSR = 122 * MiB, WS_SINR = 124 * MiB;
constexpr size_t WS_MEMN = 126 * MiB, WS_MK = 130 * MiB, WS_MV = 132 * MiB;
constexpr size_t WS_QA = 134 * MiB, WS_OB = 150 * MiB, WS_OC = 166 * MiB, WS_MQ = 182 * MiB;
constexpr size_t WS_KA = 198 * MiB, WS_VA = 202 * MiB, WS_CQ = 206 * MiB, WS_CKV = 218 * MiB, WS_KR = 226 * MiB, WS_PCQ = 227 * MiB, WS_PCKV = 227 * MiB + 512 * 1024;
constexpr size_t WS_CB = 228 * MiB;
constexpr size_t WS_GATES = 372 * MiB, WS_U = WS_CB;
constexpr size_t WS_QB = 500 * MiB, WS_KN = 524 * MiB, WS_VB = 540 * MiB, WS_LSE = 556 * MiB, WS_GY = 558 * MiB;
constexpr size_t WS_END = 622 * MiB;

constexpr int LDS_BYTES = 155648;
constexpr int LDS_SCR = 149504;

struct Params {
    const float* in[26];
    float* out;
    unsigned char* ws;
    float inv_h[32];
    float inv_r[16];
    int pad[2];
};

DI unsigned cvtpk(float lo, float hi) { f32x2_t v = {lo, hi}; bf16x2_t b = __builtin_convertvector(v, bf16x2_t); return __builtin_bit_cast(unsigned, b); }
DI float bf_lo(unsigned w) { return __uint_as_float(w << 16); }
DI float bf_hi(unsigned w) { return __uint_as_float(w & 0xffff0000u); }
DI u32x4 pack8(const float* v) { u32x4 w; w.x = cvtpk(v[0], v[1]); w.y = cvtpk(v[2], v[3]); w.z = cvtpk(v[4], v[5]); w.w = cvtpk(v[6], v[7]); return w; }
DI void unpack8(u32x4 w, float* v) { v[0] = bf_lo(w.x); v[1] = bf_hi(w.x); v[2] = bf_lo(w.y); v[3] = bf_hi(w.y); v[4] = bf_lo(w.z); v[5] = bf_hi(w.z); v[6] = bf_lo(w.w); v[7] = bf_hi(w.w); }
DI float wave_sum(float v) {
#pragma unroll
    for (int o = 1; o < 64; o <<= 1) v += __shfl_xor(v, o);
    return v;
}
struct RopeTabs { const float* cosh; const float* sinh; const float* cosr; const float* sinr; };
typedef const struct Params __attribute__((address_space(4))) CParams;
DI CParams* fresh_params() { unsigned long long k = (unsigned long long)__builtin_amdgcn_kernarg_segment_ptr(); asm volatile("" : "+s"(k)); return (CParams*)k; }
#define PHASE_CTX \
    CParams* q = fresh_params(); unsigned char* ws = q->ws; (void)ws; \
    bf16_t* XB = (bf16_t*)(ws + WS_XB); float* PX = (float*)(ws + WS_PX); (void)XB; (void)PX; \
    const RopeTabs rt{(const float*)(ws + WS_COSH), (const float*)(ws + WS_SINH), (const float*)(ws + WS_COSR), (const float*)(ws + WS_SINR)}; (void)rt;
DI int opaque(int v) { asm volatile("" : "+v"(v)); return v; }
DI int lane_id() { int v; asm volatile("v_mbcnt_lo_u32_b32 %0, -1, 0\n\tv_mbcnt_hi_u32_b32 %0, -1, %0" : "=v"(v)); return v; }
#define LDS_WAIT() asm volatile("s_waitcnt lgkmcnt(0)" ::: "memory")

namespace pg8 {
constexpr int BM = 256, BK = 64, HALF = 128, HTB = HALF * BK * 2, STAGE_BYTES = 8 * HTB, NXCD = 8, WGM = 8;
DI int lds_byte(int r, int c) { const int st = (r >> 4) * 2 + (c >> 5), rr = r & 15, cc = c & 31, ob = rr * 64 + cc * 2; return st * 1024 + (ob ^ (((ob >> 9) & 1) << 5)); }
DI void stage_rc(int b, int& R, int& C) { const int st = b / 1024, sb = b % 1024, swz = sb ^ (((sb >> 9) & 1) << 5); R = (st >> 1) * 16 + swz / 64; C = (st & 1) * 32 + (swz % 64) / 2; }
DI int perm32(int rho) { const int n = rho >> 4, i = rho & 15; return 8 * (i >> 2) + 4 * n + (i & 3); }

struct Unit { int pm, pn, seg; const bf16_t* A; const bf16_t* Bt; };

struct TileOrder {
    int nM, nN, nwg, G, c, nseg;
    const bf16_t* A0; const bf16_t* B0; size_t segA, segB;
    DI void init(int M, int N, int G_, int c_, const bf16_t* A, const bf16_t* B) { nM = M / BM; nN = N / BM; nwg = nM * nN; G = G_; c = c_; nseg = 1; A0 = A; B0 = B; segA = 0; segB = 0; }
    DI bool next(int i, Unit& u) const {
        const int seg = i % nseg, ti = i / nseg;
        const long L = (long)ti * G + c; if (L >= nwg) return false;
        int wgid = (int)L; { const int q = nwg / NXCD, r = nwg % NXCD, xcd = wgid % NXCD, off = wgid / NXCD; wgid = (xcd < r ? xcd * (q + 1) : r * (q + 1) + (xcd - r) * q) + off; }
        const int nig = WGM * nN, gid = wgid / nig, fm = gid * WGM, gsz = (nM - fm) < WGM ? (nM - fm) : WGM;
        u.pm = fm + ((wgid % nig) % gsz); u.pn = (wgid % nig) / gsz; u.seg = seg;
        u.A = A0 + (size_t)seg * segA; u.Bt = B0 + (size_t)seg * segB;
        return true;
    }
};

template <class Epi, class Sched>
DI void gemm_phase(LAS unsigned char* lds, const int K, const int lda, const Sched& S, const Epi& E, const int wid) {
    const int lane = opaque(lane_id()), tid = wid * 64 + lane, wr = wid >> 2, wc = wid & 3, fr = lane & 15, fq = lane >> 4;
    const int nt = K / BK;
    unsigned voffA[2], voffB[2];
#pragma unroll
    for (int i = 0; i < 2; ++i) { int R, C; stage_rc(tid * 16 + i * 8192, R, C); const int Rb = (R & ~31) + perm32(R & 31);
        voffA[i] = (unsigned)(R * lda + C) * 2u; voffB[i] = (unsigned)(Rb * K + C) * 2u; }
    const size_t kstep = (size_t)(BK * 2);
    const size_t hstepA = (size_t)HALF * lda * 2, hstepB = (size_t)HALF * K * 2;
    const size_t tstepA = 2 * hstepA, tstepB = 2 * hstepB;
    const unsigned ldsw = (unsigned)wid * 1024u;
    const int aoff = lds_byte(wr * 64 + fr, fq * 8), boff = lds_byte(wc * 32 + fr, fq * 8);
#define PG8_SA(b, h) (((b) * 2 + (h)) * HTB)
#define PG8_SB(b, h) ((4 + (b) * 2 + (h)) * HTB)
#define PG8_STAGE(bufoff, gbase, voff) do { _Pragma("unroll") for (int _i = 0; _i < 2; ++_i) \
        __builtin_amdgcn_global_load_lds((const unsigned*)((const char*)(gbase) + (voff)[_i]), (LAS unsigned*)(lds + (bufoff) + ldsw + _i * 8192), 16, 0, 0); } while (0)
#define PG8_LDA(dst, b, h) do { _Pragma("unroll") for (int m = 0; m < 4; ++m) _Pragma("unroll") for (int k = 0; k < 2; ++k) dst[m][k] = *(const LAS bf16x8*)(lds + PG8_SA(b, h) + aoff + m * 2048 + k * 1024); } while (0)
#define PG8_LDB(dst, b, h) do { _Pragma("unroll") for (int n = 0; n < 2; ++n) _Pragma("unroll") for (int k = 0; k < 2; ++k) dst[n][k] = *(const LAS bf16x8*)(lds + PG8_SB(b, h) + boff + n * 2048 + k * 1024); } while (0)
#define PG8_MMA(ai, bj, At, Bt) do { __builtin_amdgcn_s_setprio(1); _Pragma("unroll") for (int m = 0; m < 4; ++m) _Pragma("unroll") for (int n = 0; n < 2; ++n) _Pragma("unroll") for (int k = 0; k < 2; ++k) \
        acc[ai][bj][m][n] = __builtin_amdgcn_mfma_f32_16x16x32_bf16(Bt[n][k], At[m][k], acc[ai][bj][m][n], 0, 0, 0); __builtin_amdgcn_s_setprio(0); } while (0)
#define PG8_WAIT_V(n) asm volatile("s_waitcnt vmcnt(" #n ")" ::: "memory")
#define PG8_WAIT_L(n) asm volatile("s_waitcnt lgkmcnt(" #n ")" ::: "memory")
#define PG8_BAR __builtin_amdgcn_s_barrier()
#define PG8_SCHED __builtin_amdgcn_sched_barrier(0)
    Unit cur, nxt; int ui = 0;
    if (!S.next(0, cur)) return;
    f32x4 acc[2][2][4][2];
#pragma unroll
    for (int a = 0; a < 2; ++a)
#pragma unroll
        for (int b = 0; b < 2; ++b)
#pragma unroll
            for (int m = 0; m < 4; ++m)
#pragma unroll
                for (int n = 0; n < 2; ++n) acc[a][b][m][n] = (f32x4){0.f, 0.f, 0.f, 0.f};
    bf16x8 At[4][2], B0[2][2], B1[2][2];
    const char* cA = (const char*)cur.A + (size_t)cur.pm * tstepA; const char* cB = (const char*)cur.Bt + (size_t)cur.pn * tstepB;
    PG8_STAGE(PG8_SB(0, 0), cB, voffB); PG8_STAGE(PG8_SB(0, 1), cB + hstepB, voffB); PG8_STAGE(PG8_SA(0, 0), cA, voffA); PG8_STAGE(PG8_SA(0, 1), cA + hstepA, voffA);
    if (wr == 1) PG8_BAR;
    PG8_WAIT_V(2); PG8_BAR;
    PG8_STAGE(PG8_SB(1, 0), cB + kstep, voffB); PG8_STAGE(PG8_SA(1, 0), cA + kstep, voffA); PG8_STAGE(PG8_SB(1, 1), cB + hstepB + kstep, voffB);
    PG8_WAIT_V(6); PG8_BAR;
    for (;;) {
        const bool has_next = S.next(ui + 1, nxt);
        const char* nA = has_next ? (const char*)nxt.A + (size_t)nxt.pm * tstepA : cA; const char* nB = has_next ? (const char*)nxt.Bt + (size_t)nxt.pn * tstepB : cB;
#pragma unroll 1
        for (int t = 0; t < nt; t += 2) {
            const bool last = (t == nt - 2);
            const char* a1 = cA + (size_t)(t + 1) * kstep;
            const char* a2 = last ? nA : cA + (size_t)(t + 2) * kstep; const char* b2 = last ? nB : cB + (size_t)(t + 2) * kstep;
            const char* a3 = a2 + kstep; const char* b3 = b2 + kstep;
            PG8_LDB(B0, 0, 0); PG8_LDB(B1, 0, 1); PG8_SCHED; PG8_LDA(At, 0, 0); PG8_STAGE(PG8_SA(1, 1), a1 + hstepA, voffA);
            PG8_WAIT_V(8); PG8_WAIT_L(0); PG8_BAR; PG8_MMA(0, 0, At, B0); PG8_MMA(0, 1, At, B1); PG8_BAR; PG8_SCHED;
            PG8_LDA(At, 0, 1); PG8_STAGE(PG8_SB(0, 0), b2, voffB); PG8_STAGE(PG8_SB(0, 1), b2 + hstepB, voffB); PG8_STAGE(PG8_SA(0, 0), a2, voffA);
            PG8_WAIT_V(8); PG8_WAIT_L(0); PG8_BAR; PG8_MMA(1, 0, At, B0); PG8_MMA(1, 1, At, B1); PG8_BAR; PG8_SCHED;
            PG8_LDB(B0, 1, 0); PG8_LDB(B1, 1, 1); PG8_SCHED; PG8_LDA(At, 1, 0); PG8_STAGE(PG8_SA(0, 1), a2 + hstepA, voffA);
            PG8_WAIT_V(8); PG8_WAIT_L(0); PG8_BAR; PG8_MMA(0, 0, At, B0); PG8_MMA(0, 1, At, B1); PG8_BAR; PG8_SCHED;
            PG8_LDA(At, 1, 1); PG8_STAGE(PG8_SB(1, 0), b3, voffB); PG8_STAGE(PG8_SB(1, 1), b3 + hstepB, voffB); PG8_STAGE(PG8_SA(1, 0), a3, voffA);
            PG8_WAIT_V(8); PG8_WAIT_L(0); PG8_BAR; PG8_MMA(1, 0, At, B0); PG8_MMA(1, 1, At, B1); PG8_BAR; PG8_SCHED;
        }
        if (wr == 0) PG8_BAR;
        E(acc, cur, wr, wc, fr, fq);
        if (!has_next) break;
#pragma unroll
        for (int a = 0; a < 2; ++a)
#pragma unroll
            for (int b = 0; b < 2; ++b)
#pragma unroll
                for (int m = 0; m < 4; ++m)
#pragma unroll
                    for (int n = 0; n < 2; ++n) acc[a][b][m][n] = (f32x4){0.f, 0.f, 0.f, 0.f};
        cur = nxt; cA = nA; cB = nB; ++ui;
        if (wr == 1) PG8_BAR;
    }
    PG8_WAIT_V(0);
    PG8_BAR;
#undef PG8_SA
#undef PG8_SB
#undef PG8_STAGE
#undef PG8_LDA
#undef PG8_LDB
#undef PG8_MMA
#undef PG8_WAIT_V
#undef PG8_WAIT_L
#undef PG8_BAR
#undef PG8_SCHED
}
}

struct RowScale {
    const float* part; int stride; int cnt; float inv_n;
    DI float get(int row) const {
        if (!part) return 1.f;
        float s = 0.f;
        const float* p = part + (size_t)row * stride;
        for (int i = 0; i < cnt; i += 4) { const f32x4 v = *(const f32x4*)(p + i); s += (v.x + v.y) + (v.z + v.w); }
        return __builtin_amdgcn_rsqf(s * inv_n + EPS);
    }
};

DI void rs_preload(const RowScale& rs, int rowbase, int fq, float (&out)[8]) {
    if (!rs.part) {
#pragma unroll
        for (int i = 0; i < 8; ++i) out[i] = 1.f;
        return;
    }
#pragma unroll
    for (int hb = 0; hb < 2; ++hb) {
        float s[4];
#pragma unroll
        for (int i = 0; i < 4; ++i) { s[i] = 0.f;
            if (4 * fq < rs.cnt) { const f32x4 v = *(const f32x4*)(rs.part + (size_t)(rowbase + hb * 128 + i * 16) * rs.stride + 4 * fq);
                s[i] = v.x + (4 * fq + 1 < rs.cnt ? v.y : 0.f) + (4 * fq + 2 < rs.cnt ? v.z : 0.f) + (4 * fq + 3 < rs.cnt ? v.w : 0.f); } }
#pragma unroll
        for (int i = 0; i < 4; ++i) { float t = s[i]; t += __shfl_xor(t, 16); t += __shfl_xor(t, 32); out[hb * 4 + i] = __builtin_amdgcn_rsqf(t * rs.inv_n + EPS); }
        asm volatile("" ::: "memory");
    }
}
enum { SK_SKIP = 0, SK_RAW = 1, SK_HEAD = 2, SK_ROPE32 = 3, SK_GATE = 4 };
struct SlotDesc { int kind; bf16_t* dst; int ld; int col; const float* gain; float scale; int rope; float* part; int pstride; int pidx; const float* bias; };


template <class Cfg>
struct EpiSlot {
    Cfg cfg; RowScale rs; int rs_off; RopeTabs rt; int tok_off;
    template <int KIND>
    DI void run(const f32x4 (&acc)[2][2][4][2], const pg8::Unit& u, const SlotDesc& d, int wr, int fr, int fq) const {
        const int d0 = 8 * fq;
        float rsv[8]; rs_preload(rs, u.pm * 256 + wr * 64 + fr + rs_off, fq, rsv);
        float g0[8], g1[8];
        if (KIND == 2 || KIND == 5) {
#pragma unroll
            for (int i = 0; i < 8; ++i) { g0[i] = d.gain[d0 + i] * d.scale; g1[i] = d.gain[32 + d0 + i] * d.scale; }
        } else if (KIND == 3) {
#pragma unroll
            for (int i = 0; i < 8; ++i) { g0[i] = fq < 2 ? d.gain[d0 + i] * d.scale : 0.f; g1[i] = fq < 2 ? d.gain[16 + d0 + i] * d.scale : 0.f; }
        } else if (KIND == 4) {
#pragma unroll
            for (int i = 0; i < 8; ++i) { g0[i] = d.bias[d.col + d0 + i]; g1[i] = d.bias[d.col + 32 + d0 + i]; }
        }
#pragma unroll
        for (int ai = 0; ai < 2; ++ai)
#pragma unroll
            for (int m = 0; m < 4; ++m) {
                const int row = u.pm * 256 + ai * 128 + wr * 64 + m * 16 + fr;
                const float r = rsv[ai * 4 + m];
                float v0[8], v1[8];
#pragma unroll
                for (int n = 0; n < 2; ++n)
#pragma unroll
                    for (int j = 0; j < 4; ++j) { v0[4 * n + j] = acc[ai][0][m][n][j] * r; v1[4 * n + j] = acc[ai][1][m][n][j] * r; }
                bf16_t* dp = d.dst + (size_t)row * d.ld + d.col;
                if (KIND == 1) {
                    if (d.part) {
                        float ss = 0.f;
#pragma unroll
                        for (int i = 0; i < 8; ++i) ss += v0[i] * v0[i] + v1[i] * v1[i];
                        ss += __shfl_xor(ss, 16); ss += __shfl_xor(ss, 32);
                        if (fq == 0) d.part[(size_t)row * d.pstride + d.pidx] = ss;
                    }
                    *(u32x4*)(dp + d0) = pack8(v0); *(u32x4*)(dp + 32 + d0) = pack8(v1);
                } else if (KIND == 4) {
#pragma unroll
                    for (int i = 0; i < 8; ++i) { v0[i] = __builtin_amdgcn_rcpf(1.f + __builtin_amdgcn_exp2f(-(v0[i] + g0[i]) * LOG2E)); v1[i] = __builtin_amdgcn_rcpf(1.f + __builtin_amdgcn_exp2f(-(v1[i] + g1[i]) * LOG2E)); }
                    *(u32x4*)(dp + d0) = pack8(v0); *(u32x4*)(dp + 32 + d0) = pack8(v1);
                } else if (KIND == 2 || KIND == 5) {
                    float ss = 0.f;
#pragma unroll
                    for (int i = 0; i < 8; ++i) ss += v0[i] * v0[i] + v1[i] * v1[i];
                    ss += __shfl_xor(ss, 16); ss += __shfl_xor(ss, 32);
                    const float inv = __builtin_amdgcn_rsqf(ss * (1.f / 64.f) + EPS);
#pragma unroll
                    for (int i = 0; i < 8; ++i) { v0[i] *= inv * g0[i]; v1[i] *= inv * g1[i]; }
                    if (KIND == 5) {
                        const float* cp = rt.cosh + (size_t)(row + tok_off) * 32 + d0; const float* sp = rt.sinh + (size_t)(row + tok_off) * 32 + d0;
                        const f32x4 c0 = *(const f32x4*)cp, c1 = *(const f32x4*)(cp + 4), s0 = *(const f32x4*)sp, s1 = *(const f32x4*)(sp + 4);
#pragma unroll
                        for (int i = 0; i < 8; ++i) { const float c = i < 4 ? c0[i & 3] : c1[i & 3], sn = i < 4 ? s0[i & 3] : s1[i & 3];
                            const float a = v0[i], b = v1[i]; v0[i] = a * c - b * sn; v1[i] = b * c + a * sn; }
                    }
                    *(u32x4*)(dp + d0) = pack8(v0); *(u32x4*)(dp + 32 + d0) = pack8(v1);
                } else {
                    float ss = 0.f;
#pragma unroll
                    for (int i = 0; i < 8; ++i) ss += v0[i] * v0[i] + v1[i] * v1[i];
                    ss += __shfl_xor(ss, 16); ss += __shfl_xor(ss, 32);
                    const float inv = __builtin_amdgcn_rsqf(ss * (1.f / 32.f) + EPS);
                    if (fq < 2) {
#pragma unroll
                        for (int i = 0; i < 8; ++i) { v0[i] *= inv * g0[i]; v1[i] *= inv * g1[i]; }
                        const float* cp = rt.cosr + (size_t)(row + tok_off) * 16 + d0; const float* sp = rt.sinr + (size_t)(row + tok_off) * 16 + d0;
                        const f32x4 c0 = *(const f32x4*)cp, c1 = *(const f32x4*)(cp + 4), s0 = *(const f32x4*)sp, s1 = *(const f32x4*)(sp + 4);
#pragma unroll
                        for (int i = 0; i < 8; ++i) { const float c = i < 4 ? c0[i & 3] : c1[i & 3], sn = i < 4 ? s0[i & 3] : s1[i & 3];
                            const float a = v0[i], b = v1[i]; v0[i] = a * c - b * sn; v1[i] = b * c + a * sn; }
                        *(u32x4*)(dp + d0) = pack8(v0); *(u32x4*)(dp + 16 + d0) = pack8(v1);
                    }
                }
            }
    }
    DI void operator()(const f32x4 (&acc)[2][2][4][2], const pg8::Unit& u, int wr, int wc, int fr, int fq) const {
        const SlotDesc d = cfg.get(u.pn * 4 + wc);
        if (d.kind == SK_RAW) run<1>(acc, u, d, wr, fr, fq);
        else if (d.kind == SK_GATE) run<4>(acc, u, d, wr, fr, fq);
        else if (d.kind == SK_HEAD) { if (d.rope) run<5>(acc, u, d, wr, fr, fq); else run<2>(acc, u, d, wr, fr, fq); }
        else if (d.kind == SK_ROPE32) run<3>(acc, u, d, wr, fr, fq);
    }
};

struct CfgIn {
    unsigned char* ws; const float* a_qn; const float* a_kn; const float* b_kn; const float* c_qn; const float* c_kn; const float* b_gate;
    DI SlotDesc get(int s) const {
        SlotDesc d; d.kind = SK_SKIP; d.dst = nullptr; d.ld = 0; d.col = 0; d.gain = nullptr; d.scale = 1.f; d.rope = 0; d.part = nullptr; d.pstride = 0; d.pidx = 0; d.bias = nullptr;
        if (s < 8) { d.kind = SK_HEAD; d.dst = (bf16_t*)(ws + WS_QA); d.ld = 512; d.col = 64 * s; d.gain = a_qn; d.scale = 0.125f * LOG2E; d.rope = 1; }
        else if (s < 10) { d.kind = SK_HEAD; d.dst = (bf16_t*)(ws + WS_KA); d.ld = 128; d.col = 64 * (s - 8); d.gain = a_kn; d.rope = 1; }
        else if (s < 12) { d.kind = SK_RAW; d.dst = (bf16_t*)(ws + WS_VA); d.ld = 128; d.col = 64 * (s - 10); }
        else if (s < 18) { d.kind = SK_RAW; d.dst = (bf16_t*)(ws + WS_CQ); d.ld = 384; d.col = 64 * (s - 12); d.part = (float*)(ws + WS_PCQ); d.pstride = 8; d.pidx = s - 12; }
        else if (s < 22) { d.kind = SK_RAW; d.dst = (bf16_t*)(ws + WS_CKV); d.ld = 256; d.col = 64 * (s - 18); d.part = (float*)(ws + WS_PCKV); d.pstride = 4; d.pidx = s - 18; }
        else if (s == 22) { d.kind = SK_ROPE32; d.dst = (bf16_t*)(ws + WS_KR); d.ld = 32; d.col = 0; d.gain = b_kn + 64; }
        else if (s < 95) { const int p = (s - 23) >> 3, h = (s - 23) & 7, g = p / 3, t = p % 3;
            d.dst = (bf16_t*)(ws + WS_CB + (size_t)p * 16 * MiB); d.ld = 512; d.col = 64 * h;
            if (t == 0) { d.kind = SK_HEAD; d.gain = c_qn + 64 * g; d.scale = 0.125f * LOG2E; d.rope = 1; }
            else if (t == 1) { d.kind = SK_HEAD; d.gain = c_kn + 64 * g; d.rope = 1; }
            else d.kind = SK_RAW; }
        else if (s < 103) { d.kind = SK_RAW; d.dst = (bf16_t*)(ws + WS_MQ); d.ld = 512; d.col = 64 * (s - 95); }
        else if (s < 167) { d.kind = SK_GATE; d.dst = (bf16_t*)(ws + WS_GATES); d.ld = 4096; d.col = 64 * (s - 103); d.bias = b_gate; }
        return d;
    }
};
DI void in_slot_src(int s, int& src, int& kind) {
    kind = 0;
    if (s < 22) src = 64 * s;
    else if (s == 22) { src = 1408; kind = 1; }
    else if (s < 167) src = 1440 + 64 * (s - 23);
    else { src = 0; kind = 2; }
}
struct CfgUq {
    unsigned char* ws; const float* b_qn;
    DI SlotDesc get(int s) const {
        SlotDesc d; d.dst = (bf16_t*)(ws + WS_QB); d.ld = 768; d.scale = 0.10206207261596575f * LOG2E; d.rope = 0; d.part = nullptr; d.pstride = 0; d.pidx = 0; d.bias = nullptr;
        if (s < 8) { d.kind = SK_HEAD; d.col = 96 * s; d.gain = b_qn; }
        else { d.kind = SK_ROPE32; d.col = 96 * (s - 8) + 64; d.gain = b_qn + 64; }
        return d;
    }
};
struct CfgUkv {
    unsigned char* ws; const float* b_kn;
    DI SlotDesc get(int s) const {
        SlotDesc d; d.ld = 512; d.scale = 1.f; d.rope = 0; d.part = nullptr; d.pstride = 0; d.pidx = 0; d.bias = nullptr; d.gain = b_kn;
        if (s < 8) { d.kind = SK_HEAD; d.dst = (bf16_t*)(ws + WS_KN); d.col = 64 * s; }
        else { d.kind = SK_RAW; d.dst = (bf16_t*)(ws + WS_VB); d.col = 64 * (s - 8); }
        return d;
    }
};
struct CfgMkv {
    unsigned char* ws;
    DI SlotDesc get(int s) const {
        SlotDesc d; d.kind = SK_RAW; d.ld = 512; d.scale = 1.f; d.rope = 0; d.part = nullptr; d.pstride = 0; d.pidx = 0; d.bias = nullptr; d.gain = nullptr;
        if (s < 8) { d.dst = (bf16_t*)(ws + WS_MK); d.col = 64 * s; } else { d.dst = (bf16_t*)(ws + WS_MV); d.col = 64 * (s - 8); }
        return d;
    }
};

struct EpiMerge {
    const bf16_t* gates; bf16_t* gy;
    DI void operator()(const f32x4 (&acc)[2][2][4][2], const pg8::Unit& u, int wr, int wc, int fr, int fq) const {
#pragma unroll
        for (int ai = 0; ai < 2; ++ai)
#pragma unroll
            for (int m = 0; m < 4; ++m) {
                const int row = u.pm * 256 + ai * 128 + wr * 64 + m * 16 + fr;
#pragma unroll
                for (int bj = 0; bj < 2; ++bj) {
                    const int col = u.pn * 256 + bj * 128 + wc * 32 + 8 * fq;
                    float g[8], o[8];
                    unpack8(*(const u32x4*)(gates + (size_t)row * 4096 + u.seg * 1024 + col), g);
                    bf16_t* gp = gy + (size_t)row * 1024 + col;
                    if (u.seg == 0) {
#pragma unroll
                        for (int i = 0; i < 8; ++i) o[i] = 0.f;
                    } else unpack8(*(const u32x4*)gp, o);
#pragma unroll
                    for (int n = 0; n < 2; ++n)
#pragma unroll
                        for (int j = 0; j < 4; ++j) o[4 * n + j] += g[4 * n + j] * acc[ai][bj][m][n][j];
                    *(u32x4*)gp = pack8(o);
                }
            }
    }
};
struct EpiRes {
    const float* xsrc; float* xdst; bf16_t* xb; float* px;
    DI void operator()(const f32x4 (&acc)[2][2][4][2], const pg8::Unit& u, int wr, int wc, int fr, int fq) const {
#pragma unroll
        for (int ai = 0; ai < 2; ++ai)
#pragma unroll
            for (int m = 0; m < 4; ++m) {
                const int row = u.pm * 256 + ai * 128 + wr * 64 + m * 16 + fr;
                float ss = 0.f;
#pragma unroll
                for (int bj = 0; bj < 2; ++bj) {
                    const size_t off = (size_t)row * 1024 + u.pn * 256 + bj * 128 + wc * 32 + 8 * fq;
                    float o[8];
#pragma unroll
                    for (int n = 0; n < 2; ++n) { const f32x4 xs = *(const f32x4*)(xsrc + off + 4 * n); const f32x4 xn = xs + acc[ai][bj][m][n]; *(f32x4*)(xdst + off + 4 * n) = xn;
#pragma unroll
                        for (int j = 0; j < 4; ++j) { o[4 * n + j] = xn[j]; ss += xn[j] * xn[j]; } }
                    *(u32x4*)(xb + off) = pack8(o);
                }
                ss += __shfl_xor(ss, 16); ss += __shfl_xor(ss, 32);
                if (fq == 0) px[(size_t)row * 16 + u.pn * 4 + wc] = ss;
            }
    }
};
struct EpiUp {
    bf16_t* U; RowScale rs; int rs_off;
    DI void operator()(const f32x4 (&acc)[2][2][4][2], const pg8::Unit& u, int wr, int wc, int fr, int fq) const {
        float rsv[8]; rs_preload(rs, u.pm * 256 + wr * 64 + fr + rs_off, fq, rsv);
#pragma unroll
        for (int ai = 0; ai < 2; ++ai)
#pragma unroll
            for (int m = 0; m < 4; ++m) {
                const int row = u.pm * 256 + ai * 128 + wr * 64 + m * 16 + fr;
                const float r = rsv[ai * 4 + m];
#pragma unroll
                for (int bj = 0; bj < 2; ++bj) {
                    float o[8];
#pragma unroll
                    for (int n = 0; n < 2; ++n)
#pragma unroll
                        for (int j = 0; j < 4; ++j) { const float v = fmaxf(acc[ai][bj][m][n][j] * r, 0.f); o[4 * n + j] = v * v; }
                    *(u32x4*)(U + (size_t)row * DFF + u.pn * 256 + bj * 128 + wc * 32 + 8 * fq) = pack8(o);
                }
            }
    }
};

DI void transpose_item(const float* W, int K, int N, const float* gk, bf16_t* WT, int rho0, int k0, int src0, int nvalid, LAS float* scr, int lane) {
    { const int c4 = (lane & 7) * 4;
#pragma unroll
      for (int i = 0; i < 8; ++i) { const int kk = 8 * i + (lane >> 3);
        f32x4 v = (f32x4){0.f, 0.f, 0.f, 0.f};
        if (c4 < nvalid) v = *(const f32x4*)(W + (size_t)(k0 + kk) * N + src0 + c4);
        if (gk) v = v * gk[k0 + kk];
        scr[kk * 33 + c4] = v.x; scr[kk * 33 + c4 + 1] = v.y; scr[kk * 33 + c4 + 2] = v.z; scr[kk * 33 + c4 + 3] = v.w; } }
    LDS_WAIT();
    const int c8 = lane & 7;
#pragma unroll
    for (int j = 0; j < 4; ++j) { const int n = (lane >> 3) + 8 * j; const LAS float* s = scr + (8 * c8) * 33 + n;
        u32x4 o; o.x = cvtpk(s[0 * 33], s[1 * 33]); o.y = cvtpk(s[2 * 33], s[3 * 33]); o.z = cvtpk(s[4 * 33], s[5 * 33]); o.w = cvtpk(s[6 * 33], s[7 * 33]);
        *(u32x4*)(WT + (size_t)(rho0 + n) * K + k0 + 8 * c8) = o; }
    LDS_WAIT();
}
DI void block_src(int mapk, int q  , int& src0, int& nvalid) {
    if (mapk == 0) { src0 = 32 * q; nvalid = 32; return; }
    const int pn = q >> 3, bj = (q >> 2) & 1, wc = q & 3, s = 4 * pn + wc;
    if (mapk == 1) { int src, kind; in_slot_src(s, src, kind);
        if (kind == 0) { src0 = src + 32 * bj; nvalid = 32; } else if (kind == 1) { src0 = src + 16 * bj; nvalid = 16; } else { src0 = 0; nvalid = 0; } }
    else if (mapk == 2) { if (s < 8) { src0 = 96 * s + 32 * bj; nvalid = 32; } else { src0 = 96 * (s - 8) + 64 + 16 * bj; nvalid = 16; } }
    else if (mapk == 3) { if (s < 8) { src0 = 128 * s + 32 * bj; nvalid = 32; } else { src0 = 128 * (s - 8) + 64 + 32 * bj; nvalid = 32; } }
    else { src0 = 64 * s + 32 * bj; nvalid = 32; }
}
DI void convert_matrix(const float* W, int K, int N, int Nt, const float* gk, bf16_t* WT, int mapk, LAS float* scr, int gw, int NGW, int lane) {
    const int nblk = Nt / 32, items = (K / 64) * nblk;
    for (int it = gw; it < items; it += NGW) {
        const int kb = it / nblk, q = it % nblk; int src0, nvalid; block_src(mapk, q, src0, nvalid);
        transpose_item(W, K, N, gk, WT, 32 * q, 64 * kb, src0, nvalid, scr, lane);
    }
}
DI void convert_layer(int l, LAS unsigned char* lds, int gw, int NGW, int wave) {
    const int lane = lane_id();
    CParams* q = fresh_params();
    LAS float* scr = (LAS float*)(lds + wave * 16384);
    unsigned char* ws = q->ws;
    convert_matrix(q->in[4] + (size_t)l * D * N_IN, D, N_IN, NT_IN, q->in[3] + l * D, (bf16_t*)(ws + WS_WIN), 1, scr, gw, NGW, lane);
    convert_matrix(q->in[11] + (size_t)l * 384 * 768, 384, 768, 1024, q->in[9] + l * 384, (bf16_t*)(ws + WS_WUQ), 2, scr, gw, NGW, lane);
    convert_matrix(q->in[12] + (size_t)l * 256 * 1024, 256, 1024, 1024, q->in[10] + l * 256, (bf16_t*)(ws + WS_WUKV), 3, scr, gw, NGW, lane);
    convert_matrix(q->in[18] + (size_t)l * D * 1024, D, 1024, 1024, q->in[17] + l * D, (bf16_t*)(ws + WS_WMKV), 4, scr, gw, NGW, lane);
    for (int n = 0; n < 4; ++n)
        convert_matrix(q->in[21] + ((size_t)l * 4 + n) * 512 * D, 512, D, D, nullptr, (bf16_t*)(ws + WS_WBR) + (size_t)n * D * 512, 0, scr, gw, NGW, lane);
    convert_matrix(q->in[22] + (size_t)l * D * D, D, D, D, nullptr, (bf16_t*)(ws + WS_WOUT), 0, scr, gw, NGW, lane);
    convert_matrix(q->in[24] + (size_t)l * D * DFF, D, DFF, DFF, q->in[23] + l * D, (bf16_t*)(ws + WS_WUP), 0, scr, gw, NGW, lane);
    convert_matrix(q->in[25] + (size_t)l * DFF * D, DFF, D, D, nullptr, (bf16_t*)(ws + WS_WDN), 0, scr, gw, NGW, lane);
}

DI int crow(int i, int h) { return (i & 3) + 8 * (i >> 2) + 4 * h; }
DI f32x16 mfma32(bf16x8 a, bf16x8 b, f32x16 c) { return __builtin_amdgcn_mfma_f32_32x32x16_bf16(a, b, c, 0, 0, 0); }
DI bf16x8 packp(const f32x16& x, int s) { u32x4 w; w.x = cvtpk(x[8 * s], x[8 * s + 1]); w.y = cvtpk(x[8 * s + 2], x[8 * s + 3]); w.z = cvtpk(x[8 * s + 4], x[8 * s + 5]); w.w = cvtpk(x[8 * s + 6], x[8 * s + 7]); return __builtin_bit_cast(bf16x8, w); }
DI s16x4 vtr(const LAS char* p) { return __builtin_bit_cast(s16x4, __builtin_amdgcn_ds_read_tr16_b64_v4i16((LAS s16x4*)p)); }

DI float max3f(float a, float b, float c) { float r; asm("v_max3_f32 %0, %1, %2, %3" : "=v"(r) : "v"(a), "v"(b), "v"(c)); return r; }
DI float xhalf_max(float v) { auto rr = __builtin_amdgcn_permlane32_swap(__float_as_uint(v), __float_as_uint(v), false, false); return fmaxf(__uint_as_float(rr[0]), __uint_as_float(rr[1])); }
DI float xhalf_sum(float v) { auto rr = __builtin_amdgcn_permlane32_swap(__float_as_uint(v), __float_as_uint(v), false, false); return __uint_as_float(rr[0]) + __uint_as_float(rr[1]); }
DI f32x16 splat16(float v) { f32x16 p;
#pragma unroll
    for (int i = 0; i < 16; ++i) p[i] = v;
    return p; }
template <int DQK, int NT, int TSTRIDE> DI void st_tiles(unsigned kaddr, const bf16x8* qf, const f32x16& init, f32x16* p) {
    bf16x8 a[NT][DQK / 16];
#pragma unroll
    for (int j = 0; j < NT; ++j)
#pragma unroll
        for (int ks = 0; ks < DQK / 16; ++ks) asm volatile("ds_read_b128 %0, %1 offset:%2" : "=v"(a[j][ks]) : "v"(kaddr), "i"(j * TSTRIDE + ks * 32));
    asm volatile("s_waitcnt lgkmcnt(0)" ::: "memory");
#pragma unroll
    for (int j = 0; j < NT; ++j)
#pragma unroll
        for (int ks = 0; ks < DQK / 16; ++ks) asm volatile("" : "+v"(a[j][ks]));
#pragma unroll
    for (int j = 0; j < NT; ++j) p[j] = init;
#pragma unroll
    for (int ks = 0; ks < DQK / 16; ++ks)
#pragma unroll
        for (int j = 0; j < NT; ++j) p[j] = mfma32(a[j][ks], qf[ks], p[j]);
}
template <int DV, int VP> DI void pv_tile(f32x16* o, const LAS char* vp, const f32x16& p, int h) {
#pragma unroll
    for (int s = 0; s < 2; ++s) {
        const bf16x8 pa = packp(p, s);
#pragma unroll
        for (int db = 0; db < DV / 32; ++db) {
            const s16x4 lo = vtr(vp + (16 * s + 4 * h) * VP + db * 64);
            const s16x4 hi = vtr(vp + (16 * s + 8 + 4 * h) * VP + db * 64);
            const bf16x8 vb = __builtin_shufflevector(lo, hi, 0, 1, 2, 3, 4, 5, 6, 7);
            o[db] = mfma32(pa, vb, o[db]);
        }
    }
}
template <int NDB> DI void scale_o(f32x16* o, float f, LAS float* sc, int r, int h) {
    if (h == 0) sc[r] = f;
    LDS_WAIT();
#pragma unroll
    for (int g = 0; g < 4; ++g) { const f32x4 f4 = *(const LAS f32x4*)(sc + 8 * g + 4 * h);
#pragma unroll
        for (int db = 0; db < NDB; ++db)
#pragma unroll
            for (int j = 0; j < 4; ++j) o[db][4 * g + j] *= f4[j]; }
    LDS_WAIT();
}
template <int NDB> DI void store_o(const f32x16* o, bf16_t* obase  , long rstride, int r, int h) {
#pragma unroll
    for (int i = 0; i < 16; ++i) { bf16_t* rp = obase + (long)crow(i, h) * rstride + r;
#pragma unroll
        for (int db = 0; db < NDB; ++db) rp[32 * db] = (bf16_t)(cvtpk(o[db][i], 0.f) & 0xffffu); }
}

constexpr int BKP = 144, BVP = 144;
constexpr int BSLOT = 256 * BKP + 256 * BVP;

DI void banded_load(LAS char* dst, int pitch, const bf16_t* src  , int ld, long row0  , int dil, int gi0, int tid) {
    u32x4 v[4];
#pragma unroll
    for (int it = 0; it < 4; ++it) {
        const int c = tid + it * NTHREADS, key = c >> 3, cc = c & 7, gi = gi0 + key, gic = gi < 0 ? 0 : gi;
        v[it] = *(const u32x4*)(src + (row0 + (long)gic * dil) * ld + cc * 8);
    }
#pragma unroll
    for (int it = 0; it < 4; ++it) {
        const int c = tid + it * NTHREADS, key = c >> 3, cc = c & 7, gi = gi0 + key;
        if (gi < 0) v[it] = (u32x4){0u, 0u, 0u, 0u};
        *(LAS u32x4*)(dst + key * pitch + cc * 16) = v[it];
    }
}
template <bool SINK, bool WANT_LSE>
DI void banded_task(const bf16_t* qrow  , bf16_t* obase, long rstride, const LAS char* Ks, const LAS char* Vs,
                    int wq, int jblk, int maxd, float sink2, float* lsep, LAS float* sc, int lane) {
    const int r = lane & 31, h = lane >> 5;
    bf16x8 qf[4];
#pragma unroll
    for (int ks = 0; ks < 4; ++ks) qf[ks] = *(const bf16x8*)(qrow + 16 * ks + 8 * h);
    f32x16 p[5];
    const f32x16 zero16 = splat16(0.f);
    { const unsigned ka = (unsigned)(uintptr_t)(Ks + (32 * wq + r) * BKP + 16 * h);
      st_tiles<64, 3, 32 * BKP>(ka, qf, zero16, p); st_tiles<64, 2, 32 * BKP>(ka + 96 * BKP, qf, zero16, p + 3); }
    const int tmin = (jblk == 0) ? 4 - wq : 0, lo = r + 128 - maxd;
#pragma unroll
    for (int t = 0; t < 5; ++t) {
        if (t < tmin) { p[t] = splat16(NEGBIG); }
        else if (t == 0) {
#pragma unroll
            for (int i = 0; i < 16; ++i) p[t][i] = (crow(i, h) >= lo) ? p[t][i] : NEGBIG;
        } else if (t == 4) {
#pragma unroll
            for (int i = 0; i < 16; ++i) p[t][i] = (crow(i, h) <= r) ? p[t][i] : NEGBIG;
        }
    }
    asm volatile("s_nop 15\n\ts_nop 7" : "+v"(p[0]), "+v"(p[1]), "+v"(p[2]), "+v"(p[3]), "+v"(p[4]));
    float mx = NEGBIG;
#pragma unroll
    for (int t = 0; t < 5; ++t)
#pragma unroll
        for (int i = 0; i < 16; i += 2) mx = max3f(mx, p[t][i], p[t][i + 1]);
    mx = xhalf_max(mx);
    if (SINK) mx = fmaxf(mx, sink2);
    float l;
    { const f32x16 mx16 = splat16(mx); f32x16 acc = splat16(0.f);
#pragma unroll
      for (int t = 0; t < 5; ++t) { p[t] = p[t] - mx16;
#pragma unroll
          for (int i = 0; i < 16; ++i) p[t][i] = __builtin_amdgcn_exp2f(p[t][i]);
          acc = acc + p[t]; }
      float a8[8];
#pragma unroll
      for (int i = 0; i < 8; ++i) a8[i] = acc[i] + acc[i + 8];
      l = ((a8[0] + a8[1]) + (a8[2] + a8[3])) + ((a8[4] + a8[5]) + (a8[6] + a8[7])); }
    l = xhalf_sum(l);
    if (SINK) l += __builtin_amdgcn_exp2f(sink2 - mx);
    f32x16 o[2];
#pragma unroll
    for (int i = 0; i < 16; ++i) { o[0][i] = 0.f; o[1][i] = 0.f; }
    const LAS char* vl = Vs + ((lane & 15) >> 2) * BVP + ((lane >> 4) & 1) * 32 + (lane & 3) * 8;
#pragma unroll
    for (int t = 0; t < 5; ++t) pv_tile<64, BVP>(o, vl + 32 * (wq + t) * BVP, p[t], h);
    scale_o<2>(o, 1.f / l, sc, r, h);
    store_o<2>(o, obase, rstride, r, h);
    if (WANT_LSE) { if (h == 0) *lsep = mx + __builtin_amdgcn_logf(l); }
}

template <int DQK, int DV, bool CAUSAL, bool SPLITK>
DI void dense_unit(const bf16_t* Q, int ldq, const bf16_t* K1, int ldk1, const bf16_t* K2, int ldk2, const bf16_t* V, int ldv, bf16_t* O, int ldo,
                   int q0  , int ntiles, LAS char* lds, LAS float* sc, int tid) {
    constexpr int KP = DQK * 2 + 16, VP = DV * 2 + 16, KCH = DQK / 8, VCH = DV / 8, NK = 64 * KCH, NCH = NK + 64 * VCH, NIT = (NCH + NTHREADS - 1) / NTHREADS;
    constexpr int KBUF = 64 * KP, VBUF = 64 * VP, TB = KBUF + VBUF;
    const int lane = tid & 63, w = __builtin_amdgcn_readfirstlane(tid >> 6), r = lane & 31, h = lane >> 5;
    LAS char* kb0 = lds; LAS char* vb0 = lds + KBUF;
    bf16x8 qf[DQK / 16];
    { const bf16_t* qr = Q + (long)(32 * w + r) * ldq;
#pragma unroll
      for (int ks = 0; ks < DQK / 16; ++ks) { qf[ks] = *(const bf16x8*)(qr + 16 * ks + 8 * h); asm volatile("" : "+v"(qf[ks])); } }
    int gb[NIT], gs[NIT], lo[NIT];
    if (SPLITK)
#pragma unroll
    for (int it = 0; it < NIT; ++it) { const int c = tid + it * NTHREADS;
        if (c < NK) { const int key = c / KCH, cc = c % KCH;
            if (SPLITK && cc >= 8) { gb[it] = (int)((const char*)K2 - (const char*)K1) + (key * ldk2 + (cc - 8) * 8) * 2; gs[it] = 64 * ldk2 * 2; }
            else { gb[it] = (key * ldk1 + cc * 8) * 2; gs[it] = 64 * ldk1 * 2; }
            lo[it] = key * KP + cc * 16; }
        else { const int c2 = (c < NCH ? c : NK) - NK, key = c2 / VCH, cc = c2 % VCH;
            gb[it] = (int)((const char*)V - (const char*)K1) + (key * ldv + cc * 8) * 2; gs[it] = 64 * ldv * 2; lo[it] = KBUF + key * VP + cc * 16; }
        asm volatile("" : "+v"(gb[it]), "+v"(gs[it]), "+v"(lo[it])); }
    u32x4 pre[NIT];
    auto gload = [&](int t) {
        if (SPLITK) {
#pragma unroll
            for (int it = 0; it < NIT; ++it) if ((it + 1) * NTHREADS <= NCH || tid + it * NTHREADS < NCH) pre[it] = *(const u32x4*)((const char*)K1 + (long)(gb[it] + t * gs[it]));
        } else {
            const int tid2 = opaque(tid);
#pragma unroll
            for (int it = 0; it < NIT; ++it) { const int c = tid2 + it * NTHREADS;
                if (c < NK) { const int key = c / KCH, cc = c % KCH; pre[it] = *(const u32x4*)(K1 + (long)(64 * t + key) * ldk1 + cc * 8); }
                else if (c < NCH) { const int c2 = c - NK, key = c2 / VCH, cc = c2 % VCH; pre[it] = *(const u32x4*)(V + (long)(64 * t + key) * ldv + cc * 8); } }
        }
    };
    auto lstore = [&](int b) {
        if (SPLITK) {
#pragma unroll
            for (int it = 0; it < NIT; ++it) if ((it + 1) * NTHREADS <= NCH || tid + it * NTHREADS < NCH) *(LAS u32x4*)(lds + b * TB + lo[it]) = pre[it];
        } else {
            const int tid2 = opaque(tid);
#pragma unroll
            for (int it = 0; it < NIT; ++it) { const int c = tid2 + it * NTHREADS;
                if (c < NK) { const int key = c / KCH, cc = c % KCH; *(LAS u32x4*)(kb0 + b * TB + key * KP + cc * 16) = pre[it]; }
                else if (c < NCH) { const int c2 = c - NK, key = c2 / VCH, cc = c2 % VCH; *(LAS u32x4*)(vb0 + b * TB + key * VP + cc * 16) = pre[it]; } }
        }
    };
    gload(0); lstore(0);
    __syncthreads();
    float m = 0.f, l = 0.f; bool first = true;
    f32x16 negm = splat16(0.f);
    f32x16 o[DV / 32];
#pragma unroll
    for (int db = 0; db < DV / 32; ++db)
#pragma unroll
        for (int i = 0; i < 16; ++i) o[db][i] = 0.f;
    const int qpos = q0 + 32 * w + r;
    for (int t = 0; t < ntiles; ++t) {
        const int b = t & 1;
        if (t + 1 < ntiles) gload(t + 1);
        if (!CAUSAL || 64 * t <= q0 + 32 * w) {
            const LAS char* kp = kb0 + b * TB + r * KP + 16 * h;
            f32x16 pp[2]; st_tiles<DQK, 2, 32 * KP>((unsigned)(uintptr_t)kp, qf, negm, pp);
            f32x16& p0 = pp[0]; f32x16& p1 = pp[1];
            if (CAUSAL && 64 * t + 63 > q0 + 32 * w) {
#pragma unroll
                for (int i = 0; i < 16; ++i) { const int key = 64 * t + crow(i, h); if (key > qpos) p0[i] = NEGBIG; if (key + 32 > qpos) p1[i] = NEGBIG; }
            }
            asm volatile("s_nop 15\n\ts_nop 7" : "+v"(p0), "+v"(p1));
            float mx = NEGBIG;
#pragma unroll
            for (int i = 0; i < 16; ++i) mx = max3f(mx, p0[i], p1[i]);
            mx = xhalf_max(mx);
            if (first || __any(mx > 8.f)) {
                const float dl = first ? mx : (mx > 8.f ? mx : 0.f);
                m += dl;
                const float f = __builtin_amdgcn_exp2f(-dl);
                l *= f;
#pragma unroll
                for (int i = 0; i < 16; ++i) { p0[i] -= dl; p1[i] -= dl; }
                if (!first) scale_o<DV / 32>(o, f, sc, r, h);
                negm = splat16(-m);
                first = false;
            }
#pragma unroll
            for (int i = 0; i < 16; ++i) { p0[i] = __builtin_amdgcn_exp2f(p0[i]); p1[i] = __builtin_amdgcn_exp2f(p1[i]); l += p0[i] + p1[i]; }
            const LAS char* vl = vb0 + b * TB + ((lane & 15) >> 2) * VP + ((lane >> 4) & 1) * 32 + (lane & 3) * 8;
            pv_tile<DV, VP>(o, vl, p0, h);
            pv_tile<DV, VP>(o, vl + 32 * VP, p1, h);
        }
        if (t + 1 < ntiles) lstore(b ^ 1);
        __syncthreads();
    }
    l = xhalf_sum(l);
    scale_o<DV / 32>(o, 1.f / l, sc, r, h);
    store_o<DV / 32>(o, O + (long)(32 * w) * ldo, ldo, r, h);
}


#define XB_TMO      128
#define XB_XCNT(j)  (256  + 64 * (j))
#define XB_XSUB(j)  (1280 + 64 * (j))
#define XB_XGEN(j)  (2304 + 64 * (j))
#define XB_TOP      3328
#define XB_TOPGEN   3392
#define XCD_BAR_WORDS 3456
#define XB_SPIN_CAP (1u << 22)
DI unsigned xb_ld(unsigned* p)              { return __hip_atomic_load(p, __ATOMIC_RELAXED, __HIP_MEMORY_SCOPE_AGENT); }
DI unsigned xb_add(unsigned* p, unsigned v) { return __hip_atomic_fetch_add(p, v, __ATOMIC_RELAXED, __HIP_MEMORY_SCOPE_AGENT); }
DI unsigned xb_xcc_id() { return (unsigned)__builtin_amdgcn_s_getreg((3 << 11) | 20) & 0xFu; }
#define XB_SPIN(cond, bar) do { unsigned _sp = 0; while (cond) { __builtin_amdgcn_s_sleep(1); \
    if ((++_sp & 255u) == 0u) { if (xb_ld(&(bar)[XB_TMO])) break; if (_sp > XB_SPIN_CAP) { atomicAdd(&(bar)[XB_TMO], 1u); break; } } } } while (0)
struct XcdBarrier { unsigned* bar; unsigned x; volatile LAS unsigned* st; };
DI XcdBarrier xcd_barrier_post(unsigned* bar, volatile LAS unsigned* st) {
    XcdBarrier b; b.bar = bar; b.x = xb_xcc_id(); b.st = st;
    if (threadIdx.x == 0) (void)xb_add(&bar[XB_XCNT(b.x)], 1u);
    return b;
}
DI void xcd_barrier_complete(unsigned* bar, unsigned x, unsigned& nloc, unsigned& nx) {
    const unsigned G = gridDim.x * gridDim.y * gridDim.z;
    unsigned sum, cnt, mine, sp = 0u;
    for (;;) {
        sum = 0u; cnt = 0u; mine = 0u;
#pragma unroll
        for (unsigned j = 0; j < 16; ++j) { const unsigned c = xb_ld(&bar[XB_XCNT(j)]); sum += c; cnt += (c > 0u) ? 1u : 0u; mine = (j == x) ? c : mine; }
        if (sum == G) break;
        __builtin_amdgcn_s_sleep(1);
        if ((++sp & 255u) == 0u) { if (xb_ld(&bar[XB_TMO])) break; if (sp > XB_SPIN_CAP) { atomicAdd(&bar[XB_TMO], 1u); break; } }
    }
    nloc = mine > 0u ? mine : 1u; nx = cnt > 0u ? cnt : 1u;
}
DI void xcd_barrier(unsigned* bar, unsigned x, volatile LAS unsigned* st) {
    asm volatile("s_waitcnt vmcnt(0)" ::: "memory");
    __syncthreads();
    if (threadIdx.x == 0) {
        __builtin_amdgcn_s_waitcnt(0);
        unsigned nloc = st[0], nx = st[1];
        if (nloc == 0u) { xcd_barrier_complete(bar, x, nloc, nx); st[0] = nloc; st[1] = nx; }
        const unsigned old = xb_add(&bar[XB_XSUB(x)], 1u);
        const unsigned gen = old / nloc;
        if (old + 1u == (gen + 1u) * nloc) {
            __builtin_amdgcn_fence(__ATOMIC_RELEASE, "agent");
            asm volatile("s_waitcnt vmcnt(0)" ::: "memory");
            const unsigned og = xb_add(&bar[XB_TOP], 1u);
            const unsigned tg = og / nx;
            if (og + 1u == (tg + 1u) * nx) xb_add(&bar[XB_TOPGEN], 1u);
            else XB_SPIN(xb_ld(&bar[XB_TOPGEN]) == tg, bar);
            __builtin_amdgcn_fence(__ATOMIC_ACQUIRE, "agent");
            xb_add(&bar[XB_XGEN(x)], 1u);
            asm volatile("s_waitcnt vmcnt(0)" ::: "memory");
        } else {
            XB_SPIN(xb_ld(&bar[XB_XGEN(x)]) == gen, bar);
            __builtin_amdgcn_fence(__ATOMIC_ACQUIRE, "agent");
            asm volatile("s_waitcnt vmcnt(0)" ::: "memory");
        }
    }
    __syncthreads();
}

DI void sincos_acc(float ang, float& c, float& s) {
    const double x = (double)ang;
    const double n = __builtin_rint(x * 0.63661977236758134308);
    double rr = __builtin_fma(-n, 1.57079632679489655800e+00, x); rr = __builtin_fma(-n, 6.12323399573676603587e-17, rr);
    const double r2 = rr * rr;
    const double sn = rr * (1.0 + r2 * (-1.0 / 6 + r2 * (1.0 / 120 + r2 * (-1.0 / 5040 + r2 * (1.0 / 362880 + r2 * (-1.0 / 39916800 + r2 * (1.0 / 6227020800.0)))))));
    const double cs = 1.0 + r2 * (-0.5 + r2 * (1.0 / 24 + r2 * (-1.0 / 720 + r2 * (1.0 / 40320 + r2 * (-1.0 / 3628800 + r2 * (1.0 / 479001600.0))))));
    const int q = ((int)n) & 3;
    const double cc = (q == 0) ? cs : (q == 1) ? -sn : (q == 2) ? -cs : sn;
    const double ss = (q == 0) ? sn : (q == 1) ? cs : (q == 2) ? -sn : -cs;
    c = (float)cc; s = (float)ss;
}

#ifndef PH
#define PH 255
#endif
#ifndef REP_P1
#define REP_P1 1
#endif
#ifndef REP_B
#define REP_B 1
#endif
#ifndef REP_CONV
#define REP_CONV 1
#endif
#ifndef REP_P7
#define REP_P7 1
#endif
#define GRID_SYNC() do { CParams* qb_ = fresh_params(); xcd_barrier((unsigned*)(qb_->ws + WS_CTL), xcc, MISC); } while (0)

__global__ void __launch_bounds__(NTHREADS, 2) fwd_megakernel(Params p) {
    extern __shared__ __attribute__((aligned(16))) unsigned char lds_raw[];
    cg::grid_group grid = cg::this_grid();
    LAS unsigned char* lds = (LAS unsigned char*)lds_raw;
    const int wave = __builtin_amdgcn_readfirstlane((int)threadIdx.x >> 6);
    const int G = gridDim.x, bid = blockIdx.x;
    const int gw = bid * NWAVES + wave, NGW = G * NWAVES;
    LAS float* sc = (LAS float*)(lds + LDS_SCR) + wave * 64;
    volatile LAS unsigned* MISC = (volatile LAS unsigned*)(lds + LDS_SCR + 2048);
    if (threadIdx.x < 4) MISC[threadIdx.x] = 0u;
    __syncthreads();
    unsigned xcc;
    { CParams* q0 = fresh_params(); const XcdBarrier xb = xcd_barrier_post((unsigned*)(q0->ws + WS_CTL), MISC); xcc = xb.x; }

#ifndef NOPRO
    {
        PHASE_CTX
        float* COSH = (float*)(ws + WS_COSH); float* SINH = (float*)(ws + WS_SINH); float* COSR = (float*)(ws + WS_COSR); float* SINR = (float*)(ws + WS_SINR);
        const float* x = q->in[0]; const int* pos = (const int*)q->in[2];
        const int lane = lane_id(), tid = wave * 64 + lane;
        for (int i = bid * NTHREADS + tid; i < TT * 32; i += G * NTHREADS) { const int t = i >> 5, k = i & 31; float c, s; sincos_acc((float)pos[t] * q->inv_h[k], c, s); COSH[i] = c; SINH[i] = s; }
        for (int i = bid * NTHREADS + tid; i < TT * 16; i += G * NTHREADS) { const int t = i >> 4, k = i & 15; float c, s; sincos_acc((float)pos[t] * q->inv_r[k], c, s); COSR[i] = c; SINR[i] = s; }
        for (int row = gw; row < TT; row += NGW) {
            const f32x4* xr = (const f32x4*)(x + (size_t)row * D) + lane; float ss = 0.f;
            u32x2* o8 = (u32x2*)(XB + (size_t)row * D) + lane;
#pragma unroll
            for (int j = 0; j < 4; ++j) { const f32x4 v = xr[64 * j]; ss += (v.x * v.x + v.y * v.y) + (v.z * v.z + v.w * v.w); u32x2 w; w.x = cvtpk(v.x, v.y); w.y = cvtpk(v.z, v.w); o8[64 * j] = w; }
            ss = wave_sum(ss);
            if (lane < 16) PX[(size_t)row * 16 + lane] = lane == 0 ? ss : 0.f;
        }
        const float* mem = q->in[1]; bf16_t* MEMN = (bf16_t*)(ws + WS_MEMN);
        for (int row = gw; row < BATCH * NMEM; row += NGW) {
            const f32x4* xr = (const f32x4*)(mem + (size_t)row * D) + lane; f32x4 v[4]; float ss = 0.f;
#pragma unroll
            for (int j = 0; j < 4; ++j) { v[j] = xr[64 * j]; ss += (v[j].x * v[j].x + v[j].y * v[j].y) + (v[j].z * v[j].z + v[j].w * v[j].w); }
            const float rstd = __builtin_amdgcn_rsqf(wave_sum(ss) * (1.f / D) + EPS);
            u32x2* o8 = (u32x2*)(MEMN + (size_t)row * D) + lane;
#pragma unroll
            for (int j = 0; j < 4; ++j) { u32x2 w; w.x = cvtpk(v[j].x * rstd, v[j].y * rstd); w.y = cvtpk(v[j].z * rstd, v[j].w * rstd); o8[64 * j] = w; }
        }
    }

#endif
    for (int l = 0; l < DEPTH; ++l) {
#ifndef NOCONV
#pragma unroll 1
        for (int rep = 0; rep < REP_CONV; ++rep) convert_layer(l, lds, gw, NGW, wave);
#endif
        if (l == 0) grid.sync(); else GRID_SYNC();
        for (int ch = 0; ch < NCHUNK; ++ch) {
            const int tok0 = ch * TC;
#if PH & 1
            {
                PHASE_CTX
                pg8::TileOrder S; S.init(TC, NT_IN, G, bid, XB + (size_t)tok0 * D, (const bf16_t*)(ws + WS_WIN));
                EpiSlot<CfgIn> E{CfgIn{ws, q->in[6] + l * 64, q->in[7] + l * 64, q->in[14] + l * 96, q->in[15] + l * 192, q->in[16] + l * 192, q->in[5] + l * 4096},
                                 RowScale{PX, 16, 16, 1.f / D}, tok0, rt, tok0};
#pragma unroll 1
                for (int rep = 0; rep < REP_P1; ++rep) pg8::gemm_phase(lds, D, D, S, E, wave);
                if (ch == 0) {
                    pg8::TileOrder S2; S2.init(BATCH * NMEM, 1024, G, (bid + 128) % G, (const bf16_t*)(ws + WS_MEMN), (const bf16_t*)(ws + WS_WMKV));
                    EpiSlot<CfgMkv> E2{CfgMkv{ws}, RowScale{nullptr, 0, 0, 0.f}, 0, rt, 0};
                    pg8::gemm_phase(lds, D, D, S2, E2, wave);
                }
            }

#endif
            GRID_SYNC();
#if PH & 2
            {
                PHASE_CTX
                pg8::TileOrder S; S.init(TC, 1024, G, bid, (const bf16_t*)(ws + WS_CQ), (const bf16_t*)(ws + WS_WUQ));
                EpiSlot<CfgUq> E{CfgUq{ws, q->in[13] + l * 96}, RowScale{(const float*)(ws + WS_PCQ), 8, 6, 1.f / 384.f}, 0, rt, tok0};
                pg8::gemm_phase(lds, 384, 384, S, E, wave);
                pg8::TileOrder S2; S2.init(TC, 1024, G, bid, (const bf16_t*)(ws + WS_CKV), (const bf16_t*)(ws + WS_WUKV));
                EpiSlot<CfgUkv> E2{CfgUkv{ws, q->in[14] + l * 96}, RowScale{(const float*)(ws + WS_PCKV), 4, 4, 1.f / 256.f}, 0, rt, tok0};
                pg8::gemm_phase(lds, 256, 256, S2, E2, wave);
                const int lane = opaque(lane_id());
                const int nrows = TC + (ch == 0 ? BATCH * NMEM : 0);
                for (int rw = gw; rw < nrows; rw += NGW) {
                    const bool isq = rw < TC;
                    bf16_t* rp = isq ? (bf16_t*)(ws + WS_MQ) + (size_t)rw * 512 : (bf16_t*)(ws + WS_MK) + (size_t)(rw - TC) * 512;
                    const float* gn = (isq ? q->in[19] : q->in[20]) + l * 128 + (lane & 15) * 8;
                    const float scl = isq ? 0.08838834764831845f * LOG2E : 1.f;
                    float v[8]; unpack8(*(const u32x4*)(rp + lane * 8), v);
                    float ss = 0.f;
#pragma unroll
                    for (int i = 0; i < 8; ++i) ss += v[i] * v[i];
                    ss += __shfl_xor(ss, 1); ss += __shfl_xor(ss, 2); ss += __shfl_xor(ss, 4); ss += __shfl_xor(ss, 8);
                    const float inv = __builtin_amdgcn_rsqf(ss * (1.f / 128.f) + EPS) * scl;
#pragma unroll
                    for (int i = 0; i < 8; ++i) v[i] *= inv * gn[i];
                    *(u32x4*)(rp + lane * 8) = pack8(v);
                }
            }

#endif
            GRID_SYNC();
#if PH & 4
            {
                PHASE_CTX
                LAS char* al = (LAS char*)lds;
                const int lane = opaque(lane_id()), tid = wave * 64 + lane;
#pragma unroll 1
                for (int rep = 0; rep < REP_B; ++rep)
                for (int idx = bid; idx < BC * 8 * 16; idx += G) {
                    const int half = idx / (BC * 64), rem = idx % (BC * 64), bh = rem / 8, s = rem % 8;
                    const int qb = half == 0 ? s : 15 - s, b = bh / 8, hh = bh % 8;
                    const long r0 = (long)b * SEQ;
                    dense_unit<96, 64, true, true>((const bf16_t*)(ws + WS_QB) + (r0 + 256 * qb) * 768 + 96 * hh, 768,
                        (const bf16_t*)(ws + WS_KN) + r0 * 512 + 64 * hh, 512, (const bf16_t*)(ws + WS_KR) + r0 * 32, 32,
                        (const bf16_t*)(ws + WS_VB) + r0 * 512 + 64 * hh, 512, (bf16_t*)(ws + WS_OB) + (r0 + 256 * qb) * 512 + 64 * hh, 512,
                        256 * qb, 4 * (qb + 1), al, sc, tid);
                }
                for (int idx = bid; idx < 3 * BC * 32 * 4; idx += G) {
                    const int g = idx / (BC * 128), rem = idx % (BC * 128), hp = rem & 3, sj = rem >> 2;
                    const int dil = g == 0 ? 1 : g == 1 ? 4 : 16, nb = 32 / dil;
                    const int n = sj / nb, j = sj % nb, b = n / dil, res = n % dil;
                    const long row0 = (long)b * SEQ + res;
                    const bf16_t* Qg = (const bf16_t*)(ws + WS_CB + (size_t)(3 * g) * 16 * MiB); const bf16_t* Kg = (const bf16_t*)(ws + WS_CB + (size_t)(3 * g + 1) * 16 * MiB); const bf16_t* Vg = (const bf16_t*)(ws + WS_CB + (size_t)(3 * g + 2) * 16 * MiB);
#pragma unroll
                    for (int sl = 0; sl < 2; ++sl) {
                        banded_load(al + sl * BSLOT, BKP, Kg + 64 * (2 * hp + sl), 512, row0, dil, 128 * (j - 1), tid);
                        banded_load(al + sl * BSLOT + 256 * BKP, BVP, Vg + 64 * (2 * hp + sl), 512, row0, dil, 128 * (j - 1), tid);
                    }
                    __syncthreads();
                    { const int sl = wave >> 2, wq = wave & 3, hd = 2 * hp + sl, r = lane & 31;
                      const long qtok = row0 + (long)(128 * j + 32 * wq + r) * dil;
                      bf16_t* ob = (bf16_t*)Qg + (row0 + (long)(128 * j + 32 * wq) * dil) * 512 + 64 * hd;
                      banded_task<false, true>(Qg + qtok * 512 + 64 * hd, ob, (long)dil * 512, al + sl * BSLOT, al + sl * BSLOT + 256 * BKP, wq, j, 128, 0.f,
                                               (float*)(ws + WS_LSE) + (qtok * 8 + hd) * 4 + g, sc, lane); }
                    __syncthreads();
                }
                for (int idx = bid; idx < BC * 32 * 2; idx += G) {
                    const int kvh = idx & 1, j = (idx >> 1) & 31, b = idx >> 6;
                    const long row0 = (long)b * SEQ;
                    banded_load(al, BKP, (const bf16_t*)(ws + WS_KA) + 64 * kvh, 128, row0, 1, 128 * (j - 1), tid);
                    banded_load(al + 256 * BKP, BVP, (const bf16_t*)(ws + WS_VA) + 64 * kvh, 128, row0, 1, 128 * (j - 1), tid);
                    __syncthreads();
#pragma unroll 1
                    for (int pass = 0; pass < 2; ++pass) {
                        const int hq = kvh * 4 + (wave >> 2) + 2 * pass, wq = wave & 3, r = lane & 31;
                        const long qtok = row0 + 128 * j + 32 * wq + r;
                        bf16_t* QA = (bf16_t*)(ws + WS_QA);
                        banded_task<true, false>(QA + qtok * 512 + 64 * hq, QA + (row0 + 128 * j + 32 * wq) * 512 + 64 * hq, 512, al, al + 256 * BKP, wq, j, 127,
                                                 (q->in[8] + l * 8)[hq] * LOG2E, nullptr, sc, lane);
                    }
                    __syncthreads();
                }
                for (int idx = bid; idx < BC * 4 * 16; idx += G) {
                    const int qb = idx & 15, hh = (idx >> 4) & 3, b = idx >> 6;
                    const long r0 = (long)b * SEQ + 256 * qb; const long m0 = (long)(ch * BC + b) * NMEM;
                    bf16_t* MQ = (bf16_t*)(ws + WS_MQ);
                    dense_unit<128, 128, false, false>(MQ + r0 * 512 + 128 * hh, 512, (const bf16_t*)(ws + WS_MK) + m0 * 512 + 128 * hh, 512, nullptr, 0,
                        (const bf16_t*)(ws + WS_MV) + m0 * 512 + 128 * hh, 512, MQ + r0 * 512 + 128 * hh, 512, 0, 4, al, sc, tid);
                }
            }

#endif
            GRID_SYNC();
#if PH & 8
            {
                PHASE_CTX
                const float* LSE = (const float*)(ws + WS_LSE); bf16_t* OC = (bf16_t*)(ws + WS_OC);
                const int tid = wave * 64 + opaque(lane_id());
                for (int i = bid * NTHREADS + tid; i < TC * 64; i += G * NTHREADS) {
                    const int tok = i >> 6, c8 = i & 63, hd = c8 >> 3;
                    const f32x4 ls = *(const f32x4*)(LSE + ((size_t)tok * 8 + hd) * 4);
                    const float mx = fmaxf(ls.x, fmaxf(ls.y, ls.z));
                    float w0 = __builtin_amdgcn_exp2f(ls.x - mx), w1 = __builtin_amdgcn_exp2f(ls.y - mx), w2 = __builtin_amdgcn_exp2f(ls.z - mx);
                    const float inv = 1.f / (w0 + w1 + w2); w0 *= inv; w1 *= inv; w2 *= inv;
                    float a[8], b[8], c[8], o[8];
                    unpack8(*(const u32x4*)((const bf16_t*)(ws + WS_CB) + (size_t)tok * 512 + c8 * 8), a);
                    unpack8(*(const u32x4*)((const bf16_t*)(ws + WS_CB + 48 * MiB) + (size_t)tok * 512 + c8 * 8), b);
                    unpack8(*(const u32x4*)((const bf16_t*)(ws + WS_CB + 96 * MiB) + (size_t)tok * 512 + c8 * 8), c);
#pragma unroll
                    for (int k = 0; k < 8; ++k) o[k] = w0 * a[k] + w1 * b[k] + w2 * c[k];
                    *(u32x4*)(OC + (size_t)tok * 512 + c8 * 8) = pack8(o);
                }
            }

#endif
            GRID_SYNC();
#if PH & 16
            {
                PHASE_CTX
                pg8::TileOrder S; S.init(TC, D, G, bid, (const bf16_t*)(ws + WS_QA), (const bf16_t*)(ws + WS_WBR)); S.nseg = 4;
                S.segA = 8 * MiB; S.segB = (size_t)D * 512;
                EpiMerge E{(const bf16_t*)(ws + WS_GATES), (bf16_t*)(ws + WS_GY) + (size_t)tok0 * D};
                pg8::gemm_phase(lds, 512, 512, S, E, wave);
            }

#endif
            GRID_SYNC();
        }
        {
            const int tok0 = 0;
#if PH & 32
            {
                PHASE_CTX
                pg8::TileOrder S; S.init(TT, D, G, bid, (const bf16_t*)(ws + WS_GY), (const bf16_t*)(ws + WS_WOUT));
                EpiRes E{((l == 0) ? q->in[0] : q->out) + (size_t)tok0 * D, q->out + (size_t)tok0 * D, XB + (size_t)tok0 * D, PX + (size_t)tok0 * 16};
                pg8::gemm_phase(lds, D, D, S, E, wave);
            }

#endif
            GRID_SYNC();
#if PH & 64
            {
                PHASE_CTX
                pg8::TileOrder S; S.init(TT, DFF, G, bid, XB + (size_t)tok0 * D, (const bf16_t*)(ws + WS_WUP));
                EpiUp E{(bf16_t*)(ws + WS_U), RowScale{PX, 16, 16, 1.f / D}, tok0};
#pragma unroll 1
                for (int rep = 0; rep < REP_P7; ++rep) pg8::gemm_phase(lds, D, D, S, E, wave);
            }

#endif
            GRID_SYNC();
#if PH & 128
            {
                PHASE_CTX
                pg8::TileOrder S; S.init(TT, D, G, bid, (const bf16_t*)(ws + WS_U), (const bf16_t*)(ws + WS_WDN));
                EpiRes E{q->out + (size_t)tok0 * D, q->out + (size_t)tok0 * D, XB + (size_t)tok0 * D, PX + (size_t)tok0 * 16};
                pg8::gemm_phase(lds, DFF, DFF, S, E, wave);
            }

#endif
            GRID_SYNC();
        }
    }
}

extern "C" void kernel_launch(void* const* d_in, const int* in_sizes, int n_in, void* d_out, int out_size, void* d_ws, size_t ws_size, hipStream_t stream) {
    static int grid = 0;
    if (grid == 0) {
        if (n_in != 26 || out_size != TT * D || ws_size < WS_END) { fprintf(stderr, "kernel_launch: unexpected shapes (n_in %d out %d ws %zu)\n", n_in, out_size, ws_size); grid = -1; return; }
        int dev = 0, cus = 0, per_cu = 0;
        hipGetDevice(&dev); hipDeviceGetAttribute(&cus, hipDeviceAttributeMultiprocessorCount, dev);
        hipFuncSetAttribute((const void*)fwd_megakernel, hipFuncAttributeMaxDynamicSharedMemorySize, LDS_BYTES);
        hipOccupancyMaxActiveBlocksPerMultiprocessor(&per_cu, (const void*)fwd_megakernel, NTHREADS, LDS_BYTES);
        if (per_cu < 1) { fprintf(stderr, "kernel_launch: occupancy query says %d blocks per CU\n", per_cu); per_cu = 1; }
        (void)hipGetLastError();
        grid = cus;
    }
    if (grid < 0) return;
    if (hipMemsetAsync((char*)d_ws + WS_CTL, 0, XCD_BAR_WORDS * 4, stream) != hipSuccess) { fprintf(stderr, "kernel_launch: memset failed\n"); return; }
    Params p{};
    for (int i = 0; i < 26; ++i) p.in[i] = (const float*)d_in[i];
    p.out = (float*)d_out; p.ws = (unsigned char*)d_ws;
    for (int i = 0; i < 32; ++i) p.inv_h[i] = (float)std::pow(10000.0, -(double)(2 * i) / 64.0);
    for (int i = 0; i < 16; ++i) p.inv_r[i] = (float)std::pow(10000.0, -(double)(2 * i) / 32.0);
    void* args[] = {&p};
    hipError_t e = hipLaunchCooperativeKernel((const void*)fwd_megakernel, dim3(grid), dim3(NTHREADS), args, LDS_BYTES, stream);
    if (e != hipSuccess) fprintf(stderr, "cooperative launch failed: %s (grid %d)\n", hipGetErrorString(e), grid);
}
```

```cpp
#include <hip/hip_runtime.h>
#include <hip/hip_cooperative_groups.h>
#include <cstdio>
#include <cstdint>
#include <cmath>
namespace cg = cooperative_groups;

#define LAS __attribute__((address_space(3)))
#define DI __device__ __forceinline__
typedef unsigned short bf16_t;
typedef short bf16x8 __attribute__((ext_vector_type(8)));
typedef short s16x4 __attribute__((ext_vector_type(4)));
typedef float f32x4 __attribute__((ext_vector_type(4)));
typedef float f32x16 __attribute__((ext_vector_type(16)));
typedef unsigned u32x4 __attribute__((ext_vector_type(4)));
typedef unsigned u32x2 __attribute__((ext_vector_type(2)));
typedef float f32x2_t __attribute__((ext_vector_type(2)));
typedef __bf16 bf16x2_t __attribute__((ext_vector_type(2)));

constexpr int D = 1024, BATCH = 8, SEQ = 4096, DEPTH = 4, TT = BATCH * SEQ;
constexpr int NCHUNK = 2, BC = BATCH / NCHUNK, TC = BC * SEQ;
constexpr int N_IN = 10656, NT_IN = 10752;
constexpr int DFF = 4096, NMEM = 256;
constexpr float EPS = 1e-6f;
constexpr float LOG2E = 1.4426950408889634f;
constexpr float NEGBIG = -1e30f;
constexpr int NTHREADS = 512, NWAVES = 8;

constexpr size_t MiB = 1u << 20;
constexpr size_t WS_CTL = 0;
constexpr size_t WS_WIN = 1 * MiB, WS_WUQ = 22 * MiB, WS_WUKV = 23 * MiB, WS_WMKV = 24 * MiB, WS_WBR = 26 * MiB, WS_WOUT = 30 * MiB, WS_WUP = 32 * MiB, WS_WDN = 40 * MiB;
constexpr size_t WS_XB = 48 * MiB, WS_PX = 112 * MiB, WS_COSH = 114 * MiB, WS_SINH = 118 * MiB, WS_COSR = 122 * MiB, WS_SINR = 124 * MiB;
constexpr size_t WS_MEMN = 126 * MiB, WS_MK = 130 * MiB, WS_MV = 132 * MiB;
constexpr size_t WS_QA = 134 * MiB, WS_OB = 150 * MiB, WS_OC = 166 * MiB, WS_MQ = 182 * MiB;
constexpr size_t WS_KA = 198 * MiB, WS_VA = 202 * MiB, WS_CQ = 206 * MiB, WS_CKV = 218 * MiB, WS_KR = 226 * MiB, WS_PCQ = 227 * MiB, WS_PCKV = 227 * MiB + 512 * 1024;
constexpr size_t WS_CB = 228 * MiB;
constexpr size_t WS_GATES = 372 * MiB, WS_U = WS_CB;
constexpr size_t WS_QB = 500 * MiB, WS_KN = 524 * MiB, WS_VB = 540 * MiB, WS_LSE = 556 * MiB, WS_GY = 558 * MiB;
constexpr size_t WS_END = 622 * MiB;

constexpr int LDS_BYTES = 155648;
constexpr int LDS_SCR = 149504;

struct Params {
    const float* in[26];
    float* out;
    unsigned char* ws;
    float inv_h[32];
    float inv_r[16];
    int pad[2];
};

DI unsigned cvtpk(float lo, float hi) { f32x2_t v = {lo, hi}; bf16x2_t b = __builtin_convertvector(v, bf16x2_t); return __builtin_bit_cast(unsigned, b); }
DI float bf_lo(unsigned w) { return __uint_as_float(w << 16); }
DI float bf_hi(unsigned w) { return __uint_as_float(w & 0xffff0000u); }
DI u32x4 pack8(const float* v) { u32x4 w; w.x = cvtpk(v[0], v[1]); w.y = cvtpk(v[2], v[3]); w.z = cvtpk(v[4], v[5]); w.w = cvtpk(v[6], v[7]); return w; }
DI void unpack8(u32x4 w, float* v) { v[0] = bf_lo(w.x); v[1] = bf_hi(w.x); v[2] = bf_lo(w.y); v[3] = bf_hi(w.y); v[4] = bf_lo(w.z); v[5] = bf_hi(w.z); v[6] = bf_lo(w.w); v[7] = bf_hi(w.w); }
DI float wave_sum(float v) {
#pragma unroll
    for (int o = 1; o < 64; o <<= 1) v += __shfl_xor(v, o);
    return v;
}
struct RopeTabs { const float* cosh; const float* sinh; const float* cosr; const float* sinr; };
typedef const struct Params __attribute__((address_space(4))) CParams;
DI CParams* fresh_params() { unsigned long long k = (unsigned long long)__builtin_amdgcn_kernarg_segment_ptr(); asm volatile("" : "+s"(k)); return (CParams*)k; }
#define PHASE_CTX \
    CParams* q = fresh_params(); unsigned char* ws = q->ws; (void)ws; \
    bf16_t* XB = (bf16_t*)(ws + WS_XB); float* PX = (float*)(ws + WS_PX); (void)XB; (void)PX; \
    const RopeTabs rt{(const float*)(ws + WS_COSH), (const float*)(ws + WS_SINH), (const float*)(ws + WS_COSR), (const float*)(ws + WS_SINR)}; (void)rt;
DI int opaque(int v) { asm volatile("" : "+v"(v)); return v; }
DI int lane_id() { int v; asm volatile("v_mbcnt_lo_u32_b32 %0, -1, 0\n\tv_mbcnt_hi_u32_b32 %0, -1, %0" : "=v"(v)); return v; }
#define LDS_WAIT() asm volatile("s_waitcnt lgkmcnt(0)" ::: "memory")

namespace pg8 {
constexpr int BM = 256, BK = 64, HALF = 128, HTB = HALF * BK * 2, STAGE_BYTES = 8 * HTB, NXCD = 8, WGM = 8;
DI int lds_byte(int r, int c) { const int st = (r >> 4) * 2 + (c >> 5), rr = r & 15, cc = c & 31, ob = rr * 64 + cc * 2; return st * 1024 + (ob ^ (((ob >> 9) & 1) << 5)); }
DI void stage_rc(int b, int& R, int& C) { const int st = b / 1024, sb = b % 1024, swz = sb ^ (((sb >> 9) & 1) << 5); R = (st >> 1) * 16 + swz / 64; C = (st & 1) * 32 + (swz % 64) / 2; }
DI int perm32(int rho) { const int n = rho >> 4, i = rho & 15; return 8 * (i >> 2) + 4 * n + (i & 3); }

struct Unit { int pm, pn, seg; const bf16_t* A; const bf16_t* Bt; };

struct TileOrder {
    int nM, nN, nwg, G, c, nseg;
    const bf16_t* A0; const bf16_t* B0; size_t segA, segB;
    DI void init(int M, int N, int G_, int c_, const bf16_t* A, const bf16_t* B) { nM = M / BM; nN = N / BM; nwg = nM * nN; G = G_; c = c_; nseg = 1; A0 = A; B0 = B; segA = 0; segB = 0; }
    DI bool next(int i, Unit& u) const {
        const int seg = i % nseg, ti = i / nseg;
        const long L = (long)ti * G + c; if (L >= nwg) return false;
        int wgid = (int)L; { const int q = nwg / NXCD, r = nwg % NXCD, xcd = wgid % NXCD, off = wgid / NXCD; wgid = (xcd < r ? xcd * (q + 1) : r * (q + 1) + (xcd - r) * q) + off; }
        const int nig = WGM * nN, gid = wgid / nig, fm = gid * WGM, gsz = (nM - fm) < WGM ? (nM - fm) : WGM;
        u.pm = fm + ((wgid % nig) % gsz); u.pn = (wgid % nig) / gsz; u.seg = seg;
        u.A = A0 + (size_t)seg * segA; u.Bt = B0 + (size_t)seg * segB;
        return true;
    }
};

template <class Epi, class Sched>
DI void gemm_phase(LAS unsigned char* lds, const int K, const int lda, const Sched& S, const Epi& E, const int wid) {
    const int lane = opaque(lane_id()), tid = wid * 64 + lane, wr = wid >> 2, wc = wid & 3, fr = lane & 15, fq = lane >> 4;
    const int nt = K / BK;
    unsigned voffA[2], voffB[2];
#pragma unroll
    for (int i = 0; i < 2; ++i) { int R, C; stage_rc(tid * 16 + i * 8192, R, C); const int Rb = (R & ~31) + perm32(R & 31);
        voffA[i] = (unsigned)(R * lda + C) * 2u; voffB[i] = (unsigned)(Rb * K + C) * 2u; }
    const size_t kstep = (size_t)(BK * 2);
    const size_t hstepA = (size_t)HALF * lda * 2, hstepB = (size_t)HALF * K * 2;
    const size_t tstepA = 2 * hstepA, tstepB = 2 * hstepB;
    const unsigned ldsw = (unsigned)wid * 1024u;
    const int aoff = lds_byte(wr * 64 + fr, fq * 8), boff = lds_byte(wc * 32 + fr, fq * 8);
#define PG8_SA(b, h) (((b) * 2 + (h)) * HTB)
#define PG8_SB(b, h) ((4 + (b) * 2 + (h)) * HTB)
#define PG8_STAGE(bufoff, gbase, voff) do { _Pragma("unroll") for (int _i = 0; _i < 2; ++_i) \
        __builtin_amdgcn_global_load_lds((const unsigned*)((const char*)(gbase) + (voff)[_i]), (LAS unsigned*)(lds + (bufoff) + ldsw + _i * 8192), 16, 0, 0); } while (0)
#define PG8_LDA(dst, b, h) do { _Pragma("unroll") for (int m = 0; m < 4; ++m) _Pragma("unroll") for (int k = 0; k < 2; ++k) dst[m][k] = *(const LAS bf16x8*)(lds + PG8_SA(b, h) + aoff + m * 2048 + k * 1024); } while (0)
#define PG8_LDB(dst, b, h) do { _Pragma("unroll") for (int n = 0; n < 2; ++n) _Pragma("unroll") for (int k = 0; k < 2; ++k) dst[n][k] = *(const LAS bf16x8*)(lds + PG8_SB(b, h) + boff + n * 2048 + k * 1024); } while (0)
#define PG8_MMA(ai, bj, At, Bt) do { __builtin_amdgcn_s_setprio(1); _Pragma("unroll") for (int m = 0; m < 4; ++m) _Pragma("unroll") for (int n = 0; n < 2; ++n) _Pragma("unroll") for (int k = 0; k < 2; ++k) \
        acc[ai][bj][m][n] = __builtin_amdgcn_mfma_f32_16x16x32_bf16(Bt[n][k], At[m][k], acc[ai][bj][m][n], 0, 0, 0); __builtin_amdgcn_s_setprio(0); } while (0)
#define PG8_WAIT_V(n) asm volatile("s_waitcnt vmcnt(" #n ")" ::: "memory")
#define PG8_WAIT_L(n) asm volatile("s_waitcnt lgkmcnt(" #n ")" ::: "memory")
#define PG8_BAR __builtin_amdgcn_s_barrier()
#define PG8_SCHED __builtin_amdgcn_sched_barrier(0)
    Unit cur, nxt; int ui = 0;
    if (!S.next(0, cur)) return;
    f32x4 acc[2][2][4][2];
#pragma unroll
    for (int a = 0; a < 2; ++a)
#pragma unroll
        for (int b = 0; b < 2; ++b)
#pragma unroll
            for (int m = 0; m < 4; ++m)
#pragma unroll
                for (int n = 0; n < 2; ++n) acc[a][b][m][n] = (f32x4){0.f, 0.f, 0.f, 0.f};
    bf16x8 At[4][2], B0[2][2], B1[2][2];
    const char* cA = (const char*)cur.A + (size_t)cur.pm * tstepA; const char* cB = (const char*)cur.Bt + (size_t)cur.pn * tstepB;
    PG8_STAGE(PG8_SB(0, 0), cB, voffB); PG8_STAGE(PG8_SB(0, 1), cB + hstepB, voffB); PG8_STAGE(PG8_SA(0, 0), cA, voffA); PG8_STAGE(PG8_SA(0, 1), cA + hstepA, voffA);
    if (wr == 1) PG8_BAR;
    PG8_WAIT_V(2); PG8_BAR;
    PG8_STAGE(PG8_SB(1, 0), cB + kstep, voffB); PG8_STAGE(PG8_SA(1, 0), cA + kstep, voffA); PG8_STAGE(PG8_SB(1, 1), cB + hstepB + kstep, voffB);
    PG8_WAIT_V(6); PG8_BAR;
    for (;;) {
        const bool has_next = S.next(ui + 1, nxt);
        const char* nA = has_next ? (const char*)nxt.A + (size_t)nxt.pm * tstepA : cA; const char* nB = has_next ? (const char*)nxt.Bt + (size_t)nxt.pn * tstepB : cB;
#pragma unroll 1
        for (int t = 0; t < nt; t += 2) {
            const bool last = (t == nt - 2);
            const char* a1 = cA + (size_t)(t + 1) * kstep;
            const char* a2 = last ? nA : cA + (size_t)(t + 2) * kstep; const char* b2 = last ? nB : cB + (size_t)(t + 2) * kstep;
            const char* a3 = a2 + kstep; const char* b3 = b2 + kstep;
            PG8_LDB(B0, 0, 0); PG8_LDB(B1, 0, 1); PG8_SCHED; PG8_LDA(At, 0, 0); PG8_STAGE(PG8_SA(1, 1), a1 + hstepA, voffA);
            PG8_WAIT_V(8); PG8_WAIT_L(0); PG8_BAR; PG8_MMA(0, 0, At, B0); PG8_MMA(0, 1, At, B1); PG8_BAR; PG8_SCHED;
            PG8_LDA(At, 0, 1); PG8_STAGE(PG8_SB(0, 0), b2, voffB); PG8_STAGE(PG8_SB(0, 1), b2 + hstepB, voffB); PG8_STAGE(PG8_SA(0, 0), a2, voffA);
            PG8_WAIT_V(8); PG8_WAIT_L(0); PG8_BAR; PG8_MMA(1, 0, At, B0); PG8_MMA(1, 1, At, B1); PG8_BAR; PG8_SCHED;
            PG8_LDB(B0, 1, 0); PG8_LDB(B1, 1, 1); PG8_SCHED; PG8_LDA(At, 1, 0); PG8_STAGE(PG8_SA(0, 1), a2 + hstepA, voffA);
            PG8_WAIT_V(8); PG8_WAIT_L(0); PG8_BAR; PG8_MMA(0, 0, At, B0); PG8_MMA(0, 1, At, B1); PG8_BAR; PG8_SCHED;
            PG8_LDA(At, 1, 1); PG8_STAGE(PG8_SB(1, 0), b3, voffB); PG8_STAGE(PG8_SB(1, 1), b3 + hstepB, voffB); PG8_STAGE(PG8_SA(1, 0), a3, voffA);
            PG8_WAIT_V(8); PG8_WAIT_L(0); PG8_BAR; PG8_MMA(1, 0, At, B0); PG8_MMA(1, 1, At, B1); PG8_BAR; PG8_SCHED;
        }
        if (wr == 0) PG8_BAR;
        E(acc, cur, wr, wc, fr, fq);
        if (!has_next) break;
#pragma unroll
        for (int a = 0; a < 2; ++a)
#pragma unroll
            for (int b = 0; b < 2; ++b)
#pragma unroll
                for (int m = 0; m < 4; ++m)
#pragma unroll
                    for (int n = 0; n < 2; ++n) acc[a][b][m][n] = (f32x4){0.f, 0.f, 0.f, 0.f};
        cur = nxt; cA = nA; cB = nB; ++ui;
        if (wr == 1) PG8_BAR;
    }
    PG8_WAIT_V(0);
    PG8_BAR;
#undef PG8_SA
#undef PG8_SB
#undef PG8_STAGE
#undef PG8_LDA
#undef PG8_LDB
#undef PG8_MMA
#undef PG8_WAIT_V
#undef PG8_WAIT_L
#undef PG8_BAR
#undef PG8_SCHED
}
}

struct RowScale {
    const float* part; int stride; int cnt; float inv_n;
    DI float get(int row) const {
        if (!part) return 1.f;
        float s = 0.f;
        const float* p = part + (size_t)row * stride;
        for (int i = 0; i < cnt; i += 4) { const f32x4 v = *(const f32x4*)(p + i); s += (v.x + v.y) + (v.z + v.w); }
        return __builtin_amdgcn_rsqf(s * inv_n + EPS);
    }
};

DI void rs_preload(const RowScale& rs, int rowbase, int fq, float (&out)[8]) {
    if (!rs.part) {
#pragma unroll
        for (int i = 0; i < 8; ++i) out[i] = 1.f;
        return;
    }
    const int ng = (rs.cnt + 3) >> 2, gq = fq < ng ? fq : ng - 1;
    const float w0 = (fq < ng && 4 * gq + 0 < rs.cnt) ? 1.f : 0.f, w1 = (fq < ng && 4 * gq + 1 < rs.cnt) ? 1.f : 0.f, w2 = (fq < ng && 4 * gq + 2 < rs.cnt) ? 1.f : 0.f, w3 = (fq < ng && 4 * gq + 3 < rs.cnt) ? 1.f : 0.f;
#pragma unroll
    for (int hb = 0; hb < 2; ++hb) {
        f32x4 v[4];
#pragma unroll
        for (int i = 0; i < 4; ++i) v[i] = *(const f32x4*)(rs.part + (size_t)(rowbase + hb * 128 + i * 16) * rs.stride + 4 * gq);
#pragma unroll
        for (int i = 0; i < 4; ++i) { float t = (v[i].x * w0 + v[i].y * w1) + (v[i].z * w2 + v[i].w * w3); t += __shfl_xor(t, 16); t += __shfl_xor(t, 32); out[hb * 4 + i] = __builtin_amdgcn_rsqf(t * rs.inv_n + EPS); }
    }
}
enum { SK_SKIP = 0, SK_RAW = 1, SK_HEAD = 2, SK_ROPE32 = 3, SK_GATE = 4 };
struct SlotDesc { int kind; bf16_t* dst; int ld; int col; const float* gain; float scale; int rope; float* part; int pstride; int pidx; const float* bias; };


template <class Cfg>
struct EpiSlot {
    Cfg cfg; RowScale rs; int rs_off; RopeTabs rt; int tok_off;
    template <int KIND>
    DI void run(const f32x4 (&acc)[2][2][4][2], const pg8::Unit& u, const SlotDesc& d, int wr, int fr, int fq) const {
        const int d0 = 8 * fq;
        float rsv[8]; rs_preload(rs, u.pm * 256 + wr * 64 + fr + rs_off, fq, rsv);
        float g0[8], g1[8];
        if (KIND == 2 || KIND == 5) {
#pragma unroll
            for (int i = 0; i < 8; ++i) { g0[i] = d.gain[d0 + i] * d.scale; g1[i] = d.gain[32 + d0 + i] * d.scale; }
        } else if (KIND == 3) {
#pragma unroll
            for (int i = 0; i < 8; ++i) { g0[i] = fq < 2 ? d.gain[d0 + i] * d.scale : 0.f; g1[i] = fq < 2 ? d.gain[16 + d0 + i] * d.scale : 0.f; }
        } else if (KIND == 4) {
#pragma unroll
            for (int i = 0; i < 8; ++i) { g0[i] = d.bias[d.col + d0 + i]; g1[i] = d.bias[d.col + 32 + d0 + i]; }
        }
#pragma unroll
        for (int ai = 0; ai < 2; ++ai)
#pragma unroll
            for (int m = 0; m < 4; ++m) {
                const int row = u.pm * 256 + ai * 128 + wr * 64 + m * 16 + fr;
                const float r = rsv[ai * 4 + m];
                float v0[8], v1[8];
#pragma unroll
                for (int n = 0; n < 2; ++n)
#pragma unroll
                    for (int j = 0; j < 4; ++j) { v0[4 * n + j] = acc[ai][0][m][n][j] * r; v1[4 * n + j] = acc[ai][1][m][n][j] * r; }
                bf16_t* dp = d.dst + (size_t)row * d.ld + d.col;
                if (KIND == 1) {
                    if (d.part) {
                        float ss = 0.f;
#pragma unroll
                        for (int i = 0; i < 8; ++i) ss += v0[i] * v0[i] + v1[i] * v1[i];
                        ss += __shfl_xor(ss, 16); ss += __shfl_xor(ss, 32);
                        if (fq == 0) d.part[(size_t)row * d.pstride + d.pidx] = ss;
                    }
                    *(u32x4*)(dp + d0) = pack8(v0); *(u32x4*)(dp + 32 + d0) = pack8(v1);
                } else if (KIND == 4) {
#pragma unroll
                    for (int i = 0; i < 8; ++i) { v0[i] = __builtin_amdgcn_rcpf(1.f + __builtin_amdgcn_exp2f(-(v0[i] + g0[i]) * LOG2E)); v1[i] = __builtin_amdgcn_rcpf(1.f + __builtin_amdgcn_exp2f(-(v1[i] + g1[i]) * LOG2E)); }
                    *(u32x4*)(dp + d0) = pack8(v0); *(u32x4*)(dp + 32 + d0) = pack8(v1);
                } else if (KIND == 2 || KIND == 5) {
                    float ss = 0.f;
#pragma unroll
                    for (int i = 0; i < 8; ++i) ss += v0[i] * v0[i] + v1[i] * v1[i];
                    ss += __shfl_xor(ss, 16); ss += __shfl_xor(ss, 32);
                    const float inv = __builtin_amdgcn_rsqf(ss * (1.f / 64.f) + EPS);
#pragma unroll
                    for (int i = 0; i < 8; ++i) { v0[i] *= inv * g0[i]; v1[i] *= inv * g1[i]; }
                    if (KIND == 5) {
                        const float* cp = rt.cosh + (size_t)(row + tok_off) * 32 + d0; const float* sp = rt.sinh + (size_t)(row + tok_off) * 32 + d0;
                        const f32x4 c0 = *(const f32x4*)cp, c1 = *(const f32x4*)(cp + 4), s0 = *(const f32x4*)sp, s1 = *(const f32x4*)(sp + 4);
#pragma unroll
                        for (int i = 0; i < 8; ++i) { const float c = i < 4 ? c0[i & 3] : c1[i & 3], sn = i < 4 ? s0[i & 3] : s1[i & 3];
                            const float a = v0[i], b = v1[i]; v0[i] = a * c - b * sn; v1[i] = b * c + a * sn; }
                    }
                    *(u32x4*)(dp + d0) = pack8(v0); *(u32x4*)(dp + 32 + d0) = pack8(v1);
                } else {
                    float ss = 0.f;
#pragma unroll
                    for (int i = 0; i < 8; ++i) ss += v0[i] * v0[i] + v1[i] * v1[i];
                    ss += __shfl_xor(ss, 16); ss += __shfl_xor(ss, 32);
                    const float inv = __builtin_amdgcn_rsqf(ss * (1.f / 32.f) + EPS);
                    if (fq < 2) {
#pragma unroll
                        for (int i = 0; i < 8; ++i) { v0[i] *= inv * g0[i]; v1[i] *= inv * g1[i]; }
                        const float* cp = rt.cosr + (size_t)(row + tok_off) * 16 + d0; const float* sp = rt.sinr + (size_t)(row + tok_off) * 16 + d0;
                        const f32x4 c0 = *(const f32x4*)cp, c1 = *(const f32x4*)(cp + 4), s0 = *(const f32x4*)sp, s1 = *(const f32x4*)(sp + 4);
#pragma unroll
                        for (int i = 0; i < 8; ++i) { const float c = i < 4 ? c0[i & 3] : c1[i & 3], sn = i < 4 ? s0[i & 3] : s1[i & 3];
                            const float a = v0[i], b = v1[i]; v0[i] = a * c - b * sn; v1[i] = b * c + a * sn; }
                        *(u32x4*)(dp + d0) = pack8(v0); *(u32x4*)(dp + 16 + d0) = pack8(v1);
                    }
                }
            }
    }
    DI void operator()(const f32x4 (&acc)[2][2][4][2], const pg8::Unit& u, int wr, int wc, int fr_, int fq_) const {
        const int fr = opaque(fr_), fq = opaque(fq_);
        const SlotDesc d = cfg.get(u.pn * 4 + wc);
        if (d.kind == SK_RAW) run<1>(acc, u, d, wr, fr, fq);
        else if (d.kind == SK_GATE) run<4>(acc, u, d, wr, fr, fq);
        else if (d.kind == SK_HEAD) { if (d.rope) run<5>(acc, u, d, wr, fr, fq); else run<2>(acc, u, d, wr, fr, fq); }
        else if (d.kind == SK_ROPE32) run<3>(acc, u, d, wr, fr, fq);
    }
};

struct CfgIn {
    unsigned char* ws; const float* a_qn; const float* a_kn; const float* b_kn; const float* c_qn; const float* c_kn; const float* b_gate;
    DI SlotDesc get(int s) const {
        SlotDesc d; d.kind = SK_SKIP; d.dst = nullptr; d.ld = 0; d.col = 0; d.gain = nullptr; d.scale = 1.f; d.rope = 0; d.part = nullptr; d.pstride = 0; d.pidx = 0; d.bias = nullptr;
        if (s < 8) { d.kind = SK_HEAD; d.dst = (bf16_t*)(ws + WS_QA); d.ld = 512; d.col = 64 * s; d.gain = a_qn; d.scale = 0.125f * LOG2E; d.rope = 1; }
        else if (s < 10) { d.kind = SK_HEAD; d.dst = (bf16_t*)(ws + WS_KA); d.ld = 128; d.col = 64 * (s - 8); d.gain = a_kn; d.rope = 1; }
        else if (s < 12) { d.kind = SK_RAW; d.dst = (bf16_t*)(ws + WS_VA); d.ld = 128; d.col = 64 * (s - 10); }
        else if (s < 18) { d.kind = SK_RAW; d.dst = (bf16_t*)(ws + WS_CQ); d.ld = 384; d.col = 64 * (s - 12); d.part = (float*)(ws + WS_PCQ); d.pstride = 8; d.pidx = s - 12; }
        else if (s < 22) { d.kind = SK_RAW; d.dst = (bf16_t*)(ws + WS_CKV); d.ld = 256; d.col = 64 * (s - 18); d.part = (float*)(ws + WS_PCKV); d.pstride = 4; d.pidx = s - 18; }
        else if (s == 22) { d.kind = SK_ROPE32; d.dst = (bf16_t*)(ws + WS_KR); d.ld = 32; d.col = 0; d.gain = b_kn + 64; }
        else if (s < 95) { const int p = (s - 23) >> 3, h = (s - 23) & 7, g = p / 3, t = p % 3;
            d.dst = (bf16_t*)(ws + WS_CB + (size_t)p * 16 * MiB); d.ld = 512; d.col = 64 * h;
            if (t == 0) { d.kind = SK_HEAD; d.gain = c_qn + 64 * g; d.scale = 0.125f * LOG2E; d.rope = 1; }
            else if (t == 1) { d.kind = SK_HEAD; d.gain = c_kn + 64 * g; d.rope = 1; }
            else d.kind = SK_RAW; }
        else if (s < 103) { d.kind = SK_RAW; d.dst = (bf16_t*)(ws + WS_MQ); d.ld = 512; d.col = 64 * (s - 95); }
        else if (s < 167) { d.kind = SK_GATE; d.dst = (bf16_t*)(ws + WS_GATES); d.ld = 4096; d.col = 64 * (s - 103); d.bias = b_gate; }
        return d;
    }
};
DI void in_slot_src(int s, int& src, int& kind) {
    kind = 0;
    if (s < 22) src = 64 * s;
    else if (s == 22) { src = 1408; kind = 1; }
    else if (s < 167) src = 1440 + 64 * (s - 23);
    else { src = 0; kind = 2; }
}
struct CfgUq {
    unsigned char* ws; const float* b_qn;
    DI SlotDesc get(int s) const {
        SlotDesc d; d.dst = (bf16_t*)(ws + WS_QB); d.ld = 768; d.scale = 0.10206207261596575f * LOG2E; d.rope = 0; d.part = nullptr; d.pstride = 0; d.pidx = 0; d.bias = nullptr;
        if (s < 8) { d.kind = SK_HEAD; d.col = 96 * s; d.gain = b_qn; }
        else { d.kind = SK_ROPE32; d.col = 96 * (s - 8) + 64; d.gain = b_qn + 64; }
        return d;
    }
};
struct CfgUkv {
    unsigned char* ws; const float* b_kn;
    DI SlotDesc get(int s) const {
        SlotDesc d; d.ld = 512; d.scale = 1.f; d.rope = 0; d.part = nullptr; d.pstride = 0; d.pidx = 0; d.bias = nullptr; d.gain = b_kn;
        if (s < 8) { d.kind = SK_HEAD; d.dst = (bf16_t*)(ws + WS_KN); d.col = 64 * s; }
        else { d.kind = SK_RAW; d.dst = (bf16_t*)(ws + WS_VB); d.col = 64 * (s - 8); }
        return d;
    }
};
struct CfgMkv {
    unsigned char* ws;
    DI SlotDesc get(int s) const {
        SlotDesc d; d.kind = SK_RAW; d.ld = 512; d.scale = 1.f; d.rope = 0; d.part = nullptr; d.pstride = 0; d.pidx = 0; d.bias = nullptr; d.gain = nullptr;
        if (s < 8) { d.dst = (bf16_t*)(ws + WS_MK); d.col = 64 * s; } else { d.dst = (bf16_t*)(ws + WS_MV); d.col = 64 * (s - 8); }
        return d;
    }
};

struct EpiMerge {
    const bf16_t* gates; bf16_t* gy;
    template <bool FIRST>
    DI void run(const f32x4 (&acc)[2][2][4][2], const pg8::Unit& u, int wr, int wc, int fr, int fq) const {
#pragma unroll
        for (int ai = 0; ai < 2; ++ai)
#pragma unroll
            for (int m = 0; m < 4; ++m) {
                const int row = u.pm * 256 + ai * 128 + wr * 64 + m * 16 + fr;
#pragma unroll
                for (int bj = 0; bj < 2; ++bj) {
                    const int col = u.pn * 256 + bj * 128 + wc * 32 + 8 * fq;
                    float g[8], o[8];
                    unpack8(*(const u32x4*)(gates + (size_t)row * 4096 + u.seg * 1024 + col), g);
                    bf16_t* gp = gy + (size_t)row * 1024 + col;
                    if (FIRST) {
#pragma unroll
                        for (int i = 0; i < 8; ++i) o[i] = 0.f;
                    } else unpack8(*(const u32x4*)gp, o);
#pragma unroll
                    for (int n = 0; n < 2; ++n)
#pragma unroll
                        for (int j = 0; j < 4; ++j) o[4 * n + j] += g[4 * n + j] * acc[ai][bj][m][n][j];
                    *(u32x4*)gp = pack8(o);
                }
            }
    }
    DI void operator()(const f32x4 (&acc)[2][2][4][2], const pg8::Unit& u, int wr, int wc, int fr, int fq) const {
        if (u.seg == 0) run<true>(acc, u, wr, wc, fr, fq); else run<false>(acc, u, wr, wc, fr, fq);
    }
};
struct EpiRes {
    const float* xsrc; float* xdst; bf16_t* xb; float* px;
    DI void operator()(const f32x4 (&acc)[2][2][4][2], const pg8::Unit& u, int wr, int wc, int fr, int fq) const {
#pragma unroll
        for (int ai = 0; ai < 2; ++ai)
#pragma unroll
            for (int m = 0; m < 4; ++m) {
                const int row = u.pm * 256 + ai * 128 + wr * 64 + m * 16 + fr;
                float ss = 0.f;
#pragma unroll
                for (int bj = 0; bj < 2; ++bj) {
                    const size_t off = (size_t)row * 1024 + u.pn * 256 + bj * 128 + wc * 32 + 8 * fq;
                    float o[8];
#pragma unroll
                    for (int n = 0; n < 2; ++n) { const f32x4 xs = *(const f32x4*)(xsrc + off + 4 * n); const f32x4 xn = xs + acc[ai][bj][m][n]; *(f32x4*)(xdst + off + 4 * n) = xn;
#pragma unroll
                        for (int j = 0; j < 4; ++j) { o[4 * n + j] = xn[j]; ss += xn[j] * xn[j]; } }
                    *(u32x4*)(xb + off) = pack8(o);
                }
                ss += __shfl_xor(ss, 16); ss += __shfl_xor(ss, 32);
                if (fq == 0) px[(size_t)row * 16 + u.pn * 4 + wc] = ss;
            }
    }
};
struct EpiUp {
    bf16_t* U; RowScale rs; int rs_off;
    DI void operator()(const f32x4 (&acc)[2][2][4][2], const pg8::Unit& u, int wr, int wc, int fr, int fq) const {
        float rsv[8]; rs_preload(rs, u.pm * 256 + wr * 64 + fr + rs_off, fq, rsv);
#pragma unroll
        for (int ai = 0; ai < 2; ++ai)
#pragma unroll
            for (int m = 0; m < 4; ++m) {
                const int row = u.pm * 256 + ai * 128 + wr * 64 + m * 16 + fr;
                const float r = rsv[ai * 4 + m];
#pragma unroll
                for (int bj = 0; bj < 2; ++bj) {
                    float o[8];
#pragma unroll
                    for (int n = 0; n < 2; ++n)
#pragma unroll
                        for (int j = 0; j < 4; ++j) { const float v = fmaxf(acc[ai][bj][m][n][j] * r, 0.f); o[4 * n + j] = v * v; }
                    *(u32x4*)(U + (size_t)row * DFF + u.pn * 256 + bj * 128 + wc * 32 + 8 * fq) = pack8(o);
                }
            }
    }
};

DI void transpose_item(const float* W, int K, int N, const float* gk, bf16_t* WT, int rho0, int k0, int src0, int nvalid, LAS float* scr, int lane) {
    { const int c4 = (lane & 7) * 4, cs = c4 < nvalid ? c4 : 0; const float keep = c4 < nvalid ? 1.f : 0.f;
      f32x4 v[8]; float g[8];
#pragma unroll
      for (int i = 0; i < 8; ++i) v[i] = *(const f32x4*)(W + (size_t)(k0 + 8 * i + (lane >> 3)) * N + src0 + cs);
      if (gk) {
#pragma unroll
          for (int i = 0; i < 8; ++i) g[i] = gk[k0 + 8 * i + (lane >> 3)] * keep;
      } else {
#pragma unroll
          for (int i = 0; i < 8; ++i) g[i] = keep;
      }
#pragma unroll
      for (int i = 0; i < 8; ++i) { const int kk = 8 * i + (lane >> 3); const f32x4 t = v[i] * g[i];
        scr[kk * 33 + c4] = t.x; scr[kk * 33 + c4 + 1] = t.y; scr[kk * 33 + c4 + 2] = t.z; scr[kk * 33 + c4 + 3] = t.w; } }
    LDS_WAIT();
    const int c8 = lane & 7;
#pragma unroll
    for (int j = 0; j < 4; ++j) { const int n = (lane >> 3) + 8 * j; const LAS float* s = scr + (8 * c8) * 33 + n;
        u32x4 o; o.x = cvtpk(s[0 * 33], s[1 * 33]); o.y = cvtpk(s[2 * 33], s[3 * 33]); o.z = cvtpk(s[4 * 33], s[5 * 33]); o.w = cvtpk(s[6 * 33], s[7 * 33]);
        *(u32x4*)(WT + (size_t)(rho0 + n) * K + k0 + 8 * c8) = o; }
    LDS_WAIT();
}
DI void block_src(int mapk, int q  , int& src0, int& nvalid) {
    if (mapk == 0) { src0 = 32 * q; nvalid = 32; return; }
    const int pn = q >> 3, bj = (q >> 2) & 1, wc = q & 3, s = 4 * pn + wc;
    if (mapk == 1) { int src, kind; in_slot_src(s, src, kind);
        if (kind == 0) { src0 = src + 32 * bj; nvalid = 32; } else if (kind == 1) { src0 = src + 16 * bj; nvalid = 16; } else { src0 = 0; nvalid = 0; } }
    else if (mapk == 2) { if (s < 8) { src0 = 96 * s + 32 * bj; nvalid = 32; } else { src0 = 96 * (s - 8) + 64 + 16 * bj; nvalid = 16; } }
    else if (mapk == 3) { if (s < 8) { src0 = 128 * s + 32 * bj; nvalid = 32; } else { src0 = 128 * (s - 8) + 64 + 32 * bj; nvalid = 32; } }
    else { src0 = 64 * s + 32 * bj; nvalid = 32; }
}
DI void convert_matrix(const float* W, int K, int N, int Nt, const float* gk, bf16_t* WT, int mapk, LAS float* scr, int gw, int NGW, int lane) {
    const int nblk = Nt / 32, items = (K / 64) * nblk;
    for (int it = gw; it < items; it += NGW) {
        const int kb = it / nblk, q = it % nblk; int src0, nvalid; block_src(mapk, q, src0, nvalid);
        transpose_item(W, K, N, gk, WT, 32 * q, 64 * kb, src0, nvalid, scr, lane);
    }
}
DI void convert_layer(int l, LAS unsigned char* lds, int gw, int NGW, int wave) {
    const int lane = lane_id();
    CParams* q = fresh_params();
    LAS float* scr = (LAS float*)(lds + wave * 16384);
    unsigned char* ws = q->ws;
    convert_matrix(q->in[4] + (size_t)l * D * N_IN, D, N_IN, NT_IN, q->in[3] + l * D, (bf16_t*)(ws + WS_WIN), 1, scr, gw, NGW, lane);
    convert_matrix(q->in[11] + (size_t)l * 384 * 768, 384, 768, 1024, q->in[9] + l * 384, (bf16_t*)(ws + WS_WUQ), 2, scr, gw, NGW, lane);
    convert_matrix(q->in[12] + (size_t)l * 256 * 1024, 256, 1024, 1024, q->in[10] + l * 256, (bf16_t*)(ws + WS_WUKV), 3, scr, gw, NGW, lane);
    convert_matrix(q->in[18] + (size_t)l * D * 1024, D, 1024, 1024, q->in[17] + l * D, (bf16_t*)(ws + WS_WMKV), 4, scr, gw, NGW, lane);
    for (int n = 0; n < 4; ++n)
        convert_matrix(q->in[21] + ((size_t)l * 4 + n) * 512 * D, 512, D, D, nullptr, (bf16_t*)(ws + WS_WBR) + (size_t)n * D * 512, 0, scr, gw, NGW, lane);
    convert_matrix(q->in[22] + (size_t)l * D * D, D, D, D, nullptr, (bf16_t*)(ws + WS_WOUT), 0, scr, gw, NGW, lane);
    convert_matrix(q->in[24] + (size_t)l * D * DFF, D, DFF, DFF, q->in[23] + l * D, (bf16_t*)(ws + WS_WUP), 0, scr, gw, NGW, lane);
    convert_matrix(q->in[25] + (size_t)l * DFF * D, DFF, D, D, nullptr, (bf16_t*)(ws + WS_WDN), 0, scr, gw, NGW, lane);
}

DI int crow(int i, int h) { return (i & 3) + 8 * (i >> 2) + 4 * h; }
DI f32x16 mfma32(bf16x8 a, bf16x8 b, f32x16 c) { return __builtin_amdgcn_mfma_f32_32x32x16_bf16(a, b, c, 0, 0, 0); }
DI bf16x8 packp(const f32x16& x, int s) { u32x4 w; w.x = cvtpk(x[8 * s], x[8 * s + 1]); w.y = cvtpk(x[8 * s + 2], x[8 * s + 3]); w.z = cvtpk(x[8 * s + 4], x[8 * s + 5]); w.w = cvtpk(x[8 * s + 6], x[8 * s + 7]); return __builtin_bit_cast(bf16x8, w); }
DI s16x4 vtr(const LAS char* p) { return __builtin_bit_cast(s16x4, __builtin_amdgcn_ds_read_tr16_b64_v4i16((LAS s16x4*)p)); }

DI float max3f(float a, float b, float c) { float r; asm("v_max3_f32 %0, %1, %2, %3" : "=v"(r) : "v"(a), "v"(b), "v"(c)); return r; }
DI float xhalf_max(float v) { auto rr = __builtin_amdgcn_permlane32_swap(__float_as_uint(v), __float_as_uint(v), false, false); return fmaxf(__uint_as_float(rr[0]), __uint_as_float(rr[1])); }
DI float xhalf_sum(float v) { auto rr = __builtin_amdgcn_permlane32_swap(__float_as_uint(v), __float_as_uint(v), false, false); return __uint_as_float(rr[0]) + __uint_as_float(rr[1]); }
DI f32x16 splat16(float v) { f32x16 p;
#pragma unroll
    for (int i = 0; i < 16; ++i) p[i] = v;
    return p; }
template <int DQK, int NT, int TSTRIDE> DI void st_tiles(unsigned kaddr, const bf16x8* qf, const f32x16& init, f32x16* p) {
    bf16x8 a[NT][DQK / 16];
#pragma unroll
    for (int j = 0; j < NT; ++j)
#pragma unroll
        for (int ks = 0; ks < DQK / 16; ++ks) asm volatile("ds_read_b128 %0, %1 offset:%2" : "=v"(a[j][ks]) : "v"(kaddr), "i"(j * TSTRIDE + ks * 32));
    asm volatile("s_waitcnt lgkmcnt(0)" ::: "memory");
#pragma unroll
    for (int j = 0; j < NT; ++j)
#pragma unroll
        for (int ks = 0; ks < DQK / 16; ++ks) asm volatile("" : "+v"(a[j][ks]));
#pragma unroll
    for (int j = 0; j < NT; ++j) p[j] = init;
#pragma unroll
    for (int ks = 0; ks < DQK / 16; ++ks)
#pragma unroll
        for (int j = 0; j < NT; ++j) p[j] = mfma32(a[j][ks], qf[ks], p[j]);
}
template <int DV, int VP> DI void pv_tile(f32x16* o, const LAS char* vp, const f32x16& p, int h) {
#pragma unroll
    for (int s = 0; s < 2; ++s) {
        const bf16x8 pa = packp(p, s);
#pragma unroll
        for (int db = 0; db < DV / 32; ++db) {
            const s16x4 lo = vtr(vp + (16 * s + 4 * h) * VP + db * 64);
            const s16x4 hi = vtr(vp + (16 * s + 8 + 4 * h) * VP + db * 64);
            const bf16x8 vb = __builtin_shufflevector(lo, hi, 0, 1, 2, 3, 4, 5, 6, 7);
            o[db] = mfma32(pa, vb, o[db]);
        }
    }
}
template <int NDB> DI void scale_o(f32x16* o, float f, LAS float* sc, int r, int h) {
    if (h == 0) sc[r] = f;
    LDS_WAIT();
#pragma unroll
    for (int g = 0; g < 4; ++g) { const f32x4 f4 = *(const LAS f32x4*)(sc + 8 * g + 4 * h);
#pragma unroll
        for (int db = 0; db < NDB; ++db)
#pragma unroll
            for (int j = 0; j < 4; ++j) o[db][4 * g + j] *= f4[j]; }
    LDS_WAIT();
}
template <int NDB> DI void store_o(const f32x16* o, bf16_t* obase  , long rstride, int r, int h) {
#pragma unroll
    for (int i = 0; i < 16; ++i) { bf16_t* rp = obase + (long)crow(i, h) * rstride + r;
#pragma unroll
        for (int db = 0; db < NDB; ++db) rp[32 * db] = (bf16_t)(cvtpk(o[db][i], 0.f) & 0xffffu); }
}

constexpr int BKP = 144, BVP = 144;
constexpr int BSLOT = 256 * BKP + 256 * BVP;

DI void banded_load(LAS char* dst, int pitch, const bf16_t* src  , int ld, long row0  , int dil, int gi0, int tid) {
    u32x4 v[4];
#pragma unroll
    for (int it = 0; it < 4; ++it) {
        const int c = tid + it * NTHREADS, key = c >> 3, cc = c & 7, gi = gi0 + key, gic = gi < 0 ? 0 : gi;
        v[it] = *(const u32x4*)(src + (row0 + (long)gic * dil) * ld + cc * 8);
    }
#pragma unroll
    for (int it = 0; it < 4; ++it) {
        const int c = tid + it * NTHREADS, key = c >> 3, cc = c & 7, gi = gi0 + key;
        if (gi < 0) v[it] = (u32x4){0u, 0u, 0u, 0u};
        *(LAS u32x4*)(dst + key * pitch + cc * 16) = v[it];
    }
}
template <bool SINK, bool WANT_LSE>
DI void banded_task(const bf16_t* qrow  , bf16_t* obase, long rstride, const LAS char* Ks, const LAS char* Vs,
                    int wq, int jblk, int maxd, float sink2, float* lsep, LAS float* sc, int lane) {
    const int r = lane & 31, h = lane >> 5;
    bf16x8 qf[4];
#pragma unroll
    for (int ks = 0; ks < 4; ++ks) qf[ks] = *(const bf16x8*)(qrow + 16 * ks + 8 * h);
    f32x16 p[5];
    const f32x16 zero16 = splat16(0.f);
    { const unsigned ka = (unsigned)(uintptr_t)(Ks + (32 * wq + r) * BKP + 16 * h);
      st_tiles<64, 3, 32 * BKP>(ka, qf, zero16, p); st_tiles<64, 2, 32 * BKP>(ka + 96 * BKP, qf, zero16, p + 3); }
    const int tmin = (jblk == 0) ? 4 - wq : 0, lo = r + 128 - maxd;
#pragma unroll
    for (int t = 0; t < 5; ++t) {
        if (t < tmin) { p[t] = splat16(NEGBIG); }
        else if (t == 0) {
#pragma unroll
            for (int i = 0; i < 16; ++i) p[t][i] = (crow(i, h) >= lo) ? p[t][i] : NEGBIG;
        } else if (t == 4) {
#pragma unroll
            for (int i = 0; i < 16; ++i) p[t][i] = (crow(i, h) <= r) ? p[t][i] : NEGBIG;
        }
    }
    asm volatile("s_nop 15\n\ts_nop 7" : "+v"(p[0]), "+v"(p[1]), "+v"(p[2]), "+v"(p[3]), "+v"(p[4]));
    float mx = NEGBIG;
#pragma unroll
    for (int t = 0; t < 5; ++t)
#pragma unroll
        for (int i = 0; i < 16; i += 2) mx = max3f(mx, p[t][i], p[t][i + 1]);
    mx = xhalf_max(mx);
    if (SINK) mx = fmaxf(mx, sink2);
    float l;
    { const f32x16 mx16 = splat16(mx); f32x16 acc = splat16(0.f);
#pragma unroll
      for (int t = 0; t < 5; ++t) { p[t] = p[t] - mx16;
#pragma unroll
          for (int i = 0; i < 16; ++i) p[t][i] = __builtin_amdgcn_exp2f(p[t][i]);
          acc = acc + p[t]; }
      float a8[8];
#pragma unroll
      for (int i = 0; i < 8; ++i) a8[i] = acc[i] + acc[i + 8];
      l = ((a8[0] + a8[1]) + (a8[2] + a8[3])) + ((a8[4] + a8[5]) + (a8[6] + a8[7])); }
    l = xhalf_sum(l);
    if (SINK) l += __builtin_amdgcn_exp2f(sink2 - mx);
    f32x16 o[2];
#pragma unroll
    for (int i = 0; i < 16; ++i) { o[0][i] = 0.f; o[1][i] = 0.f; }
    const LAS char* vl = Vs + ((lane & 15) >> 2) * BVP + ((lane >> 4) & 1) * 32 + (lane & 3) * 8;
#pragma unroll
    for (int t = 0; t < 5; ++t) pv_tile<64, BVP>(o, vl + 32 * (wq + t) * BVP, p[t], h);
    scale_o<2>(o, 1.f / l, sc, r, h);
    store_o<2>(o, obase, rstride, r, h);
    if (WANT_LSE) { if (h == 0) *lsep = mx + __builtin_amdgcn_logf(l); }
}

template <int DQK, int DV, bool CAUSAL, bool SPLITK>
DI void dense_unit(const bf16_t* Q, int ldq, const bf16_t* K1, int ldk1, const bf16_t* K2, int ldk2, const bf16_t* V, int ldv, bf16_t* O, int ldo,
                   int q0  , int ntiles, LAS char* lds, LAS float* sc, int tid) {
    constexpr int KP = DQK * 2 + 16, VP = DV * 2 + 16, KCH = DQK / 8, VCH = DV / 8, NK = 64 * KCH, NCH = NK + 64 * VCH, NIT = (NCH + NTHREADS - 1) / NTHREADS;
    constexpr int KBUF = 64 * KP, VBUF = 64 * VP, TB = KBUF + VBUF;
    const int lane = tid & 63, w = __builtin_amdgcn_readfirstlane(tid >> 6), r = lane & 31, h = lane >> 5;
    LAS char* kb0 = lds; LAS char* vb0 = lds + KBUF;
    bf16x8 qf[DQK / 16];
    { const bf16_t* qr = Q + (long)(32 * w + r) * ldq;
#pragma unroll
      for (int ks = 0; ks < DQK / 16; ++ks) { qf[ks] = *(const bf16x8*)(qr + 16 * ks + 8 * h); asm volatile("" : "+v"(qf[ks])); } }
    int gb[NIT], gs[NIT], lo[NIT];
    if (SPLITK)
#pragma unroll
    for (int it = 0; it < NIT; ++it) { const int c = tid + it * NTHREADS;
        if (c < NK) { const int key = c / KCH, cc = c % KCH;
            if (SPLITK && cc >= 8) { gb[it] = (int)((const char*)K2 - (const char*)K1) + (key * ldk2 + (cc - 8) * 8) * 2; gs[it] = 64 * ldk2 * 2; }
            else { gb[it] = (key * ldk1 + cc * 8) * 2; gs[it] = 64 * ldk1 * 2; }
            lo[it] = key * KP + cc * 16; }
        else { const int c2 = (c < NCH ? c : NK) - NK, key = c2 / VCH, cc = c2 % VCH;
            gb[it] = (int)((const char*)V - (const char*)K1) + (key * ldv + cc * 8) * 2; gs[it] = 64 * ldv * 2; lo[it] = KBUF + key * VP + cc * 16; }
        asm volatile("" : "+v"(gb[it]), "+v"(gs[it]), "+v"(lo[it])); }
    u32x4 pre[NIT];
    auto gload = [&](int t) {
        if (SPLITK) {
#pragma unroll
            for (int it = 0; it < NIT; ++it) if ((it + 1) * NTHREADS <= NCH || tid + it * NTHREADS < NCH) pre[it] = *(const u32x4*)((const char*)K1 + (long)(gb[it] + t * gs[it]));
        } else {
            const int tid2 = opaque(tid);
#pragma unroll
            for (int it = 0; it < NIT; ++it) { const int c = tid2 + it * NTHREADS;
                if (c < NK) { const int key = c / KCH, cc = c % KCH; pre[it] = *(const u32x4*)(K1 + (long)(64 * t + key) * ldk1 + cc * 8); }
                else if (c < NCH) { const int c2 = c - NK, key = c2 / VCH, cc = c2 % VCH; pre[it] = *(const u32x4*)(V + (long)(64 * t + key) * ldv + cc * 8); } }
        }
    };
    auto lstore = [&](int b) {
        if (SPLITK) {
#pragma unroll
            for (int it = 0; it < NIT; ++it) if ((it + 1) * NTHREADS <= NCH || tid + it * NTHREADS < NCH) *(LAS u32x4*)(lds + b * TB + lo[it]) = pre[it];
        } else {
            const int tid2 = opaque(tid);
#pragma unroll
            for (int it = 0; it < NIT; ++it) { const int c = tid2 + it * NTHREADS;
                if (c < NK) { const int key = c / KCH, cc = c % KCH; *(LAS u32x4*)(kb0 + b * TB + key * KP + cc * 16) = pre[it]; }
                else if (c < NCH) { const int c2 = c - NK, key = c2 / VCH, cc = c2 % VCH; *(LAS u32x4*)(vb0 + b * TB + key * VP + cc * 16) = pre[it]; } }
        }
    };
    gload(0); lstore(0);
    __syncthreads();
    float m = 0.f, l = 0.f; bool first = true;
    f32x16 negm = splat16(0.f);
    f32x16 o[DV / 32];
#pragma unroll
    for (int db = 0; db < DV / 32; ++db)
#pragma unroll
        for (int i = 0; i < 16; ++i) o[db][i] = 0.f;
    const int qpos = q0 + 32 * w + r;
    for (int t = 0; t < ntiles; ++t) {
        const int b = t & 1;
        if (t + 1 < ntiles) gload(t + 1);
        if (!CAUSAL || 64 * t <= q0 + 32 * w) {
            const LAS char* kp = kb0 + b * TB + r * KP + 16 * h;
            f32x16 pp[2]; st_tiles<DQK, 2, 32 * KP>((unsigned)(uintptr_t)kp, qf, negm, pp);
            f32x16& p0 = pp[0]; f32x16& p1 = pp[1];
            if (CAUSAL && 64 * t + 63 > q0 + 32 * w) {
#pragma unroll
                for (int i = 0; i < 16; ++i) { const int key = 64 * t + crow(i, h); if (key > qpos) p0[i] = NEGBIG; if (key + 32 > qpos) p1[i] = NEGBIG; }
            }
            asm volatile("s_nop 15\n\ts_nop 7" : "+v"(p0), "+v"(p1));
            float mx = NEGBIG;
#pragma unroll
            for (int i = 0; i < 16; ++i) mx = max3f(mx, p0[i], p1[i]);
            mx = xhalf_max(mx);
            if (first || __any(mx > 8.f)) {
                const float dl = first ? mx : (mx > 8.f ? mx : 0.f);
                m += dl;
                const float f = __builtin_amdgcn_exp2f(-dl);
                l *= f;
#pragma unroll
                for (int i = 0; i < 16; ++i) { p0[i] -= dl; p1[i] -= dl; }
                if (!first) scale_o<DV / 32>(o, f, sc, r, h);
                negm = splat16(-m);
                first = false;
            }
#pragma unroll
            for (int i = 0; i < 16; ++i) { p0[i] = __builtin_amdgcn_exp2f(p0[i]); p1[i] = __builtin_amdgcn_exp2f(p1[i]); l += p0[i] + p1[i]; }
            const LAS char* vl = vb0 + b * TB + ((lane & 15) >> 2) * VP + ((lane >> 4) & 1) * 32 + (lane & 3) * 8;
            pv_tile<DV, VP>(o, vl, p0, h);
            pv_tile<DV, VP>(o, vl + 32 * VP, p1, h);
        }
        if (t + 1 < ntiles) lstore(b ^ 1);
        __syncthreads();
    }
    l = xhalf_sum(l);
    scale_o<DV / 32>(o, 1.f / l, sc, r, h);
    store_o<DV / 32>(o, O + (long)(32 * w) * ldo, ldo, r, h);
}


#define XB_TMO      128
#define XB_XCNT(j)  (256  + 64 * (j))
#define XB_XSUB(j)  (1280 + 64 * (j))
#define XB_XGEN(j)  (2304 + 64 * (j))
#define XB_TOP      3328
#define XB_TOPGEN   3392
#define XCD_BAR_WORDS 3456
#define XB_SPIN_CAP (1u << 22)
DI unsigned xb_ld(unsigned* p)              { return __hip_atomic_load(p, __ATOMIC_RELAXED, __HIP_MEMORY_SCOPE_AGENT); }
DI unsigned xb_add(unsigned* p, unsigned v) { return __hip_atomic_fetch_add(p, v, __ATOMIC_RELAXED, __HIP_MEMORY_SCOPE_AGENT); }
DI unsigned xb_xcc_id() { return (unsigned)__builtin_amdgcn_s_getreg((3 << 11) | 20) & 0xFu; }
#define XB_SPIN(cond, bar) do { unsigned _sp = 0; while (cond) { __builtin_amdgcn_s_sleep(1); \
    if ((++_sp & 255u) == 0u) { if (xb_ld(&(bar)[XB_TMO])) break; if (_sp > XB_SPIN_CAP) { atomicAdd(&(bar)[XB_TMO], 1u); break; } } } } while (0)
struct XcdBarrier { unsigned* bar; unsigned x; volatile LAS unsigned* st; };
DI XcdBarrier xcd_barrier_post(unsigned* bar, volatile LAS unsigned* st) {
    XcdBarrier b; b.bar = bar; b.x = xb_xcc_id(); b.st = st;
    if (threadIdx.x == 0) (void)xb_add(&bar[XB_XCNT(b.x)], 1u);
    return b;
}
DI void xcd_barrier_complete(unsigned* bar, unsigned x, unsigned& nloc, unsigned& nx) {
    const unsigned G = gridDim.x * gridDim.y * gridDim.z;
    unsigned sum, cnt, mine, sp = 0u;
    for (;;) {
        sum = 0u; cnt = 0u; mine = 0u;
#pragma unroll
        for (unsigned j = 0; j < 16; ++j) { const unsigned c = xb_ld(&bar[XB_XCNT(j)]); sum += c; cnt += (c > 0u) ? 1u : 0u; mine = (j == x) ? c : mine; }
        if (sum == G) break;
        __builtin_amdgcn_s_sleep(1);
        if ((++sp & 255u) == 0u) { if (xb_ld(&bar[XB_TMO])) break; if (sp > XB_SPIN_CAP) { atomicAdd(&bar[XB_TMO], 1u); break; } }
    }
    nloc = mine > 0u ? mine : 1u; nx = cnt > 0u ? cnt : 1u;
}
DI void xcd_barrier(unsigned* bar, unsigned x, volatile LAS unsigned* st) {
    asm volatile("s_waitcnt vmcnt(0)" ::: "memory");
    __syncthreads();
    if (threadIdx.x == 0) {
        __builtin_amdgcn_s_waitcnt(0);
        unsigned nloc = st[0], nx = st[1];
        if (nloc == 0u) { xcd_barrier_complete(bar, x, nloc, nx); st[0] = nloc; st[1] = nx; }
        const unsigned old = xb_add(&bar[XB_XSUB(x)], 1u);
        const unsigned gen = old / nloc;
        if (old + 1u == (gen + 1u) * nloc) {
            __builtin_amdgcn_fence(__ATOMIC_RELEASE, "agent");
            asm volatile("s_waitcnt vmcnt(0)" ::: "memory");
            const unsigned og = xb_add(&bar[XB_TOP], 1u);
            const unsigned tg = og / nx;
            if (og + 1u == (tg + 1u) * nx) xb_add(&bar[XB_TOPGEN], 1u);
            else XB_SPIN(xb_ld(&bar[XB_TOPGEN]) == tg, bar);
            __builtin_amdgcn_fence(__ATOMIC_ACQUIRE, "agent");
            xb_add(&bar[XB_XGEN(x)], 1u);
            asm volatile("s_waitcnt vmcnt(0)" ::: "memory");
        } else {
            XB_SPIN(xb_ld(&bar[XB_XGEN(x)]) == gen, bar);
            __builtin_amdgcn_fence(__ATOMIC_ACQUIRE, "agent");
            asm volatile("s_waitcnt vmcnt(0)" ::: "memory");
        }
    }
    __syncthreads();
}

DI void sincos_acc(float ang, float& c, float& s) {
    const double x = (double)ang;
    const double n = __builtin_rint(x * 0.63661977236758134308);
    double rr = __builtin_fma(-n, 1.57079632679489655800e+00, x); rr = __builtin_fma(-n, 6.12323399573676603587e-17, rr);
    const double r2 = rr * rr;
    const double sn = rr * (1.0 + r2 * (-1.0 / 6 + r2 * (1.0 / 120 + r2 * (-1.0 / 5040 + r2 * (1.0 / 362880 + r2 * (-1.0 / 39916800 + r2 * (1.0 / 6227020800.0)))))));
    const double cs = 1.0 + r2 * (-0.5 + r2 * (1.0 / 24 + r2 * (-1.0 / 720 + r2 * (1.0 / 40320 + r2 * (-1.0 / 3628800 + r2 * (1.0 / 479001600.0))))));
    const int q = ((int)n) & 3;
    const double cc = (q == 0) ? cs : (q == 1) ? -sn : (q == 2) ? -cs : sn;
    const double ss = (q == 0) ? sn : (q == 1) ? cs : (q == 2) ? -sn : -cs;
    c = (float)cc; s = (float)ss;
}

#ifndef PH
#define PH 255
#endif
#ifndef REP_P1
#define REP_P1 1
#endif
#ifndef REP_B
#define REP_B 1
#endif
#ifndef REP_CONV
#define REP_CONV 1
#endif
#ifndef REP_P7
#define REP_P7 1
#endif
#define GRID_SYNC() do { CParams* qb_ = fresh_params(); xcd_barrier((unsigned*)(qb_->ws + WS_CTL), xcc, MISC); } while (0)

__global__ void __launch_bounds__(NTHREADS, 2) fwd_megakernel(Params p) {
    extern __shared__ __attribute__((aligned(16))) unsigned char lds_raw[];
    cg::grid_group grid = cg::this_grid();
    LAS unsigned char* lds = (LAS unsigned char*)lds_raw;
    const int wave = __builtin_amdgcn_readfirstlane((int)threadIdx.x >> 6);
    const int G = gridDim.x, bid = blockIdx.x;
    const int gw = bid * NWAVES + wave, NGW = G * NWAVES;
    LAS float* sc = (LAS float*)(lds + LDS_SCR) + wave * 64;
    volatile LAS unsigned* MISC = (volatile LAS unsigned*)(lds + LDS_SCR + 2048);
    if (threadIdx.x < 4) MISC[threadIdx.x] = 0u;
    __syncthreads();
    unsigned xcc;
    { CParams* q0 = fresh_params(); const XcdBarrier xb = xcd_barrier_post((unsigned*)(q0->ws + WS_CTL), MISC); xcc = xb.x; }

#ifndef NOPRO
    {
        PHASE_CTX
        float* COSH = (float*)(ws + WS_COSH); float* SINH = (float*)(ws + WS_SINH); float* COSR = (float*)(ws + WS_COSR); float* SINR = (float*)(ws + WS_SINR);
        const float* x = q->in[0]; const int* pos = (const int*)q->in[2];
        const int lane = lane_id(), tid = wave * 64 + lane;
        for (int i = bid * NTHREADS + tid; i < TT * 32; i += G * NTHREADS) { const int t = i >> 5, k = i & 31; float c, s; sincos_acc((float)pos[t] * q->inv_h[k], c, s); COSH[i] = c; SINH[i] = s; }
        for (int i = bid * NTHREADS + tid; i < TT * 16; i += G * NTHREADS) { const int t = i >> 4, k = i & 15; float c, s; sincos_acc((float)pos[t] * q->inv_r[k], c, s); COSR[i] = c; SINR[i] = s; }
        for (int row = gw; row < TT; row += NGW) {
            const f32x4* xr = (const f32x4*)(x + (size_t)row * D) + lane; float ss = 0.f;
            u32x2* o8 = (u32x2*)(XB + (size_t)row * D) + lane;
#pragma unroll
            for (int j = 0; j < 4; ++j) { const f32x4 v = xr[64 * j]; ss += (v.x * v.x + v.y * v.y) + (v.z * v.z + v.w * v.w); u32x2 w; w.x = cvtpk(v.x, v.y); w.y = cvtpk(v.z, v.w); o8[64 * j] = w; }
            ss = wave_sum(ss);
            if (lane < 16) PX[(size_t)row * 16 + lane] = lane == 0 ? ss : 0.f;
        }
        const float* mem = q->in[1]; bf16_t* MEMN = (bf16_t*)(ws + WS_MEMN);
        for (int row = gw; row < BATCH * NMEM; row += NGW) {
            const f32x4* xr = (const f32x4*)(mem + (size_t)row * D) + lane; f32x4 v[4]; float ss = 0.f;
#pragma unroll
            for (int j = 0; j < 4; ++j) { v[j] = xr[64 * j]; ss += (v[j].x * v[j].x + v[j].y * v[j].y) + (v[j].z * v[j].z + v[j].w * v[j].w); }
            const float rstd = __builtin_amdgcn_rsqf(wave_sum(ss) * (1.f / D) + EPS);
            u32x2* o8 = (u32x2*)(MEMN + (size_t)row * D) + lane;
#pragma unroll
            for (int j = 0; j < 4; ++j) { u32x2 w; w.x = cvtpk(v[j].x * rstd, v[j].y * rstd); w.y = cvtpk(v[j].z * rstd, v[j].w * rstd); o8[64 * j] = w; }
        }
    }

#endif
    for (int l = 0; l < DEPTH; ++l) {
#ifndef NOCONV
#pragma unroll 1
        for (int rep = 0; rep < REP_CONV; ++rep) convert_layer(l, lds, gw, NGW, wave);
#endif
        if (l == 0) grid.sync(); else GRID_SYNC();
        for (int ch = 0; ch < NCHUNK; ++ch) {
            const int tok0 = ch * TC;
#if PH & 1
            {
                PHASE_CTX
                pg8::TileOrder S; S.init(TC, NT_IN, G, bid, XB + (size_t)tok0 * D, (const bf16_t*)(ws + WS_WIN));
                EpiSlot<CfgIn> E{CfgIn{ws, q->in[6] + l * 64, q->in[7] + l * 64, q->in[14] + l * 96, q->in[15] + l * 192, q->in[16] + l * 192, q->in[5] + l * 4096},
                                 RowScale{PX, 16, 16, 1.f / D}, tok0, rt, tok0};
#pragma unroll 1
                for (int rep = 0; rep < REP_P1; ++rep) pg8::gemm_phase(lds, D, D, S, E, wave);
                if (ch == 0) {
                    pg8::TileOrder S2; S2.init(BATCH * NMEM, 1024, G, (bid + 128) % G, (const bf16_t*)(ws + WS_MEMN), (const bf16_t*)(ws + WS_WMKV));
                    EpiSlot<CfgMkv> E2{CfgMkv{ws}, RowScale{nullptr, 0, 0, 0.f}, 0, rt, 0};
                    pg8::gemm_phase(lds, D, D, S2, E2, wave);
                }
            }

#endif
            GRID_SYNC();
#if PH & 2
            {
                PHASE_CTX
                pg8::TileOrder S; S.init(TC, 1024, G, bid, (const bf16_t*)(ws + WS_CQ), (const bf16_t*)(ws + WS_WUQ));
                EpiSlot<CfgUq> E{CfgUq{ws, q->in[13] + l * 96}, RowScale{(const float*)(ws + WS_PCQ), 8, 6, 1.f / 384.f}, 0, rt, tok0};
                pg8::gemm_phase(lds, 384, 384, S, E, wave);
                pg8::TileOrder S2; S2.init(TC, 1024, G, bid, (const bf16_t*)(ws + WS_CKV), (const bf16_t*)(ws + WS_WUKV));
                EpiSlot<CfgUkv> E2{CfgUkv{ws, q->in[14] + l * 96}, RowScale{(const float*)(ws + WS_PCKV), 4, 4, 1.f / 256.f}, 0, rt, tok0};
                pg8::gemm_phase(lds, 256, 256, S2, E2, wave);
                const int lane = opaque(lane_id());
                const int nrows = TC + (ch == 0 ? BATCH * NMEM : 0);
                for (int rw = gw; rw < nrows; rw += NGW) {
                    const bool isq = rw < TC;
                    bf16_t* rp = isq ? (bf16_t*)(ws + WS_MQ) + (size_t)rw * 512 : (bf16_t*)(ws + WS_MK) + (size_t)(rw - TC) * 512;
                    const float* gn = (isq ? q->in[19] : q->in[20]) + l * 128 + (lane & 15) * 8;
                    const float scl = isq ? 0.08838834764831845f * LOG2E : 1.f;
                    float v[8]; unpack8(*(const u32x4*)(rp + lane * 8), v);
                    float ss = 0.f;
#pragma unroll
                    for (int i = 0; i < 8; ++i) ss += v[i] * v[i];
                    ss += __shfl_xor(ss, 1); ss += __shfl_xor(ss, 2); ss += __shfl_xor(ss, 4); ss += __shfl_xor(ss, 8);
                    const float inv = __builtin_amdgcn_rsqf(ss * (1.f / 128.f) + EPS) * scl;
#pragma unroll
                    for (int i = 0; i < 8; ++i) v[i] *= inv * gn[i];
                    *(u32x4*)(rp + lane * 8) = pack8(v);
                }
            }

#endif
            GRID_SYNC();
#if PH & 4
            {
                PHASE_CTX
                LAS char* al = (LAS char*)lds;
                const int lane = opaque(lane_id()), tid = wave * 64 + lane;
#pragma unroll 1
                for (int rep = 0; rep < REP_B; ++rep)
                for (int idx = bid; idx < BC * 8 * 16; idx += G) {
                    const int half = idx / (BC * 64), rem = idx % (BC * 64), bh = rem / 8, s = rem % 8;
                    const int qb = half == 0 ? s : 15 - s, b = bh / 8, hh = bh % 8;
                    const long r0 = (long)b * SEQ;
                    dense_unit<96, 64, true, true>((const bf16_t*)(ws + WS_QB) + (r0 + 256 * qb) * 768 + 96 * hh, 768,
                        (const bf16_t*)(ws + WS_KN) + r0 * 512 + 64 * hh, 512, (const bf16_t*)(ws + WS_KR) + r0 * 32, 32,
                        (const bf16_t*)(ws + WS_VB) + r0 * 512 + 64 * hh, 512, (bf16_t*)(ws + WS_OB) + (r0 + 256 * qb) * 512 + 64 * hh, 512,
                        256 * qb, 4 * (qb + 1), al, sc, tid);
                }
                for (int idx = bid; idx < 3 * BC * 32 * 4; idx += G) {
                    const int g = idx / (BC * 128), rem = idx % (BC * 128), hp = rem & 3, sj = rem >> 2;
                    const int dil = g == 0 ? 1 : g == 1 ? 4 : 16, nb = 32 / dil;
                    const int n = sj / nb, j = sj % nb, b = n / dil, res = n % dil;
                    const long row0 = (long)b * SEQ + res;
                    const bf16_t* Qg = (const bf16_t*)(ws + WS_CB + (size_t)(3 * g) * 16 * MiB); const bf16_t* Kg = (const bf16_t*)(ws + WS_CB + (size_t)(3 * g + 1) * 16 * MiB); const bf16_t* Vg = (const bf16_t*)(ws + WS_CB + (size_t)(3 * g + 2) * 16 * MiB);
#pragma unroll
                    for (int sl = 0; sl < 2; ++sl) {
                        banded_load(al + sl * BSLOT, BKP, Kg + 64 * (2 * hp + sl), 512, row0, dil, 128 * (j - 1), tid);
                        banded_load(al + sl * BSLOT + 256 * BKP, BVP, Vg + 64 * (2 * hp + sl), 512, row0, dil, 128 * (j - 1), tid);
                    }
                    __syncthreads();
                    { const int sl = wave >> 2, wq = wave & 3, hd = 2 * hp + sl, r = lane & 31;
                      const long qtok = row0 + (long)(128 * j + 32 * wq + r) * dil;
                      bf16_t* ob = (bf16_t*)Qg + (row0 + (long)(128 * j + 32 * wq) * dil) * 512 + 64 * hd;
                      banded_task<false, true>(Qg + qtok * 512 + 64 * hd, ob, (long)dil * 512, al + sl * BSLOT, al + sl * BSLOT + 256 * BKP, wq, j, 128, 0.f,
                                               (float*)(ws + WS_LSE) + (qtok * 8 + hd) * 4 + g, sc, lane); }
                    __syncthreads();
                }
                for (int idx = bid; idx < BC * 32 * 2; idx += G) {
                    const int kvh = idx & 1, j = (idx >> 1) & 31, b = idx >> 6;
                    const long row0 = (long)b * SEQ;
                    banded_load(al, BKP, (const bf16_t*)(ws + WS_KA) + 64 * kvh, 128, row0, 1, 128 * (j - 1), tid);
                    banded_load(al + 256 * BKP, BVP, (const bf16_t*)(ws + WS_VA) + 64 * kvh, 128, row0, 1, 128 * (j - 1), tid);
                    __syncthreads();
#pragma unroll 1
                    for (int pass = 0; pass < 2; ++pass) {
                        const int hq = kvh * 4 + (wave >> 2) + 2 * pass, wq = wave & 3, r = lane & 31;
                        const long qtok = row0 + 128 * j + 32 * wq + r;
                        bf16_t* QA = (bf16_t*)(ws + WS_QA);
                        banded_task<true, false>(QA + qtok * 512 + 64 * hq, QA + (row0 + 128 * j + 32 * wq) * 512 + 64 * hq, 512, al, al + 256 * BKP, wq, j, 127,
                                                 (q->in[8] + l * 8)[hq] * LOG2E, nullptr, sc, lane);
                    }
                    __syncthreads();
                }
                for (int idx = bid; idx < BC * 4 * 16; idx += G) {
                    const int qb = idx & 15, hh = (idx >> 4) & 3, b = idx >> 6;
                    const long r0 = (long)b * SEQ + 256 * qb; const long m0 = (long)(ch * BC + b) * NMEM;
                    bf16_t* MQ = (bf16_t*)(ws + WS_MQ);
                    dense_unit<128, 128, false, false>(MQ + r0 * 512 + 128 * hh, 512, (const bf16_t*)(ws + WS_MK) + m0 * 512 + 128 * hh, 512, nullptr, 0,
                        (const bf16_t*)(ws + WS_MV) + m0 * 512 + 128 * hh, 512, MQ + r0 * 512 + 128 * hh, 512, 0, 4, al, sc, tid);
                }
            }

#endif
            GRID_SYNC();
#if PH & 8
            {
                PHASE_CTX
                const float* LSE = (const float*)(ws + WS_LSE); bf16_t* OC = (bf16_t*)(ws + WS_OC);
                const int tid = wave * 64 + opaque(lane_id());
                for (int i = bid * NTHREADS + tid; i < TC * 64; i += G * NTHREADS) {
                    const int tok = i >> 6, c8 = i & 63, hd = c8 >> 3;
                    const f32x4 ls = *(const f32x4*)(LSE + ((size_t)tok * 8 + hd) * 4);
                    const float mx = fmaxf(ls.x, fmaxf(ls.y, ls.z));
                    float w0 = __builtin_amdgcn_exp2f(ls.x - mx), w1 = __builtin_amdgcn_exp2f(ls.y - mx), w2 = __builtin_amdgcn_exp2f(ls.z - mx);
                    const float inv = 1.f / (w0 + w1 + w2); w0 *= inv; w1 *= inv; w2 *= inv;
                    float a[8], b[8], c[8], o[8];
                    unpack8(*(const u32x4*)((const bf16_t*)(ws + WS_CB) + (size_t)tok * 512 + c8 * 8), a);
                    unpack8(*(const u32x4*)((const bf16_t*)(ws + WS_CB + 48 * MiB) + (size_t)tok * 512 + c8 * 8), b);
                    unpack8(*(const u32x4*)((const bf16_t*)(ws + WS_CB + 96 * MiB) + (size_t)tok * 512 + c8 * 8), c);
#pragma unroll
                    for (int k = 0; k < 8; ++k) o[k] = w0 * a[k] + w1 * b[k] + w2 * c[k];
                    *(u32x4*)(OC + (size_t)tok * 512 + c8 * 8) = pack8(o);
                }
            }

#endif
            GRID_SYNC();
#if PH & 16
            {
                PHASE_CTX
                pg8::TileOrder S; S.init(TC, D, G, bid, (const bf16_t*)(ws + WS_QA), (const bf16_t*)(ws + WS_WBR)); S.nseg = 4;
                S.segA = 8 * MiB; S.segB = (size_t)D * 512;
                EpiMerge E{(const bf16_t*)(ws + WS_GATES), (bf16_t*)(ws + WS_GY) + (size_t)tok0 * D};
                pg8::gemm_phase(lds, 512, 512, S, E, wave);
            }

#endif
            GRID_SYNC();
        }
        {
            const int tok0 = 0;
#if PH & 32
            {
                PHASE_CTX
                pg8::TileOrder S; S.init(TT, D, G, bid, (const bf16_t*)(ws + WS_GY), (const bf16_t*)(ws + WS_WOUT));
                EpiRes E{((l == 0) ? q->in[0] : q->out) + (size_t)tok0 * D, q->out + (size_t)tok0 * D, XB + (size_t)tok0 * D, PX + (size_t)tok0 * 16};
                pg8::gemm_phase(lds, D, D, S, E, wave);
            }

#endif
            GRID_SYNC();
#if PH & 64
            {
                PHASE_CTX
                pg8::TileOrder S; S.init(TT, DFF, G, bid, XB + (size_t)tok0 * D, (const bf16_t*)(ws + WS_WUP));
                EpiUp E{(bf16_t*)(ws + WS_U), RowScale{PX, 16, 16, 1.f / D}, tok0};
#pragma unroll 1
                for (int rep = 0; rep < REP_P7; ++rep) pg8::gemm_phase(lds, D, D, S, E, wave);
            }

#endif
            GRID_SYNC();
#if PH & 128
            {
                PHASE_CTX
                pg8::TileOrder S; S.init(TT, D, G, bid, (const bf16_t*)(ws + WS_U), (const bf16_t*)(ws + WS_WDN));
                EpiRes E{q->out + (size_t)tok0 * D, q->out + (size_t)tok0 * D, XB + (size_t)tok0 * D, PX + (size_t)tok0 * 16};
                pg8::gemm_phase(lds, DFF, DFF, S, E, wave);
            }

#endif
            GRID_SYNC();
        }
    }
}

extern "C" void kernel_launch(void* const* d_in, const int* in_sizes, int n_in, void* d_out, int out_size, void* d_ws, size_t ws_size, hipStream_t stream) {
    static int grid = 0;
    if (grid == 0) {
        if (n_in != 26 || out_size != TT * D || ws_size < WS_END) { fprintf(stderr, "kernel_launch: unexpected shapes (n_in %d out %d ws %zu)\n", n_in, out_size, ws_size); grid = -1; return; }
        int dev = 0, cus = 0, per_cu = 0;
        hipGetDevice(&dev); hipDeviceGetAttribute(&cus, hipDeviceAttributeMultiprocessorCount, dev);
        hipFuncSetAttribute((const void*)fwd_megakernel, hipFuncAttributeMaxDynamicSharedMemorySize, LDS_BYTES);
        hipOccupancyMaxActiveBlocksPerMultiprocessor(&per_cu, (const void*)fwd_megakernel, NTHREADS, LDS_BYTES);
        if (per_cu < 1) { fprintf(stderr, "kernel_launch: occupancy query says %d blocks per CU\n", per_cu); per_cu = 1; }
        (void)hipGetLastError();
        grid = cus;
    }
    if (grid < 0) return;
    if (hipMemsetAsync((char*)d_ws + WS_CTL, 0, XCD_BAR_WORDS * 4, stream) != hipSuccess) { fprintf(stderr, "kernel_launch: memset failed\n"); return; }
    Params p{};
    for (int i = 0; i < 26; ++i) p.in[i] = (const float*)d_in[i];
    p.out = (float*)d_out; p.ws = (unsigned char*)d_ws;
    for (int i = 0; i < 32; ++i) p.inv_h[i] = (float)std::pow(10000.0, -(double)(2 * i) / 64.0);
    for (int i = 0; i < 16; ++i) p.inv_r[i] = (float)std::pow(10000.0, -(double)(2 * i) / 32.0);
    void* args[] = {&p};
    hipError_t e = hipLaunchCooperativeKernel((const void*)fwd_megakernel, dim3(grid), dim3(NTHREADS), args, LDS_BYTES, stream);
    if (e != hipSuccess) fprintf(stderr, "cooperative launch failed: %s (grid %d)\n", hipGetErrorString(e), grid);
}
```

```cpp
#include <hip/hip_runtime.h>
#include <hip/hip_cooperative_groups.h>
#include <cstdio>
#include <cstdint>
#include <cmath>
namespace cg = cooperative_groups;

#define LAS __attribute__((address_space(3)))
#define DI __device__ __forceinline__
typedef unsigned short bf16_t;
typedef short bf16x8 __attribute__((ext_vector_type(8)));
typedef short s16x4 __attribute__((ext_vector_type(4)));
typedef float f32x4 __attribute__((ext_vector_type(4)));
typedef float f32x16 __attribute__((ext_vector_type(16)));
typedef unsigned u32x4 __attribute__((ext_vector_type(4)));
typedef unsigned u32x2 __attribute__((ext_vector_type(2)));
typedef float f32x2_t __attribute__((ext_vector_type(2)));
typedef __bf16 bf16x2_t __attribute__((ext_vector_type(2)));

constexpr int D = 1024, BATCH = 8, SEQ = 4096, DEPTH = 4, TT = BATCH * SEQ;
constexpr int NCHUNK = 2, BC = BATCH / NCHUNK, TC = BC * SEQ;
constexpr int N_IN = 10656, NT_IN = 10752;
constexpr int DFF = 4096, NMEM = 256;
constexpr float EPS = 1e-6f;
constexpr float LOG2E = 1.4426950408889634f;
constexpr float NEGBIG = -1e30f;
constexpr int NTHREADS = 512, NWAVES = 8;

constexpr size_t MiB = 1u << 20;
constexpr size_t WS_CTL = 0;
constexpr size_t WS_WIN = 1 * MiB, WS_WUQ = 22 * MiB, WS_WUKV = 23 * MiB, WS_WMKV = 24 * MiB, WS_WBR = 26 * MiB, WS_WOUT = 30 * MiB, WS_WUP = 32 * MiB, WS_WDN = 40 * MiB;
constexpr size_t WS_XB = 48 * MiB, WS_PX = 112 * MiB, WS_COSH = 114 * MiB, WS_SINH = 118 * MiB, WS_COSR = 122 * MiB, WS_SINR = 124 * MiB;
constexpr size_t WS_MEMN = 126 * MiB, WS_MK = 130 * MiB, WS_MV = 132 * MiB;
constexpr size_t WS_QA = 134 * MiB, WS_OB = 150 * MiB, WS_OC = 166 * MiB, WS_MQ = 182 * MiB;
constexpr size_t WS_KA = 198 * MiB, WS_VA = 202 * MiB, WS_CQ = 206 * MiB, WS_CKV = 218 * MiB, WS_KR = 226 * MiB, WS_PCQ = 227 * MiB, WS_PCKV = 227 * MiB + 512 * 1024;
constexpr size_t WS_CB = 228 * MiB;
constexpr size_t WS_GATES = 372 * MiB, WS_U = WS_CB;
constexpr size_t WS_QB = 500 * MiB, WS_KN = 524 * MiB, WS_VB = 540 * MiB, WS_LSE = 556 * MiB, WS_GY = 558 * MiB;
constexpr size_t WS_END = 622 * MiB;

constexpr int LDS_BYTES = 155648;
constexpr int LDS_SCR = 149504;

struct Params {
    const float* in[26];
    float* out;
    unsigned char* ws;
    float inv_h[32];
    float inv_r[16];
    int pad[2];
};

DI unsigned cvtpk(float lo, float hi) { f32x2_t v = {lo, hi}; bf16x2_t b = __builtin_convertvector(v, bf16x2_t); return __builtin_bit_cast(unsigned, b); }
DI float bf_lo(unsigned w) { return __uint_as_float(w << 16); }
DI float bf_hi(unsigned w) { return __uint_as_float(w & 0xffff0000u); }
DI u32x4 pack8(const float* v) { u32x4 w; w.x = cvtpk(v[0], v[1]); w.y = cvtpk(v[2], v[3]); w.z = cvtpk(v[4], v[5]); w.w = cvtpk(v[6], v[7]); return w; }
DI void unpack8(u32x4 w, float* v) { v[0] = bf_lo(w.x); v[1] = bf_hi(w.x); v[2] = bf_lo(w.y); v[3] = bf_hi(w.y); v[4] = bf_lo(w.z); v[5] = bf_hi(w.z); v[6] = bf_lo(w.w); v[7] = bf_hi(w.w); }
DI float wave_sum(float v) {
#pragma unroll
    for (int o = 1; o < 64; o <<= 1) v += __shfl_xor(v, o);
    return v;
}
struct RopeTabs { const float* cosh; const float* sinh; const float* cosr; const float* sinr; };
typedef const struct Params __attribute__((address_space(4))) CParams;
DI CParams* fresh_params() { unsigned long long k = (unsigned long long)__builtin_amdgcn_kernarg_segment_ptr(); asm volatile("" : "+s"(k)); return (CParams*)k; }
#define PHASE_CTX \
    CParams* q = fresh_params(); unsigned char* ws = q->ws; (void)ws; \
    bf16_t* XB = (bf16_t*)(ws + WS_XB); float* PX = (float*)(ws + WS_PX); (void)XB; (void)PX; \
    const RopeTabs rt{(const float*)(ws + WS_COSH), (const float*)(ws + WS_SINH), (const float*)(ws + WS_COSR), (const float*)(ws + WS_SINR)}; (void)rt;
DI int opaque(int v) { asm volatile("" : "+v"(v)); return v; }
DI int lane_id() { int v; asm volatile("v_mbcnt_lo_u32_b32 %0, -1, 0\n\tv_mbcnt_hi_u32_b32 %0, -1, %0" : "=v"(v)); return v; }
#define LDS_WAIT() asm volatile("s_waitcnt lgkmcnt(0)" ::: "memory")

namespace pg8 {
constexpr int BM = 256, BK = 64, HALF = 128, HTB = HALF * BK * 2, STAGE_BYTES = 8 * HTB, NXCD = 8, WGM = 8;
DI int lds_byte(int r, int c) { const int st = (r >> 4) * 2 + (c >> 5), rr = r & 15, cc = c & 31, ob = rr * 64 + cc * 2; return st * 1024 + (ob ^ (((ob >> 9) & 1) << 5)); }
DI void stage_rc(int b, int& R, int& C) { const int st = b / 1024, sb = b % 1024, swz = sb ^ (((sb >> 9) & 1) << 5); R = (st >> 1) * 16 + swz / 64; C = (st & 1) * 32 + (swz % 64) / 2; }
DI int perm32(int rho) { const int n = rho >> 4, i = rho & 15; return 8 * (i >> 2) + 4 * n + (i & 3); }

struct Unit { int pm, pn, seg; const bf16_t* A; const bf16_t* Bt; };

struct TileOrder {
    int nM, nN, nwg, G, c, nseg;
    const bf16_t* A0; const bf16_t* B0; size_t segA, segB;
    DI void init(int M, int N, int G_, int c_, const bf16_t* A, const bf16_t* B) { nM = M / BM; nN = N / BM; nwg = nM * nN; G = G_; c = c_; nseg = 1; A0 = A; B0 = B; segA = 0; segB = 0; }
    DI bool next(int i, Unit& u) const {
        const int seg = i % nseg, ti = i / nseg;
        const long L = (long)ti * G + c; if (L >= nwg) return false;
        int wgid = (int)L; { const int q = nwg / NXCD, r = nwg % NXCD, xcd = wgid % NXCD, off = wgid / NXCD; wgid = (xcd < r ? xcd * (q + 1) : r * (q + 1) + (xcd - r) * q) + off; }
        const int nig = WGM * nN, gid = wgid / nig, fm = gid * WGM, gsz = (nM - fm) < WGM ? (nM - fm) : WGM;
        u.pm = fm + ((wgid % nig) % gsz); u.pn = (wgid % nig) / gsz; u.seg = seg;
        u.A = A0 + (size_t)seg * segA; u.Bt = B0 + (size_t)seg * segB;
        return true;
    }
};

template <class Epi, class Sched>
DI void gemm_phase(LAS unsigned char* lds, const int K, const int lda, const Sched& S, const Epi& E, const int wid) {
    const int lane = opaque(lane_id()), tid = wid * 64 + lane, wr = wid >> 2, wc = wid & 3, fr = lane & 15, fq = lane >> 4;
    const int nt = K / BK;
    unsigned voffA[2], voffB[2];
#pragma unroll
    for (int i = 0; i < 2; ++i) { int R, C; stage_rc(tid * 16 + i * 8192, R, C); const int Rb = (R & ~31) + perm32(R & 31);
        voffA[i] = (unsigned)(R * lda + C) * 2u; voffB[i] = (unsigned)(Rb * K + C) * 2u; }
    const size_t kstep = (size_t)(BK * 2);
    const size_t hstepA = (size_t)HALF * lda * 2, hstepB = (size_t)HALF * K * 2;
    const size_t tstepA = 2 * hstepA, tstepB = 2 * hstepB;
    const unsigned ldsw = (unsigned)wid * 1024u;
    const int aoff = lds_byte(wr * 64 + fr, fq * 8), boff = lds_byte(wc * 32 + fr, fq * 8);
#define PG8_SA(b, h) (((b) * 2 + (h)) * HTB)
#define PG8_SB(b, h) ((4 + (b) * 2 + (h)) * HTB)
#define PG8_STAGE(bufoff, gbase, voff) do { _Pragma("unroll") for (int _i = 0; _i < 2; ++_i) \
        __builtin_amdgcn_global_load_lds((const unsigned*)((const char*)(gbase) + (voff)[_i]), (LAS unsigned*)(lds + (bufoff) + ldsw + _i * 8192), 16, 0, 0); } while (0)
#define PG8_LDA(dst, b, h) do { _Pragma("unroll") for (int m = 0; m < 4; ++m) _Pragma("unroll") for (int k = 0; k < 2; ++k) dst[m][k] = *(const LAS bf16x8*)(lds + PG8_SA(b, h) + aoff + m * 2048 + k * 1024); } while (0)
#define PG8_LDB(dst, b, h) do { _Pragma("unroll") for (int n = 0; n < 2; ++n) _Pragma("unroll") for (int k = 0; k < 2; ++k) dst[n][k] = *(const LAS bf16x8*)(lds + PG8_SB(b, h) + boff + n * 2048 + k * 1024); } while (0)
#define PG8_MMA(ai, bj, At, Bt) do { __builtin_amdgcn_s_setprio(1); _Pragma("unroll") for (int m = 0; m < 4; ++m) _Pragma("unroll") for (int n = 0; n < 2; ++n) _Pragma("unroll") for (int k = 0; k < 2; ++k) \
        acc[ai][bj][m][n] = __builtin_amdgcn_mfma_f32_16x16x32_bf16(Bt[n][k], At[m][k], acc[ai][bj][m][n], 0, 0, 0); __builtin_amdgcn_s_setprio(0); } while (0)
#define PG8_WAIT_V(n) asm volatile("s_waitcnt vmcnt(" #n ")" ::: "memory")
#define PG8_WAIT_L(n) asm volatile("s_waitcnt lgkmcnt(" #n ")" ::: "memory")
#define PG8_BAR __builtin_amdgcn_s_barrier()
#define PG8_SCHED __builtin_amdgcn_sched_barrier(0)
    Unit cur, nxt; int ui = 0;
    if (!S.next(0, cur)) return;
    f32x4 acc[2][2][4][2];
#pragma unroll
    for (int a = 0; a < 2; ++a)
#pragma unroll
        for (int b = 0; b < 2; ++b)
#pragma unroll
            for (int m = 0; m < 4; ++m)
#pragma unroll
                for (int n = 0; n < 2; ++n) acc[a][b][m][n] = (f32x4){0.f, 0.f, 0.f, 0.f};
    bf16x8 At[4][2], B0[2][2], B1[2][2];
    const char* cA = (const char*)cur.A + (size_t)cur.pm * tstepA; const char* cB = (const char*)cur.Bt + (size_t)cur.pn * tstepB;
    PG8_STAGE(PG8_SB(0, 0), cB, voffB); PG8_STAGE(PG8_SB(0, 1), cB + hstepB, voffB); PG8_STAGE(PG8_SA(0, 0), cA, voffA); PG8_STAGE(PG8_SA(0, 1), cA + hstepA, voffA);
    if (wr == 1) PG8_BAR;
    PG8_WAIT_V(2); PG8_BAR;
    PG8_STAGE(PG8_SB(1, 0), cB + kstep, voffB); PG8_STAGE(PG8_SA(1, 0), cA + kstep, voffA); PG8_STAGE(PG8_SB(1, 1), cB + hstepB + kstep, voffB);
    PG8_WAIT_V(6); PG8_BAR;
    for (;;) {
        const bool has_next = S.next(ui + 1, nxt);
        const char* nA = has_next ? (const char*)nxt.A + (size_t)nxt.pm * tstepA : cA; const char* nB = has_next ? (const char*)nxt.Bt + (size_t)nxt.pn * tstepB : cB;
#pragma unroll 1
        for (int t = 0; t < nt; t += 2) {
            const bool last = (t == nt - 2);
            const char* a1 = cA + (size_t)(t + 1) * kstep;
            const char* a2 = last ? nA : cA + (size_t)(t + 2) * kstep; const char* b2 = last ? nB : cB + (size_t)(t + 2) * kstep;
            const char* a3 = a2 + kstep; const char* b3 = b2 + kstep;
            PG8_LDB(B0, 0, 0); PG8_LDB(B1, 0, 1); PG8_SCHED; PG8_LDA(At, 0, 0); PG8_STAGE(PG8_SA(1, 1), a1 + hstepA, voffA);
            PG8_WAIT_V(8); PG8_WAIT_L(0); PG8_BAR; PG8_MMA(0, 0, At, B0); PG8_MMA(0, 1, At, B1); PG8_BAR; PG8_SCHED;
            PG8_LDA(At, 0, 1); PG8_STAGE(PG8_SB(0, 0), b2, voffB); PG8_STAGE(PG8_SB(0, 1), b2 + hstepB, voffB); PG8_STAGE(PG8_SA(0, 0), a2, voffA);
            PG8_WAIT_V(8); PG8_WAIT_L(0); PG8_BAR; PG8_MMA(1, 0, At, B0); PG8_MMA(1, 1, At, B1); PG8_BAR; PG8_SCHED;
            PG8_LDB(B0, 1, 0); PG8_LDB(B1, 1, 1); PG8_SCHED; PG8_LDA(At, 1, 0); PG8_STAGE(PG8_SA(0, 1), a2 + hstepA, voffA);
            PG8_WAIT_V(8); PG8_WAIT_L(0); PG8_BAR; PG8_MMA(0, 0, At, B0); PG8_MMA(0, 1, At, B1); PG8_BAR; PG8_SCHED;
            PG8_LDA(At, 1, 1); PG8_STAGE(PG8_SB(1, 0), b3, voffB); PG8_STAGE(PG8_SB(1, 1), b3 + hstepB, voffB); PG8_STAGE(PG8_SA(1, 0), a3, voffA);
            PG8_WAIT_V(8); PG8_WAIT_L(0); PG8_BAR; PG8_MMA(1, 0, At, B0); PG8_MMA(1, 1, At, B1); PG8_BAR; PG8_SCHED;
        }
        if (wr == 0) PG8_BAR;
        E(acc, cur, wr, wc, fr, fq);
        if (!has_next) break;
#pragma unroll
        for (int a = 0; a < 2; ++a)
#pragma unroll
            for (int b = 0; b < 2; ++b)
#pragma unroll
                for (int m = 0; m < 4; ++m)
#pragma unroll
                    for (int n = 0; n < 2; ++n) acc[a][b][m][n] = (f32x4){0.f, 0.f, 0.f, 0.f};
        cur = nxt; cA = nA; cB = nB; ++ui;
        if (wr == 1) PG8_BAR;
    }
    PG8_WAIT_V(0);
    PG8_BAR;
#undef PG8_SA
#undef PG8_SB
#undef PG8_STAGE
#undef PG8_LDA
#undef PG8_LDB
#undef PG8_MMA
#undef PG8_WAIT_V
#undef PG8_WAIT_L
#undef PG8_BAR
#undef PG8_SCHED
}
}

struct RowScale {
    const float* part; int stride; int cnt; float inv_n;
    DI float get(int row) const {
        if (!part) return 1.f;
        float s = 0.f;
        const float* p = part + (size_t)row * stride;
        for (int i = 0; i < cnt; i += 4) { const f32x4 v = *(const f32x4*)(p + i); s += (v.x + v.y) + (v.z + v.w); }
        return __builtin_amdgcn_rsqf(s * inv_n + EPS);
    }
};

DI void rs_preload(const RowScale& rs, int rowbase, int fq, float (&out)[8]) {
    if (!rs.part) {
#pragma unroll
        for (int i = 0; i < 8; ++i) out[i] = 1.f;
        return;
    }
    const int ng = (rs.cnt + 3) >> 2, gq = fq < ng ? fq : ng - 1;
    const float w0 = (fq < ng && 4 * gq + 0 < rs.cnt) ? 1.f : 0.f, w1 = (fq < ng && 4 * gq + 1 < rs.cnt) ? 1.f : 0.f, w2 = (fq < ng && 4 * gq + 2 < rs.cnt) ? 1.f : 0.f, w3 = (fq < ng && 4 * gq + 3 < rs.cnt) ? 1.f : 0.f;
#pragma unroll
    for (int hb = 0; hb < 2; ++hb) {
        f32x4 v[4];
#pragma unroll
        for (int i = 0; i < 4; ++i) v[i] = *(const f32x4*)(rs.part + (size_t)(rowbase + hb * 128 + i * 16) * rs.stride + 4 * gq);
#pragma unroll
        for (int i = 0; i < 4; ++i) { float t = (v[i].x * w0 + v[i].y * w1) + (v[i].z * w2 + v[i].w * w3); t += __shfl_xor(t, 16); t += __shfl_xor(t, 32); out[hb * 4 + i] = __builtin_amdgcn_rsqf(t * rs.inv_n + EPS); }
    }
}
enum { SK_SKIP = 0, SK_RAW = 1, SK_HEAD = 2, SK_ROPE32 = 3, SK_GATE = 4 };
struct SlotDesc { int kind; bf16_t* dst; int ld; int col; const float* gain; float scale; int rope; float* part; int pstride; int pidx; const float* bias; };


template <class Cfg>
struct EpiSlot {
    Cfg cfg; RowScale rs; int rs_off; RopeTabs rt; int tok_off;
    template <int KIND>
    DI void run(const f32x4 (&acc)[2][2][4][2], const pg8::Unit& u, const SlotDesc& d, int wr, int fr, int fq) const {
        const int d0 = 8 * fq;
        float rsv[8]; rs_preload(rs, u.pm * 256 + wr * 64 + fr + rs_off, fq, rsv);
        float g0[8], g1[8];
        {
            const float* gp0 = (KIND == 4) ? d.bias + d.col + d0 : d.gain + ((KIND == 3 && fq >= 2) ? 0 : d0);
            const float* gp1 = gp0 + ((KIND == 3) ? 16 : 32);
            f32x4 a = (f32x4){0.f, 0.f, 0.f, 0.f}, b = a, c = a, e = a;
            if (KIND != 1) { a = *(const f32x4*)gp0; b = *(const f32x4*)(gp0 + 4); c = *(const f32x4*)gp1; e = *(const f32x4*)(gp1 + 4); }
            const float sc = (KIND == 4) ? 1.f : ((KIND == 3 && fq >= 2) ? 0.f : d.scale);
#pragma unroll
            for (int i = 0; i < 4; ++i) { g0[i] = a[i] * sc; g0[4 + i] = b[i] * sc; g1[i] = c[i] * sc; g1[4 + i] = e[i] * sc; }
        }
#pragma unroll
        for (int ai = 0; ai < 2; ++ai)
#pragma unroll
            for (int m = 0; m < 4; ++m) {
                const int row = u.pm * 256 + ai * 128 + wr * 64 + m * 16 + fr;
                const float r = rsv[ai * 4 + m];
                float v0[8], v1[8];
#pragma unroll
                for (int n = 0; n < 2; ++n)
#pragma unroll
                    for (int j = 0; j < 4; ++j) { v0[4 * n + j] = acc[ai][0][m][n][j] * r; v1[4 * n + j] = acc[ai][1][m][n][j] * r; }
                bf16_t* dp = d.dst + (size_t)row * d.ld + d.col;
                if (KIND == 1) {
                    if (d.part) {
                        float ss = 0.f;
#pragma unroll
                        for (int i = 0; i < 8; ++i) ss += v0[i] * v0[i] + v1[i] * v1[i];
                        ss += __shfl_xor(ss, 16); ss += __shfl_xor(ss, 32);
                        if (fq == 0) d.part[(size_t)row * d.pstride + d.pidx] = ss;
                    }
                    *(u32x4*)(dp + d0) = pack8(v0); *(u32x4*)(dp + 32 + d0) = pack8(v1);
                } else if (KIND == 4) {
#pragma unroll
                    for (int i = 0; i < 8; ++i) { v0[i] = __builtin_amdgcn_rcpf(1.f + __builtin_amdgcn_exp2f(-(v0[i] + g0[i]) * LOG2E)); v1[i] = __builtin_amdgcn_rcpf(1.f + __builtin_amdgcn_exp2f(-(v1[i] + g1[i]) * LOG2E)); }
                    *(u32x4*)(dp + d0) = pack8(v0); *(u32x4*)(dp + 32 + d0) = pack8(v1);
                } else if (KIND == 2 || KIND == 5) {
                    float ss = 0.f;
#pragma unroll
                    for (int i = 0; i < 8; ++i) ss += v0[i] * v0[i] + v1[i] * v1[i];
                    ss += __shfl_xor(ss, 16); ss += __shfl_xor(ss, 32);
                    const float inv = __builtin_amdgcn_rsqf(ss * (1.f / 64.f) + EPS);
#pragma unroll
                    for (int i = 0; i < 8; ++i) { v0[i] *= inv * g0[i]; v1[i] *= inv * g1[i]; }
                    if (KIND == 5) {
                        const float* cp = rt.cosh + (size_t)(row + tok_off) * 32 + d0; const float* sp = rt.sinh + (size_t)(row + tok_off) * 32 + d0;
                        const f32x4 c0 = *(const f32x4*)cp, c1 = *(const f32x4*)(cp + 4), s0 = *(const f32x4*)sp, s1 = *(const f32x4*)(sp + 4);
#pragma unroll
                        for (int i = 0; i < 8; ++i) { const float c = i < 4 ? c0[i & 3] : c1[i & 3], sn = i < 4 ? s0[i & 3] : s1[i & 3];
                            const float a = v0[i], b = v1[i]; v0[i] = a * c - b * sn; v1[i] = b * c + a * sn; }
                    }
                    *(u32x4*)(dp + d0) = pack8(v0); *(u32x4*)(dp + 32 + d0) = pack8(v1);
                } else {
                    float ss = 0.f;
#pragma unroll
                    for (int i = 0; i < 8; ++i) ss += v0[i] * v0[i] + v1[i] * v1[i];
                    ss += __shfl_xor(ss, 16); ss += __shfl_xor(ss, 32);
                    const float inv = __builtin_amdgcn_rsqf(ss * (1.f / 32.f) + EPS);
                    if (fq < 2) {
#pragma unroll
                        for (int i = 0; i < 8; ++i) { v0[i] *= inv * g0[i]; v1[i] *= inv * g1[i]; }
                        const float* cp = rt.cosr + (size_t)(row + tok_off) * 16 + d0; const float* sp = rt.sinr + (size_t)(row + tok_off) * 16 + d0;
                        const f32x4 c0 = *(const f32x4*)cp, c1 = *(const f32x4*)(cp + 4), s0 = *(const f32x4*)sp, s1 = *(const f32x4*)(sp + 4);
#pragma unroll
                        for (int i = 0; i < 8; ++i) { const float c = i < 4 ? c0[i & 3] : c1[i & 3], sn = i < 4 ? s0[i & 3] : s1[i & 3];
                            const float a = v0[i], b = v1[i]; v0[i] = a * c - b * sn; v1[i] = b * c + a * sn; }
                        *(u32x4*)(dp + d0) = pack8(v0); *(u32x4*)(dp + 16 + d0) = pack8(v1);
                    }
                }
            }
    }
    DI void operator()(const f32x4 (&acc)[2][2][4][2], const pg8::Unit& u, int wr, int wc, int fr_, int fq_) const {
        const int fr = opaque(fr_), fq = opaque(fq_);
        const SlotDesc d = cfg.get(u.pn * 4 + wc);
        if (d.kind == SK_RAW) run<1>(acc, u, d, wr, fr, fq);
        else if (d.kind == SK_GATE) run<4>(acc, u, d, wr, fr, fq);
        else if (d.kind == SK_HEAD) { if (d.rope) run<5>(acc, u, d, wr, fr, fq); else run<2>(acc, u, d, wr, fr, fq); }
        else if (d.kind == SK_ROPE32) run<3>(acc, u, d, wr, fr, fq);
    }
};

struct CfgIn {
    unsigned char* ws; const float* a_qn; const float* a_kn; const float* b_kn; const float* c_qn; const float* c_kn; const float* b_gate;
    DI SlotDesc get(int s) const {
        SlotDesc d; d.kind = SK_SKIP; d.dst = nullptr; d.ld = 0; d.col = 0; d.gain = nullptr; d.scale = 1.f; d.rope = 0; d.part = nullptr; d.pstride = 0; d.pidx = 0; d.bias = nullptr;
        if (s < 8) { d.kind = SK_HEAD; d.dst = (bf16_t*)(ws + WS_QA); d.ld = 512; d.col = 64 * s; d.gain = a_qn; d.scale = 0.125f * LOG2E; d.rope = 1; }
        else if (s < 10) { d.kind = SK_HEAD; d.dst = (bf16_t*)(ws + WS_KA); d.ld = 128; d.col = 64 * (s - 8); d.gain = a_kn; d.rope = 1; }
        else if (s < 12) { d.kind = SK_RAW; d.dst = (bf16_t*)(ws + WS_VA); d.ld = 128; d.col = 64 * (s - 10); }
        else if (s < 18) { d.kind = SK_RAW; d.dst = (bf16_t*)(ws + WS_CQ); d.ld = 384; d.col = 64 * (s - 12); d.part = (float*)(ws + WS_PCQ); d.pstride = 8; d.pidx = s - 12; }
        else if (s < 22) { d.kind = SK_RAW; d.dst = (bf16_t*)(ws + WS_CKV); d.ld = 256; d.col = 64 * (s - 18); d.part = (float*)(ws + WS_PCKV); d.pstride = 4; d.pidx = s - 18; }
        else if (s == 22) { d.kind = SK_ROPE32; d.dst = (bf16_t*)(ws + WS_KR); d.ld = 32; d.col = 0; d.gain = b_kn + 64; }
        else if (s < 95) { const int p = (s - 23) >> 3, h = (s - 23) & 7, g = p / 3, t = p % 3;
            d.dst = (bf16_t*)(ws + WS_CB + (size_t)p * 16 * MiB); d.ld = 512; d.col = 64 * h;
            if (t == 0) { d.kind = SK_HEAD; d.gain = c_qn + 64 * g; d.scale = 0.125f * LOG2E; d.rope = 1; }
            else if (t == 1) { d.kind = SK_HEAD; d.gain = c_kn + 64 * g; d.rope = 1; }
            else d.kind = SK_RAW; }
        else if (s < 103) { d.kind = SK_RAW; d.dst = (bf16_t*)(ws + WS_MQ); d.ld = 512; d.col = 64 * (s - 95); }
        else if (s < 167) { d.kind = SK_GATE; d.dst = (bf16_t*)(ws + WS_GATES); d.ld = 4096; d.col = 64 * (s - 103); d.bias = b_gate; }
        return d;
    }
};
DI void in_slot_src(int s, int& src, int& kind) {
    kind = 0;
    if (s < 22) src = 64 * s;
    else if (s == 22) { src = 1408; kind = 1; }
    else if (s < 167) src = 1440 + 64 * (s - 23);
    else { src = 0; kind = 2; }
}
struct CfgUq {
    unsigned char* ws; const float* b_qn;
    DI SlotDesc get(int s) const {
        SlotDesc d; d.dst = (bf16_t*)(ws + WS_QB); d.ld = 768; d.scale = 0.10206207261596575f * LOG2E; d.rope = 0; d.part = nullptr; d.pstride = 0; d.pidx = 0; d.bias = nullptr;
        if (s < 8) { d.kind = SK_HEAD; d.col = 96 * s; d.gain = b_qn; }
        else { d.kind = SK_ROPE32; d.col = 96 * (s - 8) + 64; d.gain = b_qn + 64; }
        return d;
    }
};
struct CfgUkv {
    unsigned char* ws; const float* b_kn;
    DI SlotDesc get(int s) const {
        SlotDesc d; d.ld = 512; d.scale = 1.f; d.rope = 0; d.part = nullptr; d.pstride = 0; d.pidx = 0; d.bias = nullptr; d.gain = b_kn;
        if (s < 8) { d.kind = SK_HEAD; d.dst = (bf16_t*)(ws + WS_KN); d.col = 64 * s; }
        else { d.kind = SK_RAW; d.dst = (bf16_t*)(ws + WS_VB); d.col = 64 * (s - 8); }
        return d;
    }
};
struct CfgMkv {
    unsigned char* ws;
    DI SlotDesc get(int s) const {
        SlotDesc d; d.kind = SK_RAW; d.ld = 512; d.scale = 1.f; d.rope = 0; d.part = nullptr; d.pstride = 0; d.pidx = 0; d.bias = nullptr; d.gain = nullptr;
        if (s < 8) { d.dst = (bf16_t*)(ws + WS_MK); d.col = 64 * s; } else { d.dst = (bf16_t*)(ws + WS_MV); d.col = 64 * (s - 8); }
        return d;
    }
};

struct EpiMerge {
    const bf16_t* gates; bf16_t* gy;
    template <bool FIRST>
    DI void run(const f32x4 (&acc)[2][2][4][2], const pg8::Unit& u, int wr, int wc, int fr, int fq) const {
#pragma unroll
        for (int ai = 0; ai < 2; ++ai)
#pragma unroll
            for (int mp = 0; mp < 2; ++mp) {
                u32x4 gl[2][2], ol[2][2];
#pragma unroll
                for (int mm = 0; mm < 2; ++mm)
#pragma unroll
                    for (int bj = 0; bj < 2; ++bj) {
                        const int row = u.pm * 256 + ai * 128 + wr * 64 + (2 * mp + mm) * 16 + fr, col = u.pn * 256 + bj * 128 + wc * 32 + 8 * fq;
                        gl[mm][bj] = *(const u32x4*)(gates + (size_t)row * 4096 + u.seg * 1024 + col);
                        if (!FIRST) ol[mm][bj] = *(const u32x4*)(gy + (size_t)row * 1024 + col);
                    }
#pragma unroll
                for (int mm = 0; mm < 2; ++mm)
#pragma unroll
                    for (int bj = 0; bj < 2; ++bj) {
                        const int m = 2 * mp + mm;
                        const int row = u.pm * 256 + ai * 128 + wr * 64 + m * 16 + fr, col = u.pn * 256 + bj * 128 + wc * 32 + 8 * fq;
                        float g[8], o[8];
                        unpack8(gl[mm][bj], g);
                        if (FIRST) {
#pragma unroll
                            for (int i = 0; i < 8; ++i) o[i] = 0.f;
                        } else unpack8(ol[mm][bj], o);
#pragma unroll
                        for (int n = 0; n < 2; ++n)
#pragma unroll
                            for (int j = 0; j < 4; ++j) o[4 * n + j] += g[4 * n + j] * acc[ai][bj][m][n][j];
                        *(u32x4*)(gy + (size_t)row * 1024 + col) = pack8(o);
                    }
            }
    }
    DI void operator()(const f32x4 (&acc)[2][2][4][2], const pg8::Unit& u, int wr, int wc, int fr_, int fq_) const {
        const int fr = opaque(fr_), fq = opaque(fq_);
        if (u.seg == 0) run<true>(acc, u, wr, wc, fr, fq); else run<false>(acc, u, wr, wc, fr, fq);
    }
};
struct EpiRes {
    const float* xsrc; float* xdst; bf16_t* xb; float* px;
    DI void operator()(const f32x4 (&acc)[2][2][4][2], const pg8::Unit& u, int wr, int wc, int fr_, int fq_) const {
        const int fr = opaque(fr_), fq = opaque(fq_);
#pragma unroll
        for (int ai = 0; ai < 2; ++ai)
#pragma unroll
            for (int mp = 0; mp < 2; ++mp) {
                f32x4 xs[2][2][2];
#pragma unroll
                for (int mm = 0; mm < 2; ++mm)
#pragma unroll
                    for (int bj = 0; bj < 2; ++bj) {
                        const size_t off = (size_t)(u.pm * 256 + ai * 128 + wr * 64 + (2 * mp + mm) * 16 + fr) * 1024 + u.pn * 256 + bj * 128 + wc * 32 + 8 * fq;
                        xs[mm][bj][0] = *(const f32x4*)(xsrc + off); xs[mm][bj][1] = *(const f32x4*)(xsrc + off + 4);
                    }
#pragma unroll
                for (int mm = 0; mm < 2; ++mm) {
                    const int m = 2 * mp + mm, row = u.pm * 256 + ai * 128 + wr * 64 + m * 16 + fr;
                    float ss = 0.f;
#pragma unroll
                    for (int bj = 0; bj < 2; ++bj) {
                        const size_t off = (size_t)row * 1024 + u.pn * 256 + bj * 128 + wc * 32 + 8 * fq;
                        float o[8];
#pragma unroll
                        for (int n = 0; n < 2; ++n) { const f32x4 xn = xs[mm][bj][n] + acc[ai][bj][m][n]; *(f32x4*)(xdst + off + 4 * n) = xn;
#pragma unroll
                            for (int j = 0; j < 4; ++j) { o[4 * n + j] = xn[j]; ss += xn[j] * xn[j]; } }
                        *(u32x4*)(xb + off) = pack8(o);
                    }
                    ss += __shfl_xor(ss, 16); ss += __shfl_xor(ss, 32);
                    if (fq == 0) px[(size_t)row * 16 + u.pn * 4 + wc] = ss;
                }
            }
    }
};
struct EpiUp {
    bf16_t* U; RowScale rs; int rs_off;
    DI void operator()(const f32x4 (&acc)[2][2][4][2], const pg8::Unit& u, int wr, int wc, int fr, int fq) const {
        float rsv[8]; rs_preload(rs, u.pm * 256 + wr * 64 + fr + rs_off, fq, rsv);
#pragma unroll
        for (int ai = 0; ai < 2; ++ai)
#pragma unroll
            for (int m = 0; m < 4; ++m) {
                const int row = u.pm * 256 + ai * 128 + wr * 64 + m * 16 + fr;
                const float r = rsv[ai * 4 + m];
#pragma unroll
                for (int bj = 0; bj < 2; ++bj) {
                    float o[8];
#pragma unroll
                    for (int n = 0; n < 2; ++n)
#pragma unroll
                        for (int j = 0; j < 4; ++j) { const float v = fmaxf(acc[ai][bj][m][n][j] * r, 0.f); o[4 * n + j] = v * v; }
                    *(u32x4*)(U + (size_t)row * DFF + u.pn * 256 + bj * 128 + wc * 32 + 8 * fq) = pack8(o);
                }
            }
    }
};

DI void transpose_item(const float* W, int K, int N, const float* gk, bf16_t* WT, int rho0, int k0, int src0, int nvalid, LAS float* scr, int lane) {
    { const int c4 = (lane & 7) * 4, cs = c4 < nvalid ? c4 : 0; const float keep = c4 < nvalid ? 1.f : 0.f;
      f32x4 v[8]; float g[8];
#pragma unroll
      for (int i = 0; i < 8; ++i) v[i] = *(const f32x4*)(W + (size_t)(k0 + 8 * i + (lane >> 3)) * N + src0 + cs);
      if (gk) {
#pragma unroll
          for (int i = 0; i < 8; ++i) g[i] = gk[k0 + 8 * i + (lane >> 3)] * keep;
      } else {
#pragma unroll
          for (int i = 0; i < 8; ++i) g[i] = keep;
      }
#pragma unroll
      for (int i = 0; i < 8; ++i) { const int kk = 8 * i + (lane >> 3); const f32x4 t = v[i] * g[i];
        scr[kk * 33 + c4] = t.x; scr[kk * 33 + c4 + 1] = t.y; scr[kk * 33 + c4 + 2] = t.z; scr[kk * 33 + c4 + 3] = t.w; } }
    LDS_WAIT();
    const int c8 = lane & 7;
#pragma unroll
    for (int j = 0; j < 4; ++j) { const int n = (lane >> 3) + 8 * j; const LAS float* s = scr + (8 * c8) * 33 + n;
        u32x4 o; o.x = cvtpk(s[0 * 33], s[1 * 33]); o.y = cvtpk(s[2 * 33], s[3 * 33]); o.z = cvtpk(s[4 * 33], s[5 * 33]); o.w = cvtpk(s[6 * 33], s[7 * 33]);
        *(u32x4*)(WT + (size_t)(rho0 + n) * K + k0 + 8 * c8) = o; }
    LDS_WAIT();
}
DI void block_src(int mapk, int q  , int& src0, int& nvalid) {
    if (mapk == 0) { src0 = 32 * q; nvalid = 32; return; }
    const int pn = q >> 3, bj = (q >> 2) & 1, wc = q & 3, s = 4 * pn + wc;
    if (mapk == 1) { int src, kind; in_slot_src(s, src, kind);
        if (kind == 0) { src0 = src + 32 * bj; nvalid = 32; } else if (kind == 1) { src0 = src + 16 * bj; nvalid = 16; } else { src0 = 0; nvalid = 0; } }
    else if (mapk == 2) { if (s < 8) { src0 = 96 * s + 32 * bj; nvalid = 32; } else { src0 = 96 * (s - 8) + 64 + 16 * bj; nvalid = 16; } }
    else if (mapk == 3) { if (s < 8) { src0 = 128 * s + 32 * bj; nvalid = 32; } else { src0 = 128 * (s - 8) + 64 + 32 * bj; nvalid = 32; } }
    else { src0 = 64 * s + 32 * bj; nvalid = 32; }
}
DI void convert_matrix(const float* W, int K, int N, int Nt, const float* gk, bf16_t* WT, int mapk, LAS float* scr, int gw, int NGW, int lane) {
    const int nblk = Nt / 32, items = (K / 64) * nblk;
    for (int it = gw; it < items; it += NGW) {
        const int kb = it / nblk, q = it % nblk; int src0, nvalid; block_src(mapk, q, src0, nvalid);
        transpose_item(W, K, N, gk, WT, 32 * q, 64 * kb, src0, nvalid, scr, lane);
    }
}
DI void convert_layer(int l, LAS unsigned char* lds, int gw, int NGW, int wave) {
    const int lane = lane_id();
    CParams* q = fresh_params();
    LAS float* scr = (LAS float*)(lds + wave * 16384);
    unsigned char* ws = q->ws;
    convert_matrix(q->in[4] + (size_t)l * D * N_IN, D, N_IN, NT_IN, q->in[3] + l * D, (bf16_t*)(ws + WS_WIN), 1, scr, gw, NGW, lane);
    convert_matrix(q->in[11] + (size_t)l * 384 * 768, 384, 768, 1024, q->in[9] + l * 384, (bf16_t*)(ws + WS_WUQ), 2, scr, gw, NGW, lane);
    convert_matrix(q->in[12] + (size_t)l * 256 * 1024, 256, 1024, 1024, q->in[10] + l * 256, (bf16_t*)(ws + WS_WUKV), 3, scr, gw, NGW, lane);
    convert_matrix(q->in[18] + (size_t)l * D * 1024, D, 1024, 1024, q->in[17] + l * D, (bf16_t*)(ws + WS_WMKV), 4, scr, gw, NGW, lane);
    for (int n = 0; n < 4; ++n)
        convert_matrix(q->in[21] + ((size_t)l * 4 + n) * 512 * D, 512, D, D, nullptr, (bf16_t*)(ws + WS_WBR) + (size_t)n * D * 512, 0, scr, gw, NGW, lane);
    convert_matrix(q->in[22] + (size_t)l * D * D, D, D, D, nullptr, (bf16_t*)(ws + WS_WOUT), 0, scr, gw, NGW, lane);
    convert_matrix(q->in[24] + (size_t)l * D * DFF, D, DFF, DFF, q->in[23] + l * D, (bf16_t*)(ws + WS_WUP), 0, scr, gw, NGW, lane);
    convert_matrix(q->in[25] + (size_t)l * DFF * D, DFF, D, D, nullptr, (bf16_t*)(ws + WS_WDN), 0, scr, gw, NGW, lane);
}

DI int crow(int i, int h) { return (i & 3) + 8 * (i >> 2) + 4 * h; }
DI f32x16 mfma32(bf16x8 a, bf16x8 b, f32x16 c) { return __builtin_amdgcn_mfma_f32_32x32x16_bf16(a, b, c, 0, 0, 0); }
DI bf16x8 packp(const f32x16& x, int s) { u32x4 w; w.x = cvtpk(x[8 * s], x[8 * s + 1]); w.y = cvtpk(x[8 * s + 2], x[8 * s + 3]); w.z = cvtpk(x[8 * s + 4], x[8 * s + 5]); w.w = cvtpk(x[8 * s + 6], x[8 * s + 7]); return __builtin_bit_cast(bf16x8, w); }
DI s16x4 vtr(const LAS char* p) { return __builtin_bit_cast(s16x4, __builtin_amdgcn_ds_read_tr16_b64_v4i16((LAS s16x4*)p)); }

DI float max3f(float a, float b, float c) { float r; asm("v_max3_f32 %0, %1, %2, %3" : "=v"(r) : "v"(a), "v"(b), "v"(c)); return r; }
DI float xhalf_max(float v) { auto rr = __builtin_amdgcn_permlane32_swap(__float_as_uint(v), __float_as_uint(v), false, false); return fmaxf(__uint_as_float(rr[0]), __uint_as_float(rr[1])); }
DI float xhalf_sum(float v) { auto rr = __builtin_amdgcn_permlane32_swap(__float_as_uint(v), __float_as_uint(v), false, false); return __uint_as_float(rr[0]) + __uint_as_float(rr[1]); }
DI f32x16 splat16(float v) { f32x16 p;
#pragma unroll
    for (int i = 0; i < 16; ++i) p[i] = v;
    return p; }
template <int DQK, int NT, int TSTRIDE> DI void st_tiles(unsigned kaddr, const bf16x8* qf, const f32x16& init, f32x16* p) {
    bf16x8 a[NT][DQK / 16];
#pragma unroll
    for (int j = 0; j < NT; ++j)
#pragma unroll
        for (int ks = 0; ks < DQK / 16; ++ks) asm volatile("ds_read_b128 %0, %1 offset:%2" : "=v"(a[j][ks]) : "v"(kaddr), "i"(j * TSTRIDE + ks * 32));
    asm volatile("s_waitcnt lgkmcnt(0)" ::: "memory");
#pragma unroll
    for (int j = 0; j < NT; ++j)
#pragma unroll
        for (int ks = 0; ks < DQK / 16; ++ks) asm volatile("" : "+v"(a[j][ks]));
#pragma unroll
    for (int j = 0; j < NT; ++j) p[j] = init;
#pragma unroll
    for (int ks = 0; ks < DQK / 16; ++ks)
#pragma unroll
        for (int j = 0; j < NT; ++j) p[j] = mfma32(a[j][ks], qf[ks], p[j]);
}
template <int DV, int VP> DI void pv_tile(f32x16* o, const LAS char* vp, const f32x16& p, int h) {
#pragma unroll
    for (int s = 0; s < 2; ++s) {
        const bf16x8 pa = packp(p, s);
#pragma unroll
        for (int db = 0; db < DV / 32; ++db) {
            const s16x4 lo = vtr(vp + (16 * s + 4 * h) * VP + db * 64);
            const s16x4 hi = vtr(vp + (16 * s + 8 + 4 * h) * VP + db * 64);
            const bf16x8 vb = __builtin_shufflevector(lo, hi, 0, 1, 2, 3, 4, 5, 6, 7);
            o[db] = mfma32(pa, vb, o[db]);
        }
    }
}
template <int NDB> DI void scale_o(f32x16* o, float f, LAS float* sc, int r, int h) {
    if (h == 0) sc[r] = f;
    LDS_WAIT();
#pragma unroll
    for (int g = 0; g < 4; ++g) { const f32x4 f4 = *(const LAS f32x4*)(sc + 8 * g + 4 * h);
#pragma unroll
        for (int db = 0; db < NDB; ++db)
#pragma unroll
            for (int j = 0; j < 4; ++j) o[db][4 * g + j] *= f4[j]; }
    LDS_WAIT();
}
template <int NDB> DI void store_o(const f32x16* o, bf16_t* obase  , long rstride, int r, int h) {
#pragma unroll
    for (int i = 0; i < 16; ++i) { bf16_t* rp = obase + (long)crow(i, h) * rstride + r;
#pragma unroll
        for (int db = 0; db < NDB; ++db) rp[32 * db] = (bf16_t)(cvtpk(o[db][i], 0.f) & 0xffffu); }
}

constexpr int BKP = 144, BVP = 144;
constexpr int BSLOT = 256 * BKP + 256 * BVP;

DI void banded_load(LAS char* dst, int pitch, const bf16_t* src  , int ld, long row0  , int dil, int gi0, int tid) {
    u32x4 v[4];
#pragma unroll
    for (int it = 0; it < 4; ++it) {
        const int c = tid + it * NTHREADS, key = c >> 3, cc = c & 7, gi = gi0 + key, gic = gi < 0 ? 0 : gi;
        v[it] = *(const u32x4*)(src + (row0 + (long)gic * dil) * ld + cc * 8);
    }
#pragma unroll
    for (int it = 0; it < 4; ++it) {
        const int c = tid + it * NTHREADS, key = c >> 3, cc = c & 7, gi = gi0 + key;
        if (gi < 0) v[it] = (u32x4){0u, 0u, 0u, 0u};
        *(LAS u32x4*)(dst + key * pitch + cc * 16) = v[it];
    }
}
template <bool SINK, bool WANT_LSE>
DI void banded_task(const bf16_t* qrow  , bf16_t* obase, long rstride, const LAS char* Ks, const LAS char* Vs,
                    int wq, int jblk, int maxd, float sink2, float* lsep, LAS float* sc, int lane) {
    const int r = lane & 31, h = lane >> 5;
    bf16x8 qf[4];
#pragma unroll
    for (int ks = 0; ks < 4; ++ks) qf[ks] = *(const bf16x8*)(qrow + 16 * ks + 8 * h);
    f32x16 p[5];
    const f32x16 zero16 = splat16(0.f);
    { const unsigned ka = (unsigned)(uintptr_t)(Ks + (32 * wq + r) * BKP + 16 * h);
      st_tiles<64, 3, 32 * BKP>(ka, qf, zero16, p); st_tiles<64, 2, 32 * BKP>(ka + 96 * BKP, qf, zero16, p + 3); }
    const int tmin = (jblk == 0) ? 4 - wq : 0, lo = r + 128 - maxd;
#pragma unroll
    for (int t = 0; t < 5; ++t) {
        if (t < tmin) { p[t] = splat16(NEGBIG); }
        else if (t == 0) {
#pragma unroll
            for (int i = 0; i < 16; ++i) p[t][i] = (crow(i, h) >= lo) ? p[t][i] : NEGBIG;
        } else if (t == 4) {
#pragma unroll
            for (int i = 0; i < 16; ++i) p[t][i] = (crow(i, h) <= r) ? p[t][i] : NEGBIG;
        }
    }
    asm volatile("s_nop 15\n\ts_nop 7" : "+v"(p[0]), "+v"(p[1]), "+v"(p[2]), "+v"(p[3]), "+v"(p[4]));
    float mx = NEGBIG;
#pragma unroll
    for (int t = 0; t < 5; ++t)
#pragma unroll
        for (int i = 0; i < 16; i += 2) mx = max3f(mx, p[t][i], p[t][i + 1]);
    mx = xhalf_max(mx);
    if (SINK) mx = fmaxf(mx, sink2);
    float l;
    { const f32x16 mx16 = splat16(mx); f32x16 acc = splat16(0.f);
#pragma unroll
      for (int t = 0; t < 5; ++t) { p[t] = p[t] - mx16;
#pragma unroll
          for (int i = 0; i < 16; ++i) p[t][i] = __builtin_amdgcn_exp2f(p[t][i]);
          acc = acc + p[t]; }
      float a8[8];
#pragma unroll
      for (int i = 0; i < 8; ++i) a8[i] = acc[i] + acc[i + 8];
      l = ((a8[0] + a8[1]) + (a8[2] + a8[3])) + ((a8[4] + a8[5]) + (a8[6] + a8[7])); }
    l = xhalf_sum(l);
    if (SINK) l += __builtin_amdgcn_exp2f(sink2 - mx);
    f32x16 o[2];
#pragma unroll
    for (int i = 0; i < 16; ++i) { o[0][i] = 0.f; o[1][i] = 0.f; }
    const LAS char* vl = Vs + ((lane & 15) >> 2) * BVP + ((lane >> 4) & 1) * 32 + (lane & 3) * 8;
#pragma unroll
    for (int t = 0; t < 5; ++t) pv_tile<64, BVP>(o, vl + 32 * (wq + t) * BVP, p[t], h);
    scale_o<2>(o, 1.f / l, sc, r, h);
    store_o<2>(o, obase, rstride, r, h);
    if (WANT_LSE) { if (h == 0) *lsep = mx + __builtin_amdgcn_logf(l); }
}

template <int DQK, int DV, bool CAUSAL, bool SPLITK>
DI void dense_unit(const bf16_t* Q, int ldq, const bf16_t* K1, int ldk1, const bf16_t* K2, int ldk2, const bf16_t* V, int ldv, bf16_t* O, int ldo,
                   int q0  , int ntiles, LAS char* lds, LAS float* sc, int tid) {
    constexpr int KP = DQK * 2 + 16, VP = DV * 2 + 16, KCH = DQK / 8, VCH = DV / 8, NK = 64 * KCH, NCH = NK + 64 * VCH, NIT = (NCH + NTHREADS - 1) / NTHREADS;
    constexpr int KBUF = 64 * KP, VBUF = 64 * VP, TB = KBUF + VBUF;
    const int lane = tid & 63, w = __builtin_amdgcn_readfirstlane(tid >> 6), r = lane & 31, h = lane >> 5;
    LAS char* kb0 = lds; LAS char* vb0 = lds + KBUF;
    bf16x8 qf[DQK / 16];
    { const bf16_t* qr = Q + (long)(32 * w + r) * ldq;
#pragma unroll
      for (int ks = 0; ks < DQK / 16; ++ks) qf[ks] = *(const bf16x8*)(qr + 16 * ks + 8 * h);
#pragma unroll
      for (int ks = 0; ks < DQK / 16; ++ks) asm volatile("" : "+v"(qf[ks])); }
    int gb[NIT], gs[NIT], lo[NIT];
    if (SPLITK)
#pragma unroll
    for (int it = 0; it < NIT; ++it) { const int c = tid + it * NTHREADS;
        if (c < NK) { const int key = c / KCH, cc = c % KCH;
            if (SPLITK && cc >= 8) { gb[it] = (int)((const char*)K2 - (const char*)K1) + (key * ldk2 + (cc - 8) * 8) * 2; gs[it] = 64 * ldk2 * 2; }
            else { gb[it] = (key * ldk1 + cc * 8) * 2; gs[it] = 64 * ldk1 * 2; }
            lo[it] = key * KP + cc * 16; }
        else { const int c2 = (c < NCH ? c : NK) - NK, key = c2 / VCH, cc = c2 % VCH;
            gb[it] = (int)((const char*)V - (const char*)K1) + (key * ldv + cc * 8) * 2; gs[it] = 64 * ldv * 2; lo[it] = KBUF + key * VP + cc * 16; }
        asm volatile("" : "+v"(gb[it]), "+v"(gs[it]), "+v"(lo[it])); }
    u32x4 pre[NIT];
    auto gload = [&](int t) {
        if (SPLITK) {
#pragma unroll
            for (int it = 0; it < NIT; ++it) if ((it + 1) * NTHREADS <= NCH || tid + it * NTHREADS < NCH) pre[it] = *(const u32x4*)((const char*)K1 + (long)(gb[it] + t * gs[it]));
        } else {
            const int tid2 = opaque(tid);
#pragma unroll
            for (int it = 0; it < NIT; ++it) { const int c = tid2 + it * NTHREADS;
                if (c < NK) { const int key = c / KCH, cc = c % KCH; pre[it] = *(const u32x4*)(K1 + (long)(64 * t + key) * ldk1 + cc * 8); }
                else if (c < NCH) { const int c2 = c - NK, key = c2 / VCH, cc = c2 % VCH; pre[it] = *(const u32x4*)(V + (long)(64 * t + key) * ldv + cc * 8); } }
        }
    };
    auto lstore = [&](int b) {
        if (SPLITK) {
#pragma unroll
            for (int it = 0; it < NIT; ++it) if ((it + 1) * NTHREADS <= NCH || tid + it * NTHREADS < NCH) *(LAS u32x4*)(lds + b * TB + lo[it]) = pre[it];
        } else {
            const int tid2 = opaque(tid);
#pragma unroll
            for (int it = 0; it < NIT; ++it) { const int c = tid2 + it * NTHREADS;
                if (c < NK) { const int key = c / KCH, cc = c % KCH; *(LAS u32x4*)(kb0 + b * TB + key * KP + cc * 16) = pre[it]; }
                else if (c < NCH) { const int c2 = c - NK, key = c2 / VCH, cc = c2 % VCH; *(LAS u32x4*)(vb0 + b * TB + key * VP + cc * 16) = pre[it]; } }
        }
    };
    gload(0); lstore(0);
    __syncthreads();
    float m = 0.f, l = 0.f; bool first = true;
    f32x16 negm = splat16(0.f);
    f32x16 o[DV / 32];
#pragma unroll
    for (int db = 0; db < DV / 32; ++db)
#pragma unroll
        for (int i = 0; i < 16; ++i) o[db][i] = 0.f;
    const int qpos = q0 + 32 * w + r;
    for (int t = 0; t < ntiles; ++t) {
        const int b = t & 1;
        if (t + 1 < ntiles) gload(t + 1);
        if (!CAUSAL || 64 * t <= q0 + 32 * w) {
            const LAS char* kp = kb0 + b * TB + r * KP + 16 * h;
            f32x16 pp[2]; st_tiles<DQK, 2, 32 * KP>((unsigned)(uintptr_t)kp, qf, negm, pp);
            f32x16& p0 = pp[0]; f32x16& p1 = pp[1];
            if (CAUSAL && 64 * t + 63 > q0 + 32 * w) {
#pragma unroll
                for (int i = 0; i < 16; ++i) { const int key = 64 * t + crow(i, h); if (key > qpos) p0[i] = NEGBIG; if (key + 32 > qpos) p1[i] = NEGBIG; }
            }
            asm volatile("s_nop 15\n\ts_nop 7" : "+v"(p0), "+v"(p1));
            float mx = NEGBIG;
#pragma unroll
            for (int i = 0; i < 16; ++i) mx = max3f(mx, p0[i], p1[i]);
            mx = xhalf_max(mx);
            if (first || __any(mx > 8.f)) {
                const float dl = first ? mx : (mx > 8.f ? mx : 0.f);
                m += dl;
                const float f = __builtin_amdgcn_exp2f(-dl);
                l *= f;
#pragma unroll
                for (int i = 0; i < 16; ++i) { p0[i] -= dl; p1[i] -= dl; }
                if (!first) scale_o<DV / 32>(o, f, sc, r, h);
                negm = splat16(-m);
                first = false;
            }
#pragma unroll
            for (int i = 0; i < 16; ++i) { p0[i] = __builtin_amdgcn_exp2f(p0[i]); p1[i] = __builtin_amdgcn_exp2f(p1[i]); l += p0[i] + p1[i]; }
            const LAS char* vl = vb0 + b * TB + ((lane & 15) >> 2) * VP + ((lane >> 4) & 1) * 32 + (lane & 3) * 8;
            pv_tile<DV, VP>(o, vl, p0, h);
            pv_tile<DV, VP>(o, vl + 32 * VP, p1, h);
        }
        if (t + 1 < ntiles) lstore(b ^ 1);
        __syncthreads();
    }
    l = xhalf_sum(l);
    scale_o<DV / 32>(o, 1.f / l, sc, r, h);
    store_o<DV / 32>(o, O + (long)(32 * w) * ldo, ldo, r, h);
}


#define XB_TMO      128
#define XB_XCNT(j)  (256  + 64 * (j))
#define XB_XSUB(j)  (1280 + 64 * (j))
#define XB_XGEN(j)  (2304 + 64 * (j))
#define XB_TOP      3328
#define XB_TOPGEN   3392
#define XCD_BAR_WORDS 3456
#define XB_SPIN_CAP (1u << 22)
DI unsigned xb_ld(unsigned* p)              { return __hip_atomic_load(p, __ATOMIC_RELAXED, __HIP_MEMORY_SCOPE_AGENT); }
DI unsigned xb_add(unsigned* p, unsigned v) { return __hip_atomic_fetch_add(p, v, __ATOMIC_RELAXED, __HIP_MEMORY_SCOPE_AGENT); }
DI unsigned xb_xcc_id() { return (unsigned)__builtin_amdgcn_s_getreg((3 << 11) | 20) & 0xFu; }
#define XB_SPIN(cond, bar) do { unsigned _sp = 0; while (cond) { __builtin_amdgcn_s_sleep(1); \
    if ((++_sp & 255u) == 0u) { if (xb_ld(&(bar)[XB_TMO])) break; if (_sp > XB_SPIN_CAP) { atomicAdd(&(bar)[XB_TMO], 1u); break; } } } } while (0)
struct XcdBarrier { unsigned* bar; unsigned x; volatile LAS unsigned* st; };
DI XcdBarrier xcd_barrier_post(unsigned* bar, volatile LAS unsigned* st) {
    XcdBarrier b; b.bar = bar; b.x = xb_xcc_id(); b.st = st;
    if (threadIdx.x == 0) (void)xb_add(&bar[XB_XCNT(b.x)], 1u);
    return b;
}
DI void xcd_barrier_complete(unsigned* bar, unsigned x, unsigned& nloc, unsigned& nx) {
    const unsigned G = gridDim.x * gridDim.y * gridDim.z;
    unsigned sum, cnt, mine, sp = 0u;
    for (;;) {
        sum = 0u; cnt = 0u; mine = 0u;
#pragma unroll
        for (unsigned j = 0; j < 16; ++j) { const unsigned c = xb_ld(&bar[XB_XCNT(j)]); sum += c; cnt += (c > 0u) ? 1u : 0u; mine = (j == x) ? c : mine; }
        if (sum == G) break;
        __builtin_amdgcn_s_sleep(1);
        if ((++sp & 255u) == 0u) { if (xb_ld(&bar[XB_TMO])) break; if (sp > XB_SPIN_CAP) { atomicAdd(&bar[XB_TMO], 1u); break; } }
    }
    nloc = mine > 0u ? mine : 1u; nx = cnt > 0u ? cnt : 1u;
}
DI void xcd_barrier(unsigned* bar, unsigned x, volatile LAS unsigned* st) {
    asm volatile("s_waitcnt vmcnt(0)" ::: "memory");
    __syncthreads();
    if (threadIdx.x == 0) {
        __builtin_amdgcn_s_waitcnt(0);
        unsigned nloc = st[0], nx = st[1];
        if (nloc == 0u) { xcd_barrier_complete(bar, x, nloc, nx); st[0] = nloc; st[1] = nx; }
        const unsigned old = xb_add(&bar[XB_XSUB(x)], 1u);
        const unsigned gen = old / nloc;
        if (old + 1u == (gen + 1u) * nloc) {
            __builtin_amdgcn_fence(__ATOMIC_RELEASE, "agent");
            asm volatile("s_waitcnt vmcnt(0)" ::: "memory");
            const unsigned og = xb_add(&bar[XB_TOP], 1u);
            const unsigned tg = og / nx;
            if (og + 1u == (tg + 1u) * nx) xb_add(&bar[XB_TOPGEN], 1u);
            else XB_SPIN(xb_ld(&bar[XB_TOPGEN]) == tg, bar);
            __builtin_amdgcn_fence(__ATOMIC_ACQUIRE, "agent");
            xb_add(&bar[XB_XGEN(x)], 1u);
            asm volatile("s_waitcnt vmcnt(0)" ::: "memory");
        } else {
            XB_SPIN(xb_ld(&bar[XB_XGEN(x)]) == gen, bar);
            __builtin_amdgcn_fence(__ATOMIC_ACQUIRE, "agent");
            asm volatile("s_waitcnt vmcnt(0)" ::: "memory");
        }
    }
    __syncthreads();
}

DI void sincos_acc(float ang, float& c, float& s) {
    const double x = (double)ang;
    const double n = __builtin_rint(x * 0.63661977236758134308);
    double rr = __builtin_fma(-n, 1.57079632679489655800e+00, x); rr = __builtin_fma(-n, 6.12323399573676603587e-17, rr);
    const double r2 = rr * rr;
    const double sn = rr * (1.0 + r2 * (-1.0 / 6 + r2 * (1.0 / 120 + r2 * (-1.0 / 5040 + r2 * (1.0 / 362880 + r2 * (-1.0 / 39916800 + r2 * (1.0 / 6227020800.0)))))));
    const double cs = 1.0 + r2 * (-0.5 + r2 * (1.0 / 24 + r2 * (-1.0 / 720 + r2 * (1.0 / 40320 + r2 * (-1.0 / 3628800 + r2 * (1.0 / 479001600.0))))));
    const int q = ((int)n) & 3;
    const double cc = (q == 0) ? cs : (q == 1) ? -sn : (q == 2) ? -cs : sn;
    const double ss = (q == 0) ? sn : (q == 1) ? cs : (q == 2) ? -sn : -cs;
    c = (float)cc; s = (float)ss;
}

#ifndef PH
#define PH 255
#endif
#ifndef REP_P1
#define REP_P1 1
#endif
#ifndef REP_B
#define REP_B 1
#endif
#ifndef REP_CONV
#define REP_CONV 1
#endif
#ifndef REP_P7
#define REP_P7 1
#endif
#define GRID_SYNC() do { CParams* qb_ = fresh_params(); xcd_barrier((unsigned*)(qb_->ws + WS_CTL), xcc, MISC); } while (0)

__global__ void __launch_bounds__(NTHREADS, 2) fwd_megakernel(Params p) {
    extern __shared__ __attribute__((aligned(16))) unsigned char lds_raw[];
    cg::grid_group grid = cg::this_grid();
    LAS unsigned char* lds = (LAS unsigned char*)lds_raw;
    const int wave = __builtin_amdgcn_readfirstlane((int)threadIdx.x >> 6);
    const int G = gridDim.x, bid = blockIdx.x;
    const int gw = bid * NWAVES + wave, NGW = G * NWAVES;
    LAS float* sc = (LAS float*)(lds + LDS_SCR) + wave * 64;
    volatile LAS unsigned* MISC = (volatile LAS unsigned*)(lds + LDS_SCR + 2048);
    if (threadIdx.x < 4) MISC[threadIdx.x] = 0u;
    __syncthreads();
    unsigned xcc;
    { CParams* q0 = fresh_params(); const XcdBarrier xb = xcd_barrier_post((unsigned*)(q0->ws + WS_CTL), MISC); xcc = xb.x; }

#ifndef NOPRO
    {
        PHASE_CTX
        float* COSH = (float*)(ws + WS_COSH); float* SINH = (float*)(ws + WS_SINH); float* COSR = (float*)(ws + WS_COSR); float* SINR = (float*)(ws + WS_SINR);
        const float* x = q->in[0]; const int* pos = (const int*)q->in[2];
        const int lane = lane_id(), tid = wave * 64 + lane;
        for (int i = bid * NTHREADS + tid; i < TT * 32; i += G * NTHREADS) { const int t = i >> 5, k = i & 31; float c, s; sincos_acc((float)pos[t] * q->inv_h[k], c, s); COSH[i] = c; SINH[i] = s; }
        for (int i = bid * NTHREADS + tid; i < TT * 16; i += G * NTHREADS) { const int t = i >> 4, k = i & 15; float c, s; sincos_acc((float)pos[t] * q->inv_r[k], c, s); COSR[i] = c; SINR[i] = s; }
        for (int row = gw; row < TT; row += NGW) {
            const f32x4* xr = (const f32x4*)(x + (size_t)row * D) + lane; float ss = 0.f;
            u32x2* o8 = (u32x2*)(XB + (size_t)row * D) + lane;
#pragma unroll
            for (int j = 0; j < 4; ++j) { const f32x4 v = xr[64 * j]; ss += (v.x * v.x + v.y * v.y) + (v.z * v.z + v.w * v.w); u32x2 w; w.x = cvtpk(v.x, v.y); w.y = cvtpk(v.z, v.w); o8[64 * j] = w; }
            ss = wave_sum(ss);
            if (lane < 16) PX[(size_t)row * 16 + lane] = lane == 0 ? ss : 0.f;
        }
        const float* mem = q->in[1]; bf16_t* MEMN = (bf16_t*)(ws + WS_MEMN);
        for (int row = gw; row < BATCH * NMEM; row += NGW) {
            const f32x4* xr = (const f32x4*)(mem + (size_t)row * D) + lane; f32x4 v[4]; float ss = 0.f;
#pragma unroll
            for (int j = 0; j < 4; ++j) { v[j] = xr[64 * j]; ss += (v[j].x * v[j].x + v[j].y * v[j].y) + (v[j].z * v[j].z + v[j].w * v[j].w); }
            const float rstd = __builtin_amdgcn_rsqf(wave_sum(ss) * (1.f / D) + EPS);
            u32x2* o8 = (u32x2*)(MEMN + (size_t)row * D) + lane;
#pragma unroll
            for (int j = 0; j < 4; ++j) { u32x2 w; w.x = cvtpk(v[j].x * rstd, v[j].y * rstd); w.y = cvtpk(v[j].z * rstd, v[j].w * rstd); o8[64 * j] = w; }
        }
    }

#endif
    for (int l = 0; l < DEPTH; ++l) {
#ifndef NOCONV
#pragma unroll 1
        for (int rep = 0; rep < REP_CONV; ++rep) convert_layer(l, lds, gw, NGW, wave);
#endif
        if (l == 0) grid.sync(); else GRID_SYNC();
        for (int ch = 0; ch < NCHUNK; ++ch) {
            const int tok0 = ch * TC;
#if PH & 1
            {
                PHASE_CTX
                pg8::TileOrder S; S.init(TC, NT_IN, G, bid, XB + (size_t)tok0 * D, (const bf16_t*)(ws + WS_WIN));
                EpiSlot<CfgIn> E{CfgIn{ws, q->in[6] + l * 64, q->in[7] + l * 64, q->in[14] + l * 96, q->in[15] + l * 192, q->in[16] + l * 192, q->in[5] + l * 4096},
                                 RowScale{PX, 16, 16, 1.f / D}, tok0, rt, tok0};
#pragma unroll 1
                for (int rep = 0; rep < REP_P1; ++rep) pg8::gemm_phase(lds, D, D, S, E, wave);
                if (ch == 0) {
                    pg8::TileOrder S2; S2.init(BATCH * NMEM, 1024, G, (bid + 128) % G, (const bf16_t*)(ws + WS_MEMN), (const bf16_t*)(ws + WS_WMKV));
                    EpiSlot<CfgMkv> E2{CfgMkv{ws}, RowScale{nullptr, 0, 0, 0.f}, 0, rt, 0};
                    pg8::gemm_phase(lds, D, D, S2, E2, wave);
                }
            }

#endif
            GRID_SYNC();
#if PH & 2
            {
                PHASE_CTX
                pg8::TileOrder S; S.init(TC, 1024, G, bid, (const bf16_t*)(ws + WS_CQ), (const bf16_t*)(ws + WS_WUQ));
                EpiSlot<CfgUq> E{CfgUq{ws, q->in[13] + l * 96}, RowScale{(const float*)(ws + WS_PCQ), 8, 6, 1.f / 384.f}, 0, rt, tok0};
                pg8::gemm_phase(lds, 384, 384, S, E, wave);
                pg8::TileOrder S2; S2.init(TC, 1024, G, bid, (const bf16_t*)(ws + WS_CKV), (const bf16_t*)(ws + WS_WUKV));
                EpiSlot<CfgUkv> E2{CfgUkv{ws, q->in[14] + l * 96}, RowScale{(const float*)(ws + WS_PCKV), 4, 4, 1.f / 256.f}, 0, rt, tok0};
                pg8::gemm_phase(lds, 256, 256, S2, E2, wave);
                const int lane = opaque(lane_id());
                const int nrows = TC + (ch == 0 ? BATCH * NMEM : 0);
                for (int rw = gw; rw < nrows; rw += NGW) {
                    const bool isq = rw < TC;
                    bf16_t* rp = isq ? (bf16_t*)(ws + WS_MQ) + (size_t)rw * 512 : (bf16_t*)(ws + WS_MK) + (size_t)(rw - TC) * 512;
                    const float* gn = (isq ? q->in[19] : q->in[20]) + l * 128 + (lane & 15) * 8;
                    const float scl = isq ? 0.08838834764831845f * LOG2E : 1.f;
                    float v[8]; unpack8(*(const u32x4*)(rp + lane * 8), v);
                    float ss = 0.f;
#pragma unroll
                    for (int i = 0; i < 8; ++i) ss += v[i] * v[i];
                    ss += __shfl_xor(ss, 1); ss += __shfl_xor(ss, 2); ss += __shfl_xor(ss, 4); ss += __shfl_xor(ss, 8);
                    const float inv = __builtin_amdgcn_rsqf(ss * (1.f / 128.f) + EPS) * scl;
#pragma unroll
                    for (int i = 0; i < 8; ++i) v[i] *= inv * gn[i];
                    *(u32x4*)(rp + lane * 8) = pack8(v);
                }
            }

#endif
            GRID_SYNC();
#if PH & 4
            {
                PHASE_CTX
                LAS char* al = (LAS char*)lds;
                const int lane = opaque(lane_id()), tid = wave * 64 + lane;
#pragma unroll 1
                for (int rep = 0; rep < REP_B; ++rep)
                for (int idx = bid; idx < BC * 8 * 16; idx += G) {
                    const int half = idx / (BC * 64), rem = idx % (BC * 64), bh = rem / 8, s = rem % 8;
                    const int qb = half == 0 ? s : 15 - s, b = bh / 8, hh = bh % 8;
                    const long r0 = (long)b * SEQ;
                    dense_unit<96, 64, true, true>((const bf16_t*)(ws + WS_QB) + (r0 + 256 * qb) * 768 + 96 * hh, 768,
                        (const bf16_t*)(ws + WS_KN) + r0 * 512 + 64 * hh, 512, (const bf16_t*)(ws + WS_KR) + r0 * 32, 32,
                        (const bf16_t*)(ws + WS_VB) + r0 * 512 + 64 * hh, 512, (bf16_t*)(ws + WS_OB) + (r0 + 256 * qb) * 512 + 64 * hh, 512,
                        256 * qb, 4 * (qb + 1), al, sc, tid);
                }
                for (int idx = bid; idx < 3 * BC * 32 * 4; idx += G) {
                    const int g = idx / (BC * 128), rem = idx % (BC * 128), hp = rem & 3, sj = rem >> 2;
                    const int dil = g == 0 ? 1 : g == 1 ? 4 : 16, nb = 32 / dil;
                    const int n = sj / nb, j = sj % nb, b = n / dil, res = n % dil;
                    const long row0 = (long)b * SEQ + res;
                    const bf16_t* Qg = (const bf16_t*)(ws + WS_CB + (size_t)(3 * g) * 16 * MiB); const bf16_t* Kg = (const bf16_t*)(ws + WS_CB + (size_t)(3 * g + 1) * 16 * MiB); const bf16_t* Vg = (const bf16_t*)(ws + WS_CB + (size_t)(3 * g + 2) * 16 * MiB);
#pragma unroll
                    for (int sl = 0; sl < 2; ++sl) {
                        banded_load(al + sl * BSLOT, BKP, Kg + 64 * (2 * hp + sl), 512, row0, dil, 128 * (j - 1), tid);
                        banded_load(al + sl * BSLOT + 256 * BKP, BVP, Vg + 64 * (2 * hp + sl), 512, row0, dil, 128 * (j - 1), tid);
                    }
                    __syncthreads();
                    { const int sl = wave >> 2, wq = wave & 3, hd = 2 * hp + sl, r = lane & 31;
                      const long qtok = row0 + (long)(128 * j + 32 * wq + r) * dil;
                      bf16_t* ob = (bf16_t*)Qg + (row0 + (long)(128 * j + 32 * wq) * dil) * 512 + 64 * hd;
                      banded_task<false, true>(Qg + qtok * 512 + 64 * hd, ob, (long)dil * 512, al + sl * BSLOT, al + sl * BSLOT + 256 * BKP, wq, j, 128, 0.f,
                                               (float*)(ws + WS_LSE) + (qtok * 8 + hd) * 4 + g, sc, lane); }
                    __syncthreads();
                }
                for (int idx = bid; idx < BC * 32 * 2; idx += G) {
                    const int kvh = idx & 1, j = (idx >> 1) & 31, b = idx >> 6;
                    const long row0 = (long)b * SEQ;
                    banded_load(al, BKP, (const bf16_t*)(ws + WS_KA) + 64 * kvh, 128, row0, 1, 128 * (j - 1), tid);
                    banded_load(al + 256 * BKP, BVP, (const bf16_t*)(ws + WS_VA) + 64 * kvh, 128, row0, 1, 128 * (j - 1), tid);
                    __syncthreads();
#pragma unroll 1
                    for (int pass = 0; pass < 2; ++pass) {
                        const int hq = kvh * 4 + (wave >> 2) + 2 * pass, wq = wave & 3, r = lane & 31;
                        const long qtok = row0 + 128 * j + 32 * wq + r;
                        bf16_t* QA = (bf16_t*)(ws + WS_QA);
                        banded_task<true, false>(QA + qtok * 512 + 64 * hq, QA + (row0 + 128 * j + 32 * wq) * 512 + 64 * hq, 512, al, al + 256 * BKP, wq, j, 127,
                                                 (q->in[8] + l * 8)[hq] * LOG2E, nullptr, sc, lane);
                    }
                    __syncthreads();
                }
                for (int idx = bid; idx < BC * 4 * 16; idx += G) {
                    const int qb = idx & 15, hh = (idx >> 4) & 3, b = idx >> 6;
                    const long r0 = (long)b * SEQ + 256 * qb; const long m0 = (long)(ch * BC + b) * NMEM;
                    bf16_t* MQ = (bf16_t*)(ws + WS_MQ);
                    dense_unit<128, 128, false, false>(MQ + r0 * 512 + 128 * hh, 512, (const bf16_t*)(ws + WS_MK) + m0 * 512 + 128 * hh, 512, nullptr, 0,
                        (const bf16_t*)(ws + WS_MV) + m0 * 512 + 128 * hh, 512, MQ + r0 * 512 + 128 * hh, 512, 0, 4, al, sc, tid);
                }
            }

#endif
            GRID_SYNC();
#if PH & 8
            {
                PHASE_CTX
                const float* LSE = (const float*)(ws + WS_LSE); bf16_t* OC = (bf16_t*)(ws + WS_OC);
                const int tid = wave * 64 + opaque(lane_id());
                for (int i = bid * NTHREADS + tid; i < TC * 64; i += G * NTHREADS) {
                    const int tok = i >> 6, c8 = i & 63, hd = c8 >> 3;
                    const f32x4 ls = *(const f32x4*)(LSE + ((size_t)tok * 8 + hd) * 4);
                    const float mx = fmaxf(ls.x, fmaxf(ls.y, ls.z));
                    float w0 = __builtin_amdgcn_exp2f(ls.x - mx), w1 = __builtin_amdgcn_exp2f(ls.y - mx), w2 = __builtin_amdgcn_exp2f(ls.z - mx);
                    const float inv = 1.f / (w0 + w1 + w2); w0 *= inv; w1 *= inv; w2 *= inv;
                    float a[8], b[8], c[8], o[8];
                    unpack8(*(const u32x4*)((const bf16_t*)(ws + WS_CB) + (size_t)tok * 512 + c8 * 8), a);
                    unpack8(*(const u32x4*)((const bf16_t*)(ws + WS_CB + 48 * MiB) + (size_t)tok * 512 + c8 * 8), b);
                    unpack8(*(const u32x4*)((const bf16_t*)(ws + WS_CB + 96 * MiB) + (size_t)tok * 512 + c8 * 8), c);
#pragma unroll
                    for (int k = 0; k < 8; ++k) o[k] = w0 * a[k] + w1 * b[k] + w2 * c[k];
                    *(u32x4*)(OC + (size_t)tok * 512 + c8 * 8) = pack8(o);
                }
            }

#endif
            GRID_SYNC();
#if PH & 16
            {
                PHASE_CTX
                pg8::TileOrder S; S.init(TC, D, G, bid, (const bf16_t*)(ws + WS_QA), (const bf16_t*)(ws + WS_WBR)); S.nseg = 4;
                S.segA = 8 * MiB; S.segB = (size_t)D * 512;
                EpiMerge E{(const bf16_t*)(ws + WS_GATES), (bf16_t*)(ws + WS_GY) + (size_t)tok0 * D};
                pg8::gemm_phase(lds, 512, 512, S, E, wave);
            }

#endif
            GRID_SYNC();
        }
        {
            const int tok0 = 0;
#if PH & 32
            {
                PHASE_CTX
                pg8::TileOrder S; S.init(TT, D, G, bid, (const bf16_t*)(ws + WS_GY), (const bf16_t*)(ws + WS_WOUT));
                EpiRes E{((l == 0) ? q->in[0] : q->out) + (size_t)tok0 * D, q->out + (size_t)tok0 * D, XB + (size_t)tok0 * D, PX + (size_t)tok0 * 16};
                pg8::gemm_phase(lds, D, D, S, E, wave);
            }

#endif
            GRID_SYNC();
#if PH & 64
            {
                PHASE_CTX
                pg8::TileOrder S; S.init(TT, DFF, G, bid, XB + (size_t)tok0 * D, (const bf16_t*)(ws + WS_WUP));
                EpiUp E{(bf16_t*)(ws + WS_U), RowScale{PX, 16, 16, 1.f / D}, tok0};
#pragma unroll 1
                for (int rep = 0; rep < REP_P7; ++rep) pg8::gemm_phase(lds, D, D, S, E, wave);
            }

#endif
            GRID_SYNC();
#if PH & 128
            {
                PHASE_CTX
                pg8::TileOrder S; S.init(TT, D, G, bid, (const bf16_t*)(ws + WS_U), (const bf16_t*)(ws + WS_WDN));
                EpiRes E{q->out + (size_t)tok0 * D, q->out + (size_t)tok0 * D, XB + (size_t)tok0 * D, PX + (size_t)tok0 * 16};
                pg8::gemm_phase(lds, DFF, DFF, S, E, wave);
            }

#endif
            GRID_SYNC();
        }
    }
}

extern "C" void kernel_launch(void* const* d_in, const int* in_sizes, int n_in, void* d_out, int out_size, void* d_ws, size_t ws_size, hipStream_t stream) {
    static int grid = 0;
    if (grid == 0) {
        if (n_in != 26 || out_size != TT * D || ws_size < WS_END) { fprintf(stderr, "kernel_launch: unexpected shapes (n_in %d out %d ws %zu)\n", n_in, out_size, ws_size); grid = -1; return; }
        int dev = 0, cus = 0, per_cu = 0;
        hipGetDevice(&dev); hipDeviceGetAttribute(&cus, hipDeviceAttributeMultiprocessorCount, dev);
        hipFuncSetAttribute((const void*)fwd_megakernel, hipFuncAttributeMaxDynamicSharedMemorySize, LDS_BYTES);
        hipOccupancyMaxActiveBlocksPerMultiprocessor(&per_cu, (const void*)fwd_megakernel, NTHREADS, LDS_BYTES);
        if (per_cu < 1) { fprintf(stderr, "kernel_launch: occupancy query says %d blocks per CU\n", per_cu); per_cu = 1; }
        (void)hipGetLastError();
        grid = cus;
    }
    if (grid < 0) return;
    if (hipMemsetAsync((char*)d_ws + WS_CTL, 0, XCD_BAR_WORDS * 4, stream) != hipSuccess) { fprintf(stderr, "kernel_launch: memset failed\n"); return; }
    Params p{};
    for (int i = 0; i < 26; ++i) p.in[i] = (const float*)d_in[i];
    p.out = (float*)d_out; p.ws = (unsigned char*)d_ws;
    for (int i = 0; i < 32; ++i) p.inv_h[i] = (float)std::pow(10000.0, -(double)(2 * i) / 64.0);
    for (int i = 0; i < 16; ++i) p.inv_r[i] = (float)std::pow(10000.0, -(double)(2 * i) / 32.0);
    void* args[] = {&p};
    hipError_t e = hipLaunchCooperativeKernel((const void*)fwd_megakernel, dim3(grid), dim3(NTHREADS), args, LDS_BYTES, stream);
    if (e != hipSuccess) fprintf(stderr, "cooperative launch failed: %s (grid %d)\n", hipGetErrorString(e), grid);
}
```

```cpp
#include <hip/hip_runtime.h>
#include <hip/hip_cooperative_groups.h>
#include <cstdio>
#include <cstdint>
#include <cmath>
namespace cg = cooperative_groups;

#define LAS __attribute__((address_space(3)))
#define DI __device__ __forceinline__
typedef unsigned short bf16_t;
typedef short bf16x8 __attribute__((ext_vector_type(8)));
typedef short s16x4 __attribute__((ext_vector_type(4)));
typedef float f32x4 __attribute__((ext_vector_type(4)));
typedef float f32x16 __attribute__((ext_vector_type(16)));
typedef unsigned u32x4 __attribute__((ext_vector_type(4)));
typedef unsigned u32x2 __attribute__((ext_vector_type(2)));
typedef float f32x2_t __attribute__((ext_vector_type(2)));
typedef __bf16 bf16x2_t __attribute__((ext_vector_type(2)));

constexpr int D = 1024, BATCH = 8, SEQ = 4096, DEPTH = 4, TT = BATCH * SEQ;
constexpr int NCHUNK = 2, BC = BATCH / NCHUNK, TC = BC * SEQ;
constexpr int N_IN = 10656, NT_IN = 10752;
constexpr int DFF = 4096, NMEM = 256;
constexpr float EPS = 1e-6f;
constexpr float LOG2E = 1.4426950408889634f;
constexpr float NEGBIG = -1e30f;
constexpr int NTHREADS = 512, NWAVES = 8;

constexpr size_t MiB = 1u << 20;
constexpr size_t WS_CTL = 0;
constexpr size_t WS_WIN = 1 * MiB, WS_WUQ = 22 * MiB, WS_WUKV = 23 * MiB, WS_WMKV = 24 * MiB, WS_WBR = 26 * MiB, WS_WOUT = 30 * MiB, WS_WUP = 32 * MiB, WS_WDN = 40 * MiB;
constexpr size_t WS_XB = 48 * MiB, WS_PX = 112 * MiB, WS_COSH = 114 * MiB, WS_SINH = 118 * MiB, WS_COSR = 122 * MiB, WS_SINR = 124 * MiB;
constexpr size_t WS_MEMN = 126 * MiB, WS_MK = 130 * MiB, WS_MV = 132 * MiB;
constexpr size_t WS_QA = 134 * MiB, WS_OB = 150 * MiB, WS_OC = 166 * MiB, WS_MQ = 182 * MiB;
constexpr size_t WS_KA = 198 * MiB, WS_VA = 202 * MiB, WS_CQ = 206 * MiB, WS_CKV = 218 * MiB, WS_KR = 226 * MiB, WS_PCQ = 227 * MiB, WS_PCKV = 227 * MiB + 512 * 1024;
constexpr size_t WS_CB = 228 * MiB;
constexpr size_t WS_GATES = 372 * MiB, WS_U = WS_CB;
constexpr size_t WS_QB = 500 * MiB, WS_KN = 524 * MiB, WS_VB = 540 * MiB, WS_LSE = 556 * MiB, WS_GY = 558 * MiB;
constexpr size_t WS_END = 622 * MiB;

constexpr int LDS_BYTES = 155648;
constexpr int LDS_SCR = 149504;

struct Params {
    const float* in[26];
    float* out;
    unsigned char* ws;
    float inv_h[32];
    float inv_r[16];
    int pad[2];
};

DI unsigned cvtpk(float lo, float hi) { f32x2_t v = {lo, hi}; bf16x2_t b = __builtin_convertvector(v, bf16x2_t); return __builtin_bit_cast(unsigned, b); }
DI float bf_lo(unsigned w) { return __uint_as_float(w << 16); }
DI float bf_hi(unsigned w) { return __uint_as_float(w & 0xffff0000u); }
DI u32x4 pack8(const float* v) { u32x4 w; w.x = cvtpk(v[0], v[1]); w.y = cvtpk(v[2], v[3]); w.z = cvtpk(v[4], v[5]); w.w = cvtpk(v[6], v[7]); return w; }
DI void unpack8(u32x4 w, float* v) { v[0] = bf_lo(w.x); v[1] = bf_hi(w.x); v[2] = bf_lo(w.y); v[3] = bf_hi(w.y); v[4] = bf_lo(w.z); v[5] = bf_hi(w.z); v[6] = bf_lo(w.w); v[7] = bf_hi(w.w); }
DI float wave_sum(float v) {
#pragma unroll
    for (int o = 1; o < 64; o <<= 1) v += __shfl_xor(v, o);
    return v;
}
struct RopeTabs { const float* cosh; const float* sinh; const float* cosr; const float* sinr; };
typedef const struct Params __attribute__((address_space(4))) CParams;
DI CParams* fresh_params() { unsigned long long k = (unsigned long long)__builtin_amdgcn_kernarg_segment_ptr(); asm volatile("" : "+s"(k)); return (CParams*)k; }
#define PHASE_CTX \
    CParams* q = fresh_params(); unsigned char* ws = q->ws; (void)ws; \
    bf16_t* XB = (bf16_t*)(ws + WS_XB); float* PX = (float*)(ws + WS_PX); (void)XB; (void)PX; \
    const RopeTabs rt{(const float*)(ws + WS_COSH), (const float*)(ws + WS_SINH), (const float*)(ws + WS_COSR), (const float*)(ws + WS_SINR)}; (void)rt;
DI int opaque(int v) { asm volatile("" : "+v"(v)); return v; }
DI int lane_id() { int v; asm volatile("v_mbcnt_lo_u32_b32 %0, -1, 0\n\tv_mbcnt_hi_u32_b32 %0, -1, %0" : "=v"(v)); return v; }
#define LDS_WAIT() asm volatile("s_waitcnt lgkmcnt(0)" ::: "memory")

namespace pg8 {
constexpr int BM = 256, BK = 64, HALF = 128, HTB = HALF * BK * 2, STAGE_BYTES = 8 * HTB, NXCD = 8, WGM = 8;
DI int lds_byte(int r, int c) { const int st = (r >> 4) * 2 + (c >> 5), rr = r & 15, cc = c & 31, ob = rr * 64 + cc * 2; return st * 1024 + (ob ^ (((ob >> 9) & 1) << 5)); }
DI void stage_rc(int b, int& R, int& C) { const int st = b / 1024, sb = b % 1024, swz = sb ^ (((sb >> 9) & 1) << 5); R = (st >> 1) * 16 + swz / 64; C = (st & 1) * 32 + (swz % 64) / 2; }
DI int perm32(int rho) { const int n = rho >> 4, i = rho & 15; return 8 * (i >> 2) + 4 * n + (i & 3); }

struct Unit { int pm, pn, seg; const bf16_t* A; const bf16_t* Bt; };

struct TileOrder {
    int nM, nN, nwg, G, c, nseg;
    const bf16_t* A0; const bf16_t* B0; size_t segA, segB;
    DI void init(int M, int N, int G_, int c_, const bf16_t* A, const bf16_t* B) { nM = M / BM; nN = N / BM; nwg = nM * nN; G = G_; c = c_; nseg = 1; A0 = A; B0 = B; segA = 0; segB = 0; }
    DI bool next(int i, Unit& u) const {
        const int seg = i % nseg, ti = i / nseg;
        const long L = (long)ti * G + c; if (L >= nwg) return false;
        int wgid = (int)L; { const int q = nwg / NXCD, r = nwg % NXCD, xcd = wgid % NXCD, off = wgid / NXCD; wgid = (xcd < r ? xcd * (q + 1) : r * (q + 1) + (xcd - r) * q) + off; }
        const int nig = WGM * nN, gid = wgid / nig, fm = gid * WGM, gsz = (nM - fm) < WGM ? (nM - fm) : WGM;
        u.pm = fm + ((wgid % nig) % gsz); u.pn = (wgid % nig) / gsz; u.seg = seg;
        u.A = A0 + (size_t)seg * segA; u.Bt = B0 + (size_t)seg * segB;
        return true;
    }
};

template <class Epi, class Sched>
DI void gemm_phase(LAS unsigned char* lds, const int K, const int lda, const Sched& S, const Epi& E, const int wid) {
    const int lane = opaque(lane_id()), tid = wid * 64 + lane, wr = wid >> 2, wc = wid & 3, fr = lane & 15, fq = lane >> 4;
    const int nt = K / BK;
    unsigned voffA[2], voffB[2];
#pragma unroll
    for (int i = 0; i < 2; ++i) { int R, C; stage_rc(tid * 16 + i * 8192, R, C); const int Rb = (R & ~31) + perm32(R & 31);
        voffA[i] = (unsigned)(R * lda + C) * 2u; voffB[i] = (unsigned)(Rb * K + C) * 2u; }
    const size_t kstep = (size_t)(BK * 2);
    const size_t hstepA = (size_t)HALF * lda * 2, hstepB = (size_t)HALF * K * 2;
    const size_t tstepA = 2 * hstepA, tstepB = 2 * hstepB;
    const unsigned ldsw = (unsigned)wid * 1024u;
    const int aoff = lds_byte(wr * 64 + fr, fq * 8), boff = lds_byte(wc * 32 + fr, fq * 8);
#define PG8_SA(b, h) (((b) * 2 + (h)) * HTB)
#define PG8_SB(b, h) ((4 + (b) * 2 + (h)) * HTB)
#define PG8_STAGE(bufoff, gbase, voff) do { _Pragma("unroll") for (int _i = 0; _i < 2; ++_i) \
        __builtin_amdgcn_global_load_lds((const unsigned*)((const char*)(gbase) + (voff)[_i]), (LAS unsigned*)(lds + (bufoff) + ldsw + _i * 8192), 16, 0, 0); } while (0)
#define PG8_LDA(dst, b, h) do { _Pragma("unroll") for (int m = 0; m < 4; ++m) _Pragma("unroll") for (int k = 0; k < 2; ++k) dst[m][k] = *(const LAS bf16x8*)(lds + PG8_SA(b, h) + aoff + m * 2048 + k * 1024); } while (0)
#define PG8_LDB(dst, b, h) do { _Pragma("unroll") for (int n = 0; n < 2; ++n) _Pragma("unroll") for (int k = 0; k < 2; ++k) dst[n][k] = *(const LAS bf16x8*)(lds + PG8_SB(b, h) + boff + n * 2048 + k * 1024); } while (0)
#define PG8_MMA(ai, bj, At, Bt) do { __builtin_amdgcn_s_setprio(1); _Pragma("unroll") for (int m = 0; m < 4; ++m) _Pragma("unroll") for (int n = 0; n < 2; ++n) _Pragma("unroll") for (int k = 0; k < 2; ++k) \
        acc[ai][bj][m][n] = __builtin_amdgcn_mfma_f32_16x16x32_bf16(Bt[n][k], At[m][k], acc[ai][bj][m][n], 0, 0, 0); __builtin_amdgcn_s_setprio(0); } while (0)
#define PG8_WAIT_V(n) asm volatile("s_waitcnt vmcnt(" #n ")" ::: "memory")
#define PG8_WAIT_L(n) asm volatile("s_waitcnt lgkmcnt(" #n ")" ::: "memory")
#define PG8_BAR __builtin_amdgcn_s_barrier()
#define PG8_SCHED __builtin_amdgcn_sched_barrier(0)
    Unit cur, nxt; int ui = 0;
    if (!S.next(0, cur)) return;
    f32x4 acc[2][2][4][2];
#pragma unroll
    for (int a = 0; a < 2; ++a)
#pragma unroll
        for (int b = 0; b < 2; ++b)
#pragma unroll
            for (int m = 0; m < 4; ++m)
#pragma unroll
                for (int n = 0; n < 2; ++n) acc[a][b][m][n] = (f32x4){0.f, 0.f, 0.f, 0.f};
    bf16x8 At[4][2], B0[2][2], B1[2][2];
    const char* cA = (const char*)cur.A + (size_t)cur.pm * tstepA; const char* cB = (const char*)cur.Bt + (size_t)cur.pn * tstepB;
    PG8_STAGE(PG8_SB(0, 0), cB, voffB); PG8_STAGE(PG8_SB(0, 1), cB + hstepB, voffB); PG8_STAGE(PG8_SA(0, 0), cA, voffA); PG8_STAGE(PG8_SA(0, 1), cA + hstepA, voffA);
    if (wr == 1) PG8_BAR;
    PG8_WAIT_V(2); PG8_BAR;
    PG8_STAGE(PG8_SB(1, 0), cB + kstep, voffB); PG8_STAGE(PG8_SA(1, 0), cA + kstep, voffA); PG8_STAGE(PG8_SB(1, 1), cB + hstepB + kstep, voffB);
    PG8_WAIT_V(6); PG8_BAR;
    for (;;) {
        const bool has_next = S.next(ui + 1, nxt);
        const char* nA = has_next ? (const char*)nxt.A + (size_t)nxt.pm * tstepA : cA; const char* nB = has_next ? (const char*)nxt.Bt + (size_t)nxt.pn * tstepB : cB;
#pragma unroll 1
        for (int t = 0; t < nt; t += 2) {
            const bool last = (t == nt - 2);
            const char* a1 = cA + (size_t)(t + 1) * kstep;
            const char* a2 = last ? nA : cA + (size_t)(t + 2) * kstep; const char* b2 = last ? nB : cB + (size_t)(t + 2) * kstep;
            const char* a3 = a2 + kstep; const char* b3 = b2 + kstep;
            PG8_LDB(B0, 0, 0); PG8_LDB(B1, 0, 1); PG8_SCHED; PG8_LDA(At, 0, 0); PG8_STAGE(PG8_SA(1, 1), a1 + hstepA, voffA);
            PG8_WAIT_V(8); PG8_WAIT_L(0); PG8_BAR; PG8_MMA(0, 0, At, B0); PG8_MMA(0, 1, At, B1); PG8_BAR; PG8_SCHED;
            PG8_LDA(At, 0, 1); PG8_STAGE(PG8_SB(0, 0), b2, voffB); PG8_STAGE(PG8_SB(0, 1), b2 + hstepB, voffB); PG8_STAGE(PG8_SA(0, 0), a2, voffA);
            PG8_WAIT_V(8); PG8_WAIT_L(0); PG8_BAR; PG8_MMA(1, 0, At, B0); PG8_MMA(1, 1, At, B1); PG8_BAR; PG8_SCHED;
            PG8_LDB(B0, 1, 0); PG8_LDB(B1, 1, 1); PG8_SCHED; PG8_LDA(At, 1, 0); PG8_STAGE(PG8_SA(0, 1), a2 + hstepA, voffA);
            PG8_WAIT_V(8); PG8_WAIT_L(0); PG8_BAR; PG8_MMA(0, 0, At, B0); PG8_MMA(0, 1, At, B1); PG8_BAR; PG8_SCHED;
            PG8_LDA(At, 1, 1); PG8_STAGE(PG8_SB(1, 0), b3, voffB); PG8_STAGE(PG8_SB(1, 1), b3 + hstepB, voffB); PG8_STAGE(PG8_SA(1, 0), a3, voffA);
            PG8_WAIT_V(8); PG8_WAIT_L(0); PG8_BAR; PG8_MMA(1, 0, At, B0); PG8_MMA(1, 1, At, B1); PG8_BAR; PG8_SCHED;
        }
        if (wr == 0) PG8_BAR;
        E(acc, cur, wr, wc, fr, fq);
        if (!has_next) break;
#pragma unroll
        for (int a = 0; a < 2; ++a)
#pragma unroll
            for (int b = 0; b < 2; ++b)
#pragma unroll
                for (int m = 0; m < 4; ++m)
#pragma unroll
                    for (int n = 0; n < 2; ++n) acc[a][b][m][n] = (f32x4){0.f, 0.f, 0.f, 0.f};
        cur = nxt; cA = nA; cB = nB; ++ui;
        if (wr == 1) PG8_BAR;
    }
    PG8_WAIT_V(0);
    PG8_BAR;
#undef PG8_SA
#undef PG8_SB
#undef PG8_STAGE
#undef PG8_LDA
#undef PG8_LDB
#undef PG8_MMA
#undef PG8_WAIT_V
#undef PG8_WAIT_L
#undef PG8_BAR
#undef PG8_SCHED
}
}

struct RowScale {
    const float* part; int stride; int cnt; float inv_n;
    DI float get(int row) const {
        if (!part) return 1.f;
        float s = 0.f;
        const float* p = part + (size_t)row * stride;
        for (int i = 0; i < cnt; i += 4) { const f32x4 v = *(const f32x4*)(p + i); s += (v.x + v.y) + (v.z + v.w); }
        return __builtin_amdgcn_rsqf(s * inv_n + EPS);
    }
};

DI void rs_preload(const RowScale& rs, int rowbase, int fq, float (&out)[8]) {
    if (!rs.part) {
#pragma unroll
        for (int i = 0; i < 8; ++i) out[i] = 1.f;
        return;
    }
    const int ng = (rs.cnt + 3) >> 2, gq = fq < ng ? fq : ng - 1;
    const float w0 = (fq < ng && 4 * gq + 0 < rs.cnt) ? 1.f : 0.f, w1 = (fq < ng && 4 * gq + 1 < rs.cnt) ? 1.f : 0.f, w2 = (fq < ng && 4 * gq + 2 < rs.cnt) ? 1.f : 0.f, w3 = (fq < ng && 4 * gq + 3 < rs.cnt) ? 1.f : 0.f;
#pragma unroll
    for (int hb = 0; hb < 2; ++hb) {
        f32x4 v[4];
#pragma unroll
        for (int i = 0; i < 4; ++i) v[i] = *(const f32x4*)(rs.part + (size_t)(rowbase + hb * 128 + i * 16) * rs.stride + 4 * gq);
#pragma unroll
        for (int i = 0; i < 4; ++i) { float t = (v[i].x * w0 + v[i].y * w1) + (v[i].z * w2 + v[i].w * w3); t += __shfl_xor(t, 16); t += __shfl_xor(t, 32); out[hb * 4 + i] = __builtin_amdgcn_rsqf(t * rs.inv_n + EPS); }
    }
}
enum { SK_SKIP = 0, SK_RAW = 1, SK_HEAD = 2, SK_ROPE32 = 3, SK_GATE = 4 };
struct SlotDesc { int kind; bf16_t* dst; int ld; int col; const float* gain; float scale; int rope; float* part; int pstride; int pidx; const float* bias; };


template <class Cfg>
struct EpiSlot {
    Cfg cfg; RowScale rs; int rs_off; RopeTabs rt; int tok_off;
    template <int KIND>
    DI void run(const f32x4 (&acc)[2][2][4][2], const pg8::Unit& u, const SlotDesc& d, int wr, int fr, int fq) const {
        const int d0 = 8 * fq;
        float rsv[8]; rs_preload(rs, u.pm * 256 + wr * 64 + fr + rs_off, fq, rsv);
        float g0[8], g1[8];
        {
            const float* gp0 = (KIND == 4) ? d.bias + d.col + d0 : d.gain + ((KIND == 3 && fq >= 2) ? 0 : d0);
            const float* gp1 = gp0 + ((KIND == 3) ? 16 : 32);
            f32x4 a = (f32x4){0.f, 0.f, 0.f, 0.f}, b = a, c = a, e = a;
            if (KIND != 1) { a = *(const f32x4*)gp0; b = *(const f32x4*)(gp0 + 4); c = *(const f32x4*)gp1; e = *(const f32x4*)(gp1 + 4); }
            const float sc = (KIND == 4) ? 1.f : ((KIND == 3 && fq >= 2) ? 0.f : d.scale);
#pragma unroll
            for (int i = 0; i < 4; ++i) { g0[i] = a[i] * sc; g0[4 + i] = b[i] * sc; g1[i] = c[i] * sc; g1[4 + i] = e[i] * sc; }
        }
#pragma unroll
        for (int ai = 0; ai < 2; ++ai)
#pragma unroll
            for (int m = 0; m < 4; ++m) {
                const int row = u.pm * 256 + ai * 128 + wr * 64 + m * 16 + fr;
                const float r = rsv[ai * 4 + m];
                float v0[8], v1[8];
#pragma unroll
                for (int n = 0; n < 2; ++n)
#pragma unroll
                    for (int j = 0; j < 4; ++j) { v0[4 * n + j] = acc[ai][0][m][n][j] * r; v1[4 * n + j] = acc[ai][1][m][n][j] * r; }
                bf16_t* dp = d.dst + (size_t)row * d.ld + d.col;
                if (KIND == 1) {
                    if (d.part) {
                        float ss = 0.f;
#pragma unroll
                        for (int i = 0; i < 8; ++i) ss += v0[i] * v0[i] + v1[i] * v1[i];
                        ss += __shfl_xor(ss, 16); ss += __shfl_xor(ss, 32);
                        if (fq == 0) d.part[(size_t)row * d.pstride + d.pidx] = ss;
                    }
                    *(u32x4*)(dp + d0) = pack8(v0); *(u32x4*)(dp + 32 + d0) = pack8(v1);
                } else if (KIND == 4) {
#pragma unroll
                    for (int i = 0; i < 8; ++i) { v0[i] = __builtin_amdgcn_rcpf(1.f + __builtin_amdgcn_exp2f(-(v0[i] + g0[i]) * LOG2E)); v1[i] = __builtin_amdgcn_rcpf(1.f + __builtin_amdgcn_exp2f(-(v1[i] + g1[i]) * LOG2E)); }
                    *(u32x4*)(dp + d0) = pack8(v0); *(u32x4*)(dp + 32 + d0) = pack8(v1);
                } else if (KIND == 2 || KIND == 5) {
                    float ss = 0.f;
#pragma unroll
                    for (int i = 0; i < 8; ++i) ss += v0[i] * v0[i] + v1[i] * v1[i];
                    ss += __shfl_xor(ss, 16); ss += __shfl_xor(ss, 32);
                    const float inv = __builtin_amdgcn_rsqf(ss * (1.f / 64.f) + EPS);
#pragma unroll
                    for (int i = 0; i < 8; ++i) { v0[i] *= inv * g0[i]; v1[i] *= inv * g1[i]; }
                    if (KIND == 5) {
                        const float* cp = rt.cosh + (size_t)(row + tok_off) * 32 + d0; const float* sp = rt.sinh + (size_t)(row + tok_off) * 32 + d0;
                        const f32x4 c0 = *(const f32x4*)cp, c1 = *(const f32x4*)(cp + 4), s0 = *(const f32x4*)sp, s1 = *(const f32x4*)(sp + 4);
#pragma unroll
                        for (int i = 0; i < 8; ++i) { const float c = i < 4 ? c0[i & 3] : c1[i & 3], sn = i < 4 ? s0[i & 3] : s1[i & 3];
                            const float a = v0[i], b = v1[i]; v0[i] = a * c - b * sn; v1[i] = b * c + a * sn; }
                    }
                    *(u32x4*)(dp + d0) = pack8(v0); *(u32x4*)(dp + 32 + d0) = pack8(v1);
                } else {
                    float ss = 0.f;
#pragma unroll
                    for (int i = 0; i < 8; ++i) ss += v0[i] * v0[i] + v1[i] * v1[i];
                    ss += __shfl_xor(ss, 16); ss += __shfl_xor(ss, 32);
                    const float inv = __builtin_amdgcn_rsqf(ss * (1.f / 32.f) + EPS);
                    if (fq < 2) {
#pragma unroll
                        for (int i = 0; i < 8; ++i) { v0[i] *= inv * g0[i]; v1[i] *= inv * g1[i]; }
                        const float* cp = rt.cosr + (size_t)(row + tok_off) * 16 + d0; const float* sp = rt.sinr + (size_t)(row + tok_off) * 16 + d0;
                        const f32x4 c0 = *(const f32x4*)cp, c1 = *(const f32x4*)(cp + 4), s0 = *(const f32x4*)sp, s1 = *(const f32x4*)(sp + 4);
#pragma unroll
                        for (int i = 0; i < 8; ++i) { const float c = i < 4 ? c0[i & 3] : c1[i & 3], sn = i < 4 ? s0[i & 3] : s1[i & 3];
                            const float a = v0[i], b = v1[i]; v0[i] = a * c - b * sn; v1[i] = b * c + a * sn; }
                        *(u32x4*)(dp + d0) = pack8(v0); *(u32x4*)(dp + 16 + d0) = pack8(v1);
                    }
                }
            }
    }
    DI void operator()(const f32x4 (&acc)[2][2][4][2], const pg8::Unit& u, int wr, int wc, int fr_, int fq_) const {
        const int fr = opaque(fr_), fq = opaque(fq_);
        const SlotDesc d = cfg.get(u.pn * 4 + wc);
        if (d.kind == SK_RAW) run<1>(acc, u, d, wr, fr, fq);
        else if (d.kind == SK_GATE) run<4>(acc, u, d, wr, fr, fq);
        else if (d.kind == SK_HEAD) { if (d.rope) run<5>(acc, u, d, wr, fr, fq); else run<2>(acc, u, d, wr, fr, fq); }
        else if (d.kind == SK_ROPE32) run<3>(acc, u, d, wr, fr, fq);
    }
};

struct CfgIn {
    unsigned char* ws; const float* a_qn; const float* a_kn; const float* b_kn; const float* c_qn; const float* c_kn; const float* b_gate;
    DI SlotDesc get(int s) const {
        SlotDesc d; d.kind = SK_SKIP; d.dst = nullptr; d.ld = 0; d.col = 0; d.gain = nullptr; d.scale = 1.f; d.rope = 0; d.part = nullptr; d.pstride = 0; d.pidx = 0; d.bias = nullptr;
        if (s < 8) { d.kind = SK_HEAD; d.dst = (bf16_t*)(ws + WS_QA); d.ld = 512; d.col = 64 * s; d.gain = a_qn; d.scale = 0.125f * LOG2E; d.rope = 1; }
        else if (s < 10) { d.kind = SK_HEAD; d.dst = (bf16_t*)(ws + WS_KA); d.ld = 128; d.col = 64 * (s - 8); d.gain = a_kn; d.rope = 1; }
        else if (s < 12) { d.kind = SK_RAW; d.dst = (bf16_t*)(ws + WS_VA); d.ld = 128; d.col = 64 * (s - 10); }
        else if (s < 18) { d.kind = SK_RAW; d.dst = (bf16_t*)(ws + WS_CQ); d.ld = 384; d.col = 64 * (s - 12); d.part = (float*)(ws + WS_PCQ); d.pstride = 8; d.pidx = s - 12; }
        else if (s < 22) { d.kind = SK_RAW; d.dst = (bf16_t*)(ws + WS_CKV); d.ld = 256; d.col = 64 * (s - 18); d.part = (float*)(ws + WS_PCKV); d.pstride = 4; d.pidx = s - 18; }
        else if (s == 22) { d.kind = SK_ROPE32; d.dst = (bf16_t*)(ws + WS_KR); d.ld = 32; d.col = 0; d.gain = b_kn + 64; }
        else if (s < 95) { const int p = (s - 23) >> 3, h = (s - 23) & 7, g = p / 3, t = p % 3;
            d.dst = (bf16_t*)(ws + WS_CB + (size_t)p * 16 * MiB); d.ld = 512; d.col = 64 * h;
            if (t == 0) { d.kind = SK_HEAD; d.gain = c_qn + 64 * g; d.scale = 0.125f * LOG2E; d.rope = 1; }
            else if (t == 1) { d.kind = SK_HEAD; d.gain = c_kn + 64 * g; d.rope = 1; }
            else d.kind = SK_RAW; }
        else if (s < 103) { d.kind = SK_RAW; d.dst = (bf16_t*)(ws + WS_MQ); d.ld = 512; d.col = 64 * (s - 95); }
        else if (s < 167) { d.kind = SK_GATE; d.dst = (bf16_t*)(ws + WS_GATES); d.ld = 4096; d.col = 64 * (s - 103); d.bias = b_gate; }
        return d;
    }
};
DI void in_slot_src(int s, int& src, int& kind) {
    kind = 0;
    if (s < 22) src = 64 * s;
    else if (s == 22) { src = 1408; kind = 1; }
    else if (s < 167) src = 1440 + 64 * (s - 23);
    else { src = 0; kind = 2; }
}
struct CfgUq {
    unsigned char* ws; const float* b_qn;
    DI SlotDesc get(int s) const {
        SlotDesc d; d.dst = (bf16_t*)(ws + WS_QB); d.ld = 768; d.scale = 0.10206207261596575f * LOG2E; d.rope = 0; d.part = nullptr; d.pstride = 0; d.pidx = 0; d.bias = nullptr;
        if (s < 8) { d.kind = SK_HEAD; d.col = 96 * s; d.gain = b_qn; }
        else { d.kind = SK_ROPE32; d.col = 96 * (s - 8) + 64; d.gain = b_qn + 64; }
        return d;
    }
};
struct CfgUkv {
    unsigned char* ws; const float* b_kn;
    DI SlotDesc get(int s) const {
        SlotDesc d; d.ld = 512; d.scale = 1.f; d.rope = 0; d.part = nullptr; d.pstride = 0; d.pidx = 0; d.bias = nullptr; d.gain = b_kn;
        if (s < 8) { d.kind = SK_HEAD; d.dst = (bf16_t*)(ws + WS_KN); d.col = 64 * s; }
        else { d.kind = SK_RAW; d.dst = (bf16_t*)(ws + WS_VB); d.col = 64 * (s - 8); }
        return d;
    }
};
struct CfgMkv {
    unsigned char* ws;
    DI SlotDesc get(int s) const {
        SlotDesc d; d.kind = SK_RAW; d.ld = 512; d.scale = 1.f; d.rope = 0; d.part = nullptr; d.pstride = 0; d.pidx = 0; d.bias = nullptr; d.gain = nullptr;
        if (s < 8) { d.dst = (bf16_t*)(ws + WS_MK); d.col = 64 * s; } else { d.dst = (bf16_t*)(ws + WS_MV); d.col = 64 * (s - 8); }
        return d;
    }
};

struct EpiMerge {
    const bf16_t* gates; bf16_t* gy;
    template <bool FIRST>
    DI void run(const f32x4 (&acc)[2][2][4][2], const pg8::Unit& u, int wr, int wc, int fr, int fq) const {
#pragma unroll
        for (int ai = 0; ai < 2; ++ai)
#pragma unroll
            for (int mp = 0; mp < 2; ++mp) {
                u32x4 gl[2][2], ol[2][2];
#pragma unroll
                for (int mm = 0; mm < 2; ++mm)
#pragma unroll
                    for (int bj = 0; bj < 2; ++bj) {
                        const int row = u.pm * 256 + ai * 128 + wr * 64 + (2 * mp + mm) * 16 + fr, col = u.pn * 256 + bj * 128 + wc * 32 + 8 * fq;
                        gl[mm][bj] = *(const u32x4*)(gates + (size_t)row * 4096 + u.seg * 1024 + col);
                        if (!FIRST) ol[mm][bj] = *(const u32x4*)(gy + (size_t)row * 1024 + col);
                    }
#pragma unroll
                for (int mm = 0; mm < 2; ++mm)
#pragma unroll
                    for (int bj = 0; bj < 2; ++bj) {
                        const int m = 2 * mp + mm;
                        const int row = u.pm * 256 + ai * 128 + wr * 64 + m * 16 + fr, col = u.pn * 256 + bj * 128 + wc * 32 + 8 * fq;
                        float g[8], o[8];
                        unpack8(gl[mm][bj], g);
                        if (FIRST) {
#pragma unroll
                            for (int i = 0; i < 8; ++i) o[i] = 0.f;
                        } else unpack8(ol[mm][bj], o);
#pragma unroll
                        for (int n = 0; n < 2; ++n)
#pragma unroll
                            for (int j = 0; j < 4; ++j) o[4 * n + j] += g[4 * n + j] * acc[ai][bj][m][n][j];
                        *(u32x4*)(gy + (size_t)row * 1024 + col) = pack8(o);
                    }
            }
    }
    DI void operator()(const f32x4 (&acc)[2][2][4][2], const pg8::Unit& u, int wr, int wc, int fr_, int fq_) const {
        const int fr = opaque(fr_), fq = opaque(fq_);
        if (u.seg == 0) run<true>(acc, u, wr, wc, fr, fq); else run<false>(acc, u, wr, wc, fr, fq);
    }
};
template <bool WRAP>
struct EpiResT {
    const float* xsrc; float* xdst; bf16_t* xb; float* px;
    DI void operator()(const f32x4 (&acc)[2][2][4][2], const pg8::Unit& u, int wr, int wc, int fr_, int fq_) const {
        const int fr = opaque(fr_), fq = opaque(fq_);
#pragma unroll
        for (int ai = 0; ai < 2; ++ai)
#pragma unroll
            for (int mp = 0; mp < 2; ++mp) {
                f32x4 xs[2][2][2];
#pragma unroll
                for (int mm = 0; mm < 2; ++mm)
#pragma unroll
                    for (int bj = 0; bj < 2; ++bj) {
                        const size_t off = (size_t)(u.pm * 256 + ai * 128 + wr * 64 + (2 * mp + mm) * 16 + fr) * 1024 + u.pn * 256 + bj * 128 + wc * 32 + 8 * fq;
                        xs[mm][bj][0] = *(const f32x4*)(xsrc + off); xs[mm][bj][1] = *(const f32x4*)(xsrc + off + 4);
                    }
#pragma unroll
                for (int mm = 0; mm < 2; ++mm) {
                    const int m = 2 * mp + mm, row = u.pm * 256 + ai * 128 + wr * 64 + m * 16 + fr;
                    float ss = 0.f;
#pragma unroll
                    for (int bj = 0; bj < 2; ++bj) {
                        const size_t off0 = (size_t)row * 1024 + u.pn * 256 + bj * 128 + wc * 32 + 8 * fq, off = WRAP ? (off0 & 0x7FFFFFu) : off0;
                        float o[8];
#pragma unroll
                        for (int n = 0; n < 2; ++n) { const f32x4 xn = xs[mm][bj][n] + acc[ai][bj][m][n]; *(f32x4*)(xdst + off + 4 * n) = xn;
#pragma unroll
                            for (int j = 0; j < 4; ++j) { o[4 * n + j] = xn[j]; ss += xn[j] * xn[j]; } }
                        *(u32x4*)(xb + off) = pack8(o);
                    }
                    ss += __shfl_xor(ss, 16); ss += __shfl_xor(ss, 32);
                    if (fq == 0) px[WRAP ? (((size_t)row * 16 + u.pn * 4 + wc) & 0x1FFFFu) : ((size_t)row * 16 + u.pn * 4 + wc)] = ss;
                }
            }
    }
};
typedef EpiResT<false> EpiRes;
struct EpiUp {
    bf16_t* U; RowScale rs; int rs_off;
    DI void operator()(const f32x4 (&acc)[2][2][4][2], const pg8::Unit& u, int wr, int wc, int fr, int fq) const {
        float rsv[8]; rs_preload(rs, u.pm * 256 + wr * 64 + fr + rs_off, fq, rsv);
#pragma unroll
        for (int ai = 0; ai < 2; ++ai)
#pragma unroll
            for (int m = 0; m < 4; ++m) {
                const int row = u.pm * 256 + ai * 128 + wr * 64 + m * 16 + fr;
                const float r = rsv[ai * 4 + m];
#pragma unroll
                for (int bj = 0; bj < 2; ++bj) {
                    float o[8];
#pragma unroll
                    for (int n = 0; n < 2; ++n)
#pragma unroll
                        for (int j = 0; j < 4; ++j) { const float v = fmaxf(acc[ai][bj][m][n][j] * r, 0.f); o[4 * n + j] = v * v; }
                    *(u32x4*)(U + (size_t)row * DFF + u.pn * 256 + bj * 128 + wc * 32 + 8 * fq) = pack8(o);
                }
            }
    }
};

DI void transpose_item(const float* W, int K, int N, const float* gk, bf16_t* WT, int rho0, int k0, int src0, int nvalid, LAS float* scr, int lane) {
    { const int c4 = (lane & 7) * 4, cs = c4 < nvalid ? c4 : 0; const float keep = c4 < nvalid ? 1.f : 0.f;
      f32x4 v[8]; float g[8];
#pragma unroll
      for (int i = 0; i < 8; ++i) v[i] = *(const f32x4*)(W + (size_t)(k0 + 8 * i + (lane >> 3)) * N + src0 + cs);
      if (gk) {
#pragma unroll
          for (int i = 0; i < 8; ++i) g[i] = gk[k0 + 8 * i + (lane >> 3)] * keep;
      } else {
#pragma unroll
          for (int i = 0; i < 8; ++i) g[i] = keep;
      }
#pragma unroll
      for (int i = 0; i < 8; ++i) { const int kk = 8 * i + (lane >> 3); const f32x4 t = v[i] * g[i];
        scr[kk * 33 + c4] = t.x; scr[kk * 33 + c4 + 1] = t.y; scr[kk * 33 + c4 + 2] = t.z; scr[kk * 33 + c4 + 3] = t.w; } }
    LDS_WAIT();
    const int c8 = lane & 7;
#pragma unroll
    for (int j = 0; j < 4; ++j) { const int n = (lane >> 3) + 8 * j; const LAS float* s = scr + (8 * c8) * 33 + n;
        u32x4 o; o.x = cvtpk(s[0 * 33], s[1 * 33]); o.y = cvtpk(s[2 * 33], s[3 * 33]); o.z = cvtpk(s[4 * 33], s[5 * 33]); o.w = cvtpk(s[6 * 33], s[7 * 33]);
        *(u32x4*)(WT + (size_t)(rho0 + n) * K + k0 + 8 * c8) = o; }
    LDS_WAIT();
}
DI void block_src(int mapk, int q  , int& src0, int& nvalid) {
    if (mapk == 0) { src0 = 32 * q; nvalid = 32; return; }
    const int pn = q >> 3, bj = (q >> 2) & 1, wc = q & 3, s = 4 * pn + wc;
    if (mapk == 1) { int src, kind; in_slot_src(s, src, kind);
        if (kind == 0) { src0 = src + 32 * bj; nvalid = 32; } else if (kind == 1) { src0 = src + 16 * bj; nvalid = 16; } else { src0 = 0; nvalid = 0; } }
    else if (mapk == 2) { if (s < 8) { src0 = 96 * s + 32 * bj; nvalid = 32; } else { src0 = 96 * (s - 8) + 64 + 16 * bj; nvalid = 16; } }
    else if (mapk == 3) { if (s < 8) { src0 = 128 * s + 32 * bj; nvalid = 32; } else { src0 = 128 * (s - 8) + 64 + 32 * bj; nvalid = 32; } }
    else { src0 = 64 * s + 32 * bj; nvalid = 32; }
}
DI void convert_matrix(const float* W, int K, int N, int Nt, const float* gk, bf16_t* WT, int mapk, LAS float* scr, int gw, int NGW, int lane) {
    const int nblk = Nt / 32, items = (K / 64) * nblk;
    for (int it = gw; it < items; it += NGW) {
        const int kb = it / nblk, q = it % nblk; int src0, nvalid; block_src(mapk, q, src0, nvalid);
        transpose_item(W, K, N, gk, WT, 32 * q, 64 * kb, src0, nvalid, scr, lane);
    }
}
DI void convert_layer(int l, LAS unsigned char* lds, int gw, int NGW, int wave) {
    const int lane = lane_id();
    CParams* q = fresh_params();
    LAS float* scr = (LAS float*)(lds + wave * 16384);
    unsigned char* ws = q->ws;
    convert_matrix(q->in[4] + (size_t)l * D * N_IN, D, N_IN, NT_IN, q->in[3] + l * D, (bf16_t*)(ws + WS_WIN), 1, scr, gw, NGW, lane);
    convert_matrix(q->in[11] + (size_t)l * 384 * 768, 384, 768, 1024, q->in[9] + l * 384, (bf16_t*)(ws + WS_WUQ), 2, scr, gw, NGW, lane);
    convert_matrix(q->in[12] + (size_t)l * 256 * 1024, 256, 1024, 1024, q->in[10] + l * 256, (bf16_t*)(ws + WS_WUKV), 3, scr, gw, NGW, lane);
    convert_matrix(q->in[18] + (size_t)l * D * 1024, D, 1024, 1024, q->in[17] + l * D, (bf16_t*)(ws + WS_WMKV), 4, scr, gw, NGW, lane);
    for (int n = 0; n < 4; ++n)
        convert_matrix(q->in[21] + ((size_t)l * 4 + n) * 512 * D, 512, D, D, nullptr, (bf16_t*)(ws + WS_WBR) + (size_t)n * D * 512, 0, scr, gw, NGW, lane);
    convert_matrix(q->in[22] + (size_t)l * D * D, D, D, D, nullptr, (bf16_t*)(ws + WS_WOUT), 0, scr, gw, NGW, lane);
    convert_matrix(q->in[24] + (size_t)l * D * DFF, D, DFF, DFF, q->in[23] + l * D, (bf16_t*)(ws + WS_WUP), 0, scr, gw, NGW, lane);
    convert_matrix(q->in[25] + (size_t)l * DFF * D, DFF, D, D, nullptr, (bf16_t*)(ws + WS_WDN), 0, scr, gw, NGW, lane);
}

DI int crow(int i, int h) { return (i & 3) + 8 * (i >> 2) + 4 * h; }
DI f32x16 mfma32(bf16x8 a, bf16x8 b, f32x16 c) { return __builtin_amdgcn_mfma_f32_32x32x16_bf16(a, b, c, 0, 0, 0); }
DI bf16x8 packp(const f32x16& x, int s) { u32x4 w; w.x = cvtpk(x[8 * s], x[8 * s + 1]); w.y = cvtpk(x[8 * s + 2], x[8 * s + 3]); w.z = cvtpk(x[8 * s + 4], x[8 * s + 5]); w.w = cvtpk(x[8 * s + 6], x[8 * s + 7]); return __builtin_bit_cast(bf16x8, w); }
DI s16x4 vtr(const LAS char* p) { return __builtin_bit_cast(s16x4, __builtin_amdgcn_ds_read_tr16_b64_v4i16((LAS s16x4*)p)); }

DI float max3f(float a, float b, float c) { float r; asm("v_max3_f32 %0, %1, %2, %3" : "=v"(r) : "v"(a), "v"(b), "v"(c)); return r; }
DI float xhalf_max(float v) { auto rr = __builtin_amdgcn_permlane32_swap(__float_as_uint(v), __float_as_uint(v), false, false); return fmaxf(__uint_as_float(rr[0]), __uint_as_float(rr[1])); }
DI float xhalf_sum(float v) { auto rr = __builtin_amdgcn_permlane32_swap(__float_as_uint(v), __float_as_uint(v), false, false); return __uint_as_float(rr[0]) + __uint_as_float(rr[1]); }
DI f32x16 splat16(float v) { f32x16 p;
#pragma unroll
    for (int i = 0; i < 16; ++i) p[i] = v;
    return p; }
template <int DQK, int NT, int TSTRIDE> DI void st_tiles(unsigned kaddr, const bf16x8* qf, const f32x16& init, f32x16* p) {
    bf16x8 a[NT][DQK / 16];
#pragma unroll
    for (int j = 0; j < NT; ++j)
#pragma unroll
        for (int ks = 0; ks < DQK / 16; ++ks) asm volatile("ds_read_b128 %0, %1 offset:%2" : "=v"(a[j][ks]) : "v"(kaddr), "i"(j * TSTRIDE + ks * 32));
    asm volatile("s_waitcnt lgkmcnt(0)" ::: "memory");
#pragma unroll
    for (int j = 0; j < NT; ++j)
#pragma unroll
        for (int ks = 0; ks < DQK / 16; ++ks) asm volatile("" : "+v"(a[j][ks]));
#pragma unroll
    for (int j = 0; j < NT; ++j) p[j] = init;
#pragma unroll
    for (int ks = 0; ks < DQK / 16; ++ks)
#pragma unroll
        for (int j = 0; j < NT; ++j) p[j] = mfma32(a[j][ks], qf[ks], p[j]);
}
template <int DV, int VP> DI void pv_tile(f32x16* o, const LAS char* vp, const f32x16& p, int h) {
#pragma unroll
    for (int s = 0; s < 2; ++s) {
        const bf16x8 pa = packp(p, s);
#pragma unroll
        for (int db = 0; db < DV / 32; ++db) {
            const s16x4 lo = vtr(vp + (16 * s + 4 * h) * VP + db * 64);
            const s16x4 hi = vtr(vp + (16 * s + 8 + 4 * h) * VP + db * 64);
            const bf16x8 vb = __builtin_shufflevector(lo, hi, 0, 1, 2, 3, 4, 5, 6, 7);
            o[db] = mfma32(pa, vb, o[db]);
        }
    }
}
template <int NDB> DI void scale_o(f32x16* o, float f, LAS float* sc, int r, int h) {
    if (h == 0) sc[r] = f;
    LDS_WAIT();
#pragma unroll
    for (int g = 0; g < 4; ++g) { const f32x4 f4 = *(const LAS f32x4*)(sc + 8 * g + 4 * h);
#pragma unroll
        for (int db = 0; db < NDB; ++db)
#pragma unroll
            for (int j = 0; j < 4; ++j) o[db][4 * g + j] *= f4[j]; }
    LDS_WAIT();
}
template <int NDB> DI void store_o(const f32x16* o, bf16_t* obase  , long rstride, int r, int h) {
#pragma unroll
    for (int i = 0; i < 16; ++i) { bf16_t* rp = obase + (long)crow(i, h) * rstride + r;
#pragma unroll
        for (int db = 0; db < NDB; ++db) rp[32 * db] = (bf16_t)(cvtpk(o[db][i], 0.f) & 0xffffu); }
}

constexpr int BKP = 144, BVP = 144;
constexpr int BSLOT = 256 * BKP + 256 * BVP;

DI void banded_load(LAS char* dst, int pitch, const bf16_t* src  , int ld, long row0  , int dil, int gi0, int tid) {
    u32x4 v[4];
#pragma unroll
    for (int it = 0; it < 4; ++it) {
        const int c = tid + it * NTHREADS, key = c >> 3, cc = c & 7, gi = gi0 + key, gic = gi < 0 ? 0 : gi;
        v[it] = *(const u32x4*)(src + (row0 + (long)gic * dil) * ld + cc * 8);
    }
#pragma unroll
    for (int it = 0; it < 4; ++it) {
        const int c = tid + it * NTHREADS, key = c >> 3, cc = c & 7, gi = gi0 + key;
        if (gi < 0) v[it] = (u32x4){0u, 0u, 0u, 0u};
        *(LAS u32x4*)(dst + key * pitch + cc * 16) = v[it];
    }
}
template <bool SINK, bool WANT_LSE>
DI void banded_task(const bf16_t* qrow  , bf16_t* obase, long rstride, const LAS char* Ks, const LAS char* Vs,
                    int wq, int jblk, int maxd, float sink2, float* lsep, LAS float* sc, int lane) {
    const int r = lane & 31, h = lane >> 5;
    bf16x8 qf[4];
#pragma unroll
    for (int ks = 0; ks < 4; ++ks) qf[ks] = *(const bf16x8*)(qrow + 16 * ks + 8 * h);
    f32x16 p[5];
    const f32x16 zero16 = splat16(0.f);
    { const unsigned ka = (unsigned)(uintptr_t)(Ks + (32 * wq + r) * BKP + 16 * h);
      st_tiles<64, 3, 32 * BKP>(ka, qf, zero16, p); st_tiles<64, 2, 32 * BKP>(ka + 96 * BKP, qf, zero16, p + 3); }
    const int tmin = (jblk == 0) ? 4 - wq : 0, lo = r + 128 - maxd;
#pragma unroll
    for (int t = 0; t < 5; ++t) {
        if (t < tmin) { p[t] = splat16(NEGBIG); }
        else if (t == 0) {
#pragma unroll
            for (int i = 0; i < 16; ++i) p[t][i] = (crow(i, h) >= lo) ? p[t][i] : NEGBIG;
        } else if (t == 4) {
#pragma unroll
            for (int i = 0; i < 16; ++i) p[t][i] = (crow(i, h) <= r) ? p[t][i] : NEGBIG;
        }
    }
    asm volatile("s_nop 15\n\ts_nop 7" : "+v"(p[0]), "+v"(p[1]), "+v"(p[2]), "+v"(p[3]), "+v"(p[4]));
    float mx = NEGBIG;
#pragma unroll
    for (int t = 0; t < 5; ++t)
#pragma unroll
        for (int i = 0; i < 16; i += 2) mx = max3f(mx, p[t][i], p[t][i + 1]);
    mx = xhalf_max(mx);
    if (SINK) mx = fmaxf(mx, sink2);
    float l;
    { const f32x16 mx16 = splat16(mx); f32x16 acc = splat16(0.f);
#pragma unroll
      for (int t = 0; t < 5; ++t) { p[t] = p[t] - mx16;
#pragma unroll
          for (int i = 0; i < 16; ++i) p[t][i] = __builtin_amdgcn_exp2f(p[t][i]);
          acc = acc + p[t]; }
      float a8[8];
#pragma unroll
      for (int i = 0; i < 8; ++i) a8[i] = acc[i] + acc[i + 8];
      l = ((a8[0] + a8[1]) + (a8[2] + a8[3])) + ((a8[4] + a8[5]) + (a8[6] + a8[7])); }
    l = xhalf_sum(l);
    if (SINK) l += __builtin_amdgcn_exp2f(sink2 - mx);
    f32x16 o[2];
#pragma unroll
    for (int i = 0; i < 16; ++i) { o[0][i] = 0.f; o[1][i] = 0.f; }
    const LAS char* vl = Vs + ((lane & 15) >> 2) * BVP + ((lane >> 4) & 1) * 32 + (lane & 3) * 8;
#pragma unroll
    for (int t = 0; t < 5; ++t) pv_tile<64, BVP>(o, vl + 32 * (wq + t) * BVP, p[t], h);
    scale_o<2>(o, 1.f / l, sc, r, h);
    store_o<2>(o, obase, rstride, r, h);
    if (WANT_LSE) { if (h == 0) *lsep = mx + __builtin_amdgcn_logf(l); }
}

template <int DQK, int DV, bool CAUSAL, bool SPLITK>
DI void dense_unit(const bf16_t* Q, int ldq, const bf16_t* K1, int ldk1, const bf16_t* K2, int ldk2, const bf16_t* V, int ldv, bf16_t* O, int ldo,
                   int q0  , int ntiles, LAS char* lds, LAS float* sc, int tid) {
    constexpr int KP = DQK * 2 + 16, VP = DV * 2 + 16, KCH = DQK / 8, VCH = DV / 8, NK = 64 * KCH, NCH = NK + 64 * VCH, NIT = (NCH + NTHREADS - 1) / NTHREADS;
    constexpr int KBUF = 64 * KP, VBUF = 64 * VP, TB = KBUF + VBUF;
    const int lane = tid & 63, w = __builtin_amdgcn_readfirstlane(tid >> 6), r = lane & 31, h = lane >> 5;
    LAS char* kb0 = lds; LAS char* vb0 = lds + KBUF;
    bf16x8 qf[DQK / 16];
    { const bf16_t* qr = Q + (long)(32 * w + r) * ldq;
#pragma unroll
      for (int ks = 0; ks < DQK / 16; ++ks) qf[ks] = *(const bf16x8*)(qr + 16 * ks + 8 * h);
#pragma unroll
      for (int ks = 0; ks < DQK / 16; ++ks) asm volatile("" : "+v"(qf[ks])); }
    int gb[NIT], gs[NIT], lo[NIT];
    if (SPLITK)
#pragma unroll
    for (int it = 0; it < NIT; ++it) { const int c = tid + it * NTHREADS;
        if (c < NK) { const int key = c / KCH, cc = c % KCH;
            if (SPLITK && cc >= 8) { gb[it] = (int)((const char*)K2 - (const char*)K1) + (key * ldk2 + (cc - 8) * 8) * 2; gs[it] = 64 * ldk2 * 2; }
            else { gb[it] = (key * ldk1 + cc * 8) * 2; gs[it] = 64 * ldk1 * 2; }
            lo[it] = key * KP + cc * 16; }
        else { const int c2 = (c < NCH ? c : NK) - NK, key = c2 / VCH, cc = c2 % VCH;
            gb[it] = (int)((const char*)V - (const char*)K1) + (key * ldv + cc * 8) * 2; gs[it] = 64 * ldv * 2; lo[it] = KBUF + key * VP + cc * 16; }
        asm volatile("" : "+v"(gb[it]), "+v"(gs[it]), "+v"(lo[it])); }
    u32x4 pre[NIT];
    auto gload = [&](int t) {
        if (SPLITK) {
#pragma unroll
            for (int it = 0; it < NIT; ++it) if ((it + 1) * NTHREADS <= NCH || tid + it * NTHREADS < NCH) pre[it] = *(const u32x4*)((const char*)K1 + (long)(gb[it] + t * gs[it]));
        } else {
            const int tid2 = opaque(tid);
#pragma unroll
            for (int it = 0; it < NIT; ++it) { const int c = tid2 + it * NTHREADS;
                if (c < NK) { const int key = c / KCH, cc = c % KCH; pre[it] = *(const u32x4*)(K1 + (long)(64 * t + key) * ldk1 + cc * 8); }
                else if (c < NCH) { const int c2 = c - NK, key = c2 / VCH, cc = c2 % VCH; pre[it] = *(const u32x4*)(V + (long)(64 * t + key) * ldv + cc * 8); } }
        }
    };
    auto lstore = [&](int b) {
        if (SPLITK) {
#pragma unroll
            for (int it = 0; it < NIT; ++it) if ((it + 1) * NTHREADS <= NCH || tid + it * NTHREADS < NCH) *(LAS u32x4*)(lds + b * TB + lo[it]) = pre[it];
        } else {
            const int tid2 = opaque(tid);
#pragma unroll
            for (int it = 0; it < NIT; ++it) { const int c = tid2 + it * NTHREADS;
                if (c < NK) { const int key = c / KCH, cc = c % KCH; *(LAS u32x4*)(kb0 + b * TB + key * KP + cc * 16) = pre[it]; }
                else if (c < NCH) { const int c2 = c - NK, key = c2 / VCH, cc = c2 % VCH; *(LAS u32x4*)(vb0 + b * TB + key * VP + cc * 16) = pre[it]; } }
        }
    };
    gload(0); lstore(0);
    __syncthreads();
    float m = 0.f, l = 0.f; bool first = true;
    f32x16 negm = splat16(0.f);
    f32x16 o[DV / 32];
#pragma unroll
    for (int db = 0; db < DV / 32; ++db)
#pragma unroll
        for (int i = 0; i < 16; ++i) o[db][i] = 0.f;
    const int qpos = q0 + 32 * w + r;
    for (int t = 0; t < ntiles; ++t) {
        const int b = t & 1;
        if (t + 1 < ntiles) gload(t + 1);
        if (!CAUSAL || 64 * t <= q0 + 32 * w) {
            const LAS char* kp = kb0 + b * TB + r * KP + 16 * h;
            f32x16 pp[2]; st_tiles<DQK, 2, 32 * KP>((unsigned)(uintptr_t)kp, qf, negm, pp);
            f32x16& p0 = pp[0]; f32x16& p1 = pp[1];
            if (CAUSAL && 64 * t + 63 > q0 + 32 * w) {
#pragma unroll
                for (int i = 0; i < 16; ++i) { const int key = 64 * t + crow(i, h); if (key > qpos) p0[i] = NEGBIG; if (key + 32 > qpos) p1[i] = NEGBIG; }
            }
            asm volatile("s_nop 15\n\ts_nop 7" : "+v"(p0), "+v"(p1));
            float mx = NEGBIG;
#pragma unroll
            for (int i = 0; i < 16; ++i) mx = max3f(mx, p0[i], p1[i]);
            mx = xhalf_max(mx);
            if (first || __any(mx > 8.f)) {
                const float dl = first ? mx : (mx > 8.f ? mx : 0.f);
                m += dl;
                const float f = __builtin_amdgcn_exp2f(-dl);
                l *= f;
#pragma unroll
                for (int i = 0; i < 16; ++i) { p0[i] -= dl; p1[i] -= dl; }
                if (!first) scale_o<DV / 32>(o, f, sc, r, h);
                negm = splat16(-m);
                first = false;
            }
#pragma unroll
            for (int i = 0; i < 16; ++i) { p0[i] = __builtin_amdgcn_exp2f(p0[i]); p1[i] = __builtin_amdgcn_exp2f(p1[i]); l += p0[i] + p1[i]; }
            const LAS char* vl = vb0 + b * TB + ((lane & 15) >> 2) * VP + ((lane >> 4) & 1) * 32 + (lane & 3) * 8;
            pv_tile<DV, VP>(o, vl, p0, h);
            pv_tile<DV, VP>(o, vl + 32 * VP, p1, h);
        }
        if (t + 1 < ntiles) lstore(b ^ 1);
        __syncthreads();
    }
    l = xhalf_sum(l);
    scale_o<DV / 32>(o, 1.f / l, sc, r, h);
    store_o<DV / 32>(o, O + (long)(32 * w) * ldo, ldo, r, h);
}


#define XB_TMO      128
#define XB_XCNT(j)  (256  + 64 * (j))
#define XB_XSUB(j)  (1280 + 64 * (j))
#define XB_XGEN(j)  (2304 + 64 * (j))
#define XB_TOP      3328
#define XB_TOPGEN   3392
#define XCD_BAR_WORDS 3456
#define XB_SPIN_CAP (1u << 22)
DI unsigned xb_ld(unsigned* p)              { return __hip_atomic_load(p, __ATOMIC_RELAXED, __HIP_MEMORY_SCOPE_AGENT); }
DI unsigned xb_add(unsigned* p, unsigned v) { return __hip_atomic_fetch_add(p, v, __ATOMIC_RELAXED, __HIP_MEMORY_SCOPE_AGENT); }
DI unsigned xb_xcc_id() { return (unsigned)__builtin_amdgcn_s_getreg((3 << 11) | 20) & 0xFu; }
#define XB_SPIN(cond, bar) do { unsigned _sp = 0; while (cond) { __builtin_amdgcn_s_sleep(1); \
    if ((++_sp & 255u) == 0u) { if (xb_ld(&(bar)[XB_TMO])) break; if (_sp > XB_SPIN_CAP) { atomicAdd(&(bar)[XB_TMO], 1u); break; } } } } while (0)
struct XcdBarrier { unsigned* bar; unsigned x; volatile LAS unsigned* st; };
DI XcdBarrier xcd_barrier_post(unsigned* bar, volatile LAS unsigned* st) {
    XcdBarrier b; b.bar = bar; b.x = xb_xcc_id(); b.st = st;
    if (threadIdx.x == 0) (void)xb_add(&bar[XB_XCNT(b.x)], 1u);
    return b;
}
DI void xcd_barrier_complete(unsigned* bar, unsigned x, unsigned& nloc, unsigned& nx) {
    const unsigned G = gridDim.x * gridDim.y * gridDim.z;
    unsigned sum, cnt, mine, sp = 0u;
    for (;;) {
        sum = 0u; cnt = 0u; mine = 0u;
#pragma unroll
        for (unsigned j = 0; j < 16; ++j) { const unsigned c = xb_ld(&bar[XB_XCNT(j)]); sum += c; cnt += (c > 0u) ? 1u : 0u; mine = (j == x) ? c : mine; }
        if (sum == G) break;
        __builtin_amdgcn_s_sleep(1);
        if ((++sp & 255u) == 0u) { if (xb_ld(&bar[XB_TMO])) break; if (sp > XB_SPIN_CAP) { atomicAdd(&bar[XB_TMO], 1u); break; } }
    }
    nloc = mine > 0u ? mine : 1u; nx = cnt > 0u ? cnt : 1u;
}
DI void xcd_barrier(unsigned* bar, unsigned x, volatile LAS unsigned* st) {
    asm volatile("s_waitcnt vmcnt(0)" ::: "memory");
    __syncthreads();
    if (threadIdx.x == 0) {
        __builtin_amdgcn_s_waitcnt(0);
        unsigned nloc = st[0], nx = st[1];
        if (nloc == 0u) { xcd_barrier_complete(bar, x, nloc, nx); st[0] = nloc; st[1] = nx; }
        const unsigned old = xb_add(&bar[XB_XSUB(x)], 1u);
        const unsigned gen = old / nloc;
        if (old + 1u == (gen + 1u) * nloc) {
            __builtin_amdgcn_fence(__ATOMIC_RELEASE, "agent");
            asm volatile("s_waitcnt vmcnt(0)" ::: "memory");
            const unsigned og = xb_add(&bar[XB_TOP], 1u);
            const unsigned tg = og / nx;
            if (og + 1u == (tg + 1u) * nx) xb_add(&bar[XB_TOPGEN], 1u);
            else XB_SPIN(xb_ld(&bar[XB_TOPGEN]) == tg, bar);
            __builtin_amdgcn_fence(__ATOMIC_ACQUIRE, "agent");
            xb_add(&bar[XB_XGEN(x)], 1u);
            asm volatile("s_waitcnt vmcnt(0)" ::: "memory");
        } else {
            XB_SPIN(xb_ld(&bar[XB_XGEN(x)]) == gen, bar);
            __builtin_amdgcn_fence(__ATOMIC_ACQUIRE, "agent");
            asm volatile("s_waitcnt vmcnt(0)" ::: "memory");
        }
    }
    __syncthreads();
}

DI void sincos_acc(float ang, float& c, float& s) {
    const double x = (double)ang;
    const double n = __builtin_rint(x * 0.63661977236758134308);
    double rr = __builtin_fma(-n, 1.57079632679489655800e+00, x); rr = __builtin_fma(-n, 6.12323399573676603587e-17, rr);
    const double r2 = rr * rr;
    const double sn = rr * (1.0 + r2 * (-1.0 / 6 + r2 * (1.0 / 120 + r2 * (-1.0 / 5040 + r2 * (1.0 / 362880 + r2 * (-1.0 / 39916800 + r2 * (1.0 / 6227020800.0)))))));
    const double cs = 1.0 + r2 * (-0.5 + r2 * (1.0 / 24 + r2 * (-1.0 / 720 + r2 * (1.0 / 40320 + r2 * (-1.0 / 3628800 + r2 * (1.0 / 479001600.0))))));
    const int q = ((int)n) & 3;
    const double cc = (q == 0) ? cs : (q == 1) ? -sn : (q == 2) ? -cs : sn;
    const double ss = (q == 0) ? sn : (q == 1) ? cs : (q == 2) ? -sn : -cs;
    c = (float)cc; s = (float)ss;
}

#ifndef PH
#define PH 255
#endif
#ifndef REP_P1
#define REP_P1 1
#endif
#ifndef REP_B
#define REP_B 1
#endif
#ifndef REP_CONV
#define REP_CONV 1
#endif
#ifndef REP_P7
#define REP_P7 1
#endif
#define GRID_SYNC() do { CParams* qb_ = fresh_params(); xcd_barrier((unsigned*)(qb_->ws + WS_CTL), xcc, MISC); } while (0)

__global__ void __launch_bounds__(NTHREADS, 2) fwd_megakernel(Params p) {
    extern __shared__ __attribute__((aligned(16))) unsigned char lds_raw[];
    cg::grid_group grid = cg::this_grid();
    LAS unsigned char* lds = (LAS unsigned char*)lds_raw;
    const int wave = __builtin_amdgcn_readfirstlane((int)threadIdx.x >> 6);
    const int G = gridDim.x, bid = blockIdx.x;
    const int gw = bid * NWAVES + wave, NGW = G * NWAVES;
    LAS float* sc = (LAS float*)(lds + LDS_SCR) + wave * 64;
    volatile LAS unsigned* MISC = (volatile LAS unsigned*)(lds + LDS_SCR + 2048);
    if (threadIdx.x < 4) MISC[threadIdx.x] = 0u;
    __syncthreads();
    unsigned xcc;
    { CParams* q0 = fresh_params(); const XcdBarrier xb = xcd_barrier_post((unsigned*)(q0->ws + WS_CTL), MISC); xcc = xb.x; }

#ifndef NOPRO
    {
        PHASE_CTX
        float* COSH = (float*)(ws + WS_COSH); float* SINH = (float*)(ws + WS_SINH); float* COSR = (float*)(ws + WS_COSR); float* SINR = (float*)(ws + WS_SINR);
        const float* x = q->in[0]; const int* pos = (const int*)q->in[2];
        const int lane = lane_id(), tid = wave * 64 + lane;
        for (int i = bid * NTHREADS + tid; i < TT * 32; i += G * NTHREADS) { const int t = i >> 5, k = i & 31; float c, s; sincos_acc((float)pos[t] * q->inv_h[k], c, s); COSH[i] = c; SINH[i] = s; }
        for (int i = bid * NTHREADS + tid; i < TT * 16; i += G * NTHREADS) { const int t = i >> 4, k = i & 15; float c, s; sincos_acc((float)pos[t] * q->inv_r[k], c, s); COSR[i] = c; SINR[i] = s; }
        for (int row = gw; row < TT; row += NGW) {
            const f32x4* xr = (const f32x4*)(x + (size_t)row * D) + lane; float ss = 0.f;
            u32x2* o8 = (u32x2*)(XB + (size_t)row * D) + lane;
#pragma unroll
            for (int j = 0; j < 4; ++j) { const f32x4 v = xr[64 * j]; ss += (v.x * v.x + v.y * v.y) + (v.z * v.z + v.w * v.w); u32x2 w; w.x = cvtpk(v.x, v.y); w.y = cvtpk(v.z, v.w); o8[64 * j] = w; }
            ss = wave_sum(ss);
            if (lane < 16) PX[(size_t)row * 16 + lane] = lane == 0 ? ss : 0.f;
        }
        const float* mem = q->in[1]; bf16_t* MEMN = (bf16_t*)(ws + WS_MEMN);
        for (int row = gw; row < BATCH * NMEM; row += NGW) {
            const f32x4* xr = (const f32x4*)(mem + (size_t)row * D) + lane; f32x4 v[4]; float ss = 0.f;
#pragma unroll
            for (int j = 0; j < 4; ++j) { v[j] = xr[64 * j]; ss += (v[j].x * v[j].x + v[j].y * v[j].y) + (v[j].z * v[j].z + v[j].w * v[j].w); }
            const float rstd = __builtin_amdgcn_rsqf(wave_sum(ss) * (1.f / D) + EPS);
            u32x2* o8 = (u32x2*)(MEMN + (size_t)row * D) + lane;
#pragma unroll
            for (int j = 0; j < 4; ++j) { u32x2 w; w.x = cvtpk(v[j].x * rstd, v[j].y * rstd); w.y = cvtpk(v[j].z * rstd, v[j].w * rstd); o8[64 * j] = w; }
        }
    }

#endif
    for (int l = 0; l < DEPTH; ++l) {
#ifndef NOCONV
#pragma unroll 1
        for (int rep = 0; rep < REP_CONV; ++rep) convert_layer(l, lds, gw, NGW, wave);
#endif
        if (l == 0) grid.sync(); else GRID_SYNC();
        for (int ch = 0; ch < NCHUNK; ++ch) {
            const int tok0 = ch * TC;
#if PH & 1
            {
                PHASE_CTX
                pg8::TileOrder S; S.init(TC, NT_IN, G, bid, XB + (size_t)tok0 * D, (const bf16_t*)(ws + WS_WIN));
                EpiSlot<CfgIn> E{CfgIn{ws, q->in[6] + l * 64, q->in[7] + l * 64, q->in[14] + l * 96, q->in[15] + l * 192, q->in[16] + l * 192, q->in[5] + l * 4096},
                                 RowScale{PX, 16, 16, 1.f / D}, tok0, rt, tok0};
#pragma unroll 1
                for (int rep = 0; rep < REP_P1; ++rep) pg8::gemm_phase(lds, D, D, S, E, wave);
                if (ch == 0) {
                    pg8::TileOrder S2; S2.init(BATCH * NMEM, 1024, G, (bid + 128) % G, (const bf16_t*)(ws + WS_MEMN), (const bf16_t*)(ws + WS_WMKV));
                    EpiSlot<CfgMkv> E2{CfgMkv{ws}, RowScale{nullptr, 0, 0, 0.f}, 0, rt, 0};
                    pg8::gemm_phase(lds, D, D, S2, E2, wave);
                }
            }

#endif
            GRID_SYNC();
#if PH & 2
            {
                PHASE_CTX
                pg8::TileOrder S; S.init(TC, 1024, G, bid, (const bf16_t*)(ws + WS_CQ), (const bf16_t*)(ws + WS_WUQ));
                EpiSlot<CfgUq> E{CfgUq{ws, q->in[13] + l * 96}, RowScale{(const float*)(ws + WS_PCQ), 8, 6, 1.f / 384.f}, 0, rt, tok0};
                pg8::gemm_phase(lds, 384, 384, S, E, wave);
                pg8::TileOrder S2; S2.init(TC, 1024, G, bid, (const bf16_t*)(ws + WS_CKV), (const bf16_t*)(ws + WS_WUKV));
                EpiSlot<CfgUkv> E2{CfgUkv{ws, q->in[14] + l * 96}, RowScale{(const float*)(ws + WS_PCKV), 4, 4, 1.f / 256.f}, 0, rt, tok0};
                pg8::gemm_phase(lds, 256, 256, S2, E2, wave);
                const int lane = opaque(lane_id());
                const int nrows = TC + (ch == 0 ? BATCH * NMEM : 0);
                for (int rw = gw; rw < nrows; rw += NGW) {
                    const bool isq = rw < TC;
                    bf16_t* rp = isq ? (bf16_t*)(ws + WS_MQ) + (size_t)rw * 512 : (bf16_t*)(ws + WS_MK) + (size_t)(rw - TC) * 512;
                    const float* gn = (isq ? q->in[19] : q->in[20]) + l * 128 + (lane & 15) * 8;
                    const float scl = isq ? 0.08838834764831845f * LOG2E : 1.f;
                    float v[8]; unpack8(*(const u32x4*)(rp + lane * 8), v);
                    float ss = 0.f;
#pragma unroll
                    for (int i = 0; i < 8; ++i) ss += v[i] * v[i];
                    ss += __shfl_xor(ss, 1); ss += __shfl_xor(ss, 2); ss += __shfl_xor(ss, 4); ss += __shfl_xor(ss, 8);
                    const float inv = __builtin_amdgcn_rsqf(ss * (1.f / 128.f) + EPS) * scl;
#pragma unroll
                    for (int i = 0; i < 8; ++i) v[i] *= inv * gn[i];
                    *(u32x4*)(rp + lane * 8) = pack8(v);
                }
            }

#endif
            GRID_SYNC();
#if PH & 4
            {
                PHASE_CTX
                LAS char* al = (LAS char*)lds;
                const int lane = opaque(lane_id()), tid = wave * 64 + lane;
                const int vcu = (G % 8 == 0) ? (bid % 8) * (G / 8) + bid / 8 : bid;
#pragma unroll 1
                for (int rep = 0; rep < REP_B; ++rep)
                for (int idx = vcu; idx < BC * 8 * 16; idx += G) {
                    const int half = idx / (BC * 64), rem = idx % (BC * 64), bh = rem / 8, s = rem % 8;
                    const int qb = half == 0 ? s : 15 - s, b = bh / 8, hh = bh % 8;
                    const long r0 = (long)b * SEQ;
                    dense_unit<96, 64, true, true>((const bf16_t*)(ws + WS_QB) + (r0 + 256 * qb) * 768 + 96 * hh, 768,
                        (const bf16_t*)(ws + WS_KN) + r0 * 512 + 64 * hh, 512, (const bf16_t*)(ws + WS_KR) + r0 * 32, 32,
                        (const bf16_t*)(ws + WS_VB) + r0 * 512 + 64 * hh, 512, (bf16_t*)(ws + WS_OB) + (r0 + 256 * qb) * 512 + 64 * hh, 512,
                        256 * qb, 4 * (qb + 1), al, sc, tid);
                }
                for (int idx = vcu; idx < 3 * BC * 32 * 4; idx += G) {
                    const int g = idx / (BC * 128), rem = idx % (BC * 128), hp = rem / (BC * 32), sj = rem % (BC * 32);
                    const int dil = g == 0 ? 1 : g == 1 ? 4 : 16, nb = 32 / dil;
                    const int n = sj / nb, j = sj % nb, b = n / dil, res = n % dil;
                    const long row0 = (long)b * SEQ + res;
                    const bf16_t* Qg = (const bf16_t*)(ws + WS_CB + (size_t)(3 * g) * 16 * MiB); const bf16_t* Kg = (const bf16_t*)(ws + WS_CB + (size_t)(3 * g + 1) * 16 * MiB); const bf16_t* Vg = (const bf16_t*)(ws + WS_CB + (size_t)(3 * g + 2) * 16 * MiB);
#pragma unroll
                    for (int sl = 0; sl < 2; ++sl) {
                        banded_load(al + sl * BSLOT, BKP, Kg + 64 * (2 * hp + sl), 512, row0, dil, 128 * (j - 1), tid);
                        banded_load(al + sl * BSLOT + 256 * BKP, BVP, Vg + 64 * (2 * hp + sl), 512, row0, dil, 128 * (j - 1), tid);
                    }
                    __syncthreads();
                    { const int sl = wave >> 2, wq = wave & 3, hd = 2 * hp + sl, r = lane & 31;
                      const long qtok = row0 + (long)(128 * j + 32 * wq + r) * dil;
                      bf16_t* ob = (bf16_t*)Qg + (row0 + (long)(128 * j + 32 * wq) * dil) * 512 + 64 * hd;
                      banded_task<false, true>(Qg + qtok * 512 + 64 * hd, ob, (long)dil * 512, al + sl * BSLOT, al + sl * BSLOT + 256 * BKP, wq, j, 128, 0.f,
                                               (float*)(ws + WS_LSE) + (qtok * 8 + hd) * 4 + g, sc, lane); }
                    __syncthreads();
                }
                for (int idx = vcu; idx < BC * 32 * 2; idx += G) {
                    const int j = idx & 31, kvh = (idx >> 5) & 1, b = idx >> 6;
                    const long row0 = (long)b * SEQ;
                    banded_load(al, BKP, (const bf16_t*)(ws + WS_KA) + 64 * kvh, 128, row0, 1, 128 * (j - 1), tid);
                    banded_load(al + 256 * BKP, BVP, (const bf16_t*)(ws + WS_VA) + 64 * kvh, 128, row0, 1, 128 * (j - 1), tid);
                    __syncthreads();
#pragma unroll 1
                    for (int pass = 0; pass < 2; ++pass) {
                        const int hq = kvh * 4 + (wave >> 2) + 2 * pass, wq = wave & 3, r = lane & 31;
                        const long qtok = row0 + 128 * j + 32 * wq + r;
                        bf16_t* QA = (bf16_t*)(ws + WS_QA);
                        banded_task<true, false>(QA + qtok * 512 + 64 * hq, QA + (row0 + 128 * j + 32 * wq) * 512 + 64 * hq, 512, al, al + 256 * BKP, wq, j, 127,
                                                 (q->in[8] + l * 8)[hq] * LOG2E, nullptr, sc, lane);
                    }
                    __syncthreads();
                }
                for (int idx = vcu; idx < BC * 4 * 16; idx += G) {
                    const int qb = idx & 15, hh = (idx >> 4) & 3, b = idx >> 6;
                    const long r0 = (long)b * SEQ + 256 * qb; const long m0 = (long)(ch * BC + b) * NMEM;
                    bf16_t* MQ = (bf16_t*)(ws + WS_MQ);
                    dense_unit<128, 128, false, false>(MQ + r0 * 512 + 128 * hh, 512, (const bf16_t*)(ws + WS_MK) + m0 * 512 + 128 * hh, 512, nullptr, 0,
                        (const bf16_t*)(ws + WS_MV) + m0 * 512 + 128 * hh, 512, MQ + r0 * 512 + 128 * hh, 512, 0, 4, al, sc, tid);
                }
            }

#endif
            GRID_SYNC();
#if PH & 8
            {
                PHASE_CTX
                const float* LSE = (const float*)(ws + WS_LSE); bf16_t* OC = (bf16_t*)(ws + WS_OC);
                const int tid = wave * 64 + opaque(lane_id());
                for (int i = bid * NTHREADS + tid; i < TC * 64; i += G * NTHREADS) {
                    const int tok = i >> 6, c8 = i & 63, hd = c8 >> 3;
                    const f32x4 ls = *(const f32x4*)(LSE + ((size_t)tok * 8 + hd) * 4);
                    const float mx = fmaxf(ls.x, fmaxf(ls.y, ls.z));
                    float w0 = __builtin_amdgcn_exp2f(ls.x - mx), w1 = __builtin_amdgcn_exp2f(ls.y - mx), w2 = __builtin_amdgcn_exp2f(ls.z - mx);
                    const float inv = 1.f / (w0 + w1 + w2); w0 *= inv; w1 *= inv; w2 *= inv;
                    float a[8], b[8], c[8], o[8];
                    unpack8(*(const u32x4*)((const bf16_t*)(ws + WS_CB) + (size_t)tok * 512 + c8 * 8), a);
                    unpack8(*(const u32x4*)((const bf16_t*)(ws + WS_CB + 48 * MiB) + (size_t)tok * 512 + c8 * 8), b);
                    unpack8(*(const u32x4*)((const bf16_t*)(ws + WS_CB + 96 * MiB) + (size_t)tok * 512 + c8 * 8), c);
#pragma unroll
                    for (int k = 0; k < 8; ++k) o[k] = w0 * a[k] + w1 * b[k] + w2 * c[k];
                    *(u32x4*)(OC + (size_t)tok * 512 + c8 * 8) = pack8(o);
                }
            }

#endif
            GRID_SYNC();
#if PH & 16
            {
                PHASE_CTX
                pg8::TileOrder S; S.init(TC, D, G, bid, (const bf16_t*)(ws + WS_QA), (const bf16_t*)(ws + WS_WBR)); S.nseg = 4;
                S.segA = 8 * MiB; S.segB = (size_t)D * 512;
                EpiMerge E{(const bf16_t*)(ws + WS_GATES), (bf16_t*)(ws + WS_GY) + (size_t)tok0 * D};
                pg8::gemm_phase(lds, 512, 512, S, E, wave);
            }

#endif
            GRID_SYNC();
        }
        {
            const int tok0 = 0;
#if PH & 32
            {
                PHASE_CTX
                pg8::TileOrder S; S.init(TT, D, G, bid, (const bf16_t*)(ws + WS_GY), (const bf16_t*)(ws + WS_WOUT));
                EpiRes E{((l == 0) ? q->in[0] : q->out) + (size_t)tok0 * D, q->out + (size_t)tok0 * D, XB + (size_t)tok0 * D, PX + (size_t)tok0 * 16};
                pg8::gemm_phase(lds, D, D, S, E, wave);
            }

#endif
            GRID_SYNC();
#if PH & 64
            {
                PHASE_CTX
                pg8::TileOrder S; S.init(TT, DFF, G, bid, XB + (size_t)tok0 * D, (const bf16_t*)(ws + WS_WUP));
                EpiUp E{(bf16_t*)(ws + WS_U), RowScale{PX, 16, 16, 1.f / D}, tok0};
#pragma unroll 1
                for (int rep = 0; rep < REP_P7; ++rep) pg8::gemm_phase(lds, D, D, S, E, wave);
            }

#endif
            GRID_SYNC();
#if PH & 128
            {
                PHASE_CTX
                pg8::TileOrder S; S.init(TT, D, G, bid, (const bf16_t*)(ws + WS_U), (const bf16_t*)(ws + WS_WDN));
                EpiRes E{q->out + (size_t)tok0 * D, q->out + (size_t)tok0 * D, XB + (size_t)tok0 * D, PX + (size_t)tok0 * 16};
#ifdef PROBE_P8
                { EpiResT<true> E0{q->out, (float*)(ws + WS_QA), (bf16_t*)(ws + WS_KA), (float*)(ws + WS_PCQ)}; pg8::gemm_phase(lds, DFF, DFF, S, E0, wave); }
#endif
                pg8::gemm_phase(lds, DFF, DFF, S, E, wave);
            }

#endif
            GRID_SYNC();
        }
    }
}

extern "C" void kernel_launch(void* const* d_in, const int* in_sizes, int n_in, void* d_out, int out_size, void* d_ws, size_t ws_size, hipStream_t stream) {
    static int grid = 0;
    if (grid == 0) {
        if (n_in != 26 || out_size != TT * D || ws_size < WS_END) { fprintf(stderr, "kernel_launch: unexpected shapes (n_in %d out %d ws %zu)\n", n_in, out_size, ws_size); grid = -1; return; }
        int dev = 0, cus = 0, per_cu = 0;
        hipGetDevice(&dev); hipDeviceGetAttribute(&cus, hipDeviceAttributeMultiprocessorCount, dev);
        hipFuncSetAttribute((const void*)fwd_megakernel, hipFuncAttributeMaxDynamicSharedMemorySize, LDS_BYTES);
        hipOccupancyMaxActiveBlocksPerMultiprocessor(&per_cu, (const void*)fwd_megakernel, NTHREADS, LDS_BYTES);
        if (per_cu < 1) { fprintf(stderr, "kernel_launch: occupancy query says %d blocks per CU\n", per_cu); per_cu = 1; }
        (void)hipGetLastError();
        grid = cus;
    }
    if (grid < 0) return;
    if (hipMemsetAsync((char*)d_ws + WS_CTL, 0, XCD_BAR_WORDS * 4, stream) != hipSuccess) { fprintf(stderr, "kernel_launch: memset failed\n"); return; }
    Params p{};
    for (int i = 0; i < 26; ++i) p.in[i] = (const float*)d_in[i];
    p.out = (float*)d_out; p.ws = (unsigned char*)d_ws;
    for (int i = 0; i < 32; ++i) p.inv_h[i] = (float)std::pow(10000.0, -(double)(2 * i) / 64.0);
    for (int i = 0; i < 16; ++i) p.inv_r[i] = (float)std::pow(10000.0, -(double)(2 * i) / 32.0);
    void* args[] = {&p};
    hipError_t e = hipLaunchCooperativeKernel((const void*)fwd_megakernel, dim3(grid), dim3(NTHREADS), args, LDS_BYTES, stream);
    if (e != hipSuccess) fprintf(stderr, "cooperative launch failed: %s (grid %d)\n", hipGetErrorString(e), grid);
}
```
